# Optimizing an MI355X kernel written in HIP

```python
import math
import jax, jax.numpy as jnp
from jax import lax
import numpy as np

D_MODEL = 1024
BATCH = 16
SEQ = 4096
DEPTH = 1
DEC_BATCH = 32
DEC_SEQ = 64
PAST_LEN = 2048

CHUNK = 64
MIX_WIDTH = 2 * D_MODEL
HEAD_DIM = 64
N_Q_HEADS = 8
N_KV_HEADS = 2
GQA = N_Q_HEADS // N_KV_HEADS
ATTN_WIDTH = N_Q_HEADS * HEAD_DIM
KV_WIDTH = N_KV_HEADS * HEAD_DIM
WINDOW = 128
WIN_CHUNKS = WINDOW // CHUNK
ROPE_THETA = 10000.0
SSD_WIDTH = D_MODEL
SSD_HEAD_DIM = 64
SSD_HEADS = SSD_WIDTH // SSD_HEAD_DIM
SSD_GROUPS = 2
SSD_HPG = SSD_HEADS // SSD_GROUPS
SSD_STATE = 128
CONV_WIDTH = 4
CONV_CH = SSD_WIDTH + 2 * SSD_GROUPS * SSD_STATE
MEM_TOKENS = 256
MEM_HEADS = 4
MEM_HEAD_DIM = 128
MEM_WIDTH = MEM_HEADS * MEM_HEAD_DIM
EPS = 1e-6
IN_SIZES = (ATTN_WIDTH, KV_WIDTH, KV_WIDTH, ATTN_WIDTH, SSD_WIDTH, CONV_CH, SSD_HEADS, MEM_WIDTH, MEM_WIDTH)
IN_COLS = ATTN_WIDTH + 2 * KV_WIDTH + ATTN_WIDTH + SSD_WIDTH + CONV_CH + SSD_HEADS + 2 * MEM_WIDTH

kernel_name = "hymba_swa_ssd_memory_stream_step"


def split_cols(a, sizes):
    out, start = [], 0
    for s in sizes:
        out.append(a[..., start:start + s])
        start += s
    return out


def rmsnorm(x, g):
    xf = x.astype(jnp.float32)
    y = xf * lax.rsqrt(jnp.mean(xf * xf, axis=-1, keepdims=True) + EPS)
    return (y * g.astype(jnp.float32)).astype(x.dtype)


def rope(x, positions):
    half = x.shape[-1] // 2
    freqs = ROPE_THETA ** (-jnp.arange(half, dtype=jnp.float32) / half)
    ang = positions.astype(jnp.float32)[:, None] * freqs[None, :]
    cos = jnp.cos(ang)[:, None, :]
    sin = jnp.sin(ang)[:, None, :]
    x1 = x[..., :half].astype(jnp.float32)
    x2 = x[..., half:].astype(jnp.float32)
    return jnp.concatenate([x1 * cos - x2 * sin, x2 * cos + x1 * sin], axis=-1).astype(x.dtype)


def sink_softmax(s, sinks):
    sink = sinks.astype(jnp.float32).reshape(N_KV_HEADS, GQA, 1, 1)
    m = jnp.maximum(jnp.max(s, axis=-1, keepdims=True), sink)
    e = jnp.exp(s - m)
    return e / (jnp.sum(e, axis=-1, keepdims=True) + jnp.exp(sink - m))


def window_attn_prompt(q, k, v, sinks):
    b, t = q.shape[:2]
    nc = t // CHUNK
    qc = q.reshape(b, nc, CHUNK, N_KV_HEADS, GQA, HEAD_DIM)
    kc = k.reshape(b, nc, CHUNK, N_KV_HEADS, HEAD_DIM)
    vc = v.reshape(b, nc, CHUNK, N_KV_HEADS, HEAD_DIM)
    pad = ((0, 0), (WIN_CHUNKS, 0), (0, 0), (0, 0), (0, 0))
    kp = jnp.pad(kc, pad)
    vp = jnp.pad(vc, pad)
    kb = jnp.concatenate([kp[:, j:j + nc] for j in range(WIN_CHUNKS + 1)], axis=2)
    vb = jnp.concatenate([vp[:, j:j + nc] for j in range(WIN_CHUNKS + 1)], axis=2)
    chunk_idx = jnp.arange(nc)[:, None] - WIN_CHUNKS + jnp.arange(WIN_CHUNKS + 1)[None, :]
    valid = jnp.repeat(chunk_idx >= 0, CHUNK, axis=1)
    s = jnp.einsum('bcqhgd,bckhd->bchgqk', qc, kb, preferred_element_type=jnp.float32) / math.sqrt(HEAD_DIM)
    s = jnp.where(valid[None, :, None, None, None, :], s, -jnp.inf)
    p = sink_softmax(s, sinks)
    out = jnp.einsum('bchgqk,bckhd->bcqhgd', p.astype(v.dtype), vb)
    return out.reshape(b, t, ATTN_WIDTH)


def window_attn_sample(q, k_all, v_all, sinks):
    b, t = q.shape[:2]
    qg = q.reshape(b, t, N_KV_HEADS, GQA, HEAD_DIM)
    s = jnp.einsum('bqhgd,bkhd->bhgqk', qg, k_all, preferred_element_type=jnp.float32) / math.sqrt(HEAD_DIM)
    p = sink_softmax(s, sinks)
    out = jnp.einsum('bhgqk,bkhd->bqhgd', p.astype(v_all.dtype), v_all)
    return out.reshape(b, t, ATTN_WIDTH)


def causal_conv(xbc, conv_init, w, bias):
    t = xbc.shape[1]
    xp = jnp.concatenate([conv_init.astype(xbc.dtype), xbc], axis=1)
    out = bias
    for j in range(CONV_WIDTH):
        out = out + xp[:, j:j + t] * w[j]
    return jax.nn.silu(out), xp[:, -(CONV_WIDTH - 1):]


def ssd_scan(x, dt, a, bm, cm, init_state, chunk):
    b, t = x.shape[:2]
    nc = t // chunk
    f32 = jnp.float32
    xc = x.reshape(b, nc, chunk, SSD_GROUPS, SSD_HPG, SSD_HEAD_DIM).astype(f32)
    dtc = dt.reshape(b, nc, chunk, SSD_GROUPS, SSD_HPG)
    bc = bm.reshape(b, nc, chunk, SSD_GROUPS, SSD_STATE).astype(f32)
    cc = cm.reshape(b, nc, chunk, SSD_GROUPS, SSD_STATE).astype(f32)
    acum = jnp.cumsum(dtc * a.reshape(SSD_GROUPS, SSD_HPG), axis=2)
    diff = acum[:, :, :, None] - acum[:, :, None, :]
    causal = jnp.tril(jnp.ones((chunk, chunk), bool))[:, :, None, None]
    decay = jnp.exp(jnp.where(causal, diff, -jnp.inf))
    cb = jnp.einsum('bclgn,bcsgn->bclsg', cc, bc)
    w_ls = cb[..., None] * decay * dtc[:, :, None]
    y_diag = jnp.einsum('bclsgr,bcsgrp->bclgrp', w_ls, xc)
    decay_to_end = jnp.exp(acum[:, :, -1:] - acum) * dtc
    states = jnp.einsum('bclgn,bclgr,bclgrp->bcgrpn', bc, decay_to_end, xc)
    chunk_decay = jnp.exp(acum[:, :, -1])

    def step(s, inp):
        st, dec = inp
        return s * dec[..., None, None] + st, s

    init = init_state.reshape(b, SSD_GROUPS, SSD_HPG, SSD_HEAD_DIM, SSD_STATE).astype(f32)
    final, s_in = lax.scan(step, init, (jnp.moveaxis(states, 1, 0), jnp.moveaxis(chunk_decay, 1, 0)))
    s_in = jnp.moveaxis(s_in, 0, 1)
    y_off = jnp.einsum('bclgn,bcgrpn->bclgrp', cc, s_in) * jnp.exp(acum)[..., None]
    y = (y_diag + y_off).reshape(b, t, SSD_HEADS, SSD_HEAD_DIM)
    return y, final.reshape(b, SSD_HEADS, SSD_HEAD_DIM, SSD_STATE)


def memory_kv(mem, g_mem, w_mem_k, w_mem_v, g_mk):
    b = mem.shape[0]
    h = rmsnorm(mem, g_mem)
    k = rmsnorm((h @ w_mem_k).reshape(b, MEM_TOKENS, MEM_HEADS, MEM_HEAD_DIM), g_mk)
    v = (h @ w_mem_v).reshape(b, MEM_TOKENS, MEM_HEADS, MEM_HEAD_DIM)
    return k, v


def memory_attn(q, mk, mv):
    s = jnp.einsum('bqhd,bkhd->bhqk', q, mk, preferred_element_type=jnp.float32) / math.sqrt(MEM_HEAD_DIM)
    p = jax.nn.softmax(s, axis=-1)
    return jnp.einsum('bhqk,bkhd->bqhd', p.astype(mv.dtype), mv)


def parallel_layer(x, positions, win_k_past, win_v_past, ssm_init, conv_init, mem_k, mem_v, scan_chunk,
                   g_norm, w_in, g_q, g_k, sinks, conv_w, conv_b, dt_bias, a_log, d_skip, g_ssd, g_mq, w_out):
    b, t, _ = x.shape
    h = rmsnorm(x, g_norm)
    q, k, v, gate_a, z, xbc, dt_raw, mq, gate_m = split_cols(h @ w_in, IN_SIZES)

    q = rope(rmsnorm(q.reshape(b, t, N_Q_HEADS, HEAD_DIM), g_q), positions)
    k = rope(rmsnorm(k.reshape(b, t, N_KV_HEADS, HEAD_DIM), g_k), positions)
    v = v.reshape(b, t, N_KV_HEADS, HEAD_DIM)
    if win_k_past is None:
        a_out = window_attn_prompt(q, k, v, sinks)
        k_all, v_all = k, v
    else:
        k_all = jnp.concatenate([win_k_past.astype(k.dtype), k], axis=1)
        v_all = jnp.concatenate([win_v_past.astype(v.dtype), v], axis=1)
        a_out = window_attn_sample(q, k_all, v_all, sinks)
    new_k = k_all[:, -WINDOW:]
    new_v = v_all[:, -WINDOW:]
    a_out = a_out * jax.nn.silu(gate_a)

    xbc, conv_state = causal_conv(xbc, conv_init, conv_w, conv_b)
    xs, bm, cm = split_cols(xbc, (SSD_WIDTH, SSD_GROUPS * SSD_STATE, SSD_GROUPS * SSD_STATE))
    dt = jax.nn.softplus(dt_raw.astype(jnp.float32) + dt_bias.astype(jnp.float32))
    a = -jnp.exp(a_log.astype(jnp.float32))
    xs = xs.reshape(b, t, SSD_HEADS, SSD_HEAD_DIM)
    y, ssm_final = ssd_scan(xs, dt, a, bm.reshape(b, t, SSD_GROUPS, SSD_STATE),
                            cm.reshape(b, t, SSD_GROUPS, SSD_STATE), ssm_init, scan_chunk)
    y = y + d_skip.astype(jnp.float32)[:, None] * xs.astype(jnp.float32)
    s_out = rmsnorm(y.reshape(b, t, SSD_WIDTH) * jax.nn.silu(z.astype(jnp.float32)), g_ssd).astype(x.dtype)

    mq = rmsnorm(mq.reshape(b, t, MEM_HEADS, MEM_HEAD_DIM), g_mq)
    m_out = memory_attn(mq, mem_k.astype(mq.dtype), mem_v.astype(mq.dtype)).reshape(b, t, MEM_WIDTH)
    m_out = m_out * jax.nn.silu(gate_m)

    y_out = x + jnp.concatenate([a_out, s_out, m_out], axis=-1) @ w_out
    return y_out, new_k, new_v, ssm_final.astype(ssm_init.dtype), conv_state


def setup_inputs(seed: int = 0) -> dict:
    key = jax.random.key(seed)
    ks = jax.random.split(key, 32)
    f32 = jnp.float32

    def nrm(k, shape, scale=1.0):
        return jax.random.normal(k, shape, f32) * scale

    dt0 = jnp.exp(jax.random.uniform(ks[16], (DEPTH, SSD_HEADS), f32, math.log(1e-3), math.log(1e-1)))
    return {
        "x_prompt": nrm(ks[0], (BATCH, SEQ, D_MODEL)),
        "x_sample": nrm(ks[1], (DEC_BATCH, DEC_SEQ, D_MODEL)),
        "cache_win_k": nrm(ks[2], (DEPTH, DEC_BATCH, WINDOW, N_KV_HEADS, HEAD_DIM)),
        "cache_win_v": nrm(ks[3], (DEPTH, DEC_BATCH, WINDOW, N_KV_HEADS, HEAD_DIM)),
        "state_ssm": nrm(ks[4], (DEPTH, DEC_BATCH, SSD_HEADS, SSD_HEAD_DIM, SSD_STATE), 0.1),
        "state_conv": nrm(ks[5], (DEPTH, DEC_BATCH, CONV_WIDTH - 1, CONV_CH)),
        "cache_mem_k": nrm(ks[6], (DEPTH, DEC_BATCH, MEM_TOKENS, MEM_HEADS, MEM_HEAD_DIM)),
        "cache_mem_v": nrm(ks[7], (DEPTH, DEC_BATCH, MEM_TOKENS, MEM_HEADS, MEM_HEAD_DIM)),
        "mem_prompt": nrm(ks[8], (BATCH, MEM_TOKENS, D_MODEL)),
        "g_norm": 1.0 + nrm(ks[9], (DEPTH, D_MODEL), 0.01),
        "w_in": nrm(ks[10], (DEPTH, D_MODEL, IN_COLS), D_MODEL ** -0.5),
        "g_q": 1.0 + nrm(ks[11], (DEPTH, HEAD_DIM), 0.01),
        "g_k": 1.0 + nrm(ks[12], (DEPTH, HEAD_DIM), 0.01),
        "sinks": nrm(ks[13], (DEPTH, N_Q_HEADS), 0.5),
        "conv_w": nrm(ks[14], (DEPTH, CONV_WIDTH, CONV_CH), CONV_WIDTH ** -0.5),
        "conv_b": nrm(ks[15], (DEPTH, CONV_CH), 0.01),
        "dt_bias": dt0 + jnp.log(-jnp.expm1(-dt0)),
        "a_log": jnp.log(jax.random.uniform(ks[17], (DEPTH, SSD_HEADS), f32, 1.0, 16.0)),
        "d_skip": 1.0 + nrm(ks[18], (DEPTH, SSD_HEADS), 0.01),
        "g_ssd": 1.0 + nrm(ks[19], (DEPTH, SSD_WIDTH), 0.01),
        "g_mem": 1.0 + nrm(ks[20], (DEPTH, D_MODEL), 0.01),
        "w_mem_k": nrm(ks[21], (DEPTH, D_MODEL, MEM_WIDTH), D_MODEL ** -0.5),
        "w_mem_v": nrm(ks[22], (DEPTH, D_MODEL, MEM_WIDTH), D_MODEL ** -0.5),
        "g_mk": 1.0 + nrm(ks[23], (DEPTH, MEM_HEAD_DIM), 0.01),
        "g_mq": 1.0 + nrm(ks[24], (DEPTH, MEM_HEAD_DIM), 0.01),
        "w_out": nrm(ks[25], (DEPTH, MIX_WIDTH, D_MODEL), MIX_WIDTH ** -0.5),
    }


def reference(x_prompt, x_sample, cache_win_k, cache_win_v, state_ssm, state_conv, cache_mem_k, cache_mem_v,
              mem_prompt, g_norm, w_in, g_q, g_k, sinks, conv_w, conv_b, dt_bias, a_log, d_skip, g_ssd,
              g_mem, w_mem_k, w_mem_v, g_mk, g_mq, w_out):
    bp, t_p = x_prompt.shape[:2]
    t_s = x_sample.shape[1]
    pos_p = jnp.arange(t_p, dtype=jnp.int32)
    pos_s = PAST_LEN + jnp.arange(t_s, dtype=jnp.int32)
    xp, xs = x_prompt, x_sample
    wk_p, wv_p, ssm_p, conv_p, mk_p_l, mv_p_l = [], [], [], [], [], []
    wk_s, wv_s, ssm_s, conv_s = [], [], [], []
    for l in range(DEPTH):
        mk_p, mv_p = memory_kv(mem_prompt, g_mem[l], w_mem_k[l], w_mem_v[l], g_mk[l])
        lw = (g_norm[l], w_in[l], g_q[l], g_k[l], sinks[l], conv_w[l], conv_b[l], dt_bias[l], a_log[l],
              d_skip[l], g_ssd[l], g_mq[l], w_out[l])
        zeros_ssm = jnp.zeros((bp, SSD_HEADS, SSD_HEAD_DIM, SSD_STATE), x_prompt.dtype)
        zeros_conv = jnp.zeros((bp, CONV_WIDTH - 1, CONV_CH), x_prompt.dtype)
        xp, kp, vp, sp, cp = parallel_layer(xp, pos_p, None, None, zeros_ssm, zeros_conv, mk_p, mv_p, CHUNK, *lw)
        xs, ks_, vs_, ss_, cs_ = parallel_layer(xs, pos_s, cache_win_k[l], cache_win_v[l], state_ssm[l],
                                                state_conv[l], cache_mem_k[l], cache_mem_v[l], t_s, *lw)
        wk_p.append(kp); wv_p.append(vp); ssm_p.append(sp); conv_p.append(cp)
        mk_p_l.append(mk_p); mv_p_l.append(mv_p)
        wk_s.append(ks_); wv_s.append(vs_); ssm_s.append(ss_); conv_s.append(cs_)
    return (xp, xs,
            jnp.stack(wk_p), jnp.stack(wv_p), jnp.stack(ssm_p), jnp.stack(conv_p),
            jnp.stack(mk_p_l), jnp.stack(mv_p_l),
            jnp.stack(wk_s), jnp.stack(wv_s), jnp.stack(ssm_s), jnp.stack(conv_s))
```

```cpp
#include <hip/hip_runtime.h>
#include <hip/hip_cooperative_groups.h>
#include <cstdio>
#include <cstdint>
namespace cg = cooperative_groups;
namespace pg8 {
#define PG8_LAS __attribute__((address_space(3)))
typedef unsigned short bf16_t;
typedef short bf16x8 __attribute__((ext_vector_type(8)));
typedef float f32x4 __attribute__((ext_vector_type(4)));
typedef unsigned u32x4 __attribute__((ext_vector_type(4)));
constexpr int BM = 256, BK = 64, HALF = 128, HTB = HALF * BK * 2  , STAGE_BYTES = 8 * HTB, NXCD = 8, WGM = 8;

__host__ __device__ __forceinline__ int lds_byte(int r, int c) { const int st = (r >> 4) * 2 + (c >> 5), rr = r & 15, cc = c & 31, ob = rr * 64 + cc * 2; return st * 1024 + (ob ^ (((ob >> 9) & 1) << 5)); }
__host__ __device__ __forceinline__ void stage_rc(int b, int& R, int& C) { const int st = b / 1024, sb = b % 1024, swz = sb ^ (((sb >> 9) & 1) << 5); R = (st >> 1) * 16 + swz / 64; C = (st & 1) * 32 + (swz % 64) / 2; }
__host__ __device__ __forceinline__ int perm32(int rho) { const int n = rho >> 4, i = rho & 15; return 8 * (i >> 2) + 4 * n + (i & 3); }

struct Unit { int pm, pn; };
struct Gemm { const bf16_t* A; const bf16_t* Bt; int M, N, K; };

struct StaticOrder {
    int nM, nN, nwg, G, c;
    __host__ __device__ void init(int M, int N, int G_, int c_) { nM = M / BM; nN = N / BM; nwg = nM * nN; G = G_; c = c_; }
    __host__ __device__ bool next(int i, Unit& u) const {
        const long L = (long)i * G + c; if (L >= nwg) return false;
        int wgid = (int)L; { const int q = nwg / NXCD, r = nwg % NXCD, xcd = wgid % NXCD, off = wgid / NXCD; wgid = (xcd < r ? xcd * (q + 1) : r * (q + 1) + (xcd - r) * q) + off; }
        const int nig = WGM * nN, gid = wgid / nig, fm = gid * WGM, gsz = (nM - fm) < WGM ? (nM - fm) : WGM;
        u.pm = fm + ((wgid % nig) % gsz); u.pn = (wgid % nig) / gsz; return true;
    }
    __device__ __forceinline__ void a_ready(const Unit&) const {}
    __device__ __forceinline__ void done(const Unit&) const {}
};

template <class Epi, class Sched, bool ALIGN_EPI = false, bool SP2 = false>
__device__ __forceinline__ void gemm_phase(PG8_LAS unsigned char* lds, const Gemm g, const Sched& S, const Epi& E) {
    int tid_ = threadIdx.x; asm volatile("" : "+v"(tid_));
    const int tid = tid_, wid = __builtin_amdgcn_readfirstlane(tid >> 6), lane = tid & 63, wr = wid >> 2, wc = wid & 3, fr = lane & 15, fq = lane >> 4;
    const int K = g.K, nt = K / BK;
    unsigned voffA[2], voffB[2];
#pragma unroll
    for (int i = 0; i < 2; ++i) { int R, C; stage_rc(tid * 16 + i * 8192, R, C); const int Rb = Epi::PERM ? ((R & ~31) + perm32(R & 31)) : R;
        voffA[i] = (unsigned)(R * K + C) * 2u; voffB[i] = (unsigned)(Rb * K + C) * 2u; }
    const size_t kstep = (size_t)(BK * 2);
    const size_t hstep = (size_t)HALF * K * 2;
    const size_t tstep = 2 * hstep;
    const unsigned ldsw = (unsigned)wid * 1024u;
    const int aoff = lds_byte(wr * 64 + fr, fq * 8), boff = lds_byte(wc * 32 + fr, fq * 8);
#define PG8_SA(b, h) (((b) * 2 + (h)) * HTB)
#define PG8_SB(b, h) ((4 + (b) * 2 + (h)) * HTB)
#define PG8_STAGE(bufoff, gbase, voff) do { _Pragma("unroll") for (int _i = 0; _i < 2; ++_i) \
        __builtin_amdgcn_global_load_lds((const unsigned*)((const char*)(gbase) + (voff)[_i]), (PG8_LAS unsigned*)(lds + (bufoff) + ldsw + _i * 8192), 16, 0, 0); } while (0)
#define PG8_LDA(dst, b, h) do { _Pragma("unroll") for (int m = 0; m < 4; ++m) _Pragma("unroll") for (int k = 0; k < 2; ++k) dst[m][k] = *(const PG8_LAS bf16x8*)(lds + PG8_SA(b, h) + aoff + m * 2048 + k * 1024); } while (0)
#define PG8_LDB(dst, b, h) do { _Pragma("unroll") for (int n = 0; n < 2; ++n) _Pragma("unroll") for (int k = 0; k < 2; ++k) dst[n][k] = *(const PG8_LAS bf16x8*)(lds + PG8_SB(b, h) + boff + n * 2048 + k * 1024); } while (0)
#define PG8_MMA(ai, bj, At, Bt) do { __builtin_amdgcn_s_setprio(1); _Pragma("unroll") for (int m = 0; m < 4; ++m) _Pragma("unroll") for (int n = 0; n < 2; ++n) _Pragma("unroll") for (int k = 0; k < 2; ++k) \
        acc[ai][bj][m][n] = __builtin_amdgcn_mfma_f32_16x16x32_bf16(Bt[n][k], At[m][k], acc[ai][bj][m][n], 0, 0, 0); __builtin_amdgcn_s_setprio(0); } while (0)
#define PG8_WAIT_V(n) asm volatile("s_waitcnt vmcnt(" #n ")" ::: "memory")
#define PG8_WAIT_L(n) asm volatile("s_waitcnt lgkmcnt(" #n ")" ::: "memory")
#define PG8_BAR __builtin_amdgcn_s_barrier()
#define PG8_SCHED __builtin_amdgcn_sched_barrier(0)
    Unit cur, nxt; int ui = 0;
    if (!S.next(0, cur)) return;
    f32x4 acc[2][2][4][2];
#pragma unroll
    for (int a = 0; a < 2; ++a)
#pragma unroll
        for (int b = 0; b < 2; ++b)
#pragma unroll
            for (int m = 0; m < 4; ++m)
#pragma unroll
                for (int n = 0; n < 2; ++n) acc[a][b][m][n] = (f32x4){0.f, 0.f, 0.f, 0.f};
    bf16x8 At[4][2], B0[2][2], B1[2][2];
    const char* cA = (const char*)g.A + (size_t)cur.pm * tstep; const char* cB = (const char*)g.Bt + (size_t)cur.pn * tstep;
    S.a_ready(cur);
    if constexpr (SP2) {
        PG8_STAGE(PG8_SB(0, 0), cB, voffB); PG8_STAGE(PG8_SB(0, 1), cB + hstep, voffB); PG8_STAGE(PG8_SA(0, 0), cA, voffA); PG8_STAGE(PG8_SA(0, 1), cA + hstep, voffA);
        if (wr == 1) PG8_BAR;
        PG8_WAIT_V(2); PG8_BAR;
        PG8_STAGE(PG8_SB(1, 0), cB + kstep, voffB); PG8_STAGE(PG8_SA(1, 0), cA + kstep, voffA); PG8_STAGE(PG8_SB(1, 1), cB + hstep + kstep, voffB);
        PG8_WAIT_V(6); PG8_BAR;
    } else {
        PG8_STAGE(PG8_SB(0, 0), cB, voffB); PG8_STAGE(PG8_SA(0, 0), cA, voffA); PG8_STAGE(PG8_SB(0, 1), cB + hstep, voffB); PG8_STAGE(PG8_SA(0, 1), cA + hstep, voffA);
        if (wr == 1) PG8_BAR;
        PG8_WAIT_V(4); PG8_BAR;
        PG8_STAGE(PG8_SB(1, 0), cB + kstep, voffB); PG8_STAGE(PG8_SA(1, 0), cA + kstep, voffA); PG8_STAGE(PG8_SB(1, 1), cB + hstep + kstep, voffB);
        PG8_WAIT_V(6); PG8_BAR;
    }
    for (;;) {
        const bool has_next = S.next(ui + 1, nxt);
        const char* nA = has_next ? (const char*)g.A + (size_t)nxt.pm * tstep : cA; const char* nB = has_next ? (const char*)g.Bt + (size_t)nxt.pn * tstep : cB;
        for (int t = 0; t < nt; t += 2) {
            const bool last = (t == nt - 2);
            const char* a1 = cA + (size_t)(t + 1) * kstep;
            const char* a2 = last ? nA : cA + (size_t)(t + 2) * kstep; const char* b2 = last ? nB : cB + (size_t)(t + 2) * kstep;
            const char* a3 = a2 + kstep; const char* b3 = b2 + kstep;
            if (last && has_next) S.a_ready(nxt);
            if constexpr (Epi::MIDK > 0) { if (t == Epi::MIDK) E.mid(acc, cur, wr, wc, fr, fq); }
            if constexpr (SP2) {
            PG8_LDB(B0, 0, 0); PG8_LDB(B1, 0, 1); PG8_SCHED; PG8_LDA(At, 0, 0); PG8_STAGE(PG8_SA(1, 1), a1 + hstep, voffA);
            PG8_WAIT_V(8); PG8_WAIT_L(0); PG8_BAR; PG8_MMA(0, 0, At, B0); PG8_MMA(0, 1, At, B1); PG8_BAR; PG8_SCHED;
            PG8_LDA(At, 0, 1); PG8_STAGE(PG8_SB(0, 0), b2, voffB); PG8_STAGE(PG8_SB(0, 1), b2 + hstep, voffB); PG8_STAGE(PG8_SA(0, 0), a2, voffA);
            PG8_WAIT_V(8); PG8_WAIT_L(0); PG8_BAR; PG8_MMA(1, 0, At, B0); PG8_MMA(1, 1, At, B1); PG8_BAR; PG8_SCHED;
            PG8_LDB(B0, 1, 0); PG8_LDB(B1, 1, 1); PG8_SCHED; PG8_LDA(At, 1, 0); PG8_STAGE(PG8_SA(0, 1), a2 + hstep, voffA);
            PG8_WAIT_V(8); PG8_WAIT_L(0); PG8_BAR; PG8_MMA(0, 0, At, B0); PG8_MMA(0, 1, At, B1); PG8_BAR; PG8_SCHED;
            PG8_LDA(At, 1, 1); PG8_STAGE(PG8_SB(1, 0), b3, voffB); PG8_STAGE(PG8_SB(1, 1), b3 + hstep, voffB); PG8_STAGE(PG8_SA(1, 0), a3, voffA);
            PG8_WAIT_V(8); PG8_WAIT_L(0); PG8_BAR; PG8_MMA(1, 0, At, B0); PG8_MMA(1, 1, At, B1); PG8_BAR; PG8_SCHED;
            } else {
            PG8_LDB(B0, 0, 0); PG8_SCHED; PG8_LDA(At, 0, 0); PG8_STAGE(PG8_SA(1, 1), a1 + hstep, voffA);
            PG8_WAIT_L(8); PG8_BAR; PG8_WAIT_L(0); PG8_MMA(0, 0, At, B0); PG8_BAR; PG8_SCHED;
            PG8_LDB(B1, 0, 1); PG8_STAGE(PG8_SB(0, 0), b2, voffB);
            PG8_BAR; PG8_WAIT_L(0); PG8_MMA(0, 1, At, B1); PG8_BAR;
            PG8_LDA(At, 0, 1); PG8_STAGE(PG8_SA(0, 0), a2, voffA);
            PG8_BAR; PG8_WAIT_L(0); PG8_MMA(1, 0, At, B0); PG8_BAR; PG8_SCHED;
            PG8_STAGE(PG8_SB(0, 1), b2 + hstep, voffB);
            PG8_WAIT_V(6); PG8_BAR; PG8_MMA(1, 1, At, B1); PG8_BAR;
            PG8_LDB(B0, 1, 0); PG8_SCHED; PG8_LDA(At, 1, 0); PG8_STAGE(PG8_SA(0, 1), a2 + hstep, voffA);
            PG8_WAIT_L(8); PG8_BAR; PG8_WAIT_L(0); PG8_MMA(0, 0, At, B0); PG8_BAR; PG8_SCHED;
            PG8_LDB(B1, 1, 1); PG8_STAGE(PG8_SB(1, 0), b3, voffB);
            PG8_BAR; PG8_WAIT_L(0); PG8_MMA(0, 1, At, B1); PG8_BAR;
            PG8_LDA(At, 1, 1); PG8_STAGE(PG8_SA(1, 0), a3, voffA);
            PG8_BAR; PG8_WAIT_L(0); PG8_MMA(1, 0, At, B0); PG8_BAR; PG8_SCHED;
            PG8_STAGE(PG8_SB(1, 1), b3 + hstep, voffB);
            PG8_WAIT_V(6); PG8_BAR; PG8_MMA(1, 1, At, B1); PG8_BAR;
            }
        }
        if constexpr (ALIGN_EPI) { if (wr == 0) PG8_BAR; }
        if constexpr (!Epi::AFTER_DRAIN) { E(acc, cur, wr, wc, fr, fq); S.done(cur); }
        if (!has_next) break;
#pragma unroll
        for (int a = 0; a < 2; ++a)
#pragma unroll
            for (int b = 0; b < 2; ++b)
#pragma unroll
                for (int m = 0; m < 4; ++m)
#pragma unroll
                    for (int n = 0; n < 2; ++n) acc[a][b][m][n] = (f32x4){0.f, 0.f, 0.f, 0.f};
        cur = nxt; cA = nA; cB = nB; ++ui;
        if constexpr (ALIGN_EPI) { if (wr == 1) PG8_BAR; }
    }
    PG8_WAIT_V(0);
    if constexpr (!ALIGN_EPI) { if (wr == 0) PG8_BAR; }
    PG8_BAR;
    if constexpr (Epi::AFTER_DRAIN) { E.fused(acc, cur, wr, wc, fr, fq, lds, wid, lane); S.done(cur); }
#undef PG8_SA
#undef PG8_SB
#undef PG8_STAGE
#undef PG8_LDA
#undef PG8_LDB
#undef PG8_MMA
#undef PG8_WAIT_V
#undef PG8_WAIT_L
#undef PG8_BAR
#undef PG8_SCHED
}
}
#ifndef DBG_SCALE3
#define DBG_SCALE3 0
#endif
#ifndef DBG_ZERO
#define DBG_ZERO 0
#endif
#ifndef LAST_PHASE
#define LAST_PHASE 4
#endif
#ifndef REP_P0
#define REP_P0 1
#endif
#ifndef REP_P1
#define REP_P1 1
#endif
#ifndef REP_P2A
#define REP_P2A 1
#endif
#ifndef REP_P0T
#define REP_P0T 1
#endif
#ifndef REP_P0R
#define REP_P0R 1
#endif
#ifndef REP_S2
#define REP_S2 1
#endif
#ifndef REP_S3
#define REP_S3 1
#endif
#ifndef REP_S4
#define REP_S4 1
#endif
#ifndef REP_ATOM
#define REP_ATOM 1
#endif
#ifndef REP_SSD
#define REP_SSD 1
#endif
#ifndef REP_WIN
#define REP_WIN 1
#endif
#ifndef REP_MEM
#define REP_MEM 1
#endif
#ifndef REP_P3
#define REP_P3 1
#endif
#define DI __device__ __forceinline__
#define LAS __attribute__((address_space(3)))
typedef unsigned short bf16_t;
typedef short bf16x8 __attribute__((ext_vector_type(8)));
typedef float f32x4 __attribute__((ext_vector_type(4)));
typedef float f32x2 __attribute__((ext_vector_type(2)));
typedef unsigned u32x4 __attribute__((ext_vector_type(4)));
typedef unsigned u32x2 __attribute__((ext_vector_type(2)));

constexpr int NB_P = 16, T_P = 4096, NB_S = 32, T_S = 64, DM = 1024;
constexpr int MP = NB_P * T_P, MS = NB_S * T_S, MTOT = MP + MS;
constexpr int MMEM = NB_P * 256, MA = MTOT + MMEM;
constexpr int NPROJ = 4864, NBT = NPROJ + 1024, INC = 4880;
constexpr int C_Q = 0, C_K = 512, C_V = 640, C_GA = 768, C_Z = 1280, C_XBC = 2304, C_MQ = 3840, C_GM = 4352;
constexpr int NCHUNK = MTOT / 64;
constexpr float EPSF = 1e-6f;
constexpr size_t O_Y = 0;
constexpr size_t O_WKP = (size_t)MTOT * 1024;
constexpr size_t O_WVP = O_WKP + (size_t)NB_P * 128 * 128;
constexpr size_t O_SSMP = O_WVP + (size_t)NB_P * 128 * 128;
constexpr size_t O_CONVP = O_SSMP + (size_t)NB_P * 16 * 64 * 128;
constexpr size_t O_MKP = O_CONVP + (size_t)NB_P * 3 * 1536;
constexpr size_t O_MVP = O_MKP + (size_t)NB_P * 256 * 512;
constexpr size_t O_WKS = O_MVP + (size_t)NB_P * 256 * 512;
constexpr size_t O_WVS = O_WKS + (size_t)NB_S * 128 * 128;
constexpr size_t O_SSMS = O_WVS + (size_t)NB_S * 128 * 128;
constexpr size_t O_CONVS = O_SSMS + (size_t)NB_S * 16 * 64 * 128;
constexpr size_t O_END = O_CONVS + (size_t)NB_S * 3 * 1536;
static_assert(O_END == 81485824, "output size");
constexpr size_t MiB = 1u << 20;
constexpr size_t WS_ROPE = 1 * MiB;
constexpr size_t WS_BT = 2 * MiB;
constexpr size_t WS_WOUT = 14 * MiB;
constexpr size_t WS_DT = 18 * MiB;
constexpr size_t WS_SSQ = 23 * MiB;
constexpr size_t WS_CTL = 0, CTL_ZERO_BYTES = 65536;
constexpr size_t WS_MEMRAW = 32 * MiB;
constexpr size_t WS_MEMK = 40 * MiB;
constexpr size_t WS_MEMVT = 52 * MiB;
constexpr size_t WS_PROJ = 64 * MiB;
constexpr size_t WS_A = 692 * MiB;
constexpr size_t WS_MIX = 692 * MiB;
constexpr size_t WS_BCC = 956 * MiB;
constexpr size_t WS_END = 1022 * MiB;
static_assert(WS_BT + (size_t)NBT * 1024 * 2 <= WS_WOUT && WS_DT + (size_t)MTOT * 64 <= WS_SSQ && WS_SSQ + (size_t)MTOT * 128 <= WS_MEMRAW, "ws map 1");
static_assert(WS_PROJ + (size_t)MTOT * NPROJ * 2 <= WS_A && WS_A + (size_t)MA * 1024 * 2 <= WS_END && WS_MIX + (size_t)MTOT * 2048 * 2 <= WS_BCC && WS_BCC + (size_t)MTOT * 512 * 2 <= WS_END, "ws map 2");
constexpr int LDS_BYTES = 147456;

DI float bf2f(unsigned short b) { return __uint_as_float((unsigned)b << 16); }
typedef __bf16 hbf2 __attribute__((ext_vector_type(2)));
DI unsigned short f2bf(float f) { return __builtin_bit_cast(unsigned short, (__bf16)f); }
DI unsigned pk2(float lo, float hi) { const f32x2 v = {lo, hi}; return __builtin_bit_cast(unsigned, __builtin_convertvector(v, hbf2)); }
DI unsigned cvt_pk_bf16(float lo, float hi) { return pk2(lo, hi); }
DI float siluf(float x) { return x * __builtin_amdgcn_rcpf(1.0f + __expf(-x)); }
DI float wave_sum(float v) {
#pragma unroll
    for (int o = 1; o < 64; o <<= 1) v += __shfl_xor(v, o);
    return v;
}
DI void unpack8(const u32x4 v, float (&o)[8]) {
#pragma unroll
    for (int i = 0; i < 4; ++i) { o[2 * i] = __uint_as_float(v[i] << 16); o[2 * i + 1] = __uint_as_float(v[i] & 0xffff0000u); }
}
DI u32x4 pack8(const float (&o)[8]) { u32x4 v; v.x = pk2(o[0], o[1]); v.y = pk2(o[2], o[3]); v.z = pk2(o[4], o[5]); v.w = pk2(o[6], o[7]); return v; }
#define LDS_WAIT() asm volatile("s_waitcnt lgkmcnt(0)" ::: "memory")
#define MFMA16(a, b, c) __builtin_amdgcn_mfma_f32_16x16x32_bf16((a), (b), (c), 0, 0, 0)

struct Args { const float* in[26]; float* out; unsigned char* ws; };
struct Ctx {
    LAS unsigned char* lds; int tid, lane, wave, G, bid;
    const float* in[26]; float* out; unsigned char* ws;
};
#define RLX_AGENT __ATOMIC_RELAXED, __HIP_MEMORY_SCOPE_AGENT
#define XB_TMO      128
#define XB_XCNT(j)  (256  + 64 * (j))
#define XB_XSUB(j)  (1280 + 64 * (j))
#define XB_XGEN(j)  (2304 + 64 * (j))
#define XB_TOP      3328
#define XB_TOPGEN   3392
#define XCD_BAR_WORDS 3456
#define XB_SPIN_CAP (1u << 18)

__device__ __forceinline__ unsigned xb_ld(unsigned* p)              { return __hip_atomic_load(p, __ATOMIC_RELAXED, __HIP_MEMORY_SCOPE_AGENT); }
__device__ __forceinline__ unsigned xb_add(unsigned* p, unsigned v) { return __hip_atomic_fetch_add(p, v, __ATOMIC_RELAXED, __HIP_MEMORY_SCOPE_AGENT); }
__device__ __forceinline__ unsigned xb_xcc_id() { return (unsigned)__builtin_amdgcn_s_getreg((3 << 11) | 20) & 0xFu; }
#define XB_SPIN(cond, bar) do { unsigned _sp = 0; while (cond) { __builtin_amdgcn_s_sleep(1); \
    if ((++_sp & 255u) == 0u) { if (xb_ld(&(bar)[XB_TMO])) break; if (_sp > XB_SPIN_CAP) { atomicAdd(&(bar)[XB_TMO], 1u); break; } } } } while (0)

struct XcdBarrier {
    unsigned* bar; unsigned x;
    volatile LAS unsigned* st;
};

__device__ __forceinline__ XcdBarrier xcd_barrier_post(unsigned* bar, volatile LAS unsigned* st) {
    XcdBarrier b; b.bar = bar; b.x = xb_xcc_id(); b.st = st;
    if (threadIdx.x == 0) (void)xb_add(&bar[XB_XCNT(b.x)], 1u);
    return b;
}
__device__ __forceinline__ void xcd_barrier_complete(unsigned* bar, unsigned x, unsigned& nloc, unsigned& nx) {
    const unsigned G = gridDim.x * gridDim.y * gridDim.z;
    unsigned sum, cnt, mine, sp = 0u;
    for (;;) {
        sum = 0u; cnt = 0u; mine = 0u;
#pragma unroll
        for (unsigned j = 0; j < 16; ++j) { const unsigned c = xb_ld(&bar[XB_XCNT(j)]); sum += c; cnt += (c > 0u) ? 1u : 0u; mine = (j == x) ? c : mine; }
        if (sum == G) break;
        __builtin_amdgcn_s_sleep(1);
        if ((++sp & 255u) == 0u) { if (xb_ld(&bar[XB_TMO])) break; if (sp > XB_SPIN_CAP) { atomicAdd(&bar[XB_TMO], 1u); break; } }
    }
    nloc = mine > 0u ? mine : 1u; nx = cnt > 0u ? cnt : 1u;
}

__device__ __forceinline__ void xcd_barrier(const XcdBarrier& b) {
    asm volatile("s_waitcnt vmcnt(0)" ::: "memory");
    __syncthreads();
    if (threadIdx.x == 0) {
        unsigned* bar = b.bar;
        __builtin_amdgcn_s_waitcnt(0);
        unsigned nloc = b.st[0], nx = b.st[1];
        if (nloc == 0u) { xcd_barrier_complete(bar, b.x, nloc, nx); b.st[0] = nloc; b.st[1] = nx; }
        const unsigned old = xb_add(&bar[XB_XSUB(b.x)], 1u);
        const unsigned gen = old / nloc;
        if (old + 1u == (gen + 1u) * nloc) {
            __builtin_amdgcn_fence(__ATOMIC_RELEASE, "agent");
            asm volatile("s_waitcnt vmcnt(0)" ::: "memory");
            const unsigned og = xb_add(&bar[XB_TOP], 1u);
            const unsigned tg = og / nx;
            if (og + 1u == (tg + 1u) * nx) xb_add(&bar[XB_TOPGEN], 1u);
            else XB_SPIN(xb_ld(&bar[XB_TOPGEN]) == tg, bar);
            __builtin_amdgcn_fence(__ATOMIC_ACQUIRE, "agent");
            xb_add(&bar[XB_XGEN(b.x)], 1u);
            asm volatile("s_waitcnt vmcnt(0)" ::: "memory");
        } else {
            XB_SPIN(xb_ld(&bar[XB_XGEN(b.x)]) == gen, bar);
            __builtin_amdgcn_fence(__ATOMIC_ACQUIRE, "agent");
            asm volatile("s_waitcnt vmcnt(0)" ::: "memory");
        }
    }
    __syncthreads();
}

enum { I_XP = 0, I_XS, I_CWK, I_CWV, I_SSM, I_SCONV, I_CMK, I_CMV, I_MEM, I_GNORM, I_WIN, I_GQ, I_GK, I_SINKS, I_CONVW, I_CONVB, I_DTB, I_ALOG, I_DSKIP, I_GSSD, I_GMEM, I_WMK, I_WMV, I_GMK, I_GMQ, I_WOUT };

DI void p0_transpose_item(const float* W, int ldw, int src_k0, int src_n0, const float* rowscale, bf16_t* WT, int ldt, int dst_n0, int dst_k0, LAS float* scr, int lane) {
#pragma unroll 8
    for (int i = 0; i < 32; ++i) { const int kk = 2 * i + (lane >> 5); float v = W[(size_t)(src_k0 + kk) * ldw + src_n0 + (lane & 31)]; if (rowscale) v *= rowscale[kk]; scr[kk * 33 + (lane & 31)] = v; }
    LDS_WAIT();
    const int c = lane & 7;
#pragma unroll
    for (int j = 0; j < 4; ++j) { const int n = (lane >> 3) + 8 * j; const LAS float* s = scr + (8 * c) * 33 + n;
        u32x4 o; o.x = pk2(s[0 * 33], s[1 * 33]); o.y = pk2(s[2 * 33], s[3 * 33]); o.z = pk2(s[4 * 33], s[5 * 33]); o.w = pk2(s[6 * 33], s[7 * 33]);
        *(u32x4*)(WT + (size_t)(dst_n0 + n) * ldt + dst_k0 + 8 * c) = o; }
    LDS_WAIT();
}

DI float reduce16_to_lane(float (&a)[16], int lane) {
#pragma unroll
    for (int j = 0; j < 16; ++j) { a[j] += __shfl_xor(a[j], 32); a[j] += __shfl_xor(a[j], 16); }
    float r8[8], r4[4], r2[2];
    const bool b3 = (lane & 8) != 0, b2 = (lane & 4) != 0, b1 = (lane & 2) != 0, b0 = (lane & 1) != 0;
#pragma unroll
    for (int j = 0; j < 8; ++j) { const float snd = b3 ? a[j] : a[j + 8], kp = b3 ? a[j + 8] : a[j]; r8[j] = kp + __shfl_xor(snd, 8); }
#pragma unroll
    for (int j = 0; j < 4; ++j) { const float snd = b2 ? r8[j] : r8[j + 4], kp = b2 ? r8[j + 4] : r8[j]; r4[j] = kp + __shfl_xor(snd, 4); }
#pragma unroll
    for (int j = 0; j < 2; ++j) { const float snd = b1 ? r4[j] : r4[j + 2], kp = b1 ? r4[j + 2] : r4[j]; r2[j] = kp + __shfl_xor(snd, 2); }
    const float snd = b0 ? r2[0] : r2[1], kp = b0 ? r2[1] : r2[0];
    return kp + __shfl_xor(snd, 1);
}

DI void p0_rows2(f32x4 (&va)[4], f32x4 (&vb)[4], const float* g, bf16_t* oa, bf16_t* ob, float* dta, float* dtb, bool want_dt, const float* dt_bias, const LAS float* wdt, int lane) {
    float sa = 0.f, sb = 0.f;
#pragma unroll
    for (int jj = 0; jj < 4; ++jj) { sa += (va[jj].x * va[jj].x + va[jj].y * va[jj].y) + (va[jj].z * va[jj].z + va[jj].w * va[jj].w); sb += (vb[jj].x * vb[jj].x + vb[jj].y * vb[jj].y) + (vb[jj].z * vb[jj].z + vb[jj].w * vb[jj].w); }
    const float ra = 1.0f / sqrtf(wave_sum(sa) * (1.0f / DM) + EPSF), rb = 1.0f / sqrtf(wave_sum(sb) * (1.0f / DM) + EPSF);
    u32x2* pa = (u32x2*)oa + lane; u32x2* pb = (u32x2*)ob + lane;
#pragma unroll
    for (int jj = 0; jj < 4; ++jj) { const f32x4 gv = ((const f32x4*)g)[64 * jj + lane]; va[jj] = va[jj] * ra * gv; vb[jj] = vb[jj] * rb * gv;
        u32x2 w; w.x = pk2(va[jj].x, va[jj].y); w.y = pk2(va[jj].z, va[jj].w); pa[64 * jj] = w; w.x = pk2(vb[jj].x, vb[jj].y); w.y = pk2(vb[jj].z, vb[jj].w); pb[64 * jj] = w; }
    if (want_dt) {
        f32x2 ab[16];
#pragma unroll
        for (int j = 0; j < 16; ++j) ab[j] = (f32x2){0.f, 0.f};
#pragma unroll
        for (int jj = 0; jj < 4; ++jj)
#pragma unroll
            for (int e = 0; e < 4; ++e) { const f32x2 hab = {va[jj][e], vb[jj][e]}; const LAS f32x4* wr = (const LAS f32x4*)(wdt + ((jj * 4 + e) * 64 + lane) * 20);
#pragma unroll
                for (int q = 0; q < 4; ++q) { const f32x4 w4 = wr[q];
                    ab[4 * q] += hab * w4.x; ab[4 * q + 1] += hab * w4.y; ab[4 * q + 2] += hab * w4.z; ab[4 * q + 3] += hab * w4.w; }
                if (e & 1) __builtin_amdgcn_sched_barrier(0); }
        float a[16], b[16];
#pragma unroll
        for (int j = 0; j < 16; ++j) { a[j] = ab[j].x; b[j] = ab[j].y; }
        const float ta = reduce16_to_lane(a, lane), tb = reduce16_to_lane(b, lane);
        if (lane < 16) { const float xa = ta + dt_bias[lane], xb = tb + dt_bias[lane];
            dta[lane] = fmaxf(xa, 0.f) + log1pf(__expf(-fabsf(xa))); dtb[lane] = fmaxf(xb, 0.f) + log1pf(__expf(-fabsf(xb))); }
    }
}

DI void p0_row_segment(Ctx& F, const float* src, const float* g, int m0, int npair, bool tok, bf16_t* A, float* DT, const LAS float* wdt, int gw, int NGW) {
    const int lane = F.lane;
    f32x4 n0a[4], n0b[4], n1a[4], n1b[4];
#define P0_LOAD(dst_a, dst_b, pp) do { if ((pp) < npair) { _Pragma("unroll") for (int jj = 0; jj < 4; ++jj) { \
        dst_a[jj] = ((const f32x4*)(src + (size_t)(2 * (pp)) * DM))[64 * jj + lane]; dst_b[jj] = ((const f32x4*)(src + (size_t)(2 * (pp) + 1) * DM))[64 * jj + lane]; } } } while (0)
    P0_LOAD(n0a, n0b, gw); P0_LOAD(n1a, n1b, gw + NGW);
    for (int p = gw; p < npair; p += NGW) {
        f32x4 va[4], vb[4];
#pragma unroll
        for (int jj = 0; jj < 4; ++jj) { va[jj] = n0a[jj]; vb[jj] = n0b[jj]; n0a[jj] = n1a[jj]; n0b[jj] = n1b[jj]; }
        P0_LOAD(n1a, n1b, p + 2 * NGW);
        const int m = m0 + 2 * p;
        p0_rows2(va, vb, g, A + (size_t)m * DM, A + (size_t)(m + 1) * DM, DT + (size_t)(tok ? m : 0) * 16, DT + (size_t)(tok ? m + 1 : 0) * 16, tok, F.in[I_DTB], wdt, lane);
    }
#undef P0_LOAD
}

DI void p0_prologue(Ctx& F) {
    const int gw = F.bid * 8 + F.wave, NGW = F.G * 8, lane = F.lane;
    bf16_t* BT = (bf16_t*)(F.ws + WS_BT); bf16_t* WOT = (bf16_t*)(F.ws + WS_WOUT);
    for (int rep_ = 0; rep_ < REP_P0T; ++rep_) {
        LAS float* scr = (LAS float*)(F.lds + F.wave * 16384);
        constexpr int I_IN = 16 * (NPROJ / 32), I_M = 16 * 32, I_O = 32 * 32;
        for (int it = gw; it < I_IN + I_M + I_O; it += NGW) {
            int r = it;
            if (r < I_IN) { const int kb = r / (NPROJ / 32), nb = r % (NPROJ / 32); const int n0 = 32 * nb;
                p0_transpose_item(F.in[I_WIN], INC, 64 * kb, n0 + (n0 >= 3840 ? 16 : 0), nullptr, BT, 1024, n0, 64 * kb, scr, lane); continue; }
            r -= I_IN;
            if (r < I_M) { const int kb = r / 32, nb = r % 32;
                p0_transpose_item(nb < 16 ? F.in[I_WMK] : F.in[I_WMV], 512, 64 * kb, 32 * (nb & 15), nullptr, BT, 1024, NPROJ + 32 * nb, 64 * kb, scr, lane); continue; }
            r -= I_M;
            { const int kb = r / 32, nb = r % 32; const int k0 = 64 * kb;
              const int sk0 = k0 < 1024 ? 512 + k0 : (k0 < 1536 ? k0 - 1024 : k0);
              p0_transpose_item(F.in[I_WOUT], 1024, sk0, 32 * nb, k0 < 1024 ? F.in[I_GSSD] + k0 : nullptr, WOT, 2048, 32 * nb, k0, scr, lane); }
        }
    }
    { float* sq = (float*)(F.ws + WS_SSQ); for (int i = F.bid * 512 + F.tid; i < MTOT; i += F.G * 512) sq[i] = 0.f; }
    {
        f32x2* rope = (f32x2*)(F.ws + WS_ROPE);
        for (int i = F.bid * 512 + F.tid; i < 4096 * 32; i += F.G * 512) {
            const int pos = i >> 5, fi = i & 31;
            const float freq = exp2f(-(float)fi * (13.287712379549449f / 32.0f));
            double rev = (double)pos * (double)freq * 0.15915494309189535;
            rev -= __builtin_rint(rev);
            const float ang = (float)(rev * 6.283185307179586);
            rope[i] = (f32x2){cosf(ang), sinf(ang)};
        }
    }
    __syncthreads();
    for (int rep_ = 0; rep_ < REP_P0R; ++rep_) {
        if (rep_) __syncthreads();
        LAS float* wdt = (LAS float*)F.lds;
#pragma unroll 1
        for (int i0 = F.tid; i0 < 1024 * 16; i0 += 512 * 8) { float t8[8];
#pragma unroll
            for (int u = 0; u < 8; ++u) { const int i = i0 + 512 * u; t8[u] = F.in[I_WIN][(size_t)(i >> 4) * INC + 3840 + (i & 15)]; }
#pragma unroll
            for (int u = 0; u < 8; ++u) { const int i = i0 + 512 * u, k = i >> 4, j = i & 15; const int jj = k >> 8, e = k & 3, l = (k >> 2) & 63;
                wdt[((jj * 4 + e) * 64 + l) * 20 + j] = t8[u]; } }
        __syncthreads();
        bf16_t* A = (bf16_t*)(F.ws + WS_A); float* DT = (float*)(F.ws + WS_DT);
        p0_row_segment(F, F.in[I_XP], F.in[I_GNORM], 0, MP / 2, true, A, DT, wdt, gw, NGW);
        p0_row_segment(F, F.in[I_XS], F.in[I_GNORM], MP, MS / 2, true, A, DT, wdt, gw, NGW);
        p0_row_segment(F, F.in[I_MEM], F.in[I_GMEM], MTOT, MMEM / 2, false, A, DT, wdt, gw, NGW);
    }
}
struct Order1 {
    pg8::StaticOrder so; int G, c;
    __device__ void init(int G_, int c_) { so.init(MTOT, NPROJ, G_, c_); G = G_; c = c_; }
    __device__ bool next(int i, pg8::Unit& u) const {
        long L = (long)i * G + c;
        if (L >= (long)REP_P1 * (so.nwg + 64)) return false;
        L %= (so.nwg + 64);
        if (L < so.nwg) { pg8::StaticOrder t = so; t.G = 1; t.c = 0; return t.next((int)L, u); }
        const int r = (int)(L - so.nwg);
        u.pm = MTOT / 256 + (r >> 2); u.pn = NPROJ / 256 + (r & 3); return true;
    }
    __device__ __forceinline__ void a_ready(const pg8::Unit&) const {}
    __device__ __forceinline__ void done(const pg8::Unit&) const {}
};
struct Order3 {
    pg8::StaticOrder so; int G, c;
    __device__ void init(int G_, int c_) { so.init(MP, 1024, 1, 0); G = G_; c = c_; }
    __device__ bool next(int i, pg8::Unit& u) const {
        long L = (long)i * G + c;
        if (L >= (long)REP_P3 * so.nwg) return false;
        return so.next((int)(L % so.nwg), u);
    }
    __device__ __forceinline__ void a_ready(const pg8::Unit&) const {}
    __device__ __forceinline__ void done(const pg8::Unit&) const {}
};
struct EpiProj {
    static constexpr bool PERM = true, AFTER_DRAIN = false; static constexpr int MIDK = 0;
    bf16_t* proj; bf16_t* memraw;
    __device__ __forceinline__ void operator()(const f32x4 (&acc)[2][2][4][2], const pg8::Unit& u, int wr, int wc, int fr, int fq) const {
        bf16_t* base; int ldc, row0, col0;
        if (u.pn < NPROJ / 256) { base = proj; ldc = NPROJ; row0 = u.pm * 256; col0 = u.pn * 256; }
        else { base = memraw; ldc = 1024; row0 = (u.pm - MTOT / 256) * 256; col0 = (u.pn - NPROJ / 256) * 256; }
        row0 += wr * 64 + fr; col0 += wc * 32 + 8 * fq;
#pragma unroll
        for (int ai = 0; ai < 2; ++ai)
#pragma unroll
            for (int m = 0; m < 4; ++m) { bf16_t* rowp = base + (size_t)(row0 + ai * 128 + m * 16) * ldc + col0;
#pragma unroll
                for (int bj = 0; bj < 2; ++bj) { const f32x4 v0 = acc[ai][bj][m][0], v1 = acc[ai][bj][m][1];
                    u32x4 w; w.x = cvt_pk_bf16(v0[0], v0[1]); w.y = cvt_pk_bf16(v0[2], v0[3]); w.z = cvt_pk_bf16(v1[0], v1[1]); w.w = cvt_pk_bf16(v1[2], v1[3]);
                    *(u32x4*)(rowp + bj * 128) = w; } }
    }
};
struct EpiOut {
    static constexpr bool PERM = false, AFTER_DRAIN = false; static constexpr int MIDK = 16;
    const float* xp; const float* xs; float* out; const float* sumsq;
    __device__ __forceinline__ void mid(f32x4 (&acc)[2][2][4][2], const pg8::Unit& u, int wr, int wc, int fr, int fq) const {
        const float* sq = sumsq + (size_t)u.pm * 256 + wr * 64 + fr;
#pragma unroll
        for (int ai = 0; ai < 2; ++ai)
#pragma unroll
            for (int m = 0; m < 4; ++m) { const float r = 1.0f / sqrtf(sq[ai * 128 + m * 16] * (1.0f / 1024.0f) + EPSF);
#pragma unroll
                for (int bj = 0; bj < 2; ++bj)
#pragma unroll
                    for (int n = 0; n < 2; ++n) acc[ai][bj][m][n] = acc[ai][bj][m][n] * r; }
    }
    __device__ __forceinline__ void operator()(const f32x4 (&acc)[2][2][4][2], const pg8::Unit& u, int wr, int wc, int fr, int fq) const {
        const float* xb = u.pm < MP / 256 ? xp + (size_t)u.pm * 256 * DM : xs + (size_t)(u.pm - MP / 256) * 256 * DM;
        float* ob = out + (size_t)u.pm * 256 * DM;
        const int rl0 = wr * 64 + fr, col0 = u.pn * 256 + wc * 32 + 4 * fq;
#pragma unroll
        for (int ai = 0; ai < 2; ++ai) {
            f32x4 xv[4][2][2];
#pragma unroll
            for (int m = 0; m < 4; ++m)
#pragma unroll
                for (int bj = 0; bj < 2; ++bj)
#pragma unroll
                    for (int n = 0; n < 2; ++n) xv[m][bj][n] = *(const f32x4*)(xb + (size_t)(rl0 + ai * 128 + m * 16) * DM + col0 + bj * 128 + n * 16);
#pragma unroll
            for (int m = 0; m < 4; ++m)
#pragma unroll
                for (int bj = 0; bj < 2; ++bj)
#pragma unroll
                    for (int n = 0; n < 2; ++n) *(f32x4*)(ob + (size_t)(rl0 + ai * 128 + m * 16) * DM + col0 + bj * 128 + n * 16) = acc[ai][bj][m][n] + xv[m][bj][n];
            asm volatile("" ::: "memory"); }
    }
};

constexpr int SS_X = 0, SS_XD = 9216, SS_BM = 18432, SS_CM = 35840, SS_SB = 53248, SS_WM = 70656, SS_SM = 79872;
constexpr int LD64 = 144, LD128 = 272;
typedef short s16x4 __attribute__((ext_vector_type(4)));

DI bf16x8 lds_frag(const LAS unsigned char* tile, int ld, int row0, int k0, int lane) {
    return *(const LAS bf16x8*)(tile + (row0 + (lane & 15)) * ld + (k0 + 8 * (lane >> 4)) * 2);
}
DI bf16x8 lds_frag_tr(const LAS unsigned char* tile, int ld, int k0, int c0, int lane) {
    const LAS unsigned char* a = tile + (k0 + 8 * (lane >> 4) + ((lane & 15) >> 2)) * ld + (c0 + 4 * (lane & 3)) * 2;
    const s16x4 lo = __builtin_amdgcn_ds_read_tr16_b64_v4i16((LAS s16x4*)a), hi = __builtin_amdgcn_ds_read_tr16_b64_v4i16((LAS s16x4*)(a + 4 * ld));
    return (bf16x8){lo.x, lo.y, lo.z, lo.w, hi.x, hi.y, hi.z, hi.w};
}
DI bf16x8 lds_frag_tr2(const LAS unsigned char* tile, int ld, int k0, int c0, int lane) {
    const LAS unsigned char* a = tile + (k0 + 4 * (lane >> 4) + ((lane & 15) >> 2)) * ld + (c0 + 4 * (lane & 3)) * 2;
    const s16x4 lo = __builtin_amdgcn_ds_read_tr16_b64_v4i16((LAS s16x4*)a), hi = __builtin_amdgcn_ds_read_tr16_b64_v4i16((LAS s16x4*)(a + 16 * ld));
    return (bf16x8){lo.x, lo.y, lo.z, lo.w, hi.x, hi.y, hi.z, hi.w};
}
#define MFMA16T(rowsfrag, colsfrag, acc) MFMA16((colsfrag), (rowsfrag), (acc))

DI void convbc_prepass(Ctx& F) {
    const int gw = F.bid * 8 + F.wave, NGW = F.G * 8, lane = F.lane;
    const bf16_t* PROJ = (const bf16_t*)(F.ws + WS_PROJ); bf16_t* BCC = (bf16_t*)(F.ws + WS_BCC);
    const int ch0 = 1024 + lane * 8;
    float wv[4][8], bv[8];
#pragma unroll
    for (int e = 0; e < 8; ++e) { bv[e] = F.in[I_CONVB][ch0 + e];
#pragma unroll
        for (int j = 0; j < 4; ++j) wv[j][e] = F.in[I_CONVW][j * 1536 + ch0 + e]; }
    for (int t = gw; t < MTOT / 33; t += NGW) {
        const int row0 = t * 33;
        float h0[8], h1[8], h2[8];
        { const bool smp0 = row0 >= MP; const int lrow0 = smp0 ? (row0 - MP) & 63 : row0 & (T_P - 1);
          const float* sc0 = F.in[I_SCONV] + (size_t)(smp0 ? (row0 - MP) >> 6 : 0) * 3 * 1536 + ch0;
#define CONV_HALO(dst, j) do { const int lr_ = lrow0 - 3 + (j); \
              if (lr_ >= 0) unpack8(*(const u32x4*)(PROJ + (size_t)(row0 - 3 + (j)) * NPROJ + C_XBC + ch0), dst); \
              else { _Pragma("unroll") for (int e = 0; e < 8; ++e) dst[e] = smp0 ? sc0[(3 + lr_) * 1536 + e] : 0.f; } } while (0)
          CONV_HALO(h0, 0); CONV_HALO(h1, 1); CONV_HALO(h2, 2);
#undef CONV_HALO
        }
#pragma unroll 1
        for (int bt = 0; bt < 3; ++bt) {
            u32x4 raw[11];
#pragma unroll
            for (int i = 0; i < 11; ++i) raw[i] = *(const u32x4*)(PROJ + (size_t)(row0 + 11 * bt + i) * NPROJ + C_XBC + ch0);
#pragma unroll
            for (int i = 0; i < 11; ++i) { const int row = row0 + 11 * bt + i;
                const bool smp = row >= MP; const int lrow = smp ? (row - MP) & 63 : row & (T_P - 1);
                if (lrow == 0) {
                    if (smp) { const float* sc = F.in[I_SCONV] + (size_t)((row - MP) >> 6) * 3 * 1536 + ch0;
#pragma unroll
                        for (int e = 0; e < 8; ++e) { h0[e] = sc[e]; h1[e] = sc[1536 + e]; h2[e] = sc[2 * 1536 + e]; } }
                    else {
#pragma unroll
                        for (int e = 0; e < 8; ++e) { h0[e] = 0.f; h1[e] = 0.f; h2[e] = 0.f; } } }
                float cur[8], o[8];
                unpack8(raw[i], cur);
#pragma unroll
                for (int e = 0; e < 8; ++e) { o[e] = siluf(bv[e] + wv[0][e] * h0[e] + wv[1][e] * h1[e] + wv[2][e] * h2[e] + wv[3][e] * cur[e]); h0[e] = h1[e]; h1[e] = h2[e]; h2[e] = cur[e]; }
                *(u32x4*)(BCC + (size_t)row * 512 + lane * 8) = pack8(o); }
        }
    }
}

DI void ssd_item(Ctx& F, int sq, int h, bool do_sumsq) {
    LAS unsigned char* lds = F.lds;
    const int tid = F.tid, lane = F.lane, w = F.wave, g = h >> 3;
    const bool smp = sq >= NB_P; const int sb = sq - NB_P;
    const int row_base = smp ? MP + sb * 64 : sq * T_P, nchunks = smp ? 1 : 64;
    const bf16_t* PROJ = (const bf16_t*)(F.ws + WS_PROJ); const bf16_t* BCC = (const bf16_t*)(F.ws + WS_BCC); const float* DT = (const float*)(F.ws + WS_DT);
    bf16_t* MIX = (bf16_t*)(F.ws + WS_MIX); float* SUMSQ = (float*)(F.ws + WS_SSQ);
    const float a_h = -__expf(F.in[I_ALOG][h]), d_h = F.in[I_DSKIP][h];
    const int pt = w >> 1, nh = w & 1, lt = w >> 1;
    const int xl = tid >> 3, xg = tid & 7, chx = h * 64 + 8 * xg;
    LAS float* sm_cw0 = (LAS float*)(lds + SS_SM + 1024 + 768);
    if (tid >= 192 && tid < 512) { const int i = tid - 192; const int j = i >> 6, chn = h * 64 + (i & 63); sm_cw0[i] = j < 4 ? F.in[I_CONVW][j * 1536 + chn] : F.in[I_CONVB][chn]; }
    f32x4 st[4];
#pragma unroll
    for (int q = 0; q < 4; ++q) {
        if (smp) st[q] = *(const f32x4*)(F.in[I_SSM] + ((size_t)(sb * 16 + h) * 64 + 16 * pt + (lane & 15)) * 128 + 16 * (4 * nh + q) + 4 * (lane >> 4));
        else st[q] = (f32x4){0.f, 0.f, 0.f, 0.f};
    }
    u32x4 px0[4], px1[4], pbs[2], pcs[2]; u32x2 pz0[2], pz1[2]; float pdt0, pdt1;
#define SSD_ISSUE_X(c_, PX_) do { const int row0_ = row_base + 64 * (c_); \
        _Pragma("unroll") for (int j_ = 0; j_ < 4; ++j_) { int rr_ = xl - 3 + j_; if ((c_) == 0 && rr_ < 0) rr_ = 0; PX_[j_] = *(const u32x4*)(PROJ + (size_t)(row0_ + rr_) * NPROJ + C_XBC + chx); } } while (0)
#define SSD_ISSUE_BC(c_) do { const int row0_ = row_base + 64 * (c_); \
        _Pragma("unroll") for (int i_ = 0; i_ < 2; ++i_) { const int t_ = tid + 512 * i_; \
            pbs[i_] = *(const u32x4*)(BCC + (size_t)(row0_ + (t_ >> 4)) * 512 + g * 128 + 8 * (t_ & 15)); pcs[i_] = *(const u32x4*)(BCC + (size_t)(row0_ + (t_ >> 4)) * 512 + 256 + g * 128 + 8 * (t_ & 15)); } } while (0)
#define SSD_ISSUE_ZDT(c_, PZ_, PDT_) do { const int row0_ = row_base + 64 * (c_); \
        _Pragma("unroll") for (int pi_ = 0; pi_ < 2; ++pi_) PZ_[pi_] = *(const u32x2*)(PROJ + (size_t)(row0_ + 16 * lt + (lane & 15)) * NPROJ + C_Z + h * 64 + 16 * (2 * nh + pi_) + 4 * (lane >> 4)); \
        PDT_ = DT[(size_t)(row0_ + lane) * 16 + h]; } while (0)
    LAS float* sm_init = (LAS float*)(lds + SS_SM + 1024);
    if (tid < 192) sm_init[tid] = smp ? F.in[I_SCONV][(size_t)(sb * 3 + (tid >> 6)) * 1536 + h * 64 + (tid & 63)] : 0.f;
#define SSD_STEP(c, PX_, PZ_, PDT_) do { \
        const int row0 = row_base + 64 * c; \
        LAS float* sm_ac = (LAS float*)(lds + SS_SM + (c & 1) * 512); LAS float* sm_dt = sm_ac + 64; \
        const float dtl = PDT_; \
        float ac = dtl * a_h; \
_Pragma("unroll")         for (int o = 1; o < 64; o <<= 1) { const float t = __shfl_up(ac, o); if (lane >= o) ac += t; } \
        const float ac_last = __shfl(ac, 63); \
        const float wgt_l = __expf(ac_last - ac) * dtl; \
        if (w == 0) { sm_ac[lane] = ac; sm_dt[lane] = dtl; } \
        __syncthreads(); \
        { \
        { float xr[4][8], o[8], od[8]; \
_Pragma("unroll")           for (int j = 0; j < 4; ++j) unpack8(PX_[j], xr[j]); \
          if (c == 0) { \
_Pragma("unroll")               for (int j = 0; j < 3; ++j) { const int rr = xl - 3 + j; const LAS f32x4* iv = (const LAS f32x4*)(sm_init + (rr < 0 ? 3 + rr : 0) * 64 + 8 * xg); \
                  f32x4 i0 = iv[0], i1 = iv[1]; asm volatile("" : "+v"(i0), "+v"(i1)); \
_Pragma("unroll")                   for (int e = 0; e < 4; ++e) { xr[j][e] = (rr < 0) ? i0[e] : xr[j][e]; xr[j][4 + e] = (rr < 0) ? i1[e] : xr[j][4 + e]; } } } \
          const float wg = __shfl(wgt_l, xl & 63); \
          float wv[4][8], bv[8]; unsigned cwo_ = (unsigned)(8 * xg) * 4u; asm volatile("" : "+v"(cwo_)); const LAS float* sm_cw = (const LAS float*)((const LAS unsigned char*)sm_cw0 + cwo_) - 8 * xg; \
          _Pragma("unroll") for (int j_ = 0; j_ < 4; ++j_) { const f32x4 a_ = *(const LAS f32x4*)(sm_cw + j_ * 64 + 8 * xg), b_ = *(const LAS f32x4*)(sm_cw + j_ * 64 + 8 * xg + 4); \
              _Pragma("unroll") for (int e_ = 0; e_ < 4; ++e_) { wv[j_][e_] = a_[e_]; wv[j_][4 + e_] = b_[e_]; } } \
          { const f32x4 a_ = *(const LAS f32x4*)(sm_cw + 256 + 8 * xg), b_ = *(const LAS f32x4*)(sm_cw + 256 + 8 * xg + 4); _Pragma("unroll") for (int e_ = 0; e_ < 4; ++e_) { bv[e_] = a_[e_]; bv[4 + e_] = b_[e_]; } } \
_Pragma("unroll")           for (int e = 0; e < 8; ++e) { o[e] = siluf(bv[e] + wv[0][e] * xr[0][e] + wv[1][e] * xr[1][e] + wv[2][e] * xr[2][e] + wv[3][e] * xr[3][e]); od[e] = o[e] * wg; } \
          *(LAS u32x4*)(lds + SS_X + xl * LD64 + xg * 16) = pack8(o); \
          *(LAS u32x4*)(lds + SS_XD + xl * LD64 + xg * 16) = pack8(od); } \
_Pragma("unroll")         for (int i = 0; i < 2; ++i) { const int t = tid + 512 * i; \
            *(LAS u32x4*)(lds + SS_BM + (t >> 4) * LD128 + (t & 15) * 16) = pbs[i]; *(LAS u32x4*)(lds + SS_CM + (t >> 4) * LD128 + (t & 15) * 16) = pcs[i]; } \
_Pragma("unroll")         for (int q = 0; q < 4; ++q) { u32x2 v; v.x = pk2(st[q][0], st[q][1]); v.y = pk2(st[q][2], st[q][3]); \
            *(LAS u32x2*)(lds + SS_SB + (16 * pt + (lane & 15)) * LD128 + (16 * (4 * nh + q) + 4 * (lane >> 4)) * 2) = v; } \
        } \
        if (c + 2 < nchunks) SSD_ISSUE_X(c + 2, PX_); if (c + 1 < nchunks) SSD_ISSUE_BC(c + 1); \
        __syncthreads(); \
        { const float acl = sm_ac[16 * lt + (lane & 15)]; const int l = 16 * lt + (lane & 15); \
_Pragma("unroll")           for (int si = 0; si < 2; ++si) { const int stl = 2 * nh + si; f32x4 gacc = {0.f, 0.f, 0.f, 0.f}; \
              if (stl <= lt) { \
_Pragma("unroll")                   for (int ks = 0; ks < 4; ++ks) gacc = MFMA16T(lds_frag(lds + SS_CM, LD128, 16 * lt, 32 * ks, lane), lds_frag(lds + SS_BM, LD128, 16 * stl, 32 * ks, lane), gacc); } \
              const int s0 = 16 * stl + 4 * (lane >> 4); \
              const f32x4 acs = *(const LAS f32x4*)(sm_ac + s0), dts = *(const LAS f32x4*)(sm_dt + s0); \
              float v[4]; \
_Pragma("unroll")               for (int r = 0; r < 4; ++r) { v[r] = gacc[r] * __expf(fminf(acl - acs[r], 0.f)) * dts[r]; v[r] = (l >= s0 + r) ? v[r] : 0.f; } \
              u32x2 pk; pk.x = pk2(v[0], v[1]); pk.y = pk2(v[2], v[3]); \
              *(LAS u32x2*)(lds + SS_WM + l * LD64 + s0 * 2) = pk; } } \
        __syncthreads(); \
        { \
        { const int l = 16 * lt + (lane & 15); const float eal = __expf(sm_ac[l]); \
          float ssq = 0.f; \
_Pragma("unroll")           for (int pi = 0; pi < 2; ++pi) { const int ptl = 2 * nh + pi; const int p0 = 16 * ptl + 4 * (lane >> 4); \
              f32x4 y = {0.f, 0.f, 0.f, 0.f}; \
_Pragma("unroll")               for (int ks = 0; ks < 4; ++ks) y = MFMA16T(lds_frag(lds + SS_CM, LD128, 16 * lt, 32 * ks, lane), lds_frag(lds + SS_SB, LD128, 16 * ptl, 32 * ks, lane), y); \
              y = y * eal; \
_Pragma("unroll")               for (int ks = 0; ks < 2; ++ks) y = MFMA16T(lds_frag(lds + SS_WM, LD64, 16 * lt, 32 * ks, lane), lds_frag_tr(lds + SS_X, LD64, 32 * ks, 16 * ptl, lane), y); \
              const u32x2 xraw = *(const LAS u32x2*)(lds + SS_X + l * LD64 + p0 * 2); \
              const float xv[4] = {__uint_as_float(xraw.x << 16), __uint_as_float(xraw.x & 0xffff0000u), __uint_as_float(xraw.y << 16), __uint_as_float(xraw.y & 0xffff0000u)}; \
              const float zv[4] = {__uint_as_float(PZ_[pi].x << 16), __uint_as_float(PZ_[pi].x & 0xffff0000u), __uint_as_float(PZ_[pi].y << 16), __uint_as_float(PZ_[pi].y & 0xffff0000u)}; \
              float gv[4]; \
_Pragma("unroll")               for (int r = 0; r < 4; ++r) { gv[r] = (y[r] + d_h * xv[r]) * siluf(zv[r]); ssq += gv[r] * gv[r]; } \
              u32x2 pk; pk.x = pk2(gv[0], gv[1]); pk.y = pk2(gv[2], gv[3]); \
              *(u32x2*)(MIX + (size_t)(row0 + l) * 2048 + h * 64 + p0) = pk; } \
          ssq += __shfl_xor(ssq, 16); ssq += __shfl_xor(ssq, 32); \
          if (lane < 16 && do_sumsq) unsafeAtomicAdd(SUMSQ + row0 + l, ssq); } \
        } \
        { const float cd = __expf(ac_last); \
          bf16x8 xa[2]; \
_Pragma("unroll")           for (int ks = 0; ks < 2; ++ks) xa[ks] = lds_frag_tr(lds + SS_XD, LD64, 32 * ks, 16 * pt, lane); \
_Pragma("unroll")           for (int q = 0; q < 4; ++q) { f32x4 s = st[q] * cd; \
_Pragma("unroll")               for (int ks = 0; ks < 2; ++ks) s = MFMA16T(xa[ks], lds_frag_tr(lds + SS_BM, LD128, 32 * ks, 16 * (4 * nh + q), lane), s); \
              st[q] = s; } } \
        if (c + 2 < nchunks) SSD_ISSUE_ZDT(c + 2, PZ_, PDT_); \
    } while (0)
    SSD_ISSUE_X(0, px0); SSD_ISSUE_BC(0); SSD_ISSUE_ZDT(0, pz0, pdt0);
    if (nchunks > 1) { SSD_ISSUE_X(1, px1); SSD_ISSUE_ZDT(1, pz1, pdt1); }
#pragma unroll 1
    for (int c2 = 0; c2 < nchunks; c2 += 2) {
        { const int c = c2; SSD_STEP(c, px0, pz0, pdt0); }
        if (c2 + 1 < nchunks) { const int c = c2 + 1; SSD_STEP(c, px1, pz1, pdt1); }
    }
#undef SSD_STEP
#undef SSD_ISSUE_X
#undef SSD_ISSUE_BC
#undef SSD_ISSUE_ZDT
    { float* so = F.out + (smp ? O_SSMS + ((size_t)(sb * 16 + h) * 64) * 128 : O_SSMP + ((size_t)(sq * 16 + h) * 64) * 128);
#pragma unroll
      for (int q = 0; q < 4; ++q) *(f32x4*)(so + (16 * pt + (lane & 15)) * 128 + 16 * (4 * nh + q) + 4 * (lane >> 4)) = st[q]; }
    __syncthreads();
}
DI void p2a_phase(Ctx& F) {
    convbc_prepass(F);
    {
        const bf16_t* PROJ = (const bf16_t*)(F.ws + WS_PROJ);
        for (int i = F.bid * 512 + F.tid; i < 48 * 3 * 1536; i += F.G * 512) {
            const int ch = i % 1536, j = (i / 1536) % 3, sq = i / (3 * 1536);
            if (sq < NB_P) F.out[O_CONVP + (size_t)(sq * 3 + j) * 1536 + ch] = bf2f(PROJ[(size_t)(sq * T_P + T_P - 3 + j) * NPROJ + C_XBC + ch]);
            else F.out[O_CONVS + (size_t)((sq - NB_P) * 3 + j) * 1536 + ch] = bf2f(PROJ[(size_t)(MP + (sq - NB_P) * 64 + 61 + j) * NPROJ + C_XBC + ch]);
        }
    }
}
constexpr int WR_SLOT = 19456, WR_V = 9216, LDKW = 144, LDVW = 160;

DI void wa_write_k(Ctx& F, LAS unsigned char* slot, int kvh, const u32x4 ra, const u32x4 rb, int pos, float* ko) {
    const int i = F.tid >> 2, q4 = F.tid & 3;
    float a[8], bb[8], o1[8], o2[8];
    unpack8(ra, a); unpack8(rb, bb);
    float s = 0.f;
#pragma unroll
    for (int e = 0; e < 8; ++e) s += a[e] * a[e] + bb[e] * bb[e];
    s += __shfl_xor(s, 1); s += __shfl_xor(s, 2);
    const float rstd = 1.0f / sqrtf(s * (1.0f / 64.0f) + EPSF);
    const f32x2* ROPE = (const f32x2*)(F.ws + WS_ROPE);
#pragma unroll
    for (int e = 0; e < 8; ++e) { const float an = a[e] * rstd * F.in[I_GK][8 * q4 + e], bn = bb[e] * rstd * F.in[I_GK][32 + 8 * q4 + e];
        const f32x2 cs = ROPE[pos * 32 + 8 * q4 + e]; o1[e] = an * cs.x - bn * cs.y; o2[e] = bn * cs.x + an * cs.y; }
    *(LAS u32x4*)(slot + i * LDKW + (8 * q4) * 2) = pack8(o1);
    *(LAS u32x4*)(slot + i * LDKW + (32 + 8 * q4) * 2) = pack8(o2);
    if (ko) { float* p = ko + ((size_t)i * 2 + kvh) * 64;
        *(f32x4*)(p + 8 * q4) = (f32x4){o1[0], o1[1], o1[2], o1[3]}; *(f32x4*)(p + 8 * q4 + 4) = (f32x4){o1[4], o1[5], o1[6], o1[7]};
        *(f32x4*)(p + 32 + 8 * q4) = (f32x4){o2[0], o2[1], o2[2], o2[3]}; *(f32x4*)(p + 32 + 8 * q4 + 4) = (f32x4){o2[4], o2[5], o2[6], o2[7]}; }
}
DI void wa_write_v(Ctx& F, LAS unsigned char* slot, int kvh, const u32x4 rv, float* vo) {
    const int i = F.tid >> 3, q8 = F.tid & 7;
    *(LAS u32x4*)(slot + WR_V + i * LDVW + q8 * 16) = rv;
    if (vo) { float v[8]; unpack8(rv, v); float* p = vo + ((size_t)i * 2 + kvh) * 64 + 8 * q8;
        *(f32x4*)p = (f32x4){v[0], v[1], v[2], v[3]}; *(f32x4*)(p + 4) = (f32x4){v[4], v[5], v[6], v[7]}; }
}
DI void wa_stage_cache(Ctx& F, LAS unsigned char* slot, int kvh, const float* ck, const float* cv, float* ko, float* vo) {
    if (F.tid < 256) { const int i = F.tid >> 2, q4 = F.tid & 3; const float* src = ck + ((size_t)i * 2 + kvh) * 64;
        const f32x4 a0 = *(const f32x4*)(src + 8 * q4), a1 = *(const f32x4*)(src + 8 * q4 + 4), b0 = *(const f32x4*)(src + 32 + 8 * q4), b1 = *(const f32x4*)(src + 32 + 8 * q4 + 4);
        u32x4 pa, pb; pa.x = pk2(a0.x, a0.y); pa.y = pk2(a0.z, a0.w); pa.z = pk2(a1.x, a1.y); pa.w = pk2(a1.z, a1.w); pb.x = pk2(b0.x, b0.y); pb.y = pk2(b0.z, b0.w); pb.z = pk2(b1.x, b1.y); pb.w = pk2(b1.z, b1.w);
        *(LAS u32x4*)(slot + i * LDKW + (8 * q4) * 2) = pa; *(LAS u32x4*)(slot + i * LDKW + (32 + 8 * q4) * 2) = pb;
        if (ko) { float* p = ko + ((size_t)i * 2 + kvh) * 64; *(f32x4*)(p + 8 * q4) = a0; *(f32x4*)(p + 8 * q4 + 4) = a1; *(f32x4*)(p + 32 + 8 * q4) = b0; *(f32x4*)(p + 32 + 8 * q4 + 4) = b1; } }
    { const int i = F.tid >> 3, q8 = F.tid & 7; const float* src = cv + ((size_t)i * 2 + kvh) * 64 + 8 * q8; const f32x4 v0 = *(const f32x4*)src, v1 = *(const f32x4*)(src + 4);
      u32x4 pv; pv.x = pk2(v0.x, v0.y); pv.y = pk2(v0.z, v0.w); pv.z = pk2(v1.x, v1.y); pv.w = pk2(v1.z, v1.w);
      *(LAS u32x4*)(slot + WR_V + i * LDVW + q8 * 16) = pv;
      if (vo) { float* p = vo + ((size_t)i * 2 + kvh) * 64 + 8 * q8; *(f32x4*)p = v0; *(f32x4*)(p + 4) = v1; } }
}
DI void wa_compute(Ctx& F, int kvh, size_t crow0, int pos0, int sl0, int sl1, int sl2, int ninv) {
    LAS unsigned char* lds = F.lds;
    const int lane = F.lane, w = F.wave, g4 = lane >> 4;
    const bf16_t* PROJ = (const bf16_t*)(F.ws + WS_PROJ); const f32x2* ROPE = (const f32x2*)(F.ws + WS_ROPE); bf16_t* MIX = (bf16_t*)(F.ws + WS_MIX);
    const int hq = kvh * 4 + (w >> 1); const float sink = F.in[I_SINKS][hq];
    u32x2 graw2[2][4]; u32x4 qraw[2][2];
#pragma unroll
    for (int rg = 0; rg < 2; ++rg) { const size_t row = crow0 + 32 * (w & 1) + 16 * rg + (lane & 15);
#pragma unroll
        for (int dt = 0; dt < 4; ++dt) graw2[rg][dt] = *(const u32x2*)(PROJ + row * NPROJ + C_GA + hq * 64 + 16 * dt + 4 * g4);
        qraw[rg][0] = *(const u32x4*)(PROJ + row * NPROJ + C_Q + hq * 64 + 8 * g4); qraw[rg][1] = *(const u32x4*)(PROJ + row * NPROJ + C_Q + hq * 64 + 32 + 8 * g4); }
#pragma unroll
    for (int rg = 0; rg < 2; ++rg) {
        const int tb = 32 * (w & 1) + 16 * rg;
        const size_t row = crow0 + tb + (lane & 15);
        u32x2 graw[4];
#pragma unroll
        for (int dt = 0; dt < 4; ++dt) graw[dt] = graw2[rg][dt];
        bf16x8 qa[2];
        { const int d0 = 8 * g4; float a[8], bb[8];
          unpack8(qraw[rg][0], a);
          unpack8(qraw[rg][1], bb);
          float s = 0.f;
#pragma unroll
          for (int e = 0; e < 8; ++e) s += a[e] * a[e] + bb[e] * bb[e];
          s += __shfl_xor(s, 16); s += __shfl_xor(s, 32);
          const float rstd = 0.125f / sqrtf(s * (1.0f / 64.0f) + EPSF);
          const int pos = pos0 + tb + (lane & 15);
          float o1[8], o2[8];
#pragma unroll
          for (int e = 0; e < 8; ++e) { const float an = a[e] * rstd * F.in[I_GQ][d0 + e], bn = bb[e] * rstd * F.in[I_GQ][32 + d0 + e];
              const f32x2 cs = ROPE[pos * 32 + d0 + e]; o1[e] = an * cs.x - bn * cs.y; o2[e] = bn * cs.x + an * cs.y; }
          qa[0] = __builtin_bit_cast(bf16x8, pack8(o1)); qa[1] = __builtin_bit_cast(bf16x8, pack8(o2)); }
        f32x4 s[12];
#pragma unroll
        for (int jt = 0; jt < 12; ++jt) { const int j = jt >> 2; const LAS unsigned char* kt = lds + (j == 0 ? sl0 : (j == 1 ? sl1 : sl2)) * WR_SLOT;
            f32x4 acc = {0.f, 0.f, 0.f, 0.f};
            acc = MFMA16T(qa[0], lds_frag(kt, LDKW, 16 * (jt & 3), 0, lane), acc);
            acc = MFMA16T(qa[1], lds_frag(kt, LDKW, 16 * (jt & 3), 32, lane), acc);
            if (j < ninv) acc = (f32x4){-1e30f, -1e30f, -1e30f, -1e30f};
            s[jt] = acc;
            if ((jt & 3) == 3) __builtin_amdgcn_sched_barrier(0); }
        float m = sink;
#pragma unroll
        for (int jt = 0; jt < 12; ++jt)
#pragma unroll
            for (int r = 0; r < 4; ++r) m = fmaxf(m, s[jt][r]);
        m = fmaxf(m, __shfl_xor(m, 16)); m = fmaxf(m, __shfl_xor(m, 32));
        float sum = 0.f;
#pragma unroll
        for (int jt = 0; jt < 12; ++jt)
#pragma unroll
            for (int r = 0; r < 4; ++r) { const float e = __expf(s[jt][r] - m); s[jt][r] = e; sum += e; }
        sum += __shfl_xor(sum, 16); sum += __shfl_xor(sum, 32);
        const float inv = 1.0f / (sum + __expf(sink - m));
        bf16x8 pa[6];
#pragma unroll
        for (int k2 = 0; k2 < 6; ++k2) { u32x4 t; t.x = pk2(s[2 * k2][0], s[2 * k2][1]); t.y = pk2(s[2 * k2][2], s[2 * k2][3]); t.z = pk2(s[2 * k2 + 1][0], s[2 * k2 + 1][1]); t.w = pk2(s[2 * k2 + 1][2], s[2 * k2 + 1][3]);
            pa[k2] = __builtin_bit_cast(bf16x8, t); }
#pragma unroll
        for (int dt = 0; dt < 4; ++dt) { f32x4 o = {0.f, 0.f, 0.f, 0.f};
#pragma unroll
            for (int k2 = 0; k2 < 6; ++k2) { const int j = k2 >> 1; const LAS unsigned char* vt = lds + (j == 0 ? sl0 : (j == 1 ? sl1 : sl2)) * WR_SLOT + WR_V;
                o = MFMA16T(pa[k2], lds_frag_tr2(vt, LDVW, 32 * (k2 & 1), 16 * dt, lane), o); }
            const float gv[4] = {__uint_as_float(graw[dt].x << 16), __uint_as_float(graw[dt].x & 0xffff0000u), __uint_as_float(graw[dt].y << 16), __uint_as_float(graw[dt].y & 0xffff0000u)};
            u32x2 pk; pk.x = pk2(o[0] * inv * siluf(gv[0]), o[1] * inv * siluf(gv[1])); pk.y = pk2(o[2] * inv * siluf(gv[2]), o[3] * inv * siluf(gv[3]));
            *(u32x2*)(MIX + row * 2048 + 1024 + hq * 64 + 16 * dt + 4 * g4) = pk;
            __builtin_amdgcn_sched_barrier(0); }
    }
}
DI void winattn_item(Ctx& F, int item) {
    LAS unsigned char* lds = F.lds;
    const int tid = F.tid;
    const bf16_t* PROJ = (const bf16_t*)(F.ws + WS_PROJ);
    if (item >= 256) {
        const int sb = (item - 256) >> 1, kvh = item & 1; const size_t row0 = (size_t)MP + sb * 64;
        const float* ck = F.in[I_CWK] + (size_t)sb * 128 * 128; const float* cv = F.in[I_CWV] + (size_t)sb * 128 * 128;
        float* ko = F.out + O_WKS + (size_t)sb * 128 * 128; float* vo = F.out + O_WVS + (size_t)sb * 128 * 128;
        wa_stage_cache(F, lds + 0 * WR_SLOT, kvh, ck, cv, nullptr, nullptr);
        wa_stage_cache(F, lds + 1 * WR_SLOT, kvh, ck + 64 * 128, cv + 64 * 128, ko, vo);
        if (tid < 256) { const int i = tid >> 2, q4 = tid & 3; const bf16_t* p = PROJ + (row0 + i) * NPROJ + C_K + kvh * 64 + 8 * q4;
            wa_write_k(F, lds + 2 * WR_SLOT, kvh, *(const u32x4*)p, *(const u32x4*)(p + 32), 2048 + i, ko + 64 * 128); }
        { const int i = tid >> 3, q8 = tid & 7; wa_write_v(F, lds + 2 * WR_SLOT, kvh, *(const u32x4*)(PROJ + (row0 + i) * NPROJ + C_V + kvh * 64 + 8 * q8), vo + 64 * 128); }
        __syncthreads();
        wa_compute(F, kvh, row0, 2048, 0, 1, 2, 0);
        __syncthreads();
        return;
    }
    const int b = item >> 4, kvh = (item >> 3) & 1, c0 = (item & 7) * 8;
    const size_t seq0 = (size_t)b * T_P;
#pragma unroll 1
    for (int kc = c0 - 2; kc <= c0; ++kc) { LAS unsigned char* slot = lds + (kc & 3) * WR_SLOT;
        if (kc < 0) { for (int t = tid; t < WR_SLOT / 16; t += 512) *(LAS u32x4*)(slot + t * 16) = (u32x4){0u, 0u, 0u, 0u}; }
        else { const size_t row0 = seq0 + (size_t)kc * 64;
            if (tid < 256) { const int i = tid >> 2, q4 = tid & 3; const bf16_t* p = PROJ + (row0 + i) * NPROJ + C_K + kvh * 64 + 8 * q4;
                wa_write_k(F, slot, kvh, *(const u32x4*)p, *(const u32x4*)(p + 32), kc * 64 + i, nullptr); }
            { const int i = tid >> 3, q8 = tid & 7; wa_write_v(F, slot, kvh, *(const u32x4*)(PROJ + (row0 + i) * NPROJ + C_V + kvh * 64 + 8 * q8), nullptr); } } }
    __syncthreads();
#pragma unroll 1
    for (int c = c0; c < c0 + 8; ++c) {
        const bool more = c + 1 < c0 + 8;
        u32x4 ra = {0u, 0u, 0u, 0u}, rb = {0u, 0u, 0u, 0u}, rv = {0u, 0u, 0u, 0u};
        const size_t nrow0 = seq0 + (size_t)(c + 1) * 64;
        if (more) {
            if (tid < 256) { const bf16_t* p = PROJ + (nrow0 + (tid >> 2)) * NPROJ + C_K + kvh * 64 + 8 * (tid & 3); ra = *(const u32x4*)p; rb = *(const u32x4*)(p + 32); }
            rv = *(const u32x4*)(PROJ + (nrow0 + (tid >> 3)) * NPROJ + C_V + kvh * 64 + 8 * (tid & 7)); }
        wa_compute(F, kvh, seq0 + (size_t)c * 64, c * 64, (c - 2) & 3, (c - 1) & 3, c & 3, c >= 2 ? 0 : 2 - c);
        if (more) { LAS unsigned char* slot = lds + ((c + 1) & 3) * WR_SLOT; const int kc = c + 1;
            float* ko = nullptr; float* vo = nullptr;
            if (kc >= 62) { ko = F.out + O_WKP + ((size_t)b * 128 + (kc - 62) * 64) * 128; vo = F.out + O_WVP + ((size_t)b * 128 + (kc - 62) * 64) * 128; }
            if (tid < 256) wa_write_k(F, slot, kvh, ra, rb, kc * 64 + (tid >> 2), ko);
            wa_write_v(F, slot, kvh, rv, vo); }
        __syncthreads();
    }
}

constexpr int MA_K = 0, MA_V = 69632, MA_RS = 143360, LDKM = 272, LDVM = 288;
DI void memattn_item(Ctx& F, int item) {
    LAS unsigned char* lds = F.lds;
    const int tid = F.tid, lane = F.lane, w = F.wave, g4 = lane >> 4;
    const bool smp = item >= 256; const int sidx = item - 256;
    const int bb = smp ? (sidx >> 2) : (item >> 4), h = smp ? (sidx & 3) : ((item >> 2) & 3), qt = item & 3;
    const bf16_t* PROJ = (const bf16_t*)(F.ws + WS_PROJ); bf16_t* MIX = (bf16_t*)(F.ws + WS_MIX); const bf16_t* RAW = (const bf16_t*)(F.ws + WS_MEMRAW);
#pragma unroll 1
    for (int ib = 0; ib < 2; ++ib) {
      u32x4 rk[4], rvv[4]; f32x4 fk[4][2], fv[4][2];
#pragma unroll
      for (int u = 0; u < 4; ++u) { const int t = tid + 512 * (4 * ib + u), key = t >> 4, ch = t & 15;
        if (smp) { const float* ks = F.in[I_CMK] + ((size_t)(bb * 256 + key) * 4 + h) * 128 + 8 * ch; const float* vs = F.in[I_CMV] + ((size_t)(bb * 256 + key) * 4 + h) * 128 + 8 * ch;
            fk[u][0] = *(const f32x4*)ks; fk[u][1] = *(const f32x4*)(ks + 4); fv[u][0] = *(const f32x4*)vs; fv[u][1] = *(const f32x4*)(vs + 4); }
        else { rk[u] = *(const u32x4*)(RAW + (size_t)(bb * 256 + key) * 1024 + h * 128 + 8 * ch); rvv[u] = *(const u32x4*)(RAW + (size_t)(bb * 256 + key) * 1024 + 512 + h * 128 + 8 * ch); } }
#pragma unroll
      for (int u = 0; u < 4; ++u) { const int t = tid + 512 * (4 * ib + u), key = t >> 4, ch = t & 15;
        float k[8], v[8];
        if (smp) {
#pragma unroll
            for (int e = 0; e < 4; ++e) { k[e] = fk[u][0][e]; k[4 + e] = fk[u][1][e]; v[e] = fv[u][0][e]; v[4 + e] = fv[u][1][e]; } }
        else { unpack8(rk[u], k); unpack8(rvv[u], v); }
        float s = 0.f;
#pragma unroll
        for (int e = 0; e < 8; ++e) s += k[e] * k[e];
        s += __shfl_xor(s, 1); s += __shfl_xor(s, 2); s += __shfl_xor(s, 4); s += __shfl_xor(s, 8);
        if (!smp) { const float rstd = 1.0f / sqrtf(s * (1.0f / 128.0f) + EPSF);
#pragma unroll
            for (int e = 0; e < 8; ++e) k[e] = k[e] * rstd * F.in[I_GMK][8 * ch + e]; }
        { float kq[8];
#pragma unroll
          for (int e = 0; e < 8; ++e) kq[e] = k[e] * F.in[I_GMQ][8 * ch + e];
          *(LAS u32x4*)(lds + MA_K + key * LDKM + ch * 16) = pack8(kq); }
        *(LAS u32x4*)(lds + MA_V + key * LDVM + ch * 16) = pack8(v);
        if (!smp && qt == 0) {
            float* ko = F.out + O_MKP + ((size_t)(bb * 256 + key) * 4 + h) * 128 + 8 * ch; float* vo = F.out + O_MVP + ((size_t)(bb * 256 + key) * 4 + h) * 128 + 8 * ch;
            *(f32x4*)ko = (f32x4){k[0], k[1], k[2], k[3]}; *(f32x4*)(ko + 4) = (f32x4){k[4], k[5], k[6], k[7]};
            *(f32x4*)vo = (f32x4){v[0], v[1], v[2], v[3]}; *(f32x4*)(vo + 4) = (f32x4){v[4], v[5], v[6], v[7]}; }
      }
    }
    __syncthreads();
    const int ngr = smp ? 4 : 64;
    const size_t qbase = smp ? (size_t)MP + bb * 64 : (size_t)bb * T_P + qt * 1024;
    u32x4 nq[4]; u32x2 ng[8];
#define MA_LOAD(rg_) do { const size_t r_ = qbase + 16 * (rg_) + (lane & 15); \
        _Pragma("unroll") for (int ks = 0; ks < 4; ++ks) nq[ks] = *(const u32x4*)(PROJ + r_ * NPROJ + C_MQ + h * 128 + 32 * ks + 8 * g4); \
        _Pragma("unroll") for (int dt = 0; dt < 8; ++dt) ng[dt] = *(const u32x2*)(PROJ + r_ * NPROJ + C_GM + h * 128 + 16 * dt + 4 * g4); } while (0)
    if (w < ngr) MA_LOAD(w);
#pragma unroll 1
    for (int rg = w; rg < ngr; rg += 8) {
        u32x4 cq[4]; u32x2 cg[8];
#pragma unroll
        for (int ks = 0; ks < 4; ++ks) cq[ks] = nq[ks];
#pragma unroll
        for (int dt = 0; dt < 8; ++dt) cg[dt] = ng[dt];
        if (rg + 8 < ngr) MA_LOAD(rg + 8);
        bf16x8 qa[4];
        { float q[4][8]; float s = 0.f;
#pragma unroll
          for (int ks = 0; ks < 4; ++ks) { unpack8(cq[ks], q[ks]);
#pragma unroll
              for (int e = 0; e < 8; ++e) s += q[ks][e] * q[ks][e]; }
          s += __shfl_xor(s, 16); s += __shfl_xor(s, 32);
          const float rstd = 0.08838834764831845f / sqrtf(s * (1.0f / 128.0f) + EPSF);
#pragma unroll
          for (int ks = 0; ks < 4; ++ks) {
#pragma unroll
              for (int e = 0; e < 8; ++e) q[ks][e] = q[ks][e] * rstd;
              qa[ks] = __builtin_bit_cast(bf16x8, pack8(q[ks])); } }
        f32x4 s[16];
#pragma unroll
        for (int jt = 0; jt < 16; ++jt) { f32x4 acc = {0.f, 0.f, 0.f, 0.f};
#pragma unroll
            for (int ks = 0; ks < 4; ++ks) acc = MFMA16T(qa[ks], lds_frag(lds + MA_K, LDKM, 16 * jt, 32 * ks, lane), acc);
            s[jt] = acc;
            if ((jt & 3) == 3) __builtin_amdgcn_sched_barrier(0); }
        float m = s[0][0];
#pragma unroll
        for (int jt = 0; jt < 16; ++jt)
#pragma unroll
            for (int r = 0; r < 4; ++r) m = fmaxf(m, s[jt][r]);
        m = fmaxf(m, __shfl_xor(m, 16)); m = fmaxf(m, __shfl_xor(m, 32));
        float sum = 0.f;
#pragma unroll
        for (int jt = 0; jt < 16; ++jt)
#pragma unroll
            for (int r = 0; r < 4; ++r) { const float e = __expf(s[jt][r] - m); s[jt][r] = e; sum += e; }
        sum += __shfl_xor(sum, 16); sum += __shfl_xor(sum, 32);
        const float inv = 1.0f / sum;
        bf16x8 pa[8];
#pragma unroll
        for (int k2 = 0; k2 < 8; ++k2) { u32x4 t; t.x = pk2(s[2 * k2][0], s[2 * k2][1]); t.y = pk2(s[2 * k2][2], s[2 * k2][3]); t.z = pk2(s[2 * k2 + 1][0], s[2 * k2 + 1][1]); t.w = pk2(s[2 * k2 + 1][2], s[2 * k2 + 1][3]);
            pa[k2] = __builtin_bit_cast(bf16x8, t); }
        const size_t orow = qbase + 16 * rg + (lane & 15);
#pragma unroll
        for (int dt = 0; dt < 8; ++dt) { f32x4 o = {0.f, 0.f, 0.f, 0.f};
#pragma unroll
            for (int k2 = 0; k2 < 8; ++k2) o = MFMA16T(pa[k2], lds_frag_tr2(lds + MA_V, LDVM, 32 * k2, 16 * dt, lane), o);
            __builtin_amdgcn_sched_barrier(0);
            const int col = h * 128 + 16 * dt + 4 * g4;
            const u32x2 gr = cg[dt];
            const float gv[4] = {__uint_as_float(gr.x << 16), __uint_as_float(gr.x & 0xffff0000u), __uint_as_float(gr.y << 16), __uint_as_float(gr.y & 0xffff0000u)};
            u32x2 pk; pk.x = pk2(o[0] * inv * siluf(gv[0]), o[1] * inv * siluf(gv[1])); pk.y = pk2(o[2] * inv * siluf(gv[2]), o[3] * inv * siluf(gv[3]));
            *(u32x2*)(MIX + orow * 2048 + 1536 + col) = pk; }
    }
#undef MA_LOAD
    __syncthreads();
}

DI void p2a_attn(Ctx& F) {
    for (int rep = 0; rep < REP_WIN; ++rep)
    for (int it = F.bid; it < 320; it += F.G) winattn_item(F, it);
    __syncthreads();
    for (int rep = 0; rep < REP_MEM; ++rep)
    { for (int it = F.bid; it < 256; it += F.G) memattn_item(F, it);
      for (int s = (F.bid + F.G - (128 % F.G)) % F.G; s < 128; s += F.G) memattn_item(F, 256 + s); }
}
DI void p2b_phase(Ctx& F) {
    for (int rep = 0; rep < REP_SSD; ++rep)
    for (int it = F.bid; it < 48 * 16; it += F.G) ssd_item(F, it >> 4, it & 15, rep == 0);
}

constexpr int G2_A = 0, G2_B = 9216, G2_SET = 27648;
DI void gemm2_sample(Ctx& F) {
    LAS unsigned char* lds = F.lds;
    const int tid = F.tid, lane = F.lane, w = F.wave, g4 = lane >> 4;
    const bf16_t* MIX = (const bf16_t*)(F.ws + WS_MIX); const bf16_t* WOT = (const bf16_t*)(F.ws + WS_WOUT); const float* SUMSQ = (const float*)(F.ws + WS_SSQ);
    for (int tile = F.bid; tile < 256; tile += F.G) {
        const int r0 = MP + 64 * (tile >> 3), c0 = 128 * (tile & 7);
        const bf16_t* asrc = MIX + (size_t)(r0 + (tid >> 3)) * 2048 + 8 * (tid & 7);
        const bf16_t* bsrc0 = WOT + (size_t)(c0 + (tid >> 3)) * 2048 + 8 * (tid & 7);
        const bf16_t* bsrc1 = bsrc0 + (size_t)64 * 2048;
        const int aoff = G2_A + (tid >> 3) * 144 + (tid & 7) * 16, boff0 = G2_B + (tid >> 3) * 144 + (tid & 7) * 16, boff1 = boff0 + 64 * 144;
        f32x4 acc[4] = {{0.f, 0.f, 0.f, 0.f}, {0.f, 0.f, 0.f, 0.f}, {0.f, 0.f, 0.f, 0.f}, {0.f, 0.f, 0.f, 0.f}};
        u32x4 ra[4], rb0[4], rb1[4];
#pragma unroll
        for (int j = 0; j < 4; ++j) { ra[j] = *(const u32x4*)(asrc + 64 * j); rb0[j] = *(const u32x4*)(bsrc0 + 64 * j); rb1[j] = *(const u32x4*)(bsrc1 + 64 * j); }
        *(LAS u32x4*)(lds + aoff) = ra[0]; *(LAS u32x4*)(lds + boff0) = rb0[0]; *(LAS u32x4*)(lds + boff1) = rb1[0];
        ra[0] = *(const u32x4*)(asrc + 64 * 4); rb0[0] = *(const u32x4*)(bsrc0 + 64 * 4); rb1[0] = *(const u32x4*)(bsrc1 + 64 * 4);
        __syncthreads();
#pragma unroll 1
        for (int kt4 = 0; kt4 < 32; kt4 += 4) {
#pragma unroll
            for (int u = 0; u < 4; ++u) { const int kt = kt4 + u;
                const LAS unsigned char* cs = lds + (u & 1) * G2_SET; LAS unsigned char* ns = lds + ((u + 1) & 1) * G2_SET;
                if (kt == 16) { const float r = 1.0f / sqrtf(SUMSQ[r0 + 16 * (w >> 1) + (lane & 15)] * (1.0f / 1024.0f) + EPSF);
#pragma unroll
                    for (int t = 0; t < 4; ++t) acc[t] = acc[t] * r; }
#pragma unroll
                for (int ks = 0; ks < 2; ++ks) { const bf16x8 a = lds_frag(cs + G2_A, 144, 16 * (w >> 1), 32 * ks, lane);
#pragma unroll
                    for (int t = 0; t < 4; ++t) acc[t] = MFMA16T(a, lds_frag(cs + G2_B, 144, 64 * (w & 1) + 16 * t, 32 * ks, lane), acc[t]); }
                constexpr int dummy_ = 0; (void)dummy_;
                const int rs = (u + 1) & 3;
                if (kt + 1 < 32) { *(LAS u32x4*)(ns + aoff) = ra[rs]; *(LAS u32x4*)(ns + boff0) = rb0[rs]; *(LAS u32x4*)(ns + boff1) = rb1[rs]; }
                if (kt + 5 < 32) { ra[rs] = *(const u32x4*)(asrc + 64 * (kt + 5)); rb0[rs] = *(const u32x4*)(bsrc0 + 64 * (kt + 5)); rb1[rs] = *(const u32x4*)(bsrc1 + 64 * (kt + 5)); }
                __syncthreads();
            }
        }
        const int row = r0 + 16 * (w >> 1) + (lane & 15), cw = c0 + 64 * (w & 1) + 4 * g4;
        const float* xr = F.in[I_XS] + (size_t)(row - MP) * DM + cw; float* orow = F.out + (size_t)row * DM + cw;
#pragma unroll
        for (int t = 0; t < 4; ++t) *(f32x4*)(orow + 16 * t) = acc[t] + *(const f32x4*)(xr + 16 * t);
    }
}
__global__ void __launch_bounds__(512, 2) hymba_fwd(Args args) {
    extern __shared__ __attribute__((aligned(16))) unsigned char lds_raw[];
    cg::grid_group grid = cg::this_grid();
    Ctx F;
    F.lds = (LAS unsigned char*)lds_raw; F.tid = threadIdx.x; F.lane = F.tid & 63; F.wave = __builtin_amdgcn_readfirstlane(F.tid >> 6); F.G = gridDim.x; F.bid = blockIdx.x;
#pragma unroll
    for (int i = 0; i < 26; ++i) F.in[i] = args.in[i];
    F.out = args.out; F.ws = args.ws;
    volatile LAS unsigned* bst = (volatile LAS unsigned*)(F.lds + LDS_BYTES - 64);
    if (F.tid < 16) bst[F.tid] = 0u;
    __syncthreads();
    const XcdBarrier xbar = xcd_barrier_post((unsigned*)(F.ws + WS_CTL), bst);
#define GRID_BAR() xcd_barrier(xbar)

#define PHASE_FENCE() do { int t_ = threadIdx.x; asm volatile("" : "+v"(t_)); F.tid = t_; F.lane = t_ & 63; F.wave = __builtin_amdgcn_readfirstlane(t_ >> 6); } while (0)
    for (int rep = 0; rep < REP_P0; ++rep) { if (rep) __syncthreads(); p0_prologue(F); }
    GRID_BAR(); PHASE_FENCE();
    {
        pg8::Gemm g{(const bf16_t*)(F.ws + WS_A), (const bf16_t*)(F.ws + WS_BT), MA, NBT, 1024};
        Order1 S; S.init(F.G, F.bid);
        EpiProj E{(bf16_t*)(F.ws + WS_PROJ), (bf16_t*)(F.ws + WS_MEMRAW)};
        pg8::gemm_phase<EpiProj, Order1, true, true>(F.lds, g, S, E);
    }
    GRID_BAR(); PHASE_FENCE();
    for (int rep = 0; rep < REP_P2A; ++rep) p2a_phase(F);
    __syncthreads();
    p2a_attn(F);
    grid.sync(); PHASE_FENCE();
    p2b_phase(F);
    GRID_BAR(); PHASE_FENCE();
    gemm2_sample(F);
    {
        pg8::Gemm g{(const bf16_t*)(F.ws + WS_MIX), (const bf16_t*)(F.ws + WS_WOUT), MTOT, 1024, 2048};
        Order3 S; S.init(F.G, F.bid);
        EpiOut E{F.in[I_XP], F.in[I_XS], F.out, (const float*)(F.ws + WS_SSQ)};
        pg8::gemm_phase<EpiOut, Order3, true, true>(F.lds, g, S, E);
    }
#if DBG_SCALE3 || DBG_ZERO
    grid.sync();
    {
        const size_t offs[13] = {O_Y, (size_t)MP * 1024, O_WKP, O_WVP, O_SSMP, O_CONVP, O_MKP, O_MVP, O_WKS, O_WVS, O_SSMS, O_CONVS, O_END};
        for (int o = 0; o < 12; ++o) {
            const bool z = (DBG_ZERO >> o) & 1, s3 = (DBG_SCALE3 >> o) & 1;
            if (!z && !s3) continue;
            for (size_t i = offs[o] + (size_t)F.bid * 512 + F.tid; i < offs[o + 1]; i += (size_t)F.G * 512) F.out[i] = z ? 0.f : F.out[i] * 3.0f;
        }
    }
#endif
}

extern "C" void kernel_launch(void* const* d_in, const int* in_sizes, int n_in, void* d_out, int out_size, void* d_ws, size_t ws_size, hipStream_t stream) {
    static int grid = 0;
    if (grid == 0) {
        if (n_in != 26 || (size_t)out_size != O_END || ws_size < WS_END) { fprintf(stderr, "kernel_launch: unexpected problem (n_in %d out %d ws %zu)\n", n_in, out_size, ws_size); grid = -1; return; }
        int dev = 0, cus = 0, per_cu = 0;
        if (hipGetDevice(&dev) != hipSuccess || hipDeviceGetAttribute(&cus, hipDeviceAttributeMultiprocessorCount, dev) != hipSuccess) { grid = -1; return; }
        if (hipFuncSetAttribute((const void*)hymba_fwd, hipFuncAttributeMaxDynamicSharedMemorySize, LDS_BYTES) != hipSuccess) { fprintf(stderr, "kernel_launch: hipFuncSetAttribute failed\n"); grid = -1; return; }
        if (hipOccupancyMaxActiveBlocksPerMultiprocessor(&per_cu, (const void*)hymba_fwd, 512, LDS_BYTES) != hipSuccess || per_cu < 1) { fprintf(stderr, "kernel_launch: occupancy query says %d\n", per_cu); (void)hipGetLastError(); grid = -1; return; }
        grid = cus;
        fprintf(stderr, "kernel_launch: %d CUs, occupancy %d per CU, grid %d\n", cus, per_cu, grid);
    }
    if (grid < 0) return;
    Args a{};
    for (int i = 0; i < 26; ++i) a.in[i] = (const float*)d_in[i];
    a.out = (float*)d_out; a.ws = (unsigned char*)d_ws;
    if (hipMemsetAsync((char*)d_ws + WS_CTL, 0, CTL_ZERO_BYTES, stream) != hipSuccess) { fprintf(stderr, "kernel_launch: memset of the barrier words failed\n"); return; }
    void* kargs[] = {&a};
    const hipError_t e = hipLaunchCooperativeKernel((const void*)hymba_fwd, dim3(grid), dim3(512), kargs, LDS_BYTES, stream);
    if (e != hipSuccess) fprintf(stderr, "kernel_launch: cooperative launch failed: %s\n", hipGetErrorString(e));
}
```

```cpp
#include <hip/hip_runtime.h>
#include <hip/hip_cooperative_groups.h>
#include <cstdio>
#include <cstdint>
namespace cg = cooperative_groups;
namespace pg8 {
#define PG8_LAS __attribute__((address_space(3)))
typedef unsigned short bf16_t;
typedef short bf16x8 __attribute__((ext_vector_type(8)));
typedef float f32x4 __attribute__((ext_vector_type(4)));
typedef unsigned u32x4 __attribute__((ext_vector_type(4)));
constexpr int BM = 256, BK = 64, HALF = 128, HTB = HALF * BK * 2  , STAGE_BYTES = 8 * HTB, NXCD = 8, WGM = 8;

__host__ __device__ __forceinline__ int lds_byte(int r, int c) { const int st = (r >> 4) * 2 + (c >> 5), rr = r & 15, cc = c & 31, ob = rr * 64 + cc * 2; return st * 1024 + (ob ^ (((ob >> 9) & 1) << 5)); }
__host__ __device__ __forceinline__ void stage_rc(int b, int& R, int& C) { const int st = b / 1024, sb = b % 1024, swz = sb ^ (((sb >> 9) & 1) << 5); R = (st >> 1) * 16 + swz / 64; C = (st & 1) * 32 + (swz % 64) / 2; }
__host__ __device__ __forceinline__ int perm32(int rho) { const int n = rho >> 4, i = rho & 15; return 8 * (i >> 2) + 4 * n + (i & 3); }

struct Unit { int pm, pn; };
struct Gemm { const bf16_t* A; const bf16_t* Bt; int M, N, K; };

struct StaticOrder {
    int nM, nN, nwg, G, c;
    __host__ __device__ void init(int M, int N, int G_, int c_) { nM = M / BM; nN = N / BM; nwg = nM * nN; G = G_; c = c_; }
    __host__ __device__ bool next(int i, Unit& u) const {
        const long L = (long)i * G + c; if (L >= nwg) return false;
        int wgid = (int)L; { const int q = nwg / NXCD, r = nwg % NXCD, xcd = wgid % NXCD, off = wgid / NXCD; wgid = (xcd < r ? xcd * (q + 1) : r * (q + 1) + (xcd - r) * q) + off; }
        const int nig = WGM * nN, gid = wgid / nig, fm = gid * WGM, gsz = (nM - fm) < WGM ? (nM - fm) : WGM;
        u.pm = fm + ((wgid % nig) % gsz); u.pn = (wgid % nig) / gsz; return true;
    }
    __device__ __forceinline__ void a_ready(const Unit&) const {}
    __device__ __forceinline__ void done(const Unit&) const {}
};

template <class Epi, class Sched, bool ALIGN_EPI = false, bool SP2 = false>
__device__ __forceinline__ void gemm_phase(PG8_LAS unsigned char* lds, const Gemm g, const Sched& S, const Epi& E) {
    int tid_ = threadIdx.x; asm volatile("" : "+v"(tid_));
    const int tid = tid_, wid = __builtin_amdgcn_readfirstlane(tid >> 6), lane = tid & 63, wr = wid >> 2, wc = wid & 3, fr = lane & 15, fq = lane >> 4;
    const int K = g.K, nt = K / BK;
    unsigned voffA[2], voffB[2];
#pragma unroll
    for (int i = 0; i < 2; ++i) { int R, C; stage_rc(tid * 16 + i * 8192, R, C); const int Rb = Epi::PERM ? ((R & ~31) + perm32(R & 31)) : R;
        voffA[i] = (unsigned)(R * K + C) * 2u; voffB[i] = (unsigned)(Rb * K + C) * 2u; }
    const size_t kstep = (size_t)(BK * 2);
    const size_t hstep = (size_t)HALF * K * 2;
    const size_t tstep = 2 * hstep;
    const unsigned ldsw = (unsigned)wid * 1024u;
    const int aoff = lds_byte(wr * 64 + fr, fq * 8), boff = lds_byte(wc * 32 + fr, fq * 8);
#define PG8_SA(b, h) (((b) * 2 + (h)) * HTB)
#define PG8_SB(b, h) ((4 + (b) * 2 + (h)) * HTB)
#define PG8_STAGE(bufoff, gbase, voff) do { _Pragma("unroll") for (int _i = 0; _i < 2; ++_i) \
        __builtin_amdgcn_global_load_lds((const unsigned*)((const char*)(gbase) + (voff)[_i]), (PG8_LAS unsigned*)(lds + (bufoff) + ldsw + _i * 8192), 16, 0, 0); } while (0)
#define PG8_LDA(dst, b, h) do { _Pragma("unroll") for (int m = 0; m < 4; ++m) _Pragma("unroll") for (int k = 0; k < 2; ++k) dst[m][k] = *(const PG8_LAS bf16x8*)(lds + PG8_SA(b, h) + aoff + m * 2048 + k * 1024); } while (0)
#define PG8_LDB(dst, b, h) do { _Pragma("unroll") for (int n = 0; n < 2; ++n) _Pragma("unroll") for (int k = 0; k < 2; ++k) dst[n][k] = *(const PG8_LAS bf16x8*)(lds + PG8_SB(b, h) + boff + n * 2048 + k * 1024); } while (0)
#define PG8_MMA(ai, bj, At, Bt) do { __builtin_amdgcn_s_setprio(1); _Pragma("unroll") for (int m = 0; m < 4; ++m) _Pragma("unroll") for (int n = 0; n < 2; ++n) _Pragma("unroll") for (int k = 0; k < 2; ++k) \
        acc[ai][bj][m][n] = __builtin_amdgcn_mfma_f32_16x16x32_bf16(Bt[n][k], At[m][k], acc[ai][bj][m][n], 0, 0, 0); __builtin_amdgcn_s_setprio(0); } while (0)
#define PG8_WAIT_V(n) asm volatile("s_waitcnt vmcnt(" #n ")" ::: "memory")
#define PG8_WAIT_L(n) asm volatile("s_waitcnt lgkmcnt(" #n ")" ::: "memory")
#define PG8_BAR __builtin_amdgcn_s_barrier()
#define PG8_SCHED __builtin_amdgcn_sched_barrier(0)
    Unit cur, nxt; int ui = 0;
    if (!S.next(0, cur)) return;
    f32x4 acc[2][2][4][2];
#pragma unroll
    for (int a = 0; a < 2; ++a)
#pragma unroll
        for (int b = 0; b < 2; ++b)
#pragma unroll
            for (int m = 0; m < 4; ++m)
#pragma unroll
                for (int n = 0; n < 2; ++n) acc[a][b][m][n] = (f32x4){0.f, 0.f, 0.f, 0.f};
    bf16x8 At[4][2], B0[2][2], B1[2][2];
    const char* cA = (const char*)g.A + (size_t)cur.pm * tstep; const char* cB = (const char*)g.Bt + (size_t)cur.pn * tstep;
    S.a_ready(cur);
    if constexpr (SP2) {
        PG8_STAGE(PG8_SB(0, 0), cB, voffB); PG8_STAGE(PG8_SB(0, 1), cB + hstep, voffB); PG8_STAGE(PG8_SA(0, 0), cA, voffA); PG8_STAGE(PG8_SA(0, 1), cA + hstep, voffA);
        if (wr == 1) PG8_BAR;
        PG8_WAIT_V(2); PG8_BAR;
        PG8_STAGE(PG8_SB(1, 0), cB + kstep, voffB); PG8_STAGE(PG8_SA(1, 0), cA + kstep, voffA); PG8_STAGE(PG8_SB(1, 1), cB + hstep + kstep, voffB);
        PG8_WAIT_V(6); PG8_BAR;
    } else {
        PG8_STAGE(PG8_SB(0, 0), cB, voffB); PG8_STAGE(PG8_SA(0, 0), cA, voffA); PG8_STAGE(PG8_SB(0, 1), cB + hstep, voffB); PG8_STAGE(PG8_SA(0, 1), cA + hstep, voffA);
        if (wr == 1) PG8_BAR;
        PG8_WAIT_V(4); PG8_BAR;
        PG8_STAGE(PG8_SB(1, 0), cB + kstep, voffB); PG8_STAGE(PG8_SA(1, 0), cA + kstep, voffA); PG8_STAGE(PG8_SB(1, 1), cB + hstep + kstep, voffB);
        PG8_WAIT_V(6); PG8_BAR;
    }
    for (;;) {
        const bool has_next = S.next(ui + 1, nxt);
        const char* nA = has_next ? (const char*)g.A + (size_t)nxt.pm * tstep : cA; const char* nB = has_next ? (const char*)g.Bt + (size_t)nxt.pn * tstep : cB;
        for (int t = 0; t < nt; t += 2) {
            const bool last = (t == nt - 2);
            const char* a1 = cA + (size_t)(t + 1) * kstep;
            const char* a2 = last ? nA : cA + (size_t)(t + 2) * kstep; const char* b2 = last ? nB : cB + (size_t)(t + 2) * kstep;
            const char* a3 = a2 + kstep; const char* b3 = b2 + kstep;
            if (last && has_next) S.a_ready(nxt);
            if constexpr (Epi::MIDK > 0) { if (t == Epi::MIDK) E.mid(acc, cur, wr, wc, fr, fq); }
            if constexpr (SP2) {
            PG8_LDB(B0, 0, 0); PG8_LDB(B1, 0, 1); PG8_SCHED; PG8_LDA(At, 0, 0); PG8_STAGE(PG8_SA(1, 1), a1 + hstep, voffA);
            PG8_WAIT_V(8); PG8_WAIT_L(0); PG8_BAR; PG8_MMA(0, 0, At, B0); PG8_MMA(0, 1, At, B1); PG8_BAR; PG8_SCHED;
            PG8_LDA(At, 0, 1); PG8_STAGE(PG8_SB(0, 0), b2, voffB); PG8_STAGE(PG8_SB(0, 1), b2 + hstep, voffB); PG8_STAGE(PG8_SA(0, 0), a2, voffA);
            PG8_WAIT_V(8); PG8_WAIT_L(0); PG8_BAR; PG8_MMA(1, 0, At, B0); PG8_MMA(1, 1, At, B1); PG8_BAR; PG8_SCHED;
            PG8_LDB(B0, 1, 0); PG8_LDB(B1, 1, 1); PG8_SCHED; PG8_LDA(At, 1, 0); PG8_STAGE(PG8_SA(0, 1), a2 + hstep, voffA);
            PG8_WAIT_V(8); PG8_WAIT_L(0); PG8_BAR; PG8_MMA(0, 0, At, B0); PG8_MMA(0, 1, At, B1); PG8_BAR; PG8_SCHED;
            PG8_LDA(At, 1, 1); PG8_STAGE(PG8_SB(1, 0), b3, voffB); PG8_STAGE(PG8_SB(1, 1), b3 + hstep, voffB); PG8_STAGE(PG8_SA(1, 0), a3, voffA);
            PG8_WAIT_V(8); PG8_WAIT_L(0); PG8_BAR; PG8_MMA(1, 0, At, B0); PG8_MMA(1, 1, At, B1); PG8_BAR; PG8_SCHED;
            } else {
            PG8_LDB(B0, 0, 0); PG8_SCHED; PG8_LDA(At, 0, 0); PG8_STAGE(PG8_SA(1, 1), a1 + hstep, voffA);
            PG8_WAIT_L(8); PG8_BAR; PG8_WAIT_L(0); PG8_MMA(0, 0, At, B0); PG8_BAR; PG8_SCHED;
            PG8_LDB(B1, 0, 1); PG8_STAGE(PG8_SB(0, 0), b2, voffB);
            PG8_BAR; PG8_WAIT_L(0); PG8_MMA(0, 1, At, B1); PG8_BAR;
            PG8_LDA(At, 0, 1); PG8_STAGE(PG8_SA(0, 0), a2, voffA);
            PG8_BAR; PG8_WAIT_L(0); PG8_MMA(1, 0, At, B0); PG8_BAR; PG8_SCHED;
            PG8_STAGE(PG8_SB(0, 1), b2 + hstep, voffB);
            PG8_WAIT_V(6); PG8_BAR; PG8_MMA(1, 1, At, B1); PG8_BAR;
            PG8_LDB(B0, 1, 0); PG8_SCHED; PG8_LDA(At, 1, 0); PG8_STAGE(PG8_SA(0, 1), a2 + hstep, voffA);
            PG8_WAIT_L(8); PG8_BAR; PG8_WAIT_L(0); PG8_MMA(0, 0, At, B0); PG8_BAR; PG8_SCHED;
            PG8_LDB(B1, 1, 1); PG8_STAGE(PG8_SB(1, 0), b3, voffB);
            PG8_BAR; PG8_WAIT_L(0); PG8_MMA(0, 1, At, B1); PG8_BAR;
            PG8_LDA(At, 1, 1); PG8_STAGE(PG8_SA(1, 0), a3, voffA);
            PG8_BAR; PG8_WAIT_L(0); PG8_MMA(1, 0, At, B0); PG8_BAR; PG8_SCHED;
            PG8_STAGE(PG8_SB(1, 1), b3 + hstep, voffB);
            PG8_WAIT_V(6); PG8_BAR; PG8_MMA(1, 1, At, B1); PG8_BAR;
            }
        }
        if constexpr (ALIGN_EPI) { if (wr == 0) PG8_BAR; }
        if constexpr (!Epi::AFTER_DRAIN) { E(acc, cur, wr, wc, fr, fq); S.done(cur); }
        if (!has_next) break;
#pragma unroll
        for (int a = 0; a < 2; ++a)
#pragma unroll
            for (int b = 0; b < 2; ++b)
#pragma unroll
                for (int m = 0; m < 4; ++m)
#pragma unroll
                    for (int n = 0; n < 2; ++n) acc[a][b][m][n] = (f32x4){0.f, 0.f, 0.f, 0.f};
        cur = nxt; cA = nA; cB = nB; ++ui;
        if constexpr (ALIGN_EPI) { if (wr == 1) PG8_BAR; }
    }
    PG8_WAIT_V(0);
    if constexpr (!ALIGN_EPI) { if (wr == 0) PG8_BAR; }
    PG8_BAR;
    if constexpr (Epi::AFTER_DRAIN) { E.fused(acc, cur, wr, wc, fr, fq, lds, wid, lane); S.done(cur); }
#undef PG8_SA
#undef PG8_SB
#undef PG8_STAGE
#undef PG8_LDA
#undef PG8_LDB
#undef PG8_MMA
#undef PG8_WAIT_V
#undef PG8_WAIT_L
#undef PG8_BAR
#undef PG8_SCHED
}
}
#ifndef DBG_SCALE3
#define DBG_SCALE3 0
#endif
#ifndef DBG_ZERO
#define DBG_ZERO 0
#endif
#ifndef LAST_PHASE
#define LAST_PHASE 4
#endif
#ifndef REP_P0
#define REP_P0 1
#endif
#ifndef REP_P1
#define REP_P1 1
#endif
#ifndef REP_P2A
#define REP_P2A 1
#endif
#ifndef REP_P0T
#define REP_P0T 1
#endif
#ifndef REP_P0R
#define REP_P0R 1
#endif
#ifndef REP_S2
#define REP_S2 1
#endif
#ifndef REP_S3
#define REP_S3 1
#endif
#ifndef REP_S4
#define REP_S4 1
#endif
#ifndef REP_ATOM
#define REP_ATOM 1
#endif
#ifndef REP_SSD
#define REP_SSD 1
#endif
#ifndef REP_WIN
#define REP_WIN 1
#endif
#ifndef REP_MEM
#define REP_MEM 1
#endif
#ifndef REP_P3
#define REP_P3 1
#endif
#define DI __device__ __forceinline__
#define LAS __attribute__((address_space(3)))
typedef unsigned short bf16_t;
typedef short bf16x8 __attribute__((ext_vector_type(8)));
typedef float f32x4 __attribute__((ext_vector_type(4)));
typedef float f32x2 __attribute__((ext_vector_type(2)));
typedef unsigned u32x4 __attribute__((ext_vector_type(4)));
typedef unsigned u32x2 __attribute__((ext_vector_type(2)));

constexpr int NB_P = 16, T_P = 4096, NB_S = 32, T_S = 64, DM = 1024;
constexpr int MP = NB_P * T_P, MS = NB_S * T_S, MTOT = MP + MS;
constexpr int MMEM = NB_P * 256, MA = MTOT + MMEM;
constexpr int NPROJ = 4864, NBT = NPROJ + 1024, INC = 4880;
constexpr int C_Q = 0, C_K = 512, C_V = 640, C_GA = 768, C_Z = 1280, C_XBC = 2304, C_MQ = 3840, C_GM = 4352;
constexpr int NCHUNK = MTOT / 64;
constexpr float EPSF = 1e-6f;
constexpr size_t O_Y = 0;
constexpr size_t O_WKP = (size_t)MTOT * 1024;
constexpr size_t O_WVP = O_WKP + (size_t)NB_P * 128 * 128;
constexpr size_t O_SSMP = O_WVP + (size_t)NB_P * 128 * 128;
constexpr size_t O_CONVP = O_SSMP + (size_t)NB_P * 16 * 64 * 128;
constexpr size_t O_MKP = O_CONVP + (size_t)NB_P * 3 * 1536;
constexpr size_t O_MVP = O_MKP + (size_t)NB_P * 256 * 512;
constexpr size_t O_WKS = O_MVP + (size_t)NB_P * 256 * 512;
constexpr size_t O_WVS = O_WKS + (size_t)NB_S * 128 * 128;
constexpr size_t O_SSMS = O_WVS + (size_t)NB_S * 128 * 128;
constexpr size_t O_CONVS = O_SSMS + (size_t)NB_S * 16 * 64 * 128;
constexpr size_t O_END = O_CONVS + (size_t)NB_S * 3 * 1536;
static_assert(O_END == 81485824, "output size");
constexpr size_t MiB = 1u << 20;
constexpr size_t WS_ROPE = 1 * MiB;
constexpr size_t WS_BT = 2 * MiB;
constexpr size_t WS_WOUT = 14 * MiB;
constexpr size_t WS_DT = 18 * MiB;
constexpr size_t WS_SSQ = 23 * MiB;
constexpr size_t WS_CTL = 0, CTL_ZERO_BYTES = 65536;
constexpr size_t WS_MEMRAW = 32 * MiB;
constexpr size_t WS_MEMK = 40 * MiB;
constexpr size_t WS_MEMVT = 52 * MiB;
constexpr size_t WS_PROJ = 64 * MiB;
constexpr size_t WS_A = 692 * MiB;
constexpr size_t WS_MIX = 692 * MiB;
constexpr size_t WS_BCC = 956 * MiB;
constexpr size_t WS_END = 1022 * MiB;
static_assert(WS_BT + (size_t)NBT * 1024 * 2 <= WS_WOUT && WS_DT + (size_t)MTOT * 64 <= WS_SSQ && WS_SSQ + (size_t)MTOT * 128 <= WS_MEMRAW, "ws map 1");
static_assert(WS_PROJ + (size_t)MTOT * NPROJ * 2 <= WS_A && WS_A + (size_t)MA * 1024 * 2 <= WS_END && WS_MIX + (size_t)MTOT * 2048 * 2 <= WS_BCC && WS_BCC + (size_t)MTOT * 512 * 2 <= WS_END, "ws map 2");
constexpr int LDS_BYTES = 147456;

DI float bf2f(unsigned short b) { return __uint_as_float((unsigned)b << 16); }
typedef __bf16 hbf2 __attribute__((ext_vector_type(2)));
DI unsigned short f2bf(float f) { return __builtin_bit_cast(unsigned short, (__bf16)f); }
DI unsigned pk2(float lo, float hi) { const f32x2 v = {lo, hi}; return __builtin_bit_cast(unsigned, __builtin_convertvector(v, hbf2)); }
DI unsigned cvt_pk_bf16(float lo, float hi) { return pk2(lo, hi); }
DI float siluf(float x) { return x * __builtin_amdgcn_rcpf(1.0f + __expf(-x)); }
DI float wave_sum(float v) {
#pragma unroll
    for (int o = 1; o < 64; o <<= 1) v += __shfl_xor(v, o);
    return v;
}
DI void unpack8(const u32x4 v, float (&o)[8]) {
#pragma unroll
    for (int i = 0; i < 4; ++i) { o[2 * i] = __uint_as_float(v[i] << 16); o[2 * i + 1] = __uint_as_float(v[i] & 0xffff0000u); }
}
DI u32x4 pack8(const float (&o)[8]) { u32x4 v; v.x = pk2(o[0], o[1]); v.y = pk2(o[2], o[3]); v.z = pk2(o[4], o[5]); v.w = pk2(o[6], o[7]); return v; }
#define LDS_WAIT() asm volatile("s_waitcnt lgkmcnt(0)" ::: "memory")
#define MFMA16(a, b, c) __builtin_amdgcn_mfma_f32_16x16x32_bf16((a), (b), (c), 0, 0, 0)

struct Args { const float* in[26]; float* out; unsigned char* ws; };
struct Ctx {
    LAS unsigned char* lds; int tid, lane, wave, G, bid;
    const float* in[26]; float* out; unsigned char* ws;
};
#define RLX_AGENT __ATOMIC_RELAXED, __HIP_MEMORY_SCOPE_AGENT
#define XB_TMO      128
#define XB_XCNT(j)  (256  + 64 * (j))
#define XB_XSUB(j)  (1280 + 64 * (j))
#define XB_XGEN(j)  (2304 + 64 * (j))
#define XB_TOP      3328
#define XB_TOPGEN   3392
#define XCD_BAR_WORDS 3456
#define XB_SPIN_CAP (1u << 18)

__device__ __forceinline__ unsigned xb_ld(unsigned* p)              { return __hip_atomic_load(p, __ATOMIC_RELAXED, __HIP_MEMORY_SCOPE_AGENT); }
__device__ __forceinline__ unsigned xb_add(unsigned* p, unsigned v) { return __hip_atomic_fetch_add(p, v, __ATOMIC_RELAXED, __HIP_MEMORY_SCOPE_AGENT); }
__device__ __forceinline__ unsigned xb_xcc_id() { return (unsigned)__builtin_amdgcn_s_getreg((3 << 11) | 20) & 0xFu; }
#define XB_SPIN(cond, bar) do { unsigned _sp = 0; while (cond) { __builtin_amdgcn_s_sleep(1); \
    if ((++_sp & 255u) == 0u) { if (xb_ld(&(bar)[XB_TMO])) break; if (_sp > XB_SPIN_CAP) { atomicAdd(&(bar)[XB_TMO], 1u); break; } } } } while (0)

struct XcdBarrier {
    unsigned* bar; unsigned x;
    volatile LAS unsigned* st;
};

__device__ __forceinline__ XcdBarrier xcd_barrier_post(unsigned* bar, volatile LAS unsigned* st) {
    XcdBarrier b; b.bar = bar; b.x = xb_xcc_id(); b.st = st;
    if (threadIdx.x == 0) (void)xb_add(&bar[XB_XCNT(b.x)], 1u);
    return b;
}
__device__ __forceinline__ void xcd_barrier_complete(unsigned* bar, unsigned x, unsigned& nloc, unsigned& nx) {
    const unsigned G = gridDim.x * gridDim.y * gridDim.z;
    unsigned sum, cnt, mine, sp = 0u;
    for (;;) {
        sum = 0u; cnt = 0u; mine = 0u;
#pragma unroll
        for (unsigned j = 0; j < 16; ++j) { const unsigned c = xb_ld(&bar[XB_XCNT(j)]); sum += c; cnt += (c > 0u) ? 1u : 0u; mine = (j == x) ? c : mine; }
        if (sum == G) break;
        __builtin_amdgcn_s_sleep(1);
        if ((++sp & 255u) == 0u) { if (xb_ld(&bar[XB_TMO])) break; if (sp > XB_SPIN_CAP) { atomicAdd(&bar[XB_TMO], 1u); break; } }
    }
    nloc = mine > 0u ? mine : 1u; nx = cnt > 0u ? cnt : 1u;
}

__device__ __forceinline__ void xcd_barrier(const XcdBarrier& b) {
    asm volatile("s_waitcnt vmcnt(0)" ::: "memory");
    __syncthreads();
    if (threadIdx.x == 0) {
        unsigned* bar = b.bar;
        __builtin_amdgcn_s_waitcnt(0);
        unsigned nloc = b.st[0], nx = b.st[1];
        if (nloc == 0u) { xcd_barrier_complete(bar, b.x, nloc, nx); b.st[0] = nloc; b.st[1] = nx; }
        const unsigned old = xb_add(&bar[XB_XSUB(b.x)], 1u);
        const unsigned gen = old / nloc;
        if (old + 1u == (gen + 1u) * nloc) {
            __builtin_amdgcn_fence(__ATOMIC_RELEASE, "agent");
            asm volatile("s_waitcnt vmcnt(0)" ::: "memory");
            const unsigned og = xb_add(&bar[XB_TOP], 1u);
            const unsigned tg = og / nx;
            if (og + 1u == (tg + 1u) * nx) xb_add(&bar[XB_TOPGEN], 1u);
            else XB_SPIN(xb_ld(&bar[XB_TOPGEN]) == tg, bar);
            __builtin_amdgcn_fence(__ATOMIC_ACQUIRE, "agent");
            xb_add(&bar[XB_XGEN(b.x)], 1u);
            asm volatile("s_waitcnt vmcnt(0)" ::: "memory");
        } else {
            XB_SPIN(xb_ld(&bar[XB_XGEN(b.x)]) == gen, bar);
            __builtin_amdgcn_fence(__ATOMIC_ACQUIRE, "agent");
            asm volatile("s_waitcnt vmcnt(0)" ::: "memory");
        }
    }
    __syncthreads();
}

enum { I_XP = 0, I_XS, I_CWK, I_CWV, I_SSM, I_SCONV, I_CMK, I_CMV, I_MEM, I_GNORM, I_WIN, I_GQ, I_GK, I_SINKS, I_CONVW, I_CONVB, I_DTB, I_ALOG, I_DSKIP, I_GSSD, I_GMEM, I_WMK, I_WMV, I_GMK, I_GMQ, I_WOUT };

DI void p0_transpose_item(const float* W, int ldw, int src_k0, int src_n0, const float* rowscale, bf16_t* WT, int ldt, int dst_n0, int dst_k0, LAS float* scr, int lane) {
#pragma unroll 8
    for (int i = 0; i < 32; ++i) { const int kk = 2 * i + (lane >> 5); float v = W[(size_t)(src_k0 + kk) * ldw + src_n0 + (lane & 31)]; if (rowscale) v *= rowscale[kk]; scr[kk * 33 + (lane & 31)] = v; }
    LDS_WAIT();
    const int c = lane & 7;
#pragma unroll
    for (int j = 0; j < 4; ++j) { const int n = (lane >> 3) + 8 * j; const LAS float* s = scr + (8 * c) * 33 + n;
        u32x4 o; o.x = pk2(s[0 * 33], s[1 * 33]); o.y = pk2(s[2 * 33], s[3 * 33]); o.z = pk2(s[4 * 33], s[5 * 33]); o.w = pk2(s[6 * 33], s[7 * 33]);
        *(u32x4*)(WT + (size_t)(dst_n0 + n) * ldt + dst_k0 + 8 * c) = o; }
    LDS_WAIT();
}

DI float reduce16_to_lane(float (&a)[16], int lane) {
#pragma unroll
    for (int j = 0; j < 16; ++j) { a[j] += __shfl_xor(a[j], 32); a[j] += __shfl_xor(a[j], 16); }
    float r8[8], r4[4], r2[2];
    const bool b3 = (lane & 8) != 0, b2 = (lane & 4) != 0, b1 = (lane & 2) != 0, b0 = (lane & 1) != 0;
#pragma unroll
    for (int j = 0; j < 8; ++j) { const float snd = b3 ? a[j] : a[j + 8], kp = b3 ? a[j + 8] : a[j]; r8[j] = kp + __shfl_xor(snd, 8); }
#pragma unroll
    for (int j = 0; j < 4; ++j) { const float snd = b2 ? r8[j] : r8[j + 4], kp = b2 ? r8[j + 4] : r8[j]; r4[j] = kp + __shfl_xor(snd, 4); }
#pragma unroll
    for (int j = 0; j < 2; ++j) { const float snd = b1 ? r4[j] : r4[j + 2], kp = b1 ? r4[j + 2] : r4[j]; r2[j] = kp + __shfl_xor(snd, 2); }
    const float snd = b0 ? r2[0] : r2[1], kp = b0 ? r2[1] : r2[0];
    return kp + __shfl_xor(snd, 1);
}

DI void p0_rows2(f32x4 (&va)[4], f32x4 (&vb)[4], const float* g, bf16_t* oa, bf16_t* ob, float* dta, float* dtb, bool want_dt, const float* dt_bias, const LAS float* wdt, int lane) {
    float sa = 0.f, sb = 0.f;
#pragma unroll
    for (int jj = 0; jj < 4; ++jj) { sa += (va[jj].x * va[jj].x + va[jj].y * va[jj].y) + (va[jj].z * va[jj].z + va[jj].w * va[jj].w); sb += (vb[jj].x * vb[jj].x + vb[jj].y * vb[jj].y) + (vb[jj].z * vb[jj].z + vb[jj].w * vb[jj].w); }
    const float ra = 1.0f / sqrtf(wave_sum(sa) * (1.0f / DM) + EPSF), rb = 1.0f / sqrtf(wave_sum(sb) * (1.0f / DM) + EPSF);
    u32x2* pa = (u32x2*)oa + lane; u32x2* pb = (u32x2*)ob + lane;
#pragma unroll
    for (int jj = 0; jj < 4; ++jj) { const f32x4 gv = ((const f32x4*)g)[64 * jj + lane]; va[jj] = va[jj] * ra * gv; vb[jj] = vb[jj] * rb * gv;
        u32x2 w; w.x = pk2(va[jj].x, va[jj].y); w.y = pk2(va[jj].z, va[jj].w); pa[64 * jj] = w; w.x = pk2(vb[jj].x, vb[jj].y); w.y = pk2(vb[jj].z, vb[jj].w); pb[64 * jj] = w; }
    if (want_dt) {
        f32x2 ab[16];
#pragma unroll
        for (int j = 0; j < 16; ++j) ab[j] = (f32x2){0.f, 0.f};
#pragma unroll
        for (int jj = 0; jj < 4; ++jj)
#pragma unroll
            for (int e = 0; e < 4; ++e) { const f32x2 hab = {va[jj][e], vb[jj][e]}; const LAS f32x4* wr = (const LAS f32x4*)(wdt + ((jj * 4 + e) * 64 + lane) * 20);
#pragma unroll
                for (int q = 0; q < 4; ++q) { const f32x4 w4 = wr[q];
                    ab[4 * q] += hab * w4.x; ab[4 * q + 1] += hab * w4.y; ab[4 * q + 2] += hab * w4.z; ab[4 * q + 3] += hab * w4.w; }
                if (e & 1) __builtin_amdgcn_sched_barrier(0); }
        float a[16], b[16];
#pragma unroll
        for (int j = 0; j < 16; ++j) { a[j] = ab[j].x; b[j] = ab[j].y; }
        const float ta = reduce16_to_lane(a, lane), tb = reduce16_to_lane(b, lane);
        if (lane < 16) { const float xa = ta + dt_bias[lane], xb = tb + dt_bias[lane];
            dta[lane] = fmaxf(xa, 0.f) + log1pf(__expf(-fabsf(xa))); dtb[lane] = fmaxf(xb, 0.f) + log1pf(__expf(-fabsf(xb))); }
    }
}

DI void p0_row_segment(Ctx& F, const float* src, const float* g, int m0, int npair, bool tok, bf16_t* A, float* DT, const LAS float* wdt, int gw, int NGW) {
    const int lane = F.lane;
    f32x4 n0a[4], n0b[4], n1a[4], n1b[4];
#define P0_LOAD(dst_a, dst_b, pp) do { if ((pp) < npair) { _Pragma("unroll") for (int jj = 0; jj < 4; ++jj) { \
        dst_a[jj] = ((const f32x4*)(src + (size_t)(2 * (pp)) * DM))[64 * jj + lane]; dst_b[jj] = ((const f32x4*)(src + (size_t)(2 * (pp) + 1) * DM))[64 * jj + lane]; } } } while (0)
    P0_LOAD(n0a, n0b, gw); P0_LOAD(n1a, n1b, gw + NGW);
    for (int p = gw; p < npair; p += NGW) {
        f32x4 va[4], vb[4];
#pragma unroll
        for (int jj = 0; jj < 4; ++jj) { va[jj] = n0a[jj]; vb[jj] = n0b[jj]; n0a[jj] = n1a[jj]; n0b[jj] = n1b[jj]; }
        P0_LOAD(n1a, n1b, p + 2 * NGW);
        const int m = m0 + 2 * p;
        p0_rows2(va, vb, g, A + (size_t)m * DM, A + (size_t)(m + 1) * DM, DT + (size_t)(tok ? m : 0) * 16, DT + (size_t)(tok ? m + 1 : 0) * 16, tok, F.in[I_DTB], wdt, lane);
    }
#undef P0_LOAD
}

DI void p0_prologue(Ctx& F) {
    const int gw = F.bid * 8 + F.wave, NGW = F.G * 8, lane = F.lane;
    bf16_t* BT = (bf16_t*)(F.ws + WS_BT); bf16_t* WOT = (bf16_t*)(F.ws + WS_WOUT);
    for (int rep_ = 0; rep_ < REP_P0T; ++rep_) {
        LAS float* scr = (LAS float*)(F.lds + F.wave * 16384);
        constexpr int I_IN = 16 * (NPROJ / 32), I_M = 16 * 32, I_O = 32 * 32;
        for (int it = gw; it < I_IN + I_M + I_O; it += NGW) {
            int r = it;
            if (r < I_IN) { const int kb = r / (NPROJ / 32), nb = r % (NPROJ / 32); const int n0 = 32 * nb;
                p0_transpose_item(F.in[I_WIN], INC, 64 * kb, n0 + (n0 >= 3840 ? 16 : 0), nullptr, BT, 1024, n0, 64 * kb, scr, lane); continue; }
            r -= I_IN;
            if (r < I_M) { const int kb = r / 32, nb = r % 32;
                p0_transpose_item(nb < 16 ? F.in[I_WMK] : F.in[I_WMV], 512, 64 * kb, 32 * (nb & 15), nullptr, BT, 1024, NPROJ + 32 * nb, 64 * kb, scr, lane); continue; }
            r -= I_M;
            { const int kb = r / 32, nb = r % 32; const int k0 = 64 * kb;
              const int sk0 = k0 < 1024 ? 512 + k0 : (k0 < 1536 ? k0 - 1024 : k0);
              p0_transpose_item(F.in[I_WOUT], 1024, sk0, 32 * nb, k0 < 1024 ? F.in[I_GSSD] + k0 : nullptr, WOT, 2048, 32 * nb, k0, scr, lane); }
        }
    }
    { float* sq = (float*)(F.ws + WS_SSQ); for (int i = F.bid * 512 + F.tid; i < MTOT; i += F.G * 512) sq[i] = 0.f; }
    {
        f32x2* rope = (f32x2*)(F.ws + WS_ROPE);
        for (int i = F.bid * 512 + F.tid; i < 4096 * 32; i += F.G * 512) {
            const int pos = i >> 5, fi = i & 31;
            const float freq = exp2f(-(float)fi * (13.287712379549449f / 32.0f));
            double rev = (double)pos * (double)freq * 0.15915494309189535;
            rev -= __builtin_rint(rev);
            const float ang = (float)(rev * 6.283185307179586);
            rope[i] = (f32x2){cosf(ang), sinf(ang)};
        }
    }
    __syncthreads();
    for (int rep_ = 0; rep_ < REP_P0R; ++rep_) {
        if (rep_) __syncthreads();
        LAS float* wdt = (LAS float*)F.lds;
#pragma unroll 1
        for (int i0 = F.tid; i0 < 1024 * 16; i0 += 512 * 8) { float t8[8];
#pragma unroll
            for (int u = 0; u < 8; ++u) { const int i = i0 + 512 * u; t8[u] = F.in[I_WIN][(size_t)(i >> 4) * INC + 3840 + (i & 15)]; }
#pragma unroll
            for (int u = 0; u < 8; ++u) { const int i = i0 + 512 * u, k = i >> 4, j = i & 15; const int jj = k >> 8, e = k & 3, l = (k >> 2) & 63;
                wdt[((jj * 4 + e) * 64 + l) * 20 + j] = t8[u]; } }
        __syncthreads();
        bf16_t* A = (bf16_t*)(F.ws + WS_A); float* DT = (float*)(F.ws + WS_DT);
        p0_row_segment(F, F.in[I_XP], F.in[I_GNORM], 0, MP / 2, true, A, DT, wdt, gw, NGW);
        p0_row_segment(F, F.in[I_XS], F.in[I_GNORM], MP, MS / 2, true, A, DT, wdt, gw, NGW);
        p0_row_segment(F, F.in[I_MEM], F.in[I_GMEM], MTOT, MMEM / 2, false, A, DT, wdt, gw, NGW);
    }
}
struct Order1 {
    pg8::StaticOrder so; int G, c;
    __device__ void init(int G_, int c_) { so.init(MTOT, NPROJ, G_, c_); G = G_; c = c_; }
    __device__ bool next(int i, pg8::Unit& u) const {
        long L = (long)i * G + c;
        if (L >= (long)REP_P1 * (so.nwg + 64)) return false;
        L %= (so.nwg + 64);
        if (L < so.nwg) { pg8::StaticOrder t = so; t.G = 1; t.c = 0; return t.next((int)L, u); }
        const int r = (int)(L - so.nwg);
        u.pm = MTOT / 256 + (r >> 2); u.pn = NPROJ / 256 + (r & 3); return true;
    }
    __device__ __forceinline__ void a_ready(const pg8::Unit&) const {}
    __device__ __forceinline__ void done(const pg8::Unit&) const {}
};
struct Order3 {
    pg8::StaticOrder so; int G, c;
    __device__ void init(int G_, int c_) { so.init(MP, 1024, 1, 0); G = G_; c = c_; }
    __device__ bool next(int i, pg8::Unit& u) const {
        long L = (long)i * G + c;
        if (L >= (long)REP_P3 * so.nwg) return false;
        return so.next((int)(L % so.nwg), u);
    }
    __device__ __forceinline__ void a_ready(const pg8::Unit&) const {}
    __device__ __forceinline__ void done(const pg8::Unit&) const {}
};
struct EpiProj {
    static constexpr bool PERM = true, AFTER_DRAIN = false; static constexpr int MIDK = 0;
    bf16_t* proj; bf16_t* memraw;
    __device__ __forceinline__ void operator()(const f32x4 (&acc)[2][2][4][2], const pg8::Unit& u, int wr, int wc, int fr, int fq) const {
        bf16_t* base; int ldc, row0, col0;
        if (u.pn < NPROJ / 256) { base = proj; ldc = NPROJ; row0 = u.pm * 256; col0 = u.pn * 256; }
        else { base = memraw; ldc = 1024; row0 = (u.pm - MTOT / 256) * 256; col0 = (u.pn - NPROJ / 256) * 256; }
        row0 += wr * 64 + fr; col0 += wc * 32 + 8 * fq;
#pragma unroll
        for (int ai = 0; ai < 2; ++ai)
#pragma unroll
            for (int m = 0; m < 4; ++m) { bf16_t* rowp = base + (size_t)(row0 + ai * 128 + m * 16) * ldc + col0;
#pragma unroll
                for (int bj = 0; bj < 2; ++bj) { const f32x4 v0 = acc[ai][bj][m][0], v1 = acc[ai][bj][m][1];
                    u32x4 w; w.x = cvt_pk_bf16(v0[0], v0[1]); w.y = cvt_pk_bf16(v0[2], v0[3]); w.z = cvt_pk_bf16(v1[0], v1[1]); w.w = cvt_pk_bf16(v1[2], v1[3]);
                    *(u32x4*)(rowp + bj * 128) = w; } }
    }
};
struct EpiOut {
    static constexpr bool PERM = false, AFTER_DRAIN = false; static constexpr int MIDK = 16;
    const float* xp; const float* xs; float* out; const float* sumsq;
    __device__ __forceinline__ void mid(f32x4 (&acc)[2][2][4][2], const pg8::Unit& u, int wr, int wc, int fr, int fq) const {
        const float* sq = sumsq + (size_t)u.pm * 256 + wr * 64 + fr;
#pragma unroll
        for (int ai = 0; ai < 2; ++ai)
#pragma unroll
            for (int m = 0; m < 4; ++m) { const float r = 1.0f / sqrtf(sq[ai * 128 + m * 16] * (1.0f / 1024.0f) + EPSF);
#pragma unroll
                for (int bj = 0; bj < 2; ++bj)
#pragma unroll
                    for (int n = 0; n < 2; ++n) acc[ai][bj][m][n] = acc[ai][bj][m][n] * r; }
    }
    __device__ __forceinline__ void operator()(const f32x4 (&acc)[2][2][4][2], const pg8::Unit& u, int wr, int wc, int fr, int fq) const {
        const float* xb = u.pm < MP / 256 ? xp + (size_t)u.pm * 256 * DM : xs + (size_t)(u.pm - MP / 256) * 256 * DM;
        float* ob = out + (size_t)u.pm * 256 * DM;
        const int rl0 = wr * 64 + fr, col0 = u.pn * 256 + wc * 32 + 4 * fq;
#pragma unroll
        for (int ai = 0; ai < 2; ++ai) {
            f32x4 xv[4][2][2];
#pragma unroll
            for (int m = 0; m < 4; ++m)
#pragma unroll
                for (int bj = 0; bj < 2; ++bj)
#pragma unroll
                    for (int n = 0; n < 2; ++n) xv[m][bj][n] = *(const f32x4*)(xb + (size_t)(rl0 + ai * 128 + m * 16) * DM + col0 + bj * 128 + n * 16);
#pragma unroll
            for (int m = 0; m < 4; ++m)
#pragma unroll
                for (int bj = 0; bj < 2; ++bj)
#pragma unroll
                    for (int n = 0; n < 2; ++n) *(f32x4*)(ob + (size_t)(rl0 + ai * 128 + m * 16) * DM + col0 + bj * 128 + n * 16) = acc[ai][bj][m][n] + xv[m][bj][n];
            asm volatile("" ::: "memory"); }
    }
};

constexpr int SS_X = 0, SS_XD = 9216, SS_BM = 18432, SS_CM = 35840, SS_SB = 53248, SS_WM = 70656, SS_SM = 79872;
constexpr int LD64 = 144, LD128 = 272;
typedef short s16x4 __attribute__((ext_vector_type(4)));

DI bf16x8 lds_frag(const LAS unsigned char* tile, int ld, int row0, int k0, int lane) {
    return *(const LAS bf16x8*)(tile + (row0 + (lane & 15)) * ld + (k0 + 8 * (lane >> 4)) * 2);
}
DI bf16x8 lds_frag_tr(const LAS unsigned char* tile, int ld, int k0, int c0, int lane) {
    const LAS unsigned char* a = tile + (k0 + 8 * (lane >> 4) + ((lane & 15) >> 2)) * ld + (c0 + 4 * (lane & 3)) * 2;
    const s16x4 lo = __builtin_amdgcn_ds_read_tr16_b64_v4i16((LAS s16x4*)a), hi = __builtin_amdgcn_ds_read_tr16_b64_v4i16((LAS s16x4*)(a + 4 * ld));
    return (bf16x8){lo.x, lo.y, lo.z, lo.w, hi.x, hi.y, hi.z, hi.w};
}
DI bf16x8 lds_frag_tr2(const LAS unsigned char* tile, int ld, int k0, int c0, int lane) {
    const LAS unsigned char* a = tile + (k0 + 4 * (lane >> 4) + ((lane & 15) >> 2)) * ld + (c0 + 4 * (lane & 3)) * 2;
    const s16x4 lo = __builtin_amdgcn_ds_read_tr16_b64_v4i16((LAS s16x4*)a), hi = __builtin_amdgcn_ds_read_tr16_b64_v4i16((LAS s16x4*)(a + 16 * ld));
    return (bf16x8){lo.x, lo.y, lo.z, lo.w, hi.x, hi.y, hi.z, hi.w};
}
#define MFMA16T(rowsfrag, colsfrag, acc) MFMA16((colsfrag), (rowsfrag), (acc))

DI void convbc_prepass(Ctx& F) {
    const int gw = F.bid * 8 + F.wave, NGW = F.G * 8, lane = F.lane;
    const bf16_t* PROJ = (const bf16_t*)(F.ws + WS_PROJ); bf16_t* BCC = (bf16_t*)(F.ws + WS_BCC);
    const int ch0 = 1024 + lane * 8;
    float wv[4][8], bv[8];
#pragma unroll
    for (int e = 0; e < 8; ++e) { bv[e] = F.in[I_CONVB][ch0 + e];
#pragma unroll
        for (int j = 0; j < 4; ++j) wv[j][e] = F.in[I_CONVW][j * 1536 + ch0 + e]; }
    for (int t = gw; t < MTOT / 33; t += NGW) {
        const int row0 = t * 33;
        float h0[8], h1[8], h2[8];
        { const bool smp0 = row0 >= MP; const int lrow0 = smp0 ? (row0 - MP) & 63 : row0 & (T_P - 1);
          const float* sc0 = F.in[I_SCONV] + (size_t)(smp0 ? (row0 - MP) >> 6 : 0) * 3 * 1536 + ch0;
#define CONV_HALO(dst, j) do { const int lr_ = lrow0 - 3 + (j); \
              if (lr_ >= 0) unpack8(*(const u32x4*)(PROJ + (size_t)(row0 - 3 + (j)) * NPROJ + C_XBC + ch0), dst); \
              else { _Pragma("unroll") for (int e = 0; e < 8; ++e) dst[e] = smp0 ? sc0[(3 + lr_) * 1536 + e] : 0.f; } } while (0)
          CONV_HALO(h0, 0); CONV_HALO(h1, 1); CONV_HALO(h2, 2);
#undef CONV_HALO
        }
#pragma unroll 1
        for (int bt = 0; bt < 3; ++bt) {
            u32x4 raw[11];
#pragma unroll
            for (int i = 0; i < 11; ++i) raw[i] = *(const u32x4*)(PROJ + (size_t)(row0 + 11 * bt + i) * NPROJ + C_XBC + ch0);
#pragma unroll
            for (int i = 0; i < 11; ++i) { const int row = row0 + 11 * bt + i;
                const bool smp = row >= MP; const int lrow = smp ? (row - MP) & 63 : row & (T_P - 1);
                if (lrow == 0) {
                    if (smp) { const float* sc = F.in[I_SCONV] + (size_t)((row - MP) >> 6) * 3 * 1536 + ch0;
#pragma unroll
                        for (int e = 0; e < 8; ++e) { h0[e] = sc[e]; h1[e] = sc[1536 + e]; h2[e] = sc[2 * 1536 + e]; } }
                    else {
#pragma unroll
                        for (int e = 0; e < 8; ++e) { h0[e] = 0.f; h1[e] = 0.f; h2[e] = 0.f; } } }
                float cur[8], o[8];
                unpack8(raw[i], cur);
#pragma unroll
                for (int e = 0; e < 8; ++e) { o[e] = siluf(bv[e] + wv[0][e] * h0[e] + wv[1][e] * h1[e] + wv[2][e] * h2[e] + wv[3][e] * cur[e]); h0[e] = h1[e]; h1[e] = h2[e]; h2[e] = cur[e]; }
                *(u32x4*)(BCC + (size_t)row * 512 + lane * 8) = pack8(o); }
        }
    }
}

DI void ssd_item(Ctx& F, int sq, int h, bool do_sumsq) {
    LAS unsigned char* lds = F.lds;
    const int tid = F.tid, lane = F.lane, w = F.wave, g = h >> 3;
    const bool smp = sq >= NB_P; const int sb = sq - NB_P;
    const int row_base = smp ? MP + sb * 64 : sq * T_P, nchunks = smp ? 1 : 64;
    const bf16_t* PROJ = (const bf16_t*)(F.ws + WS_PROJ); const bf16_t* BCC = (const bf16_t*)(F.ws + WS_BCC); const float* DT = (const float*)(F.ws + WS_DT);
    bf16_t* MIX = (bf16_t*)(F.ws + WS_MIX); float* SUMSQ = (float*)(F.ws + WS_SSQ);
    const float a_h = -__expf(F.in[I_ALOG][h]), d_h = F.in[I_DSKIP][h];
    const int pt = w >> 1, nh = w & 1, lt = w >> 1;
    const int xl = tid >> 3, xg = tid & 7, chx = h * 64 + 8 * xg;
    LAS float* sm_cw0 = (LAS float*)(lds + SS_SM + 1024 + 768);
    if (tid >= 192 && tid < 512) { const int i = tid - 192; const int j = i >> 6, chn = h * 64 + (i & 63); sm_cw0[i] = j < 4 ? F.in[I_CONVW][j * 1536 + chn] : F.in[I_CONVB][chn]; }
    f32x4 st[4];
#pragma unroll
    for (int q = 0; q < 4; ++q) {
        if (smp) st[q] = *(const f32x4*)(F.in[I_SSM] + ((size_t)(sb * 16 + h) * 64 + 16 * pt + (lane & 15)) * 128 + 16 * (4 * nh + q) + 4 * (lane >> 4));
        else st[q] = (f32x4){0.f, 0.f, 0.f, 0.f};
    }
    u32x4 px0[4], px1[4], pbs[2], pcs[2]; u32x2 pz0[2], pz1[2]; float pdt0, pdt1;
#define SSD_ISSUE_X(c_, PX_) do { const int row0_ = row_base + 64 * (c_); \
        _Pragma("unroll") for (int j_ = 0; j_ < 4; ++j_) { int rr_ = xl - 3 + j_; if ((c_) == 0 && rr_ < 0) rr_ = 0; PX_[j_] = *(const u32x4*)(PROJ + (size_t)(row0_ + rr_) * NPROJ + C_XBC + chx); } } while (0)
#define SSD_ISSUE_BC(c_) do { const int row0_ = row_base + 64 * (c_); \
        _Pragma("unroll") for (int i_ = 0; i_ < 2; ++i_) { const int t_ = tid + 512 * i_; \
            pbs[i_] = *(const u32x4*)(BCC + (size_t)(row0_ + (t_ >> 4)) * 512 + g * 128 + 8 * (t_ & 15)); pcs[i_] = *(const u32x4*)(BCC + (size_t)(row0_ + (t_ >> 4)) * 512 + 256 + g * 128 + 8 * (t_ & 15)); } } while (0)
#define SSD_ISSUE_ZDT(c_, PZ_, PDT_) do { const int row0_ = row_base + 64 * (c_); \
        _Pragma("unroll") for (int pi_ = 0; pi_ < 2; ++pi_) PZ_[pi_] = *(const u32x2*)(PROJ + (size_t)(row0_ + 16 * lt + (lane & 15)) * NPROJ + C_Z + h * 64 + 16 * (2 * nh + pi_) + 4 * (lane >> 4)); \
        PDT_ = DT[(size_t)(row0_ + lane) * 16 + h]; } while (0)
    LAS float* sm_init = (LAS float*)(lds + SS_SM + 1024);
    if (tid < 192) sm_init[tid] = smp ? F.in[I_SCONV][(size_t)(sb * 3 + (tid >> 6)) * 1536 + h * 64 + (tid & 63)] : 0.f;
#define SSD_STEP(c, PX_, PZ_, PDT_) do { \
        const int row0 = row_base + 64 * c; \
        LAS float* sm_ac = (LAS float*)(lds + SS_SM + (c & 1) * 512); LAS float* sm_dt = sm_ac + 64; \
        const float dtl = PDT_; \
        float ac = dtl * a_h; \
_Pragma("unroll")         for (int o = 1; o < 64; o <<= 1) { const float t = __shfl_up(ac, o); if (lane >= o) ac += t; } \
        const float ac_last = __shfl(ac, 63); \
        const float wgt_l = __expf(ac_last - ac) * dtl; \
        if (w == 0) { sm_ac[lane] = ac; sm_dt[lane] = dtl; } \
        __syncthreads(); \
        { \
        { float xr[4][8], o[8], od[8]; \
_Pragma("unroll")           for (int j = 0; j < 4; ++j) unpack8(PX_[j], xr[j]); \
          if (c == 0) { \
_Pragma("unroll")               for (int j = 0; j < 3; ++j) { const int rr = xl - 3 + j; const LAS f32x4* iv = (const LAS f32x4*)(sm_init + (rr < 0 ? 3 + rr : 0) * 64 + 8 * xg); \
                  f32x4 i0 = iv[0], i1 = iv[1]; asm volatile("" : "+v"(i0), "+v"(i1)); \
_Pragma("unroll")                   for (int e = 0; e < 4; ++e) { xr[j][e] = (rr < 0) ? i0[e] : xr[j][e]; xr[j][4 + e] = (rr < 0) ? i1[e] : xr[j][4 + e]; } } } \
          const float wg = __shfl(wgt_l, xl & 63); \
          float wv[4][8], bv[8]; unsigned cwo_ = (unsigned)(8 * xg) * 4u; asm volatile("" : "+v"(cwo_)); const LAS float* sm_cw = (const LAS float*)((const LAS unsigned char*)sm_cw0 + cwo_) - 8 * xg; \
          _Pragma("unroll") for (int j_ = 0; j_ < 4; ++j_) { const f32x4 a_ = *(const LAS f32x4*)(sm_cw + j_ * 64 + 8 * xg), b_ = *(const LAS f32x4*)(sm_cw + j_ * 64 + 8 * xg + 4); \
              _Pragma("unroll") for (int e_ = 0; e_ < 4; ++e_) { wv[j_][e_] = a_[e_]; wv[j_][4 + e_] = b_[e_]; } } \
          { const f32x4 a_ = *(const LAS f32x4*)(sm_cw + 256 + 8 * xg), b_ = *(const LAS f32x4*)(sm_cw + 256 + 8 * xg + 4); _Pragma("unroll") for (int e_ = 0; e_ < 4; ++e_) { bv[e_] = a_[e_]; bv[4 + e_] = b_[e_]; } } \
_Pragma("unroll")           for (int e = 0; e < 8; ++e) { o[e] = siluf(bv[e] + wv[0][e] * xr[0][e] + wv[1][e] * xr[1][e] + wv[2][e] * xr[2][e] + wv[3][e] * xr[3][e]); od[e] = o[e] * wg; } \
          *(LAS u32x4*)(lds + SS_X + xl * LD64 + xg * 16) = pack8(o); \
          *(LAS u32x4*)(lds + SS_XD + xl * LD64 + xg * 16) = pack8(od); } \
_Pragma("unroll")         for (int i = 0; i < 2; ++i) { const int t = tid + 512 * i; \
            *(LAS u32x4*)(lds + SS_BM + (t >> 4) * LD128 + (t & 15) * 16) = pbs[i]; *(LAS u32x4*)(lds + SS_CM + (t >> 4) * LD128 + (t & 15) * 16) = pcs[i]; } \
_Pragma("unroll")         for (int q = 0; q < 4; ++q) { u32x2 v; v.x = pk2(st[q][0], st[q][1]); v.y = pk2(st[q][2], st[q][3]); \
            *(LAS u32x2*)(lds + SS_SB + (16 * pt + (lane & 15)) * LD128 + (16 * (4 * nh + q) + 4 * (lane >> 4)) * 2) = v; } \
        } \
        if (c + 2 < nchunks) SSD_ISSUE_X(c + 2, PX_); if (c + 1 < nchunks) SSD_ISSUE_BC(c + 1); \
        __syncthreads(); \
        { const float acl = sm_ac[16 * lt + (lane & 15)]; const int l = 16 * lt + (lane & 15); \
_Pragma("unroll")           for (int si = 0; si < 2; ++si) { const int stl = 2 * nh + si; f32x4 gacc = {0.f, 0.f, 0.f, 0.f}; \
              if (stl <= lt) { \
_Pragma("unroll")                   for (int ks = 0; ks < 4; ++ks) gacc = MFMA16T(lds_frag(lds + SS_CM, LD128, 16 * lt, 32 * ks, lane), lds_frag(lds + SS_BM, LD128, 16 * stl, 32 * ks, lane), gacc); } \
              const int s0 = 16 * stl + 4 * (lane >> 4); \
              const f32x4 acs = *(const LAS f32x4*)(sm_ac + s0), dts = *(const LAS f32x4*)(sm_dt + s0); \
              float v[4]; \
_Pragma("unroll")               for (int r = 0; r < 4; ++r) { v[r] = gacc[r] * __expf(fminf(acl - acs[r], 0.f)) * dts[r]; v[r] = (l >= s0 + r) ? v[r] : 0.f; } \
              u32x2 pk; pk.x = pk2(v[0], v[1]); pk.y = pk2(v[2], v[3]); \
              *(LAS u32x2*)(lds + SS_WM + l * LD64 + s0 * 2) = pk; } } \
        __syncthreads(); \
        { \
        { const int l = 16 * lt + (lane & 15); const float eal = __expf(sm_ac[l]); \
          float ssq = 0.f; \
_Pragma("unroll")           for (int pi = 0; pi < 2; ++pi) { const int ptl = 2 * nh + pi; const int p0 = 16 * ptl + 4 * (lane >> 4); \
              f32x4 y = {0.f, 0.f, 0.f, 0.f}; \
_Pragma("unroll")               for (int ks = 0; ks < 4; ++ks) y = MFMA16T(lds_frag(lds + SS_CM, LD128, 16 * lt, 32 * ks, lane), lds_frag(lds + SS_SB, LD128, 16 * ptl, 32 * ks, lane), y); \
              y = y * eal; \
_Pragma("unroll")               for (int ks = 0; ks < 2; ++ks) y = MFMA16T(lds_frag(lds + SS_WM, LD64, 16 * lt, 32 * ks, lane), lds_frag_tr(lds + SS_X, LD64, 32 * ks, 16 * ptl, lane), y); \
              const u32x2 xraw = *(const LAS u32x2*)(lds + SS_X + l * LD64 + p0 * 2); \
              const float xv[4] = {__uint_as_float(xraw.x << 16), __uint_as_float(xraw.x & 0xffff0000u), __uint_as_float(xraw.y << 16), __uint_as_float(xraw.y & 0xffff0000u)}; \
              const float zv[4] = {__uint_as_float(PZ_[pi].x << 16), __uint_as_float(PZ_[pi].x & 0xffff0000u), __uint_as_float(PZ_[pi].y << 16), __uint_as_float(PZ_[pi].y & 0xffff0000u)}; \
              float gv[4]; \
_Pragma("unroll")               for (int r = 0; r < 4; ++r) { gv[r] = (y[r] + d_h * xv[r]) * siluf(zv[r]); ssq += gv[r] * gv[r]; } \
              u32x2 pk; pk.x = pk2(gv[0], gv[1]); pk.y = pk2(gv[2], gv[3]); \
              *(u32x2*)(MIX + (size_t)(row0 + l) * 2048 + h * 64 + p0) = pk; } \
          ssq += __shfl_xor(ssq, 16); ssq += __shfl_xor(ssq, 32); \
          if (lane < 16 && do_sumsq) unsafeAtomicAdd(SUMSQ + row0 + l, ssq); } \
        } \
        { const float cd = __expf(ac_last); \
          bf16x8 xa[2]; \
_Pragma("unroll")           for (int ks = 0; ks < 2; ++ks) xa[ks] = lds_frag_tr(lds + SS_XD, LD64, 32 * ks, 16 * pt, lane); \
_Pragma("unroll")           for (int q = 0; q < 4; ++q) { f32x4 s = st[q] * cd; \
_Pragma("unroll")               for (int ks = 0; ks < 2; ++ks) s = MFMA16T(xa[ks], lds_frag_tr(lds + SS_BM, LD128, 32 * ks, 16 * (4 * nh + q), lane), s); \
              st[q] = s; } } \
        if (c + 2 < nchunks) SSD_ISSUE_ZDT(c + 2, PZ_, PDT_); \
    } while (0)
    SSD_ISSUE_X(0, px0); SSD_ISSUE_BC(0); SSD_ISSUE_ZDT(0, pz0, pdt0);
    if (nchunks > 1) { SSD_ISSUE_X(1, px1); SSD_ISSUE_ZDT(1, pz1, pdt1); }
#pragma unroll 1
    for (int c2 = 0; c2 < nchunks; c2 += 2) {
        { const int c = c2; SSD_STEP(c, px0, pz0, pdt0); }
        if (c2 + 1 < nchunks) { const int c = c2 + 1; SSD_STEP(c, px1, pz1, pdt1); }
    }
#undef SSD_STEP
#undef SSD_ISSUE_X
#undef SSD_ISSUE_BC
#undef SSD_ISSUE_ZDT
    { float* so = F.out + (smp ? O_SSMS + ((size_t)(sb * 16 + h) * 64) * 128 : O_SSMP + ((size_t)(sq * 16 + h) * 64) * 128);
#pragma unroll
      for (int q = 0; q < 4; ++q) *(f32x4*)(so + (16 * pt + (lane & 15)) * 128 + 16 * (4 * nh + q) + 4 * (lane >> 4)) = st[q]; }
    __syncthreads();
}
DI void p2a_phase(Ctx& F) {
    convbc_prepass(F);
    {
        const bf16_t* PROJ = (const bf16_t*)(F.ws + WS_PROJ);
        for (int i = F.bid * 512 + F.tid; i < 48 * 3 * 1536; i += F.G * 512) {
            const int ch = i % 1536, j = (i / 1536) % 3, sq = i / (3 * 1536);
            if (sq < NB_P) F.out[O_CONVP + (size_t)(sq * 3 + j) * 1536 + ch] = bf2f(PROJ[(size_t)(sq * T_P + T_P - 3 + j) * NPROJ + C_XBC + ch]);
            else F.out[O_CONVS + (size_t)((sq - NB_P) * 3 + j) * 1536 + ch] = bf2f(PROJ[(size_t)(MP + (sq - NB_P) * 64 + 61 + j) * NPROJ + C_XBC + ch]);
        }
    }
}
constexpr int WR_SLOT = 19456, WR_V = 9216, LDKW = 144, LDVW = 160;

DI void wa_write_k(Ctx& F, LAS unsigned char* slot, int kvh, const u32x4 ra, const u32x4 rb, int pos, float* ko) {
    const int i = F.tid >> 2, q4 = F.tid & 3;
    float a[8], bb[8], o1[8], o2[8];
    unpack8(ra, a); unpack8(rb, bb);
    float s = 0.f;
#pragma unroll
    for (int e = 0; e < 8; ++e) s += a[e] * a[e] + bb[e] * bb[e];
    s += __shfl_xor(s, 1); s += __shfl_xor(s, 2);
    const float rstd = 1.0f / sqrtf(s * (1.0f / 64.0f) + EPSF);
    const f32x2* ROPE = (const f32x2*)(F.ws + WS_ROPE);
#pragma unroll
    for (int e = 0; e < 8; ++e) { const float an = a[e] * rstd * F.in[I_GK][8 * q4 + e], bn = bb[e] * rstd * F.in[I_GK][32 + 8 * q4 + e];
        const f32x2 cs = ROPE[pos * 32 + 8 * q4 + e]; o1[e] = an * cs.x - bn * cs.y; o2[e] = bn * cs.x + an * cs.y; }
    *(LAS u32x4*)(slot + i * LDKW + (8 * q4) * 2) = pack8(o1);
    *(LAS u32x4*)(slot + i * LDKW + (32 + 8 * q4) * 2) = pack8(o2);
    if (ko) { float* p = ko + ((size_t)i * 2 + kvh) * 64;
        *(f32x4*)(p + 8 * q4) = (f32x4){o1[0], o1[1], o1[2], o1[3]}; *(f32x4*)(p + 8 * q4 + 4) = (f32x4){o1[4], o1[5], o1[6], o1[7]};
        *(f32x4*)(p + 32 + 8 * q4) = (f32x4){o2[0], o2[1], o2[2], o2[3]}; *(f32x4*)(p + 32 + 8 * q4 + 4) = (f32x4){o2[4], o2[5], o2[6], o2[7]}; }
}
DI void wa_write_v(Ctx& F, LAS unsigned char* slot, int kvh, const u32x4 rv, float* vo) {
    const int i = F.tid >> 3, q8 = F.tid & 7;
    *(LAS u32x4*)(slot + WR_V + i * LDVW + q8 * 16) = rv;
    if (vo) { float v[8]; unpack8(rv, v); float* p = vo + ((size_t)i * 2 + kvh) * 64 + 8 * q8;
        *(f32x4*)p = (f32x4){v[0], v[1], v[2], v[3]}; *(f32x4*)(p + 4) = (f32x4){v[4], v[5], v[6], v[7]}; }
}
DI void wa_stage_cache(Ctx& F, LAS unsigned char* slot, int kvh, const float* ck, const float* cv, float* ko, float* vo) {
    if (F.tid < 256) { const int i = F.tid >> 2, q4 = F.tid & 3; const float* src = ck + ((size_t)i * 2 + kvh) * 64;
        const f32x4 a0 = *(const f32x4*)(src + 8 * q4), a1 = *(const f32x4*)(src + 8 * q4 + 4), b0 = *(const f32x4*)(src + 32 + 8 * q4), b1 = *(const f32x4*)(src + 32 + 8 * q4 + 4);
        u32x4 pa, pb; pa.x = pk2(a0.x, a0.y); pa.y = pk2(a0.z, a0.w); pa.z = pk2(a1.x, a1.y); pa.w = pk2(a1.z, a1.w); pb.x = pk2(b0.x, b0.y); pb.y = pk2(b0.z, b0.w); pb.z = pk2(b1.x, b1.y); pb.w = pk2(b1.z, b1.w);
        *(LAS u32x4*)(slot + i * LDKW + (8 * q4) * 2) = pa; *(LAS u32x4*)(slot + i * LDKW + (32 + 8 * q4) * 2) = pb;
        if (ko) { float* p = ko + ((size_t)i * 2 + kvh) * 64; *(f32x4*)(p + 8 * q4) = a0; *(f32x4*)(p + 8 * q4 + 4) = a1; *(f32x4*)(p + 32 + 8 * q4) = b0; *(f32x4*)(p + 32 + 8 * q4 + 4) = b1; } }
    { const int i = F.tid >> 3, q8 = F.tid & 7; const float* src = cv + ((size_t)i * 2 + kvh) * 64 + 8 * q8; const f32x4 v0 = *(const f32x4*)src, v1 = *(const f32x4*)(src + 4);
      u32x4 pv; pv.x = pk2(v0.x, v0.y); pv.y = pk2(v0.z, v0.w); pv.z = pk2(v1.x, v1.y); pv.w = pk2(v1.z, v1.w);
      *(LAS u32x4*)(slot + WR_V + i * LDVW + q8 * 16) = pv;
      if (vo) { float* p = vo + ((size_t)i * 2 + kvh) * 64 + 8 * q8; *(f32x4*)p = v0; *(f32x4*)(p + 4) = v1; } }
}
DI void wa_compute(Ctx& F, int kvh, size_t crow0, int pos0, int sl0, int sl1, int sl2, int ninv) {
    LAS unsigned char* lds = F.lds;
    const int lane = F.lane, w = F.wave, g4 = lane >> 4;
    const bf16_t* PROJ = (const bf16_t*)(F.ws + WS_PROJ); const f32x2* ROPE = (const f32x2*)(F.ws + WS_ROPE); bf16_t* MIX = (bf16_t*)(F.ws + WS_MIX);
    const int hq = kvh * 4 + (w >> 1); const float sink = F.in[I_SINKS][hq];
    u32x2 graw[2][4]; u32x4 qraw[2][2];
#pragma unroll
    for (int rg = 0; rg < 2; ++rg) { const size_t row = crow0 + 32 * (w & 1) + 16 * rg + (lane & 15);
#pragma unroll
        for (int dt = 0; dt < 4; ++dt) graw[rg][dt] = *(const u32x2*)(PROJ + row * NPROJ + C_GA + hq * 64 + 16 * dt + 4 * g4);
        qraw[rg][0] = *(const u32x4*)(PROJ + row * NPROJ + C_Q + hq * 64 + 8 * g4); qraw[rg][1] = *(const u32x4*)(PROJ + row * NPROJ + C_Q + hq * 64 + 32 + 8 * g4); }
    bf16x8 qa[2][2];
#pragma unroll
    for (int rg = 0; rg < 2; ++rg) {
        const int d0 = 8 * g4; float a[8], bb[8];
        unpack8(qraw[rg][0], a);
        unpack8(qraw[rg][1], bb);
        float s = 0.f;
#pragma unroll
        for (int e = 0; e < 8; ++e) s += a[e] * a[e] + bb[e] * bb[e];
        s += __shfl_xor(s, 16); s += __shfl_xor(s, 32);
        const float rstd = 0.125f / sqrtf(s * (1.0f / 64.0f) + EPSF);
        const int pos = pos0 + 32 * (w & 1) + 16 * rg + (lane & 15);
        float o1[8], o2[8];
#pragma unroll
        for (int e = 0; e < 8; ++e) { const float an = a[e] * rstd * F.in[I_GQ][d0 + e], bn = bb[e] * rstd * F.in[I_GQ][32 + d0 + e];
            const f32x2 cs = ROPE[pos * 32 + d0 + e]; o1[e] = an * cs.x - bn * cs.y; o2[e] = bn * cs.x + an * cs.y; }
        qa[rg][0] = __builtin_bit_cast(bf16x8, pack8(o1)); qa[rg][1] = __builtin_bit_cast(bf16x8, pack8(o2)); }
    f32x4 s[2][12];
#pragma unroll
    for (int jt = 0; jt < 12; ++jt) { const int j = jt >> 2; const LAS unsigned char* kt = lds + (j == 0 ? sl0 : (j == 1 ? sl1 : sl2)) * WR_SLOT;
        const bf16x8 k0 = lds_frag(kt, LDKW, 16 * (jt & 3), 0, lane), k1 = lds_frag(kt, LDKW, 16 * (jt & 3), 32, lane);
#pragma unroll
        for (int rg = 0; rg < 2; ++rg) { f32x4 acc = {0.f, 0.f, 0.f, 0.f};
            acc = MFMA16T(qa[rg][0], k0, acc); acc = MFMA16T(qa[rg][1], k1, acc);
            if (j < ninv) acc = (f32x4){-1e30f, -1e30f, -1e30f, -1e30f};
            s[rg][jt] = acc; }
        if ((jt & 3) == 3) __builtin_amdgcn_sched_barrier(0); }
    float inv[2]; bf16x8 pa[2][6];
#pragma unroll
    for (int rg = 0; rg < 2; ++rg) {
        float m = sink;
#pragma unroll
        for (int jt = 0; jt < 12; ++jt)
#pragma unroll
            for (int r = 0; r < 4; ++r) m = fmaxf(m, s[rg][jt][r]);
        m = fmaxf(m, __shfl_xor(m, 16)); m = fmaxf(m, __shfl_xor(m, 32));
        float sum = 0.f;
#pragma unroll
        for (int jt = 0; jt < 12; ++jt)
#pragma unroll
            for (int r = 0; r < 4; ++r) { const float e = __expf(s[rg][jt][r] - m); s[rg][jt][r] = e; sum += e; }
        sum += __shfl_xor(sum, 16); sum += __shfl_xor(sum, 32);
        inv[rg] = 1.0f / (sum + __expf(sink - m));
#pragma unroll
        for (int k2 = 0; k2 < 6; ++k2) { u32x4 t; t.x = pk2(s[rg][2 * k2][0], s[rg][2 * k2][1]); t.y = pk2(s[rg][2 * k2][2], s[rg][2 * k2][3]);
            t.z = pk2(s[rg][2 * k2 + 1][0], s[rg][2 * k2 + 1][1]); t.w = pk2(s[rg][2 * k2 + 1][2], s[rg][2 * k2 + 1][3]);
            pa[rg][k2] = __builtin_bit_cast(bf16x8, t); } }
#pragma unroll
    for (int dt = 0; dt < 4; ++dt) { f32x4 o[2] = {{0.f, 0.f, 0.f, 0.f}, {0.f, 0.f, 0.f, 0.f}};
#pragma unroll
        for (int k2 = 0; k2 < 6; ++k2) { const int j = k2 >> 1; const LAS unsigned char* vt = lds + (j == 0 ? sl0 : (j == 1 ? sl1 : sl2)) * WR_SLOT + WR_V;
            const bf16x8 vf = lds_frag_tr2(vt, LDVW, 32 * (k2 & 1), 16 * dt, lane);
            o[0] = MFMA16T(pa[0][k2], vf, o[0]); o[1] = MFMA16T(pa[1][k2], vf, o[1]); }
#pragma unroll
        for (int rg = 0; rg < 2; ++rg) { const size_t row = crow0 + 32 * (w & 1) + 16 * rg + (lane & 15);
            const float gv[4] = {__uint_as_float(graw[rg][dt].x << 16), __uint_as_float(graw[rg][dt].x & 0xffff0000u), __uint_as_float(graw[rg][dt].y << 16), __uint_as_float(graw[rg][dt].y & 0xffff0000u)};
            u32x2 pk; pk.x = pk2(o[rg][0] * inv[rg] * siluf(gv[0]), o[rg][1] * inv[rg] * siluf(gv[1])); pk.y = pk2(o[rg][2] * inv[rg] * siluf(gv[2]), o[rg][3] * inv[rg] * siluf(gv[3]));
            *(u32x2*)(MIX + row * 2048 + 1024 + hq * 64 + 16 * dt + 4 * g4) = pk; }
        __builtin_amdgcn_sched_barrier(0); }
}
DI void winattn_item(Ctx& F, int item) {
    LAS unsigned char* lds = F.lds;
    const int tid = F.tid;
    const bf16_t* PROJ = (const bf16_t*)(F.ws + WS_PROJ);
    if (item >= 256) {
        const int sb = (item - 256) >> 1, kvh = item & 1; const size_t row0 = (size_t)MP + sb * 64;
        const float* ck = F.in[I_CWK] + (size_t)sb * 128 * 128; const float* cv = F.in[I_CWV] + (size_t)sb * 128 * 128;
        float* ko = F.out + O_WKS + (size_t)sb * 128 * 128; float* vo = F.out + O_WVS + (size_t)sb * 128 * 128;
        wa_stage_cache(F, lds + 0 * WR_SLOT, kvh, ck, cv, nullptr, nullptr);
        wa_stage_cache(F, lds + 1 * WR_SLOT, kvh, ck + 64 * 128, cv + 64 * 128, ko, vo);
        if (tid < 256) { const int i = tid >> 2, q4 = tid & 3; const bf16_t* p = PROJ + (row0 + i) * NPROJ + C_K + kvh * 64 + 8 * q4;
            wa_write_k(F, lds + 2 * WR_SLOT, kvh, *(const u32x4*)p, *(const u32x4*)(p + 32), 2048 + i, ko + 64 * 128); }
        { const int i = tid >> 3, q8 = tid & 7; wa_write_v(F, lds + 2 * WR_SLOT, kvh, *(const u32x4*)(PROJ + (row0 + i) * NPROJ + C_V + kvh * 64 + 8 * q8), vo + 64 * 128); }
        __syncthreads();
        wa_compute(F, kvh, row0, 2048, 0, 1, 2, 0);
        __syncthreads();
        return;
    }
    const int b = item >> 4, kvh = (item >> 3) & 1, c0 = (item & 7) * 8;
    const size_t seq0 = (size_t)b * T_P;
#pragma unroll 1
    for (int kc = c0 - 2; kc <= c0; ++kc) { LAS unsigned char* slot = lds + (kc & 3) * WR_SLOT;
        if (kc < 0) { for (int t = tid; t < WR_SLOT / 16; t += 512) *(LAS u32x4*)(slot + t * 16) = (u32x4){0u, 0u, 0u, 0u}; }
        else { const size_t row0 = seq0 + (size_t)kc * 64;
            if (tid < 256) { const int i = tid >> 2, q4 = tid & 3; const bf16_t* p = PROJ + (row0 + i) * NPROJ + C_K + kvh * 64 + 8 * q4;
                wa_write_k(F, slot, kvh, *(const u32x4*)p, *(const u32x4*)(p + 32), kc * 64 + i, nullptr); }
            { const int i = tid >> 3, q8 = tid & 7; wa_write_v(F, slot, kvh, *(const u32x4*)(PROJ + (row0 + i) * NPROJ + C_V + kvh * 64 + 8 * q8), nullptr); } } }
    __syncthreads();
#pragma unroll 1
    for (int c = c0; c < c0 + 8; ++c) {
        const bool more = c + 1 < c0 + 8;
        u32x4 ra = {0u, 0u, 0u, 0u}, rb = {0u, 0u, 0u, 0u}, rv = {0u, 0u, 0u, 0u};
        const size_t nrow0 = seq0 + (size_t)(c + 1) * 64;
        if (more) {
            if (tid < 256) { const bf16_t* p = PROJ + (nrow0 + (tid >> 2)) * NPROJ + C_K + kvh * 64 + 8 * (tid & 3); ra = *(const u32x4*)p; rb = *(const u32x4*)(p + 32); }
            rv = *(const u32x4*)(PROJ + (nrow0 + (tid >> 3)) * NPROJ + C_V + kvh * 64 + 8 * (tid & 7)); }
        wa_compute(F, kvh, seq0 + (size_t)c * 64, c * 64, (c - 2) & 3, (c - 1) & 3, c & 3, c >= 2 ? 0 : 2 - c);
        if (more) { LAS unsigned char* slot = lds + ((c + 1) & 3) * WR_SLOT; const int kc = c + 1;
            float* ko = nullptr; float* vo = nullptr;
            if (kc >= 62) { ko = F.out + O_WKP + ((size_t)b * 128 + (kc - 62) * 64) * 128; vo = F.out + O_WVP + ((size_t)b * 128 + (kc - 62) * 64) * 128; }
            if (tid < 256) wa_write_k(F, slot, kvh, ra, rb, kc * 64 + (tid >> 2), ko);
            wa_write_v(F, slot, kvh, rv, vo); }
        __syncthreads();
    }
}

constexpr int MA_K = 0, MA_V = 69632, MA_RS = 143360, LDKM = 272, LDVM = 288;
DI void memattn_item(Ctx& F, int item) {
    LAS unsigned char* lds = F.lds;
    const int tid = F.tid, lane = F.lane, w = F.wave, g4 = lane >> 4;
    const bool smp = item >= 256; const int sidx = item - 256;
    const int bb = smp ? (sidx >> 2) : (item >> 4), h = smp ? (sidx & 3) : ((item >> 2) & 3), qt = item & 3;
    const bf16_t* PROJ = (const bf16_t*)(F.ws + WS_PROJ); bf16_t* MIX = (bf16_t*)(F.ws + WS_MIX); const bf16_t* RAW = (const bf16_t*)(F.ws + WS_MEMRAW);
#pragma unroll 1
    for (int ib = 0; ib < 2; ++ib) {
      u32x4 rk[4], rvv[4]; f32x4 fk[4][2], fv[4][2];
#pragma unroll
      for (int u = 0; u < 4; ++u) { const int t = tid + 512 * (4 * ib + u), key = t >> 4, ch = t & 15;
        if (smp) { const float* ks = F.in[I_CMK] + ((size_t)(bb * 256 + key) * 4 + h) * 128 + 8 * ch; const float* vs = F.in[I_CMV] + ((size_t)(bb * 256 + key) * 4 + h) * 128 + 8 * ch;
            fk[u][0] = *(const f32x4*)ks; fk[u][1] = *(const f32x4*)(ks + 4); fv[u][0] = *(const f32x4*)vs; fv[u][1] = *(const f32x4*)(vs + 4); }
        else { rk[u] = *(const u32x4*)(RAW + (size_t)(bb * 256 + key) * 1024 + h * 128 + 8 * ch); rvv[u] = *(const u32x4*)(RAW + (size_t)(bb * 256 + key) * 1024 + 512 + h * 128 + 8 * ch); } }
#pragma unroll
      for (int u = 0; u < 4; ++u) { const int t = tid + 512 * (4 * ib + u), key = t >> 4, ch = t & 15;
        float k[8], v[8];
        if (smp) {
#pragma unroll
            for (int e = 0; e < 4; ++e) { k[e] = fk[u][0][e]; k[4 + e] = fk[u][1][e]; v[e] = fv[u][0][e]; v[4 + e] = fv[u][1][e]; } }
        else { unpack8(rk[u], k); unpack8(rvv[u], v); }
        float s = 0.f;
#pragma unroll
        for (int e = 0; e < 8; ++e) s += k[e] * k[e];
        s += __shfl_xor(s, 1); s += __shfl_xor(s, 2); s += __shfl_xor(s, 4); s += __shfl_xor(s, 8);
        if (!smp) { const float rstd = 1.0f / sqrtf(s * (1.0f / 128.0f) + EPSF);
#pragma unroll
            for (int e = 0; e < 8; ++e) k[e] = k[e] * rstd * F.in[I_GMK][8 * ch + e]; }
        { float kq[8];
#pragma unroll
          for (int e = 0; e < 8; ++e) kq[e] = k[e] * F.in[I_GMQ][8 * ch + e];
          *(LAS u32x4*)(lds + MA_K + key * LDKM + ch * 16) = pack8(kq); }
        *(LAS u32x4*)(lds + MA_V + key * LDVM + ch * 16) = pack8(v);
        if (!smp && qt == 0) {
            float* ko = F.out + O_MKP + ((size_t)(bb * 256 + key) * 4 + h) * 128 + 8 * ch; float* vo = F.out + O_MVP + ((size_t)(bb * 256 + key) * 4 + h) * 128 + 8 * ch;
            *(f32x4*)ko = (f32x4){k[0], k[1], k[2], k[3]}; *(f32x4*)(ko + 4) = (f32x4){k[4], k[5], k[6], k[7]};
            *(f32x4*)vo = (f32x4){v[0], v[1], v[2], v[3]}; *(f32x4*)(vo + 4) = (f32x4){v[4], v[5], v[6], v[7]}; }
      }
    }
    __syncthreads();
    const int ngr = smp ? 4 : 64;
    const size_t qbase = smp ? (size_t)MP + bb * 64 : (size_t)bb * T_P + qt * 1024;
    u32x4 nq[4]; u32x2 ng[8];
#define MA_LOAD(rg_) do { const size_t r_ = qbase + 16 * (rg_) + (lane & 15); \
        _Pragma("unroll") for (int ks = 0; ks < 4; ++ks) nq[ks] = *(const u32x4*)(PROJ + r_ * NPROJ + C_MQ + h * 128 + 32 * ks + 8 * g4); \
        _Pragma("unroll") for (int dt = 0; dt < 8; ++dt) ng[dt] = *(const u32x2*)(PROJ + r_ * NPROJ + C_GM + h * 128 + 16 * dt + 4 * g4); } while (0)
    if (w < ngr) MA_LOAD(w);
#pragma unroll 1
    for (int rg = w; rg < ngr; rg += 8) {
        u32x4 cq[4]; u32x2 cg[8];
#pragma unroll
        for (int ks = 0; ks < 4; ++ks) cq[ks] = nq[ks];
#pragma unroll
        for (int dt = 0; dt < 8; ++dt) cg[dt] = ng[dt];
        if (rg + 8 < ngr) MA_LOAD(rg + 8);
        bf16x8 qa[4];
        { float q[4][8]; float s = 0.f;
#pragma unroll
          for (int ks = 0; ks < 4; ++ks) { unpack8(cq[ks], q[ks]);
#pragma unroll
              for (int e = 0; e < 8; ++e) s += q[ks][e] * q[ks][e]; }
          s += __shfl_xor(s, 16); s += __shfl_xor(s, 32);
          const float rstd = 0.08838834764831845f / sqrtf(s * (1.0f / 128.0f) + EPSF);
#pragma unroll
          for (int ks = 0; ks < 4; ++ks) {
#pragma unroll
              for (int e = 0; e < 8; ++e) q[ks][e] = q[ks][e] * rstd;
              qa[ks] = __builtin_bit_cast(bf16x8, pack8(q[ks])); } }
        f32x4 s[16];
#pragma unroll
        for (int jt = 0; jt < 16; ++jt) { f32x4 acc = {0.f, 0.f, 0.f, 0.f};
#pragma unroll
            for (int ks = 0; ks < 4; ++ks) acc = MFMA16T(qa[ks], lds_frag(lds + MA_K, LDKM, 16 * jt, 32 * ks, lane), acc);
            s[jt] = acc;
            if ((jt & 3) == 3) __builtin_amdgcn_sched_barrier(0); }
        float m = s[0][0];
#pragma unroll
        for (int jt = 0; jt < 16; ++jt)
#pragma unroll
            for (int r = 0; r < 4; ++r) m = fmaxf(m, s[jt][r]);
        m = fmaxf(m, __shfl_xor(m, 16)); m = fmaxf(m, __shfl_xor(m, 32));
        float sum = 0.f;
#pragma unroll
        for (int jt = 0; jt < 16; ++jt)
#pragma unroll
            for (int r = 0; r < 4; ++r) { const float e = __expf(s[jt][r] - m); s[jt][r] = e; sum += e; }
        sum += __shfl_xor(sum, 16); sum += __shfl_xor(sum, 32);
        const float inv = 1.0f / sum;
        bf16x8 pa[8];
#pragma unroll
        for (int k2 = 0; k2 < 8; ++k2) { u32x4 t; t.x = pk2(s[2 * k2][0], s[2 * k2][1]); t.y = pk2(s[2 * k2][2], s[2 * k2][3]); t.z = pk2(s[2 * k2 + 1][0], s[2 * k2 + 1][1]); t.w = pk2(s[2 * k2 + 1][2], s[2 * k2 + 1][3]);
            pa[k2] = __builtin_bit_cast(bf16x8, t); }
        const size_t orow = qbase + 16 * rg + (lane & 15);
#pragma unroll
        for (int dt = 0; dt < 8; ++dt) { f32x4 o = {0.f, 0.f, 0.f, 0.f};
#pragma unroll
            for (int k2 = 0; k2 < 8; ++k2) o = MFMA16T(pa[k2], lds_frag_tr2(lds + MA_V, LDVM, 32 * k2, 16 * dt, lane), o);
            __builtin_amdgcn_sched_barrier(0);
            const int col = h * 128 + 16 * dt + 4 * g4;
            const u32x2 gr = cg[dt];
            const float gv[4] = {__uint_as_float(gr.x << 16), __uint_as_float(gr.x & 0xffff0000u), __uint_as_float(gr.y << 16), __uint_as_float(gr.y & 0xffff0000u)};
            u32x2 pk; pk.x = pk2(o[0] * inv * siluf(gv[0]), o[1] * inv * siluf(gv[1])); pk.y = pk2(o[2] * inv * siluf(gv[2]), o[3] * inv * siluf(gv[3]));
            *(u32x2*)(MIX + orow * 2048 + 1536 + col) = pk; }
    }
#undef MA_LOAD
    __syncthreads();
}

DI void p2a_attn(Ctx& F) {
    for (int rep = 0; rep < REP_WIN; ++rep)
    for (int it = F.bid; it < 320; it += F.G) winattn_item(F, it);
    __syncthreads();
    for (int rep = 0; rep < REP_MEM; ++rep)
    { for (int it = F.bid; it < 256; it += F.G) memattn_item(F, it);
      for (int s = (F.bid + F.G - (128 % F.G)) % F.G; s < 128; s += F.G) memattn_item(F, 256 + s); }
}
DI void p2b_phase(Ctx& F) {
    for (int rep = 0; rep < REP_SSD; ++rep)
    for (int it = F.bid; it < 48 * 16; it += F.G) ssd_item(F, it >> 4, it & 15, rep == 0);
}

constexpr int G2_A = 0, G2_B = 9216, G2_SET = 27648;
DI void gemm2_sample(Ctx& F) {
    LAS unsigned char* lds = F.lds;
    const int tid = F.tid, lane = F.lane, w = F.wave, g4 = lane >> 4;
    const bf16_t* MIX = (const bf16_t*)(F.ws + WS_MIX); const bf16_t* WOT = (const bf16_t*)(F.ws + WS_WOUT); const float* SUMSQ = (const float*)(F.ws + WS_SSQ);
    for (int tile = F.bid; tile < 256; tile += F.G) {
        const int r0 = MP + 64 * (tile >> 3), c0 = 128 * (tile & 7);
        const bf16_t* asrc = MIX + (size_t)(r0 + (tid >> 3)) * 2048 + 8 * (tid & 7);
        const bf16_t* bsrc0 = WOT + (size_t)(c0 + (tid >> 3)) * 2048 + 8 * (tid & 7);
        const bf16_t* bsrc1 = bsrc0 + (size_t)64 * 2048;
        const int aoff = G2_A + (tid >> 3) * 144 + (tid & 7) * 16, boff0 = G2_B + (tid >> 3) * 144 + (tid & 7) * 16, boff1 = boff0 + 64 * 144;
        f32x4 acc[4] = {{0.f, 0.f, 0.f, 0.f}, {0.f, 0.f, 0.f, 0.f}, {0.f, 0.f, 0.f, 0.f}, {0.f, 0.f, 0.f, 0.f}};
        u32x4 ra[4], rb0[4], rb1[4];
#pragma unroll
        for (int j = 0; j < 4; ++j) { ra[j] = *(const u32x4*)(asrc + 64 * j); rb0[j] = *(const u32x4*)(bsrc0 + 64 * j); rb1[j] = *(const u32x4*)(bsrc1 + 64 * j); }
        *(LAS u32x4*)(lds + aoff) = ra[0]; *(LAS u32x4*)(lds + boff0) = rb0[0]; *(LAS u32x4*)(lds + boff1) = rb1[0];
        ra[0] = *(const u32x4*)(asrc + 64 * 4); rb0[0] = *(const u32x4*)(bsrc0 + 64 * 4); rb1[0] = *(const u32x4*)(bsrc1 + 64 * 4);
        __syncthreads();
#pragma unroll 1
        for (int kt4 = 0; kt4 < 32; kt4 += 4) {
#pragma unroll
            for (int u = 0; u < 4; ++u) { const int kt = kt4 + u;
                const LAS unsigned char* cs = lds + (u & 1) * G2_SET; LAS unsigned char* ns = lds + ((u + 1) & 1) * G2_SET;
                if (kt == 16) { const float r = 1.0f / sqrtf(SUMSQ[r0 + 16 * (w >> 1) + (lane & 15)] * (1.0f / 1024.0f) + EPSF);
#pragma unroll
                    for (int t = 0; t < 4; ++t) acc[t] = acc[t] * r; }
#pragma unroll
                for (int ks = 0; ks < 2; ++ks) { const bf16x8 a = lds_frag(cs + G2_A, 144, 16 * (w >> 1), 32 * ks, lane);
#pragma unroll
                    for (int t = 0; t < 4; ++t) acc[t] = MFMA16T(a, lds_frag(cs + G2_B, 144, 64 * (w & 1) + 16 * t, 32 * ks, lane), acc[t]); }
                constexpr int dummy_ = 0; (void)dummy_;
                const int rs = (u + 1) & 3;
                if (kt + 1 < 32) { *(LAS u32x4*)(ns + aoff) = ra[rs]; *(LAS u32x4*)(ns + boff0) = rb0[rs]; *(LAS u32x4*)(ns + boff1) = rb1[rs]; }
                if (kt + 5 < 32) { ra[rs] = *(const u32x4*)(asrc + 64 * (kt + 5)); rb0[rs] = *(const u32x4*)(bsrc0 + 64 * (kt + 5)); rb1[rs] = *(const u32x4*)(bsrc1 + 64 * (kt + 5)); }
                __syncthreads();
            }
        }
        const int row = r0 + 16 * (w >> 1) + (lane & 15), cw = c0 + 64 * (w & 1) + 4 * g4;
        const float* xr = F.in[I_XS] + (size_t)(row - MP) * DM + cw; float* orow = F.out + (size_t)row * DM + cw;
#pragma unroll
        for (int t = 0; t < 4; ++t) *(f32x4*)(orow + 16 * t) = acc[t] + *(const f32x4*)(xr + 16 * t);
    }
}
__global__ void __launch_bounds__(512, 2) hymba_fwd(Args args) {
    extern __shared__ __attribute__((aligned(16))) unsigned char lds_raw[];
    cg::grid_group grid = cg::this_grid();
    Ctx F;
    F.lds = (LAS unsigned char*)lds_raw; F.tid = threadIdx.x; F.lane = F.tid & 63; F.wave = __builtin_amdgcn_readfirstlane(F.tid >> 6); F.G = gridDim.x; F.bid = blockIdx.x;
#pragma unroll
    for (int i = 0; i < 26; ++i) F.in[i] = args.in[i];
    F.out = args.out; F.ws = args.ws;
    volatile LAS unsigned* bst = (volatile LAS unsigned*)(F.lds + LDS_BYTES - 64);
    if (F.tid < 16) bst[F.tid] = 0u;
    __syncthreads();
    const XcdBarrier xbar = xcd_barrier_post((unsigned*)(F.ws + WS_CTL), bst);
#define GRID_BAR() xcd_barrier(xbar)

#define PHASE_FENCE() do { int t_ = threadIdx.x; asm volatile("" : "+v"(t_)); F.tid = t_; F.lane = t_ & 63; F.wave = __builtin_amdgcn_readfirstlane(t_ >> 6); } while (0)
    for (int rep = 0; rep < REP_P0; ++rep) { if (rep) __syncthreads(); p0_prologue(F); }
    grid.sync(); PHASE_FENCE();
    {
        pg8::Gemm g{(const bf16_t*)(F.ws + WS_A), (const bf16_t*)(F.ws + WS_BT), MA, NBT, 1024};
        Order1 S; S.init(F.G, F.bid);
        EpiProj E{(bf16_t*)(F.ws + WS_PROJ), (bf16_t*)(F.ws + WS_MEMRAW)};
        pg8::gemm_phase<EpiProj, Order1, true, true>(F.lds, g, S, E);
    }
    GRID_BAR(); PHASE_FENCE();
    for (int rep = 0; rep < REP_P2A; ++rep) p2a_phase(F);
    __syncthreads();
    p2a_attn(F);
    GRID_BAR(); PHASE_FENCE();
    p2b_phase(F);
    GRID_BAR(); PHASE_FENCE();
    gemm2_sample(F);
    {
        pg8::Gemm g{(const bf16_t*)(F.ws + WS_MIX), (const bf16_t*)(F.ws + WS_WOUT), MTOT, 1024, 2048};
        Order3 S; S.init(F.G, F.bid);
        EpiOut E{F.in[I_XP], F.in[I_XS], F.out, (const float*)(F.ws + WS_SSQ)};
        pg8::gemm_phase<EpiOut, Order3, true, true>(F.lds, g, S, E);
    }
#if DBG_SCALE3 || DBG_ZERO
    grid.sync();
    {
        const size_t offs[13] = {O_Y, (size_t)MP * 1024, O_WKP, O_WVP, O_SSMP, O_CONVP, O_MKP, O_MVP, O_WKS, O_WVS, O_SSMS, O_CONVS, O_END};
        for (int o = 0; o < 12; ++o) {
            const bool z = (DBG_ZERO >> o) & 1, s3 = (DBG_SCALE3 >> o) & 1;
            if (!z && !s3) continue;
            for (size_t i = offs[o] + (size_t)F.bid * 512 + F.tid; i < offs[o + 1]; i += (size_t)F.G * 512) F.out[i] = z ? 0.f : F.out[i] * 3.0f;
        }
    }
#endif
}

extern "C" void kernel_launch(void* const* d_in, const int* in_sizes, int n_in, void* d_out, int out_size, void* d_ws, size_t ws_size, hipStream_t stream) {
    static int grid = 0;
    if (grid == 0) {
        if (n_in != 26 || (size_t)out_size != O_END || ws_size < WS_END) { fprintf(stderr, "kernel_launch: unexpected problem (n_in %d out %d ws %zu)\n", n_in, out_size, ws_size); grid = -1; return; }
        int dev = 0, cus = 0, per_cu = 0;
        if (hipGetDevice(&dev) != hipSuccess || hipDeviceGetAttribute(&cus, hipDeviceAttributeMultiprocessorCount, dev) != hipSuccess) { grid = -1; return; }
        if (hipFuncSetAttribute((const void*)hymba_fwd, hipFuncAttributeMaxDynamicSharedMemorySize, LDS_BYTES) != hipSuccess) { fprintf(stderr, "kernel_launch: hipFuncSetAttribute failed\n"); grid = -1; return; }
        if (hipOccupancyMaxActiveBlocksPerMultiprocessor(&per_cu, (const void*)hymba_fwd, 512, LDS_BYTES) != hipSuccess || per_cu < 1) { fprintf(stderr, "kernel_launch: occupancy query says %d\n", per_cu); (void)hipGetLastError(); grid = -1; return; }
        grid = cus;
        fprintf(stderr, "kernel_launch: %d CUs, occupancy %d per CU, grid %d\n", cus, per_cu, grid);
    }
    if (grid < 0) return;
    Args a{};
    for (int i = 0; i < 26; ++i) a.in[i] = (const float*)d_in[i];
    a.out = (float*)d_out; a.ws = (unsigned char*)d_ws;
    if (hipMemsetAsync((char*)d_ws + WS_CTL, 0, CTL_ZERO_BYTES, stream) != hipSuccess) { fprintf(stderr, "kernel_launch: memset of the barrier words failed\n"); return; }
    void* kargs[] = {&a};
    const hipError_t e = hipLaunchCooperativeKernel((const void*)hymba_fwd, dim3(grid), dim3(512), kargs, LDS_BYTES, stream);
    if (e != hipSuccess) fprintf(stderr, "kernel_launch: cooperative launch failed: %s\n", hipGetErrorString(e));
}
```

```cpp
#include <hip/hip_runtime.h>
#include <hip/hip_cooperative_groups.h>
#include <cstdio>
#include <cstdint>
namespace cg = cooperative_groups;
namespace pg8 {
#define PG8_LAS __attribute__((address_space(3)))
typedef unsigned short bf16_t;
typedef short bf16x8 __attribute__((ext_vector_type(8)));
typedef float f32x4 __attribute__((ext_vector_type(4)));
typedef unsigned u32x4 __attribute__((ext_vector_type(4)));
constexpr int BM = 256, BK = 64, HALF = 128, HTB = HALF * BK * 2  , STAGE_BYTES = 8 * HTB, NXCD = 8, WGM = 8;

__host__ __device__ __forceinline__ int lds_byte(int r, int c) { const int st = (r >> 4) * 2 + (c >> 5), rr = r & 15, cc = c & 31, ob = rr * 64 + cc * 2; return st * 1024 + (ob ^ (((ob >> 9) & 1) << 5)); }
__host__ __device__ __forceinline__ void stage_rc(int b, int& R, int& C) { const int st = b / 1024, sb = b % 1024, swz = sb ^ (((sb >> 9) & 1) << 5); R = (st >> 1) * 16 + swz / 64; C = (st & 1) * 32 + (swz % 64) / 2; }
__host__ __device__ __forceinline__ int perm32(int rho) { const int n = rho >> 4, i = rho & 15; return 8 * (i >> 2) + 4 * n + (i & 3); }

struct Unit { int pm, pn; };
struct Gemm { const bf16_t* A; const bf16_t* Bt; int M, N, K; };

struct StaticOrder {
    int nM, nN, nwg, G, c;
    __host__ __device__ void init(int M, int N, int G_, int c_) { nM = M / BM; nN = N / BM; nwg = nM * nN; G = G_; c = c_; }
    __host__ __device__ bool next(int i, Unit& u) const {
        const long L = (long)i * G + c; if (L >= nwg) return false;
        int wgid = (int)L; { const int q = nwg / NXCD, r = nwg % NXCD, xcd = wgid % NXCD, off = wgid / NXCD; wgid = (xcd < r ? xcd * (q + 1) : r * (q + 1) + (xcd - r) * q) + off; }
        const int nig = WGM * nN, gid = wgid / nig, fm = gid * WGM, gsz = (nM - fm) < WGM ? (nM - fm) : WGM;
        u.pm = fm + ((wgid % nig) % gsz); u.pn = (wgid % nig) / gsz; return true;
    }
    __device__ __forceinline__ void a_ready(const Unit&) const {}
    __device__ __forceinline__ void done(const Unit&) const {}
};

template <class Epi, class Sched, bool ALIGN_EPI = false, bool SP2 = false>
__device__ __forceinline__ void gemm_phase(PG8_LAS unsigned char* lds, const Gemm g, const Sched& S, const Epi& E) {
    int tid_ = threadIdx.x; asm volatile("" : "+v"(tid_));
    const int tid = tid_, wid = __builtin_amdgcn_readfirstlane(tid >> 6), lane = tid & 63, wr = wid >> 2, wc = wid & 3, fr = lane & 15, fq = lane >> 4;
    const int K = g.K, nt = K / BK;
    unsigned voffA[2], voffB[2];
#pragma unroll
    for (int i = 0; i < 2; ++i) { int R, C; stage_rc(tid * 16 + i * 8192, R, C); const int Rb = Epi::PERM ? ((R & ~31) + perm32(R & 31)) : R;
        voffA[i] = (unsigned)(R * K + C) * 2u; voffB[i] = (unsigned)(Rb * K + C) * 2u; }
    const size_t kstep = (size_t)(BK * 2);
    const size_t hstep = (size_t)HALF * K * 2;
    const size_t tstep = 2 * hstep;
    const unsigned ldsw = (unsigned)wid * 1024u;
    const int aoff = lds_byte(wr * 64 + fr, fq * 8), boff = lds_byte(wc * 32 + fr, fq * 8);
#define PG8_SA(b, h) (((b) * 2 + (h)) * HTB)
#define PG8_SB(b, h) ((4 + (b) * 2 + (h)) * HTB)
#define PG8_STAGE(bufoff, gbase, voff) do { _Pragma("unroll") for (int _i = 0; _i < 2; ++_i) \
        __builtin_amdgcn_global_load_lds((const unsigned*)((const char*)(gbase) + (voff)[_i]), (PG8_LAS unsigned*)(lds + (bufoff) + ldsw + _i * 8192), 16, 0, 0); } while (0)
#define PG8_LDA(dst, b, h) do { _Pragma("unroll") for (int m = 0; m < 4; ++m) _Pragma("unroll") for (int k = 0; k < 2; ++k) dst[m][k] = *(const PG8_LAS bf16x8*)(lds + PG8_SA(b, h) + aoff + m * 2048 + k * 1024); } while (0)
#define PG8_LDB(dst, b, h) do { _Pragma("unroll") for (int n = 0; n < 2; ++n) _Pragma("unroll") for (int k = 0; k < 2; ++k) dst[n][k] = *(const PG8_LAS bf16x8*)(lds + PG8_SB(b, h) + boff + n * 2048 + k * 1024); } while (0)
#define PG8_MMA(ai, bj, At, Bt) do { __builtin_amdgcn_s_setprio(1); _Pragma("unroll") for (int m = 0; m < 4; ++m) _Pragma("unroll") for (int n = 0; n < 2; ++n) _Pragma("unroll") for (int k = 0; k < 2; ++k) \
        acc[ai][bj][m][n] = __builtin_amdgcn_mfma_f32_16x16x32_bf16(Bt[n][k], At[m][k], acc[ai][bj][m][n], 0, 0, 0); __builtin_amdgcn_s_setprio(0); } while (0)
#define PG8_WAIT_V(n) asm volatile("s_waitcnt vmcnt(" #n ")" ::: "memory")
#define PG8_WAIT_L(n) asm volatile("s_waitcnt lgkmcnt(" #n ")" ::: "memory")
#define PG8_BAR __builtin_amdgcn_s_barrier()
#define PG8_SCHED __builtin_amdgcn_sched_barrier(0)
    Unit cur, nxt; int ui = 0;
    if (!S.next(0, cur)) return;
    f32x4 acc[2][2][4][2];
#pragma unroll
    for (int a = 0; a < 2; ++a)
#pragma unroll
        for (int b = 0; b < 2; ++b)
#pragma unroll
            for (int m = 0; m < 4; ++m)
#pragma unroll
                for (int n = 0; n < 2; ++n) acc[a][b][m][n] = (f32x4){0.f, 0.f, 0.f, 0.f};
    bf16x8 At[4][2], B0[2][2], B1[2][2];
    const char* cA = (const char*)g.A + (size_t)cur.pm * tstep; const char* cB = (const char*)g.Bt + (size_t)cur.pn * tstep;
    S.a_ready(cur);
    if constexpr (SP2) {
        PG8_STAGE(PG8_SB(0, 0), cB, voffB); PG8_STAGE(PG8_SB(0, 1), cB + hstep, voffB); PG8_STAGE(PG8_SA(0, 0), cA, voffA); PG8_STAGE(PG8_SA(0, 1), cA + hstep, voffA);
        if (wr == 1) PG8_BAR;
        PG8_WAIT_V(2); PG8_BAR;
        PG8_STAGE(PG8_SB(1, 0), cB + kstep, voffB); PG8_STAGE(PG8_SA(1, 0), cA + kstep, voffA); PG8_STAGE(PG8_SB(1, 1), cB + hstep + kstep, voffB);
        PG8_WAIT_V(6); PG8_BAR;
    } else {
        PG8_STAGE(PG8_SB(0, 0), cB, voffB); PG8_STAGE(PG8_SA(0, 0), cA, voffA); PG8_STAGE(PG8_SB(0, 1), cB + hstep, voffB); PG8_STAGE(PG8_SA(0, 1), cA + hstep, voffA);
        if (wr == 1) PG8_BAR;
        PG8_WAIT_V(4); PG8_BAR;
        PG8_STAGE(PG8_SB(1, 0), cB + kstep, voffB); PG8_STAGE(PG8_SA(1, 0), cA + kstep, voffA); PG8_STAGE(PG8_SB(1, 1), cB + hstep + kstep, voffB);
        PG8_WAIT_V(6); PG8_BAR;
    }
    for (;;) {
        const bool has_next = S.next(ui + 1, nxt);
        const char* nA = has_next ? (const char*)g.A + (size_t)nxt.pm * tstep : cA; const char* nB = has_next ? (const char*)g.Bt + (size_t)nxt.pn * tstep : cB;
        for (int t = 0; t < nt; t += 2) {
            const bool last = (t == nt - 2);
            const char* a1 = cA + (size_t)(t + 1) * kstep;
            const char* a2 = last ? nA : cA + (size_t)(t + 2) * kstep; const char* b2 = last ? nB : cB + (size_t)(t + 2) * kstep;
            const char* a3 = a2 + kstep; const char* b3 = b2 + kstep;
            if (last && has_next) S.a_ready(nxt);
            if constexpr (Epi::MIDK > 0) { if (t == Epi::MIDK) E.mid(acc, cur, wr, wc, fr, fq); }
            if constexpr (SP2) {
            PG8_LDB(B0, 0, 0); PG8_LDB(B1, 0, 1); PG8_SCHED; PG8_LDA(At, 0, 0); PG8_STAGE(PG8_SA(1, 1), a1 + hstep, voffA);
            PG8_WAIT_V(8); PG8_WAIT_L(0); PG8_BAR; PG8_MMA(0, 0, At, B0); PG8_MMA(0, 1, At, B1); PG8_BAR; PG8_SCHED;
            PG8_LDA(At, 0, 1); PG8_STAGE(PG8_SB(0, 0), b2, voffB); PG8_STAGE(PG8_SB(0, 1), b2 + hstep, voffB); PG8_STAGE(PG8_SA(0, 0), a2, voffA);
            PG8_WAIT_V(8); PG8_WAIT_L(0); PG8_BAR; PG8_MMA(1, 0, At, B0); PG8_MMA(1, 1, At, B1); PG8_BAR; PG8_SCHED;
            PG8_LDB(B0, 1, 0); PG8_LDB(B1, 1, 1); PG8_SCHED; PG8_LDA(At, 1, 0); PG8_STAGE(PG8_SA(0, 1), a2 + hstep, voffA);
            PG8_WAIT_V(8); PG8_WAIT_L(0); PG8_BAR; PG8_MMA(0, 0, At, B0); PG8_MMA(0, 1, At, B1); PG8_BAR; PG8_SCHED;
            PG8_LDA(At, 1, 1); PG8_STAGE(PG8_SB(1, 0), b3, voffB); PG8_STAGE(PG8_SB(1, 1), b3 + hstep, voffB); PG8_STAGE(PG8_SA(1, 0), a3, voffA);
            PG8_WAIT_V(8); PG8_WAIT_L(0); PG8_BAR; PG8_MMA(1, 0, At, B0); PG8_MMA(1, 1, At, B1); PG8_BAR; PG8_SCHED;
            } else {
            PG8_LDB(B0, 0, 0); PG8_SCHED; PG8_LDA(At, 0, 0); PG8_STAGE(PG8_SA(1, 1), a1 + hstep, voffA);
            PG8_WAIT_L(8); PG8_BAR; PG8_WAIT_L(0); PG8_MMA(0, 0, At, B0); PG8_BAR; PG8_SCHED;
            PG8_LDB(B1, 0, 1); PG8_STAGE(PG8_SB(0, 0), b2, voffB);
            PG8_BAR; PG8_WAIT_L(0); PG8_MMA(0, 1, At, B1); PG8_BAR;
            PG8_LDA(At, 0, 1); PG8_STAGE(PG8_SA(0, 0), a2, voffA);
            PG8_BAR; PG8_WAIT_L(0); PG8_MMA(1, 0, At, B0); PG8_BAR; PG8_SCHED;
            PG8_STAGE(PG8_SB(0, 1), b2 + hstep, voffB);
            PG8_WAIT_V(6); PG8_BAR; PG8_MMA(1, 1, At, B1); PG8_BAR;
            PG8_LDB(B0, 1, 0); PG8_SCHED; PG8_LDA(At, 1, 0); PG8_STAGE(PG8_SA(0, 1), a2 + hstep, voffA);
            PG8_WAIT_L(8); PG8_BAR; PG8_WAIT_L(0); PG8_MMA(0, 0, At, B0); PG8_BAR; PG8_SCHED;
            PG8_LDB(B1, 1, 1); PG8_STAGE(PG8_SB(1, 0), b3, voffB);
            PG8_BAR; PG8_WAIT_L(0); PG8_MMA(0, 1, At, B1); PG8_BAR;
            PG8_LDA(At, 1, 1); PG8_STAGE(PG8_SA(1, 0), a3, voffA);
            PG8_BAR; PG8_WAIT_L(0); PG8_MMA(1, 0, At, B0); PG8_BAR; PG8_SCHED;
            PG8_STAGE(PG8_SB(1, 1), b3 + hstep, voffB);
            PG8_WAIT_V(6); PG8_BAR; PG8_MMA(1, 1, At, B1); PG8_BAR;
            }
        }
        if constexpr (ALIGN_EPI) { if (wr == 0) PG8_BAR; }
        if constexpr (!Epi::AFTER_DRAIN) { E(acc, cur, wr, wc, fr, fq); S.done(cur); }
        if (!has_next) break;
#pragma unroll
        for (int a = 0; a < 2; ++a)
#pragma unroll
            for (int b = 0; b < 2; ++b)
#pragma unroll
                for (int m = 0; m < 4; ++m)
#pragma unroll
                    for (int n = 0; n < 2; ++n) acc[a][b][m][n] = (f32x4){0.f, 0.f, 0.f, 0.f};
        cur = nxt; cA = nA; cB = nB; ++ui;
        if constexpr (ALIGN_EPI) { if (wr == 1) PG8_BAR; }
    }
    PG8_WAIT_V(0);
    if constexpr (!ALIGN_EPI) { if (wr == 0) PG8_BAR; }
    PG8_BAR;
    if constexpr (Epi::AFTER_DRAIN) { E.fused(acc, cur, wr, wc, fr, fq, lds, wid, lane); S.done(cur); }
#undef PG8_SA
#undef PG8_SB
#undef PG8_STAGE
#undef PG8_LDA
#undef PG8_LDB
#undef PG8_MMA
#undef PG8_WAIT_V
#undef PG8_WAIT_L
#undef PG8_BAR
#undef PG8_SCHED
}
}
#ifndef DBG_SCALE3
#define DBG_SCALE3 0
#endif
#ifndef DBG_ZERO
#define DBG_ZERO 0
#endif
#ifndef LAST_PHASE
#define LAST_PHASE 4
#endif
#ifndef REP_P0
#define REP_P0 1
#endif
#ifndef REP_P1
#define REP_P1 1
#endif
#ifndef REP_P2A
#define REP_P2A 1
#endif
#ifndef REP_P0T
#define REP_P0T 1
#endif
#ifndef REP_P0R
#define REP_P0R 1
#endif
#ifndef REP_S2
#define REP_S2 1
#endif
#ifndef REP_S3
#define REP_S3 1
#endif
#ifndef REP_S4
#define REP_S4 1
#endif
#ifndef REP_ATOM
#define REP_ATOM 1
#endif
#ifndef REP_SSD
#define REP_SSD 1
#endif
#ifndef REP_WIN
#define REP_WIN 1
#endif
#ifndef REP_MEM
#define REP_MEM 1
#endif
#ifndef REP_P3
#define REP_P3 1
#endif
#define DI __device__ __forceinline__
#define LAS __attribute__((address_space(3)))
typedef unsigned short bf16_t;
typedef short bf16x8 __attribute__((ext_vector_type(8)));
typedef float f32x4 __attribute__((ext_vector_type(4)));
typedef float f32x2 __attribute__((ext_vector_type(2)));
typedef unsigned u32x4 __attribute__((ext_vector_type(4)));
typedef unsigned u32x2 __attribute__((ext_vector_type(2)));

constexpr int NB_P = 16, T_P = 4096, NB_S = 32, T_S = 64, DM = 1024;
constexpr int MP = NB_P * T_P, MS = NB_S * T_S, MTOT = MP + MS;
constexpr int MMEM = NB_P * 256, MA = MTOT + MMEM;
constexpr int NPROJ = 4864, NBT = NPROJ + 1024, INC = 4880;
constexpr int C_Q = 0, C_K = 512, C_V = 640, C_GA = 768, C_Z = 1280, C_XBC = 2304, C_MQ = 3840, C_GM = 4352;
constexpr int NCHUNK = MTOT / 64;
constexpr float EPSF = 1e-6f;
constexpr size_t O_Y = 0;
constexpr size_t O_WKP = (size_t)MTOT * 1024;
constexpr size_t O_WVP = O_WKP + (size_t)NB_P * 128 * 128;
constexpr size_t O_SSMP = O_WVP + (size_t)NB_P * 128 * 128;
constexpr size_t O_CONVP = O_SSMP + (size_t)NB_P * 16 * 64 * 128;
constexpr size_t O_MKP = O_CONVP + (size_t)NB_P * 3 * 1536;
constexpr size_t O_MVP = O_MKP + (size_t)NB_P * 256 * 512;
constexpr size_t O_WKS = O_MVP + (size_t)NB_P * 256 * 512;
constexpr size_t O_WVS = O_WKS + (size_t)NB_S * 128 * 128;
constexpr size_t O_SSMS = O_WVS + (size_t)NB_S * 128 * 128;
constexpr size_t O_CONVS = O_SSMS + (size_t)NB_S * 16 * 64 * 128;
constexpr size_t O_END = O_CONVS + (size_t)NB_S * 3 * 1536;
static_assert(O_END == 81485824, "output size");
constexpr size_t MiB = 1u << 20;
constexpr size_t WS_ROPE = 1 * MiB;
constexpr size_t WS_BT = 2 * MiB;
constexpr size_t WS_WOUT = 14 * MiB;
constexpr size_t WS_DT = 18 * MiB;
constexpr size_t WS_SSQ = 23 * MiB;
constexpr size_t WS_CTL = 0, CTL_ZERO_BYTES = 65536;
constexpr size_t WS_MEMRAW = 32 * MiB;
constexpr size_t WS_MEMK = 40 * MiB;
constexpr size_t WS_MEMVT = 52 * MiB;
constexpr size_t WS_PROJ = 64 * MiB;
constexpr size_t WS_A = 692 * MiB;
constexpr size_t WS_MIX = 692 * MiB;
constexpr size_t WS_BCC = 956 * MiB;
constexpr size_t WS_END = 1022 * MiB;
static_assert(WS_BT + (size_t)NBT * 1024 * 2 <= WS_WOUT && WS_DT + (size_t)MTOT * 64 <= WS_SSQ && WS_SSQ + (size_t)MTOT * 128 <= WS_MEMRAW, "ws map 1");
static_assert(WS_PROJ + (size_t)MTOT * NPROJ * 2 <= WS_A && WS_A + (size_t)MA * 1024 * 2 <= WS_END && WS_MIX + (size_t)MTOT * 2048 * 2 <= WS_BCC && WS_BCC + (size_t)MTOT * 512 * 2 <= WS_END, "ws map 2");
constexpr int LDS_BYTES = 147456;

DI float bf2f(unsigned short b) { return __uint_as_float((unsigned)b << 16); }
typedef __bf16 hbf2 __attribute__((ext_vector_type(2)));
DI unsigned short f2bf(float f) { return __builtin_bit_cast(unsigned short, (__bf16)f); }
DI unsigned pk2(float lo, float hi) { const f32x2 v = {lo, hi}; return __builtin_bit_cast(unsigned, __builtin_convertvector(v, hbf2)); }
DI unsigned cvt_pk_bf16(float lo, float hi) { return pk2(lo, hi); }
DI float siluf(float x) { return x * __builtin_amdgcn_rcpf(1.0f + __expf(-x)); }
DI float wave_sum(float v) {
#pragma unroll
    for (int o = 1; o < 64; o <<= 1) v += __shfl_xor(v, o);
    return v;
}
DI void unpack8(const u32x4 v, float (&o)[8]) {
#pragma unroll
    for (int i = 0; i < 4; ++i) { o[2 * i] = __uint_as_float(v[i] << 16); o[2 * i + 1] = __uint_as_float(v[i] & 0xffff0000u); }
}
DI u32x4 pack8(const float (&o)[8]) { u32x4 v; v.x = pk2(o[0], o[1]); v.y = pk2(o[2], o[3]); v.z = pk2(o[4], o[5]); v.w = pk2(o[6], o[7]); return v; }
#define LDS_WAIT() asm volatile("s_waitcnt lgkmcnt(0)" ::: "memory")
#define MFMA16(a, b, c) __builtin_amdgcn_mfma_f32_16x16x32_bf16((a), (b), (c), 0, 0, 0)

struct Args { const float* in[26]; float* out; unsigned char* ws; };
struct Ctx {
    LAS unsigned char* lds; int tid, lane, wave, G, bid;
    const float* in[26]; float* out; unsigned char* ws;
};
#define RLX_AGENT __ATOMIC_RELAXED, __HIP_MEMORY_SCOPE_AGENT
#define XB_TMO      128
#define XB_XCNT(j)  (256  + 64 * (j))
#define XB_XSUB(j)  (1280 + 64 * (j))
#define XB_XGEN(j)  (2304 + 64 * (j))
#define XB_TOP      3328
#define XB_TOPGEN   3392
#define XCD_BAR_WORDS 3456
#define XB_SPIN_CAP (1u << 18)

__device__ __forceinline__ unsigned xb_ld(unsigned* p)              { return __hip_atomic_load(p, __ATOMIC_RELAXED, __HIP_MEMORY_SCOPE_AGENT); }
__device__ __forceinline__ unsigned xb_add(unsigned* p, unsigned v) { return __hip_atomic_fetch_add(p, v, __ATOMIC_RELAXED, __HIP_MEMORY_SCOPE_AGENT); }
__device__ __forceinline__ unsigned xb_xcc_id() { return (unsigned)__builtin_amdgcn_s_getreg((3 << 11) | 20) & 0xFu; }
#define XB_SPIN(cond, bar) do { unsigned _sp = 0; while (cond) { __builtin_amdgcn_s_sleep(1); \
    if ((++_sp & 255u) == 0u) { if (xb_ld(&(bar)[XB_TMO])) break; if (_sp > XB_SPIN_CAP) { atomicAdd(&(bar)[XB_TMO], 1u); break; } } } } while (0)

struct XcdBarrier {
    unsigned* bar; unsigned x;
    volatile LAS unsigned* st;
};

__device__ __forceinline__ XcdBarrier xcd_barrier_post(unsigned* bar, volatile LAS unsigned* st) {
    XcdBarrier b; b.bar = bar; b.x = xb_xcc_id(); b.st = st;
    if (threadIdx.x == 0) (void)xb_add(&bar[XB_XCNT(b.x)], 1u);
    return b;
}
__device__ __forceinline__ void xcd_barrier_complete(unsigned* bar, unsigned x, unsigned& nloc, unsigned& nx) {
    const unsigned G = gridDim.x * gridDim.y * gridDim.z;
    unsigned sum, cnt, mine, sp = 0u;
    for (;;) {
        sum = 0u; cnt = 0u; mine = 0u;
#pragma unroll
        for (unsigned j = 0; j < 16; ++j) { const unsigned c = xb_ld(&bar[XB_XCNT(j)]); sum += c; cnt += (c > 0u) ? 1u : 0u; mine = (j == x) ? c : mine; }
        if (sum == G) break;
        __builtin_amdgcn_s_sleep(1);
        if ((++sp & 255u) == 0u) { if (xb_ld(&bar[XB_TMO])) break; if (sp > XB_SPIN_CAP) { atomicAdd(&bar[XB_TMO], 1u); break; } }
    }
    nloc = mine > 0u ? mine : 1u; nx = cnt > 0u ? cnt : 1u;
}

__device__ __forceinline__ void xcd_barrier(const XcdBarrier& b) {
    asm volatile("s_waitcnt vmcnt(0)" ::: "memory");
    __syncthreads();
    if (threadIdx.x == 0) {
        unsigned* bar = b.bar;
        __builtin_amdgcn_s_waitcnt(0);
        unsigned nloc = b.st[0], nx = b.st[1];
        if (nloc == 0u) { xcd_barrier_complete(bar, b.x, nloc, nx); b.st[0] = nloc; b.st[1] = nx; }
        const unsigned old = xb_add(&bar[XB_XSUB(b.x)], 1u);
        const unsigned gen = old / nloc;
        if (old + 1u == (gen + 1u) * nloc) {
            __builtin_amdgcn_fence(__ATOMIC_RELEASE, "agent");
            asm volatile("s_waitcnt vmcnt(0)" ::: "memory");
            const unsigned og = xb_add(&bar[XB_TOP], 1u);
            const unsigned tg = og / nx;
            if (og + 1u == (tg + 1u) * nx) xb_add(&bar[XB_TOPGEN], 1u);
            else XB_SPIN(xb_ld(&bar[XB_TOPGEN]) == tg, bar);
            __builtin_amdgcn_fence(__ATOMIC_ACQUIRE, "agent");
            xb_add(&bar[XB_XGEN(b.x)], 1u);
            asm volatile("s_waitcnt vmcnt(0)" ::: "memory");
        } else {
            XB_SPIN(xb_ld(&bar[XB_XGEN(b.x)]) == gen, bar);
            __builtin_amdgcn_fence(__ATOMIC_ACQUIRE, "agent");
            asm volatile("s_waitcnt vmcnt(0)" ::: "memory");
        }
    }
    __syncthreads();
}

enum { I_XP = 0, I_XS, I_CWK, I_CWV, I_SSM, I_SCONV, I_CMK, I_CMV, I_MEM, I_GNORM, I_WIN, I_GQ, I_GK, I_SINKS, I_CONVW, I_CONVB, I_DTB, I_ALOG, I_DSKIP, I_GSSD, I_GMEM, I_WMK, I_WMV, I_GMK, I_GMQ, I_WOUT };

DI void p0_transpose_item(const float* W, int ldw, int src_k0, int src_n0, const float* rowscale, bf16_t* WT, int ldt, int dst_n0, int dst_k0, LAS float* scr, int lane) {
#pragma unroll 8
    for (int i = 0; i < 32; ++i) { const int kk = 2 * i + (lane >> 5); float v = W[(size_t)(src_k0 + kk) * ldw + src_n0 + (lane & 31)]; if (rowscale) v *= rowscale[kk]; scr[kk * 33 + (lane & 31)] = v; }
    LDS_WAIT();
    const int c = lane & 7;
#pragma unroll
    for (int j = 0; j < 4; ++j) { const int n = (lane >> 3) + 8 * j; const LAS float* s = scr + (8 * c) * 33 + n;
        u32x4 o; o.x = pk2(s[0 * 33], s[1 * 33]); o.y = pk2(s[2 * 33], s[3 * 33]); o.z = pk2(s[4 * 33], s[5 * 33]); o.w = pk2(s[6 * 33], s[7 * 33]);
        *(u32x4*)(WT + (size_t)(dst_n0 + n) * ldt + dst_k0 + 8 * c) = o; }
    LDS_WAIT();
}

DI float reduce16_to_lane(float (&a)[16], int lane) {
#pragma unroll
    for (int j = 0; j < 16; ++j) { a[j] += __shfl_xor(a[j], 32); a[j] += __shfl_xor(a[j], 16); }
    float r8[8], r4[4], r2[2];
    const bool b3 = (lane & 8) != 0, b2 = (lane & 4) != 0, b1 = (lane & 2) != 0, b0 = (lane & 1) != 0;
#pragma unroll
    for (int j = 0; j < 8; ++j) { const float snd = b3 ? a[j] : a[j + 8], kp = b3 ? a[j + 8] : a[j]; r8[j] = kp + __shfl_xor(snd, 8); }
#pragma unroll
    for (int j = 0; j < 4; ++j) { const float snd = b2 ? r8[j] : r8[j + 4], kp = b2 ? r8[j + 4] : r8[j]; r4[j] = kp + __shfl_xor(snd, 4); }
#pragma unroll
    for (int j = 0; j < 2; ++j) { const float snd = b1 ? r4[j] : r4[j + 2], kp = b1 ? r4[j + 2] : r4[j]; r2[j] = kp + __shfl_xor(snd, 2); }
    const float snd = b0 ? r2[0] : r2[1], kp = b0 ? r2[1] : r2[0];
    return kp + __shfl_xor(snd, 1);
}

DI void p0_rows2(f32x4 (&va)[4], f32x4 (&vb)[4], const float* g, bf16_t* oa, bf16_t* ob, float* dta, float* dtb, bool want_dt, const float* dt_bias, const LAS float* wdt, int lane) {
    float sa = 0.f, sb = 0.f;
#pragma unroll
    for (int jj = 0; jj < 4; ++jj) { sa += (va[jj].x * va[jj].x + va[jj].y * va[jj].y) + (va[jj].z * va[jj].z + va[jj].w * va[jj].w); sb += (vb[jj].x * vb[jj].x + vb[jj].y * vb[jj].y) + (vb[jj].z * vb[jj].z + vb[jj].w * vb[jj].w); }
    const float ra = 1.0f / sqrtf(wave_sum(sa) * (1.0f / DM) + EPSF), rb = 1.0f / sqrtf(wave_sum(sb) * (1.0f / DM) + EPSF);
    u32x2* pa = (u32x2*)oa + lane; u32x2* pb = (u32x2*)ob + lane;
#pragma unroll
    for (int jj = 0; jj < 4; ++jj) { const f32x4 gv = ((const f32x4*)g)[64 * jj + lane]; va[jj] = va[jj] * ra * gv; vb[jj] = vb[jj] * rb * gv;
        u32x2 w; w.x = pk2(va[jj].x, va[jj].y); w.y = pk2(va[jj].z, va[jj].w); pa[64 * jj] = w; w.x = pk2(vb[jj].x, vb[jj].y); w.y = pk2(vb[jj].z, vb[jj].w); pb[64 * jj] = w; }
    if (want_dt) {
        f32x2 ab[16];
#pragma unroll
        for (int j = 0; j < 16; ++j) ab[j] = (f32x2){0.f, 0.f};
#pragma unroll
        for (int jj = 0; jj < 4; ++jj)
#pragma unroll
            for (int e = 0; e < 4; ++e) { const f32x2 hab = {va[jj][e], vb[jj][e]}; const LAS f32x4* wr = (const LAS f32x4*)(wdt + ((jj * 4 + e) * 64 + lane) * 20);
#pragma unroll
                for (int q = 0; q < 4; ++q) { const f32x4 w4 = wr[q];
                    ab[4 * q] += hab * w4.x; ab[4 * q + 1] += hab * w4.y; ab[4 * q + 2] += hab * w4.z; ab[4 * q + 3] += hab * w4.w; }
                if (e & 1) __builtin_amdgcn_sched_barrier(0); }
        float a[16], b[16];
#pragma unroll
        for (int j = 0; j < 16; ++j) { a[j] = ab[j].x; b[j] = ab[j].y; }
        const float ta = reduce16_to_lane(a, lane), tb = reduce16_to_lane(b, lane);
        if (lane < 16) { const float xa = ta + dt_bias[lane], xb = tb + dt_bias[lane];
            dta[lane] = fmaxf(xa, 0.f) + log1pf(__expf(-fabsf(xa))); dtb[lane] = fmaxf(xb, 0.f) + log1pf(__expf(-fabsf(xb))); }
    }
}

DI void p0_row_segment(Ctx& F, const float* src, const float* g, int m0, int npair, bool tok, bf16_t* A, float* DT, const LAS float* wdt, int gw, int NGW) {
    const int lane = F.lane;
    f32x4 n0a[4], n0b[4], n1a[4], n1b[4];
#define P0_LOAD(dst_a, dst_b, pp) do { if ((pp) < npair) { _Pragma("unroll") for (int jj = 0; jj < 4; ++jj) { \
        dst_a[jj] = ((const f32x4*)(src + (size_t)(2 * (pp)) * DM))[64 * jj + lane]; dst_b[jj] = ((const f32x4*)(src + (size_t)(2 * (pp) + 1) * DM))[64 * jj + lane]; } } } while (0)
    P0_LOAD(n0a, n0b, gw); P0_LOAD(n1a, n1b, gw + NGW);
    for (int p = gw; p < npair; p += NGW) {
        f32x4 va[4], vb[4];
#pragma unroll
        for (int jj = 0; jj < 4; ++jj) { va[jj] = n0a[jj]; vb[jj] = n0b[jj]; n0a[jj] = n1a[jj]; n0b[jj] = n1b[jj]; }
        P0_LOAD(n1a, n1b, p + 2 * NGW);
        const int m = m0 + 2 * p;
        p0_rows2(va, vb, g, A + (size_t)m * DM, A + (size_t)(m + 1) * DM, DT + (size_t)(tok ? m : 0) * 16, DT + (size_t)(tok ? m + 1 : 0) * 16, tok, F.in[I_DTB], wdt, lane);
    }
#undef P0_LOAD
}

DI void p0_prologue(Ctx& F) {
    const int gw = F.bid * 8 + F.wave, NGW = F.G * 8, lane = F.lane;
    bf16_t* BT = (bf16_t*)(F.ws + WS_BT); bf16_t* WOT = (bf16_t*)(F.ws + WS_WOUT);
    for (int rep_ = 0; rep_ < REP_P0T; ++rep_) {
        LAS float* scr = (LAS float*)(F.lds + F.wave * 16384);
        constexpr int I_IN = 16 * (NPROJ / 32), I_M = 16 * 32, I_O = 32 * 32;
        for (int it = gw; it < I_IN + I_M + I_O; it += NGW) {
            int r = it;
            if (r < I_IN) { const int kb = r / (NPROJ / 32), nb = r % (NPROJ / 32); const int n0 = 32 * nb;
                p0_transpose_item(F.in[I_WIN], INC, 64 * kb, n0 + (n0 >= 3840 ? 16 : 0), nullptr, BT, 1024, n0, 64 * kb, scr, lane); continue; }
            r -= I_IN;
            if (r < I_M) { const int kb = r / 32, nb = r % 32;
                p0_transpose_item(nb < 16 ? F.in[I_WMK] : F.in[I_WMV], 512, 64 * kb, 32 * (nb & 15), nullptr, BT, 1024, NPROJ + 32 * nb, 64 * kb, scr, lane); continue; }
            r -= I_M;
            { const int kb = r / 32, nb = r % 32; const int k0 = 64 * kb;
              const int sk0 = k0 < 1024 ? 512 + k0 : (k0 < 1536 ? k0 - 1024 : k0);
              p0_transpose_item(F.in[I_WOUT], 1024, sk0, 32 * nb, k0 < 1024 ? F.in[I_GSSD] + k0 : nullptr, WOT, 2048, 32 * nb, k0, scr, lane); }
        }
    }
    { float* sq = (float*)(F.ws + WS_SSQ); for (int i = F.bid * 512 + F.tid; i < MTOT; i += F.G * 512) sq[i] = 0.f; }
    {
        f32x2* rope = (f32x2*)(F.ws + WS_ROPE);
        for (int i = F.bid * 512 + F.tid; i < 4096 * 32; i += F.G * 512) {
            const int pos = i >> 5, fi = i & 31;
            const float freq = exp2f(-(float)fi * (13.287712379549449f / 32.0f));
            double rev = (double)pos * (double)freq * 0.15915494309189535;
            rev -= __builtin_rint(rev);
            const float ang = (float)(rev * 6.283185307179586);
            rope[i] = (f32x2){cosf(ang), sinf(ang)};
        }
    }
    __syncthreads();
    for (int rep_ = 0; rep_ < REP_P0R; ++rep_) {
        if (rep_) __syncthreads();
        LAS float* wdt = (LAS float*)F.lds;
#pragma unroll 1
        for (int i0 = F.tid; i0 < 1024 * 16; i0 += 512 * 8) { float t8[8];
#pragma unroll
            for (int u = 0; u < 8; ++u) { const int i = i0 + 512 * u; t8[u] = F.in[I_WIN][(size_t)(i >> 4) * INC + 3840 + (i & 15)]; }
#pragma unroll
            for (int u = 0; u < 8; ++u) { const int i = i0 + 512 * u, k = i >> 4, j = i & 15; const int jj = k >> 8, e = k & 3, l = (k >> 2) & 63;
                wdt[((jj * 4 + e) * 64 + l) * 20 + j] = t8[u]; } }
        __syncthreads();
        bf16_t* A = (bf16_t*)(F.ws + WS_A); float* DT = (float*)(F.ws + WS_DT);
        p0_row_segment(F, F.in[I_XP], F.in[I_GNORM], 0, MP / 2, true, A, DT, wdt, gw, NGW);
        p0_row_segment(F, F.in[I_XS], F.in[I_GNORM], MP, MS / 2, true, A, DT, wdt, gw, NGW);
        p0_row_segment(F, F.in[I_MEM], F.in[I_GMEM], MTOT, MMEM / 2, false, A, DT, wdt, gw, NGW);
    }
}
struct Order1 {
    pg8::StaticOrder so; int G, c;
    __device__ void init(int G_, int c_) { so.init(MTOT, NPROJ, G_, c_); G = G_; c = c_; }
    __device__ bool next(int i, pg8::Unit& u) const {
        long L = (long)i * G + c;
        if (L >= (long)REP_P1 * (so.nwg + 64)) return false;
        L %= (so.nwg + 64);
        if (L < so.nwg) { pg8::StaticOrder t = so; t.G = 1; t.c = 0; return t.next((int)L, u); }
        const int r = (int)(L - so.nwg);
        u.pm = MTOT / 256 + (r >> 2); u.pn = NPROJ / 256 + (r & 3); return true;
    }
    __device__ __forceinline__ void a_ready(const pg8::Unit&) const {}
    __device__ __forceinline__ void done(const pg8::Unit&) const {}
};
struct Order3 {
    pg8::StaticOrder so; int G, c;
    __device__ void init(int G_, int c_) { so.init(MP, 1024, 1, 0); G = G_; c = c_; }
    __device__ bool next(int i, pg8::Unit& u) const {
        long L = (long)i * G + c;
        if (L >= (long)REP_P3 * so.nwg) return false;
        return so.next((int)(L % so.nwg), u);
    }
    __device__ __forceinline__ void a_ready(const pg8::Unit&) const {}
    __device__ __forceinline__ void done(const pg8::Unit&) const {}
};
struct EpiProj {
    static constexpr bool PERM = true, AFTER_DRAIN = false; static constexpr int MIDK = 0;
    bf16_t* proj; bf16_t* memraw;
    __device__ __forceinline__ void operator()(const f32x4 (&acc)[2][2][4][2], const pg8::Unit& u, int wr, int wc, int fr, int fq) const {
        bf16_t* base; int ldc, row0, col0;
        if (u.pn < NPROJ / 256) { base = proj; ldc = NPROJ; row0 = u.pm * 256; col0 = u.pn * 256; }
        else { base = memraw; ldc = 1024; row0 = (u.pm - MTOT / 256) * 256; col0 = (u.pn - NPROJ / 256) * 256; }
        row0 += wr * 64 + fr; col0 += wc * 32 + 8 * fq;
#pragma unroll
        for (int ai = 0; ai < 2; ++ai)
#pragma unroll
            for (int m = 0; m < 4; ++m) { bf16_t* rowp = base + (size_t)(row0 + ai * 128 + m * 16) * ldc + col0;
#pragma unroll
                for (int bj = 0; bj < 2; ++bj) { const f32x4 v0 = acc[ai][bj][m][0], v1 = acc[ai][bj][m][1];
                    u32x4 w; w.x = cvt_pk_bf16(v0[0], v0[1]); w.y = cvt_pk_bf16(v0[2], v0[3]); w.z = cvt_pk_bf16(v1[0], v1[1]); w.w = cvt_pk_bf16(v1[2], v1[3]);
                    *(u32x4*)(rowp + bj * 128) = w; } }
    }
};
struct EpiOut {
    static constexpr bool PERM = false, AFTER_DRAIN = false; static constexpr int MIDK = 16;
    const float* xp; const float* xs; float* out; const float* sumsq;
    __device__ __forceinline__ void mid(f32x4 (&acc)[2][2][4][2], const pg8::Unit& u, int wr, int wc, int fr, int fq) const {
        const float* sq = sumsq + (size_t)u.pm * 256 + wr * 64 + fr;
#pragma unroll
        for (int ai = 0; ai < 2; ++ai)
#pragma unroll
            for (int m = 0; m < 4; ++m) { const float r = 1.0f / sqrtf(sq[ai * 128 + m * 16] * (1.0f / 1024.0f) + EPSF);
#pragma unroll
                for (int bj = 0; bj < 2; ++bj)
#pragma unroll
                    for (int n = 0; n < 2; ++n) acc[ai][bj][m][n] = acc[ai][bj][m][n] * r; }
    }
    __device__ __forceinline__ void operator()(const f32x4 (&acc)[2][2][4][2], const pg8::Unit& u, int wr, int wc, int fr, int fq) const {
        const float* xb = u.pm < MP / 256 ? xp + (size_t)u.pm * 256 * DM : xs + (size_t)(u.pm - MP / 256) * 256 * DM;
        float* ob = out + (size_t)u.pm * 256 * DM;
        const int rl0 = wr * 64 + fr, col0 = u.pn * 256 + wc * 32 + 4 * fq;
#pragma unroll
        for (int ai = 0; ai < 2; ++ai) {
            f32x4 xv[4][2][2];
#pragma unroll
            for (int m = 0; m < 4; ++m)
#pragma unroll
                for (int bj = 0; bj < 2; ++bj)
#pragma unroll
                    for (int n = 0; n < 2; ++n) xv[m][bj][n] = *(const f32x4*)(xb + (size_t)(rl0 + ai * 128 + m * 16) * DM + col0 + bj * 128 + n * 16);
#pragma unroll
            for (int m = 0; m < 4; ++m)
#pragma unroll
                for (int bj = 0; bj < 2; ++bj)
#pragma unroll
                    for (int n = 0; n < 2; ++n) *(f32x4*)(ob + (size_t)(rl0 + ai * 128 + m * 16) * DM + col0 + bj * 128 + n * 16) = acc[ai][bj][m][n] + xv[m][bj][n];
            asm volatile("" ::: "memory"); }
    }
};

constexpr int SS_X = 0, SS_XD = 9216, SS_BM = 18432, SS_CM = 35840, SS_SB = 53248, SS_WM = 70656, SS_SM = 79872;
constexpr int LD64 = 144, LD128 = 272;
typedef short s16x4 __attribute__((ext_vector_type(4)));

DI bf16x8 lds_frag(const LAS unsigned char* tile, int ld, int row0, int k0, int lane) {
    return *(const LAS bf16x8*)(tile + (row0 + (lane & 15)) * ld + (k0 + 8 * (lane >> 4)) * 2);
}
DI bf16x8 lds_frag_tr(const LAS unsigned char* tile, int ld, int k0, int c0, int lane) {
    const LAS unsigned char* a = tile + (k0 + 8 * (lane >> 4) + ((lane & 15) >> 2)) * ld + (c0 + 4 * (lane & 3)) * 2;
    const s16x4 lo = __builtin_amdgcn_ds_read_tr16_b64_v4i16((LAS s16x4*)a), hi = __builtin_amdgcn_ds_read_tr16_b64_v4i16((LAS s16x4*)(a + 4 * ld));
    return (bf16x8){lo.x, lo.y, lo.z, lo.w, hi.x, hi.y, hi.z, hi.w};
}
DI bf16x8 lds_frag_tr2(const LAS unsigned char* tile, int ld, int k0, int c0, int lane) {
    const LAS unsigned char* a = tile + (k0 + 4 * (lane >> 4) + ((lane & 15) >> 2)) * ld + (c0 + 4 * (lane & 3)) * 2;
    const s16x4 lo = __builtin_amdgcn_ds_read_tr16_b64_v4i16((LAS s16x4*)a), hi = __builtin_amdgcn_ds_read_tr16_b64_v4i16((LAS s16x4*)(a + 16 * ld));
    return (bf16x8){lo.x, lo.y, lo.z, lo.w, hi.x, hi.y, hi.z, hi.w};
}
#define MFMA16T(rowsfrag, colsfrag, acc) MFMA16((colsfrag), (rowsfrag), (acc))

DI void convbc_prepass(Ctx& F) {
    const int gw = F.bid * 8 + F.wave, NGW = F.G * 8, lane = F.lane;
    const bf16_t* PROJ = (const bf16_t*)(F.ws + WS_PROJ); bf16_t* BCC = (bf16_t*)(F.ws + WS_BCC);
    const int ch0 = 1024 + lane * 8;
    float wv[4][8], bv[8];
#pragma unroll
    for (int e = 0; e < 8; ++e) { bv[e] = F.in[I_CONVB][ch0 + e];
#pragma unroll
        for (int j = 0; j < 4; ++j) wv[j][e] = F.in[I_CONVW][j * 1536 + ch0 + e]; }
    const bool bal = (F.G == 256);
    const int nmine = bal ? (F.bid < 64 ? 0 : (F.bid < 128 ? 2 : 1)) : (MTOT / 33 - gw + NGW - 1) / NGW;
    for (int ti = 0; ti < nmine; ++ti) {
        const int t = bal ? (F.bid < 128 ? ((F.bid - 64) * 8 + F.wave) * 2 + ti : 1024 + (F.bid - 128) * 8 + F.wave) : gw + ti * NGW;
        const int row0 = t * 33;
        float h0[8], h1[8], h2[8];
        { const bool smp0 = row0 >= MP; const int lrow0 = smp0 ? (row0 - MP) & 63 : row0 & (T_P - 1);
          const float* sc0 = F.in[I_SCONV] + (size_t)(smp0 ? (row0 - MP) >> 6 : 0) * 3 * 1536 + ch0;
#define CONV_HALO(dst, j) do { const int lr_ = lrow0 - 3 + (j); \
              if (lr_ >= 0) unpack8(*(const u32x4*)(PROJ + (size_t)(row0 - 3 + (j)) * NPROJ + C_XBC + ch0), dst); \
              else { _Pragma("unroll") for (int e = 0; e < 8; ++e) dst[e] = smp0 ? sc0[(3 + lr_) * 1536 + e] : 0.f; } } while (0)
          CONV_HALO(h0, 0); CONV_HALO(h1, 1); CONV_HALO(h2, 2);
#undef CONV_HALO
        }
#pragma unroll 1
        for (int bt = 0; bt < 3; ++bt) {
            u32x4 raw[11];
#pragma unroll
            for (int i = 0; i < 11; ++i) raw[i] = *(const u32x4*)(PROJ + (size_t)(row0 + 11 * bt + i) * NPROJ + C_XBC + ch0);
#pragma unroll
            for (int i = 0; i < 11; ++i) { const int row = row0 + 11 * bt + i;
                const bool smp = row >= MP; const int lrow = smp ? (row - MP) & 63 : row & (T_P - 1);
                if (lrow == 0) {
                    if (smp) { const float* sc = F.in[I_SCONV] + (size_t)((row - MP) >> 6) * 3 * 1536 + ch0;
#pragma unroll
                        for (int e = 0; e < 8; ++e) { h0[e] = sc[e]; h1[e] = sc[1536 + e]; h2[e] = sc[2 * 1536 + e]; } }
                    else {
#pragma unroll
                        for (int e = 0; e < 8; ++e) { h0[e] = 0.f; h1[e] = 0.f; h2[e] = 0.f; } } }
                float cur[8], o[8];
                unpack8(raw[i], cur);
#pragma unroll
                for (int e = 0; e < 8; ++e) { o[e] = siluf(bv[e] + wv[0][e] * h0[e] + wv[1][e] * h1[e] + wv[2][e] * h2[e] + wv[3][e] * cur[e]); h0[e] = h1[e]; h1[e] = h2[e]; h2[e] = cur[e]; }
                *(u32x4*)(BCC + (size_t)row * 512 + lane * 8) = pack8(o); }
        }
    }
}

DI void ssd_item(Ctx& F, int sq, int h, bool do_sumsq) {
    LAS unsigned char* lds = F.lds;
    const int tid = F.tid, lane = F.lane, w = F.wave, g = h >> 3;
    const bool smp = sq >= NB_P; const int sb = sq - NB_P;
    const int row_base = smp ? MP + sb * 64 : sq * T_P, nchunks = smp ? 1 : 64;
    const bf16_t* PROJ = (const bf16_t*)(F.ws + WS_PROJ); const bf16_t* BCC = (const bf16_t*)(F.ws + WS_BCC); const float* DT = (const float*)(F.ws + WS_DT);
    bf16_t* MIX = (bf16_t*)(F.ws + WS_MIX); float* SUMSQ = (float*)(F.ws + WS_SSQ);
    const float a_h = -__expf(F.in[I_ALOG][h]), d_h = F.in[I_DSKIP][h];
    const int pt = w >> 1, nh = w & 1, lt = w >> 1;
    const int xl = tid >> 3, xg = tid & 7, chx = h * 64 + 8 * xg;
    LAS float* sm_cw0 = (LAS float*)(lds + SS_SM + 1024 + 768);
    if (tid >= 192 && tid < 512) { const int i = tid - 192; const int j = i >> 6, chn = h * 64 + (i & 63); sm_cw0[i] = j < 4 ? F.in[I_CONVW][j * 1536 + chn] : F.in[I_CONVB][chn]; }
    f32x4 st[4];
#pragma unroll
    for (int q = 0; q < 4; ++q) {
        if (smp) st[q] = *(const f32x4*)(F.in[I_SSM] + ((size_t)(sb * 16 + h) * 64 + 16 * pt + (lane & 15)) * 128 + 16 * (4 * nh + q) + 4 * (lane >> 4));
        else st[q] = (f32x4){0.f, 0.f, 0.f, 0.f};
    }
    u32x4 px0[4], px1[4], pbs[2], pcs[2]; u32x2 pz0[2], pz1[2]; float pdt0, pdt1;
#define SSD_ISSUE_X(c_, PX_) do { const int row0_ = row_base + 64 * (c_); \
        _Pragma("unroll") for (int j_ = 0; j_ < 4; ++j_) { int rr_ = xl - 3 + j_; if ((c_) == 0 && rr_ < 0) rr_ = 0; PX_[j_] = *(const u32x4*)(PROJ + (size_t)(row0_ + rr_) * NPROJ + C_XBC + chx); } } while (0)
#define SSD_ISSUE_BC(c_) do { const int row0_ = row_base + 64 * (c_); \
        _Pragma("unroll") for (int i_ = 0; i_ < 2; ++i_) { const int t_ = tid + 512 * i_; \
            pbs[i_] = *(const u32x4*)(BCC + (size_t)(row0_ + (t_ >> 4)) * 512 + g * 128 + 8 * (t_ & 15)); pcs[i_] = *(const u32x4*)(BCC + (size_t)(row0_ + (t_ >> 4)) * 512 + 256 + g * 128 + 8 * (t_ & 15)); } } while (0)
#define SSD_ISSUE_ZDT(c_, PZ_, PDT_) do { const int row0_ = row_base + 64 * (c_); \
        _Pragma("unroll") for (int pi_ = 0; pi_ < 2; ++pi_) PZ_[pi_] = *(const u32x2*)(PROJ + (size_t)(row0_ + 16 * lt + (lane & 15)) * NPROJ + C_Z + h * 64 + 16 * (2 * nh + pi_) + 4 * (lane >> 4)); \
        PDT_ = DT[(size_t)(row0_ + lane) * 16 + h]; } while (0)
    LAS float* sm_init = (LAS float*)(lds + SS_SM + 1024);
    if (tid < 192) sm_init[tid] = smp ? F.in[I_SCONV][(size_t)(sb * 3 + (tid >> 6)) * 1536 + h * 64 + (tid & 63)] : 0.f;
#define SSD_STEP(c, PX_, PZ_, PDT_) do { \
        const int row0 = row_base + 64 * c; \
        LAS float* sm_ac = (LAS float*)(lds + SS_SM + (c & 1) * 512); LAS float* sm_dt = sm_ac + 64; \
        const float dtl = PDT_; \
        float ac = dtl * a_h; \
_Pragma("unroll")         for (int o = 1; o < 64; o <<= 1) { const float t = __shfl_up(ac, o); if (lane >= o) ac += t; } \
        const float ac_last = __shfl(ac, 63); \
        const float wgt_l = __expf(ac_last - ac) * dtl; \
        if (w == 0) { sm_ac[lane] = ac; sm_dt[lane] = dtl; } \
        __syncthreads(); \
        { \
        { float xr[4][8], o[8], od[8]; \
_Pragma("unroll")           for (int j = 0; j < 4; ++j) unpack8(PX_[j], xr[j]); \
          if (c == 0) { \
_Pragma("unroll")               for (int j = 0; j < 3; ++j) { const int rr = xl - 3 + j; const LAS f32x4* iv = (const LAS f32x4*)(sm_init + (rr < 0 ? 3 + rr : 0) * 64 + 8 * xg); \
                  f32x4 i0 = iv[0], i1 = iv[1]; asm volatile("" : "+v"(i0), "+v"(i1)); \
_Pragma("unroll")                   for (int e = 0; e < 4; ++e) { xr[j][e] = (rr < 0) ? i0[e] : xr[j][e]; xr[j][4 + e] = (rr < 0) ? i1[e] : xr[j][4 + e]; } } } \
          const float wg = __shfl(wgt_l, xl & 63); \
          float wv[4][8], bv[8]; unsigned cwo_ = (unsigned)(8 * xg) * 4u; asm volatile("" : "+v"(cwo_)); const LAS float* sm_cw = (const LAS float*)((const LAS unsigned char*)sm_cw0 + cwo_) - 8 * xg; \
          _Pragma("unroll") for (int j_ = 0; j_ < 4; ++j_) { const f32x4 a_ = *(const LAS f32x4*)(sm_cw + j_ * 64 + 8 * xg), b_ = *(const LAS f32x4*)(sm_cw + j_ * 64 + 8 * xg + 4); \
              _Pragma("unroll") for (int e_ = 0; e_ < 4; ++e_) { wv[j_][e_] = a_[e_]; wv[j_][4 + e_] = b_[e_]; } } \
          { const f32x4 a_ = *(const LAS f32x4*)(sm_cw + 256 + 8 * xg), b_ = *(const LAS f32x4*)(sm_cw + 256 + 8 * xg + 4); _Pragma("unroll") for (int e_ = 0; e_ < 4; ++e_) { bv[e_] = a_[e_]; bv[4 + e_] = b_[e_]; } } \
_Pragma("unroll")           for (int e = 0; e < 8; ++e) { o[e] = siluf(bv[e] + wv[0][e] * xr[0][e] + wv[1][e] * xr[1][e] + wv[2][e] * xr[2][e] + wv[3][e] * xr[3][e]); od[e] = o[e] * wg; } \
          *(LAS u32x4*)(lds + SS_X + xl * LD64 + xg * 16) = pack8(o); \
          *(LAS u32x4*)(lds + SS_XD + xl * LD64 + xg * 16) = pack8(od); } \
_Pragma("unroll")         for (int i = 0; i < 2; ++i) { const int t = tid + 512 * i; \
            *(LAS u32x4*)(lds + SS_BM + (t >> 4) * LD128 + (t & 15) * 16) = pbs[i]; *(LAS u32x4*)(lds + SS_CM + (t >> 4) * LD128 + (t & 15) * 16) = pcs[i]; } \
_Pragma("unroll")         for (int q = 0; q < 4; ++q) { u32x2 v; v.x = pk2(st[q][0], st[q][1]); v.y = pk2(st[q][2], st[q][3]); \
            *(LAS u32x2*)(lds + SS_SB + (16 * pt + (lane & 15)) * LD128 + (16 * (4 * nh + q) + 4 * (lane >> 4)) * 2) = v; } \
        } \
        if (c + 2 < nchunks) SSD_ISSUE_X(c + 2, PX_); if (c + 1 < nchunks) SSD_ISSUE_BC(c + 1); \
        __syncthreads(); \
        { const float acl = sm_ac[16 * lt + (lane & 15)]; const int l = 16 * lt + (lane & 15); \
_Pragma("unroll")           for (int si = 0; si < 2; ++si) { const int stl = 2 * nh + si; f32x4 gacc = {0.f, 0.f, 0.f, 0.f}; \
              if (stl <= lt) { \
_Pragma("unroll")                   for (int ks = 0; ks < 4; ++ks) gacc = MFMA16T(lds_frag(lds + SS_CM, LD128, 16 * lt, 32 * ks, lane), lds_frag(lds + SS_BM, LD128, 16 * stl, 32 * ks, lane), gacc); } \
              const int s0 = 16 * stl + 4 * (lane >> 4); \
              const f32x4 acs = *(const LAS f32x4*)(sm_ac + s0), dts = *(const LAS f32x4*)(sm_dt + s0); \
              float v[4]; \
_Pragma("unroll")               for (int r = 0; r < 4; ++r) { v[r] = gacc[r] * __expf(fminf(acl - acs[r], 0.f)) * dts[r]; v[r] = (l >= s0 + r) ? v[r] : 0.f; } \
              u32x2 pk; pk.x = pk2(v[0], v[1]); pk.y = pk2(v[2], v[3]); \
              *(LAS u32x2*)(lds + SS_WM + l * LD64 + s0 * 2) = pk; } } \
        __syncthreads(); \
        { \
        { const int l = 16 * lt + (lane & 15); const float eal = __expf(sm_ac[l]); \
          float ssq = 0.f; \
_Pragma("unroll")           for (int pi = 0; pi < 2; ++pi) { const int ptl = 2 * nh + pi; const int p0 = 16 * ptl + 4 * (lane >> 4); \
              f32x4 y = {0.f, 0.f, 0.f, 0.f}; \
_Pragma("unroll")               for (int ks = 0; ks < 4; ++ks) y = MFMA16T(lds_frag(lds + SS_CM, LD128, 16 * lt, 32 * ks, lane), lds_frag(lds + SS_SB, LD128, 16 * ptl, 32 * ks, lane), y); \
              y = y * eal; \
_Pragma("unroll")               for (int ks = 0; ks < 2; ++ks) y = MFMA16T(lds_frag(lds + SS_WM, LD64, 16 * lt, 32 * ks, lane), lds_frag_tr(lds + SS_X, LD64, 32 * ks, 16 * ptl, lane), y); \
              const u32x2 xraw = *(const LAS u32x2*)(lds + SS_X + l * LD64 + p0 * 2); \
              const float xv[4] = {__uint_as_float(xraw.x << 16), __uint_as_float(xraw.x & 0xffff0000u), __uint_as_float(xraw.y << 16), __uint_as_float(xraw.y & 0xffff0000u)}; \
              const float zv[4] = {__uint_as_float(PZ_[pi].x << 16), __uint_as_float(PZ_[pi].x & 0xffff0000u), __uint_as_float(PZ_[pi].y << 16), __uint_as_float(PZ_[pi].y & 0xffff0000u)}; \
              float gv[4]; \
_Pragma("unroll")               for (int r = 0; r < 4; ++r) { gv[r] = (y[r] + d_h * xv[r]) * siluf(zv[r]); ssq += gv[r] * gv[r]; } \
              u32x2 pk; pk.x = pk2(gv[0], gv[1]); pk.y = pk2(gv[2], gv[3]); \
              *(u32x2*)(MIX + (size_t)(row0 + l) * 2048 + h * 64 + p0) = pk; } \
          ssq += __shfl_xor(ssq, 16); ssq += __shfl_xor(ssq, 32); \
          if (lane < 16 && do_sumsq) unsafeAtomicAdd(SUMSQ + row0 + l, ssq); } \
        } \
        { const float cd = __expf(ac_last); \
          bf16x8 xa[2]; \
_Pragma("unroll")           for (int ks = 0; ks < 2; ++ks) xa[ks] = lds_frag_tr(lds + SS_XD, LD64, 32 * ks, 16 * pt, lane); \
_Pragma("unroll")           for (int q = 0; q < 4; ++q) { f32x4 s = st[q] * cd; \
_Pragma("unroll")               for (int ks = 0; ks < 2; ++ks) s = MFMA16T(xa[ks], lds_frag_tr(lds + SS_BM, LD128, 32 * ks, 16 * (4 * nh + q), lane), s); \
              st[q] = s; } } \
        if (c + 2 < nchunks) SSD_ISSUE_ZDT(c + 2, PZ_, PDT_); \
    } while (0)
    SSD_ISSUE_X(0, px0); SSD_ISSUE_BC(0); SSD_ISSUE_ZDT(0, pz0, pdt0);
    if (nchunks > 1) { SSD_ISSUE_X(1, px1); SSD_ISSUE_ZDT(1, pz1, pdt1); }
#pragma unroll 1
    for (int c2 = 0; c2 < nchunks; c2 += 2) {
        { const int c = c2; SSD_STEP(c, px0, pz0, pdt0); }
        if (c2 + 1 < nchunks) { const int c = c2 + 1; SSD_STEP(c, px1, pz1, pdt1); }
    }
#undef SSD_STEP
#undef SSD_ISSUE_X
#undef SSD_ISSUE_BC
#undef SSD_ISSUE_ZDT
    { float* so = F.out + (smp ? O_SSMS + ((size_t)(sb * 16 + h) * 64) * 128 : O_SSMP + ((size_t)(sq * 16 + h) * 64) * 128);
#pragma unroll
      for (int q = 0; q < 4; ++q) *(f32x4*)(so + (16 * pt + (lane & 15)) * 128 + 16 * (4 * nh + q) + 4 * (lane >> 4)) = st[q]; }
    __syncthreads();
}
DI void p2a_phase(Ctx& F) {
    convbc_prepass(F);
    {
        const bf16_t* PROJ = (const bf16_t*)(F.ws + WS_PROJ);
        for (int i = F.bid * 512 + F.tid; i < 48 * 3 * 1536; i += F.G * 512) {
            const int ch = i % 1536, j = (i / 1536) % 3, sq = i / (3 * 1536);
            if (sq < NB_P) F.out[O_CONVP + (size_t)(sq * 3 + j) * 1536 + ch] = bf2f(PROJ[(size_t)(sq * T_P + T_P - 3 + j) * NPROJ + C_XBC + ch]);
            else F.out[O_CONVS + (size_t)((sq - NB_P) * 3 + j) * 1536 + ch] = bf2f(PROJ[(size_t)(MP + (sq - NB_P) * 64 + 61 + j) * NPROJ + C_XBC + ch]);
        }
    }
}
constexpr int WR_SLOT = 19456, WR_V = 9216, LDKW = 144, LDVW = 160;

DI void wa_write_k(Ctx& F, LAS unsigned char* slot, int kvh, const u32x4 ra, const u32x4 rb, int pos, float* ko) {
    const int i = F.tid >> 2, q4 = F.tid & 3;
    float a[8], bb[8], o1[8], o2[8];
    unpack8(ra, a); unpack8(rb, bb);
    float s = 0.f;
#pragma unroll
    for (int e = 0; e < 8; ++e) s += a[e] * a[e] + bb[e] * bb[e];
    s += __shfl_xor(s, 1); s += __shfl_xor(s, 2);
    const float rstd = 1.0f / sqrtf(s * (1.0f / 64.0f) + EPSF);
    const f32x2* ROPE = (const f32x2*)(F.ws + WS_ROPE);
#pragma unroll
    for (int e = 0; e < 8; ++e) { const float an = a[e] * rstd * F.in[I_GK][8 * q4 + e], bn = bb[e] * rstd * F.in[I_GK][32 + 8 * q4 + e];
        const f32x2 cs = ROPE[pos * 32 + 8 * q4 + e]; o1[e] = an * cs.x - bn * cs.y; o2[e] = bn * cs.x + an * cs.y; }
    *(LAS u32x4*)(slot + i * LDKW + (8 * q4) * 2) = pack8(o1);
    *(LAS u32x4*)(slot + i * LDKW + (32 + 8 * q4) * 2) = pack8(o2);
    if (ko) { float* p = ko + ((size_t)i * 2 + kvh) * 64;
        *(f32x4*)(p + 8 * q4) = (f32x4){o1[0], o1[1], o1[2], o1[3]}; *(f32x4*)(p + 8 * q4 + 4) = (f32x4){o1[4], o1[5], o1[6], o1[7]};
        *(f32x4*)(p + 32 + 8 * q4) = (f32x4){o2[0], o2[1], o2[2], o2[3]}; *(f32x4*)(p + 32 + 8 * q4 + 4) = (f32x4){o2[4], o2[5], o2[6], o2[7]}; }
}
DI void wa_write_v(Ctx& F, LAS unsigned char* slot, int kvh, const u32x4 rv, float* vo) {
    const int i = F.tid >> 3, q8 = F.tid & 7;
    *(LAS u32x4*)(slot + WR_V + i * LDVW + q8 * 16) = rv;
    if (vo) { float v[8]; unpack8(rv, v); float* p = vo + ((size_t)i * 2 + kvh) * 64 + 8 * q8;
        *(f32x4*)p = (f32x4){v[0], v[1], v[2], v[3]}; *(f32x4*)(p + 4) = (f32x4){v[4], v[5], v[6], v[7]}; }
}
DI void wa_stage_cache(Ctx& F, LAS unsigned char* slot, int kvh, const float* ck, const float* cv, float* ko, float* vo) {
    if (F.tid < 256) { const int i = F.tid >> 2, q4 = F.tid & 3; const float* src = ck + ((size_t)i * 2 + kvh) * 64;
        const f32x4 a0 = *(const f32x4*)(src + 8 * q4), a1 = *(const f32x4*)(src + 8 * q4 + 4), b0 = *(const f32x4*)(src + 32 + 8 * q4), b1 = *(const f32x4*)(src + 32 + 8 * q4 + 4);
        u32x4 pa, pb; pa.x = pk2(a0.x, a0.y); pa.y = pk2(a0.z, a0.w); pa.z = pk2(a1.x, a1.y); pa.w = pk2(a1.z, a1.w); pb.x = pk2(b0.x, b0.y); pb.y = pk2(b0.z, b0.w); pb.z = pk2(b1.x, b1.y); pb.w = pk2(b1.z, b1.w);
        *(LAS u32x4*)(slot + i * LDKW + (8 * q4) * 2) = pa; *(LAS u32x4*)(slot + i * LDKW + (32 + 8 * q4) * 2) = pb;
        if (ko) { float* p = ko + ((size_t)i * 2 + kvh) * 64; *(f32x4*)(p + 8 * q4) = a0; *(f32x4*)(p + 8 * q4 + 4) = a1; *(f32x4*)(p + 32 + 8 * q4) = b0; *(f32x4*)(p + 32 + 8 * q4 + 4) = b1; } }
    { const int i = F.tid >> 3, q8 = F.tid & 7; const float* src = cv + ((size_t)i * 2 + kvh) * 64 + 8 * q8; const f32x4 v0 = *(const f32x4*)src, v1 = *(const f32x4*)(src + 4);
      u32x4 pv; pv.x = pk2(v0.x, v0.y); pv.y = pk2(v0.z, v0.w); pv.z = pk2(v1.x, v1.y); pv.w = pk2(v1.z, v1.w);
      *(LAS u32x4*)(slot + WR_V + i * LDVW + q8 * 16) = pv;
      if (vo) { float* p = vo + ((size_t)i * 2 + kvh) * 64 + 8 * q8; *(f32x4*)p = v0; *(f32x4*)(p + 4) = v1; } }
}
DI void wa_compute(Ctx& F, int kvh, size_t crow0, int pos0, int sl0, int sl1, int sl2, int ninv) {
    LAS unsigned char* lds = F.lds;
    const int lane = F.lane, w = F.wave, g4 = lane >> 4;
    const bf16_t* PROJ = (const bf16_t*)(F.ws + WS_PROJ); const f32x2* ROPE = (const f32x2*)(F.ws + WS_ROPE); bf16_t* MIX = (bf16_t*)(F.ws + WS_MIX);
    const int hq = kvh * 4 + (w >> 1); const float sink = F.in[I_SINKS][hq] * 1.4426950408889634f;
    u32x2 graw[2][4]; u32x4 qraw[2][2];
#pragma unroll
    for (int rg = 0; rg < 2; ++rg) { const size_t row = crow0 + 32 * (w & 1) + 16 * rg + (lane & 15);
#pragma unroll
        for (int dt = 0; dt < 4; ++dt) graw[rg][dt] = *(const u32x2*)(PROJ + row * NPROJ + C_GA + hq * 64 + 16 * dt + 4 * g4);
        qraw[rg][0] = *(const u32x4*)(PROJ + row * NPROJ + C_Q + hq * 64 + 8 * g4); qraw[rg][1] = *(const u32x4*)(PROJ + row * NPROJ + C_Q + hq * 64 + 32 + 8 * g4); }
    bf16x8 qa[2][2];
#pragma unroll
    for (int rg = 0; rg < 2; ++rg) {
        const int d0 = 8 * g4; float a[8], bb[8];
        unpack8(qraw[rg][0], a);
        unpack8(qraw[rg][1], bb);
        float s = 0.f;
#pragma unroll
        for (int e = 0; e < 8; ++e) s += a[e] * a[e] + bb[e] * bb[e];
        s += __shfl_xor(s, 16); s += __shfl_xor(s, 32);
        const float rstd = 0.18033688011112042f / sqrtf(s * (1.0f / 64.0f) + EPSF);
        const int pos = pos0 + 32 * (w & 1) + 16 * rg + (lane & 15);
        float o1[8], o2[8];
#pragma unroll
        for (int e = 0; e < 8; ++e) { const float an = a[e] * rstd * F.in[I_GQ][d0 + e], bn = bb[e] * rstd * F.in[I_GQ][32 + d0 + e];
            const f32x2 cs = ROPE[pos * 32 + d0 + e]; o1[e] = an * cs.x - bn * cs.y; o2[e] = bn * cs.x + an * cs.y; }
        qa[rg][0] = __builtin_bit_cast(bf16x8, pack8(o1)); qa[rg][1] = __builtin_bit_cast(bf16x8, pack8(o2)); }
    f32x4 s[2][12];
#pragma unroll
    for (int jt = 0; jt < 12; ++jt) { const int j = jt >> 2; const LAS unsigned char* kt = lds + (j == 0 ? sl0 : (j == 1 ? sl1 : sl2)) * WR_SLOT;
        const bf16x8 k0 = lds_frag(kt, LDKW, 16 * (jt & 3), 0, lane), k1 = lds_frag(kt, LDKW, 16 * (jt & 3), 32, lane);
#pragma unroll
        for (int rg = 0; rg < 2; ++rg) { f32x4 acc = {0.f, 0.f, 0.f, 0.f};
            acc = MFMA16T(qa[rg][0], k0, acc); acc = MFMA16T(qa[rg][1], k1, acc);
            s[rg][jt] = acc; }
        if ((jt & 3) == 3) __builtin_amdgcn_sched_barrier(0); }
    if (ninv > 0) {
#pragma unroll
        for (int jt = 0; jt < 8; ++jt) if ((jt >> 2) < ninv) { s[0][jt] = (f32x4){-1e30f, -1e30f, -1e30f, -1e30f}; s[1][jt] = (f32x4){-1e30f, -1e30f, -1e30f, -1e30f}; } }
    float inv[2]; bf16x8 pa[2][6];
#pragma unroll
    for (int rg = 0; rg < 2; ++rg) {
        float m = sink;
#pragma unroll
        for (int jt = 0; jt < 12; ++jt)
#pragma unroll
            for (int r = 0; r < 4; ++r) m = fmaxf(m, s[rg][jt][r]);
        m = fmaxf(m, __shfl_xor(m, 16)); m = fmaxf(m, __shfl_xor(m, 32));
        float sum = 0.f;
#pragma unroll
        for (int jt = 0; jt < 12; ++jt)
#pragma unroll
            for (int r = 0; r < 4; ++r) { const float e = __builtin_amdgcn_exp2f(s[rg][jt][r] - m); s[rg][jt][r] = e; sum += e; }
        sum += __shfl_xor(sum, 16); sum += __shfl_xor(sum, 32);
        inv[rg] = 1.0f / (sum + __builtin_amdgcn_exp2f(sink - m));
#pragma unroll
        for (int k2 = 0; k2 < 6; ++k2) { u32x4 t; t.x = pk2(s[rg][2 * k2][0], s[rg][2 * k2][1]); t.y = pk2(s[rg][2 * k2][2], s[rg][2 * k2][3]);
            t.z = pk2(s[rg][2 * k2 + 1][0], s[rg][2 * k2 + 1][1]); t.w = pk2(s[rg][2 * k2 + 1][2], s[rg][2 * k2 + 1][3]);
            pa[rg][k2] = __builtin_bit_cast(bf16x8, t); } }
#pragma unroll
    for (int dt = 0; dt < 4; ++dt) { f32x4 o[2] = {{0.f, 0.f, 0.f, 0.f}, {0.f, 0.f, 0.f, 0.f}};
#pragma unroll
        for (int k2 = 0; k2 < 6; ++k2) { const int j = k2 >> 1; const LAS unsigned char* vt = lds + (j == 0 ? sl0 : (j == 1 ? sl1 : sl2)) * WR_SLOT + WR_V;
            const bf16x8 vf = lds_frag_tr2(vt, LDVW, 32 * (k2 & 1), 16 * dt, lane);
            o[0] = MFMA16T(pa[0][k2], vf, o[0]); o[1] = MFMA16T(pa[1][k2], vf, o[1]); }
#pragma unroll
        for (int rg = 0; rg < 2; ++rg) { const size_t row = crow0 + 32 * (w & 1) + 16 * rg + (lane & 15);
            const float gv[4] = {__uint_as_float(graw[rg][dt].x << 16), __uint_as_float(graw[rg][dt].x & 0xffff0000u), __uint_as_float(graw[rg][dt].y << 16), __uint_as_float(graw[rg][dt].y & 0xffff0000u)};
            u32x2 pk; pk.x = pk2(o[rg][0] * inv[rg] * siluf(gv[0]), o[rg][1] * inv[rg] * siluf(gv[1])); pk.y = pk2(o[rg][2] * inv[rg] * siluf(gv[2]), o[rg][3] * inv[rg] * siluf(gv[3]));
            *(u32x2*)(MIX + row * 2048 + 1024 + hq * 64 + 16 * dt + 4 * g4) = pk; }
        __builtin_amdgcn_sched_barrier(0); }
}
DI void winattn_item(Ctx& F, int item) {
    LAS unsigned char* lds = F.lds;
    const int tid = F.tid;
    const bf16_t* PROJ = (const bf16_t*)(F.ws + WS_PROJ);
    if (item >= 256) {
        const int sb = (item - 256) >> 1, kvh = item & 1; const size_t row0 = (size_t)MP + sb * 64;
        const float* ck = F.in[I_CWK] + (size_t)sb * 128 * 128; const float* cv = F.in[I_CWV] + (size_t)sb * 128 * 128;
        float* ko = F.out + O_WKS + (size_t)sb * 128 * 128; float* vo = F.out + O_WVS + (size_t)sb * 128 * 128;
        wa_stage_cache(F, lds + 0 * WR_SLOT, kvh, ck, cv, nullptr, nullptr);
        wa_stage_cache(F, lds + 1 * WR_SLOT, kvh, ck + 64 * 128, cv + 64 * 128, ko, vo);
        if (tid < 256) { const int i = tid >> 2, q4 = tid & 3; const bf16_t* p = PROJ + (row0 + i) * NPROJ + C_K + kvh * 64 + 8 * q4;
            wa_write_k(F, lds + 2 * WR_SLOT, kvh, *(const u32x4*)p, *(const u32x4*)(p + 32), 2048 + i, ko + 64 * 128); }
        { const int i = tid >> 3, q8 = tid & 7; wa_write_v(F, lds + 2 * WR_SLOT, kvh, *(const u32x4*)(PROJ + (row0 + i) * NPROJ + C_V + kvh * 64 + 8 * q8), vo + 64 * 128); }
        __syncthreads();
        wa_compute(F, kvh, row0, 2048, 0, 1, 2, 0);
        __syncthreads();
        return;
    }
    const int b = item >> 4, kvh = (item >> 3) & 1, c0 = (item & 7) * 8;
    const size_t seq0 = (size_t)b * T_P;
#pragma unroll 1
    for (int kc = c0 - 2; kc <= c0; ++kc) { LAS unsigned char* slot = lds + (kc & 3) * WR_SLOT;
        if (kc < 0) { for (int t = tid; t < WR_SLOT / 16; t += 512) *(LAS u32x4*)(slot + t * 16) = (u32x4){0u, 0u, 0u, 0u}; }
        else { const size_t row0 = seq0 + (size_t)kc * 64;
            if (tid < 256) { const int i = tid >> 2, q4 = tid & 3; const bf16_t* p = PROJ + (row0 + i) * NPROJ + C_K + kvh * 64 + 8 * q4;
                wa_write_k(F, slot, kvh, *(const u32x4*)p, *(const u32x4*)(p + 32), kc * 64 + i, nullptr); }
            { const int i = tid >> 3, q8 = tid & 7; wa_write_v(F, slot, kvh, *(const u32x4*)(PROJ + (row0 + i) * NPROJ + C_V + kvh * 64 + 8 * q8), nullptr); } } }
    __syncthreads();
#pragma unroll 1
    for (int c = c0; c < c0 + 8; ++c) {
        const bool more = c + 1 < c0 + 8;
        u32x4 ra = {0u, 0u, 0u, 0u}, rb = {0u, 0u, 0u, 0u}, rv = {0u, 0u, 0u, 0u};
        const size_t nrow0 = seq0 + (size_t)(c + 1) * 64;
        if (more) {
            if (tid < 256) { const bf16_t* p = PROJ + (nrow0 + (tid >> 2)) * NPROJ + C_K + kvh * 64 + 8 * (tid & 3); ra = *(const u32x4*)p; rb = *(const u32x4*)(p + 32); }
            rv = *(const u32x4*)(PROJ + (nrow0 + (tid >> 3)) * NPROJ + C_V + kvh * 64 + 8 * (tid & 7)); }
        wa_compute(F, kvh, seq0 + (size_t)c * 64, c * 64, (c - 2) & 3, (c - 1) & 3, c & 3, c >= 2 ? 0 : 2 - c);
        if (more) { LAS unsigned char* slot = lds + ((c + 1) & 3) * WR_SLOT; const int kc = c + 1;
            float* ko = nullptr; float* vo = nullptr;
            if (kc >= 62) { ko = F.out + O_WKP + ((size_t)b * 128 + (kc - 62) * 64) * 128; vo = F.out + O_WVP + ((size_t)b * 128 + (kc - 62) * 64) * 128; }
            if (tid < 256) wa_write_k(F, slot, kvh, ra, rb, kc * 64 + (tid >> 2), ko);
            wa_write_v(F, slot, kvh, rv, vo); }
        __syncthreads();
    }
}

constexpr int MA_K = 0, MA_V = 69632, MA_RS = 143360, LDKM = 272, LDVM = 288;
DI void memattn_item(Ctx& F, int item) {
    LAS unsigned char* lds = F.lds;
    const int tid = F.tid, lane = F.lane, w = F.wave, g4 = lane >> 4;
    const bool smp = item >= 256; const int sidx = item - 256;
    const int bb = smp ? (sidx >> 2) : (item >> 4), h = smp ? (sidx & 3) : ((item >> 2) & 3), qt = item & 3;
    const bf16_t* PROJ = (const bf16_t*)(F.ws + WS_PROJ); bf16_t* MIX = (bf16_t*)(F.ws + WS_MIX); const bf16_t* RAW = (const bf16_t*)(F.ws + WS_MEMRAW);
#pragma unroll 1
    for (int ib = 0; ib < 2; ++ib) {
      u32x4 rk[4], rvv[4]; f32x4 fk[4][2], fv[4][2];
#pragma unroll
      for (int u = 0; u < 4; ++u) { const int t = tid + 512 * (4 * ib + u), key = t >> 4, ch = t & 15;
        if (smp) { const float* ks = F.in[I_CMK] + ((size_t)(bb * 256 + key) * 4 + h) * 128 + 8 * ch; const float* vs = F.in[I_CMV] + ((size_t)(bb * 256 + key) * 4 + h) * 128 + 8 * ch;
            fk[u][0] = *(const f32x4*)ks; fk[u][1] = *(const f32x4*)(ks + 4); fv[u][0] = *(const f32x4*)vs; fv[u][1] = *(const f32x4*)(vs + 4); }
        else { rk[u] = *(const u32x4*)(RAW + (size_t)(bb * 256 + key) * 1024 + h * 128 + 8 * ch); rvv[u] = *(const u32x4*)(RAW + (size_t)(bb * 256 + key) * 1024 + 512 + h * 128 + 8 * ch); } }
#pragma unroll
      for (int u = 0; u < 4; ++u) { const int t = tid + 512 * (4 * ib + u), key = t >> 4, ch = t & 15;
        float k[8], v[8];
        if (smp) {
#pragma unroll
            for (int e = 0; e < 4; ++e) { k[e] = fk[u][0][e]; k[4 + e] = fk[u][1][e]; v[e] = fv[u][0][e]; v[4 + e] = fv[u][1][e]; } }
        else { unpack8(rk[u], k); unpack8(rvv[u], v); }
        float s = 0.f;
#pragma unroll
        for (int e = 0; e < 8; ++e) s += k[e] * k[e];
        s += __shfl_xor(s, 1); s += __shfl_xor(s, 2); s += __shfl_xor(s, 4); s += __shfl_xor(s, 8);
        if (!smp) { const float rstd = 1.0f / sqrtf(s * (1.0f / 128.0f) + EPSF);
#pragma unroll
            for (int e = 0; e < 8; ++e) k[e] = k[e] * rstd * F.in[I_GMK][8 * ch + e]; }
        { float kq[8];
#pragma unroll
          for (int e = 0; e < 8; ++e) kq[e] = k[e] * F.in[I_GMQ][8 * ch + e];
          *(LAS u32x4*)(lds + MA_K + key * LDKM + ch * 16) = pack8(kq); }
        *(LAS u32x4*)(lds + MA_V + key * LDVM + ch * 16) = pack8(v);
        if (!smp && qt == 0) {
            float* ko = F.out + O_MKP + ((size_t)(bb * 256 + key) * 4 + h) * 128 + 8 * ch; float* vo = F.out + O_MVP + ((size_t)(bb * 256 + key) * 4 + h) * 128 + 8 * ch;
            *(f32x4*)ko = (f32x4){k[0], k[1], k[2], k[3]}; *(f32x4*)(ko + 4) = (f32x4){k[4], k[5], k[6], k[7]};
            *(f32x4*)vo = (f32x4){v[0], v[1], v[2], v[3]}; *(f32x4*)(vo + 4) = (f32x4){v[4], v[5], v[6], v[7]}; }
      }
    }
    __syncthreads();
    const int ngr = smp ? 4 : 64;
    const size_t qbase = smp ? (size_t)MP + bb * 64 : (size_t)bb * T_P + qt * 1024;
    u32x4 nq[4]; u32x2 ng[8];
#define MA_LOAD(rg_) do { const size_t r_ = qbase + 16 * (rg_) + (lane & 15); \
        _Pragma("unroll") for (int ks = 0; ks < 4; ++ks) nq[ks] = *(const u32x4*)(PROJ + r_ * NPROJ + C_MQ + h * 128 + 32 * ks + 8 * g4); \
        _Pragma("unroll") for (int dt = 0; dt < 8; ++dt) ng[dt] = *(const u32x2*)(PROJ + r_ * NPROJ + C_GM + h * 128 + 16 * dt + 4 * g4); } while (0)
    if (w < ngr) MA_LOAD(w);
#pragma unroll 1
    for (int rg = w; rg < ngr; rg += 8) {
        u32x4 cq[4]; u32x2 cg[8];
#pragma unroll
        for (int ks = 0; ks < 4; ++ks) cq[ks] = nq[ks];
#pragma unroll
        for (int dt = 0; dt < 8; ++dt) cg[dt] = ng[dt];
        if (rg + 8 < ngr) MA_LOAD(rg + 8);
        bf16x8 qa[4];
        { float q[4][8]; float s = 0.f;
#pragma unroll
          for (int ks = 0; ks < 4; ++ks) { unpack8(cq[ks], q[ks]);
#pragma unroll
              for (int e = 0; e < 8; ++e) s += q[ks][e] * q[ks][e]; }
          s += __shfl_xor(s, 16); s += __shfl_xor(s, 32);
          const float rstd = 0.12751743082459868f / sqrtf(s * (1.0f / 128.0f) + EPSF);
#pragma unroll
          for (int ks = 0; ks < 4; ++ks) {
#pragma unroll
              for (int e = 0; e < 8; ++e) q[ks][e] = q[ks][e] * rstd;
              qa[ks] = __builtin_bit_cast(bf16x8, pack8(q[ks])); } }
        f32x4 s[16];
#pragma unroll
        for (int jt = 0; jt < 16; ++jt) { f32x4 acc = {0.f, 0.f, 0.f, 0.f};
#pragma unroll
            for (int ks = 0; ks < 4; ++ks) acc = MFMA16T(qa[ks], lds_frag(lds + MA_K, LDKM, 16 * jt, 32 * ks, lane), acc);
            s[jt] = acc;
            if ((jt & 3) == 3) __builtin_amdgcn_sched_barrier(0); }
        float m = s[0][0];
#pragma unroll
        for (int jt = 0; jt < 16; ++jt)
#pragma unroll
            for (int r = 0; r < 4; ++r) m = fmaxf(m, s[jt][r]);
        m = fmaxf(m, __shfl_xor(m, 16)); m = fmaxf(m, __shfl_xor(m, 32));
        float sum = 0.f;
#pragma unroll
        for (int jt = 0; jt < 16; ++jt)
#pragma unroll
            for (int r = 0; r < 4; ++r) { const float e = __builtin_amdgcn_exp2f(s[jt][r] - m); s[jt][r] = e; sum += e; }
        sum += __shfl_xor(sum, 16); sum += __shfl_xor(sum, 32);
        const float inv = 1.0f / sum;
        bf16x8 pa[8];
#pragma unroll
        for (int k2 = 0; k2 < 8; ++k2) { u32x4 t; t.x = pk2(s[2 * k2][0], s[2 * k2][1]); t.y = pk2(s[2 * k2][2], s[2 * k2][3]); t.z = pk2(s[2 * k2 + 1][0], s[2 * k2 + 1][1]); t.w = pk2(s[2 * k2 + 1][2], s[2 * k2 + 1][3]);
            pa[k2] = __builtin_bit_cast(bf16x8, t); }
        const size_t orow = qbase + 16 * rg + (lane & 15);
#pragma unroll
        for (int dt = 0; dt < 8; ++dt) { f32x4 o = {0.f, 0.f, 0.f, 0.f};
#pragma unroll
            for (int k2 = 0; k2 < 8; ++k2) o = MFMA16T(pa[k2], lds_frag_tr2(lds + MA_V, LDVM, 32 * k2, 16 * dt, lane), o);
            __builtin_amdgcn_sched_barrier(0);
            const int col = h * 128 + 16 * dt + 4 * g4;
            const u32x2 gr = cg[dt];
            const float gv[4] = {__uint_as_float(gr.x << 16), __uint_as_float(gr.x & 0xffff0000u), __uint_as_float(gr.y << 16), __uint_as_float(gr.y & 0xffff0000u)};
            u32x2 pk; pk.x = pk2(o[0] * inv * siluf(gv[0]), o[1] * inv * siluf(gv[1])); pk.y = pk2(o[2] * inv * siluf(gv[2]), o[3] * inv * siluf(gv[3]));
            *(u32x2*)(MIX + orow * 2048 + 1536 + col) = pk; }
    }
#undef MA_LOAD
    __syncthreads();
}

DI void p2a_attn(Ctx& F) {
    for (int rep = 0; rep < REP_WIN; ++rep)
    for (int it = F.bid; it < 320; it += F.G) winattn_item(F, it);
    __syncthreads();
    for (int rep = 0; rep < REP_MEM; ++rep)
    { for (int it = F.bid; it < 256; it += F.G) memattn_item(F, it);
      for (int s = (F.bid + F.G - (128 % F.G)) % F.G; s < 128; s += F.G) memattn_item(F, 256 + s); }
}
DI void p2b_phase(Ctx& F) {
    for (int rep = 0; rep < REP_SSD; ++rep)
    for (int it = F.bid; it < 48 * 16; it += F.G) ssd_item(F, it >> 4, it & 15, rep == 0);
}

constexpr int G2_A = 0, G2_B = 9216, G2_SET = 27648;
DI void gemm2_sample(Ctx& F) {
    LAS unsigned char* lds = F.lds;
    const int tid = F.tid, lane = F.lane, w = F.wave, g4 = lane >> 4;
    const bf16_t* MIX = (const bf16_t*)(F.ws + WS_MIX); const bf16_t* WOT = (const bf16_t*)(F.ws + WS_WOUT); const float* SUMSQ = (const float*)(F.ws + WS_SSQ);
    for (int tile = F.bid; tile < 256; tile += F.G) {
        const int r0 = MP + 64 * (tile >> 3), c0 = 128 * (tile & 7);
        const bf16_t* asrc = MIX + (size_t)(r0 + (tid >> 3)) * 2048 + 8 * (tid & 7);
        const bf16_t* bsrc0 = WOT + (size_t)(c0 + (tid >> 3)) * 2048 + 8 * (tid & 7);
        const bf16_t* bsrc1 = bsrc0 + (size_t)64 * 2048;
        const int aoff = G2_A + (tid >> 3) * 144 + (tid & 7) * 16, boff0 = G2_B + (tid >> 3) * 144 + (tid & 7) * 16, boff1 = boff0 + 64 * 144;
        f32x4 acc[4] = {{0.f, 0.f, 0.f, 0.f}, {0.f, 0.f, 0.f, 0.f}, {0.f, 0.f, 0.f, 0.f}, {0.f, 0.f, 0.f, 0.f}};
        u32x4 ra[4], rb0[4], rb1[4];
#pragma unroll
        for (int j = 0; j < 4; ++j) { ra[j] = *(const u32x4*)(asrc + 64 * j); rb0[j] = *(const u32x4*)(bsrc0 + 64 * j); rb1[j] = *(const u32x4*)(bsrc1 + 64 * j); }
        *(LAS u32x4*)(lds + aoff) = ra[0]; *(LAS u32x4*)(lds + boff0) = rb0[0]; *(LAS u32x4*)(lds + boff1) = rb1[0];
        ra[0] = *(const u32x4*)(asrc + 64 * 4); rb0[0] = *(const u32x4*)(bsrc0 + 64 * 4); rb1[0] = *(const u32x4*)(bsrc1 + 64 * 4);
        __syncthreads();
#pragma unroll 1
        for (int kt4 = 0; kt4 < 32; kt4 += 4) {
#pragma unroll
            for (int u = 0; u < 4; ++u) { const int kt = kt4 + u;
                const LAS unsigned char* cs = lds + (u & 1) * G2_SET; LAS unsigned char* ns = lds + ((u + 1) & 1) * G2_SET;
                if (kt == 16) { const float r = 1.0f / sqrtf(SUMSQ[r0 + 16 * (w >> 1) + (lane & 15)] * (1.0f / 1024.0f) + EPSF);
#pragma unroll
                    for (int t = 0; t < 4; ++t) acc[t] = acc[t] * r; }
#pragma unroll
                for (int ks = 0; ks < 2; ++ks) { const bf16x8 a = lds_frag(cs + G2_A, 144, 16 * (w >> 1), 32 * ks, lane);
#pragma unroll
                    for (int t = 0; t < 4; ++t) acc[t] = MFMA16T(a, lds_frag(cs + G2_B, 144, 64 * (w & 1) + 16 * t, 32 * ks, lane), acc[t]); }
                constexpr int dummy_ = 0; (void)dummy_;
                const int rs = (u + 1) & 3;
                if (kt + 1 < 32) { *(LAS u32x4*)(ns + aoff) = ra[rs]; *(LAS u32x4*)(ns + boff0) = rb0[rs]; *(LAS u32x4*)(ns + boff1) = rb1[rs]; }
                if (kt + 5 < 32) { ra[rs] = *(const u32x4*)(asrc + 64 * (kt + 5)); rb0[rs] = *(const u32x4*)(bsrc0 + 64 * (kt + 5)); rb1[rs] = *(const u32x4*)(bsrc1 + 64 * (kt + 5)); }
                __syncthreads();
            }
        }
        const int row = r0 + 16 * (w >> 1) + (lane & 15), cw = c0 + 64 * (w & 1) + 4 * g4;
        const float* xr = F.in[I_XS] + (size_t)(row - MP) * DM + cw; float* orow = F.out + (size_t)row * DM + cw;
#pragma unroll
        for (int t = 0; t < 4; ++t) *(f32x4*)(orow + 16 * t) = acc[t] + *(const f32x4*)(xr + 16 * t);
    }
}
__global__ void __launch_bounds__(512, 2) hymba_fwd(Args args) {
    extern __shared__ __attribute__((aligned(16))) unsigned char lds_raw[];
    cg::grid_group grid = cg::this_grid();
    Ctx F;
    F.lds = (LAS unsigned char*)lds_raw; F.tid = threadIdx.x; F.lane = F.tid & 63; F.wave = __builtin_amdgcn_readfirstlane(F.tid >> 6); F.G = gridDim.x; F.bid = blockIdx.x;
#pragma unroll
    for (int i = 0; i < 26; ++i) F.in[i] = args.in[i];
    F.out = args.out; F.ws = args.ws;
    volatile LAS unsigned* bst = (volatile LAS unsigned*)(F.lds + LDS_BYTES - 64);
    if (F.tid < 16) bst[F.tid] = 0u;
    __syncthreads();
    const XcdBarrier xbar = xcd_barrier_post((unsigned*)(F.ws + WS_CTL), bst);
#define GRID_BAR() xcd_barrier(xbar)

#define PHASE_FENCE() do { int t_ = threadIdx.x; asm volatile("" : "+v"(t_)); F.tid = t_; F.lane = t_ & 63; F.wave = __builtin_amdgcn_readfirstlane(t_ >> 6); } while (0)
    for (int rep = 0; rep < REP_P0; ++rep) { if (rep) __syncthreads(); p0_prologue(F); }
    grid.sync(); PHASE_FENCE();
    {
        pg8::Gemm g{(const bf16_t*)(F.ws + WS_A), (const bf16_t*)(F.ws + WS_BT), MA, NBT, 1024};
        Order1 S; S.init(F.G, F.bid);
        EpiProj E{(bf16_t*)(F.ws + WS_PROJ), (bf16_t*)(F.ws + WS_MEMRAW)};
        pg8::gemm_phase<EpiProj, Order1, true, true>(F.lds, g, S, E);
    }
    GRID_BAR(); PHASE_FENCE();
    for (int rep = 0; rep < REP_P2A; ++rep) p2a_phase(F);
    __syncthreads();
    p2a_attn(F);
    GRID_BAR(); PHASE_FENCE();
    p2b_phase(F);
    GRID_BAR(); PHASE_FENCE();
    gemm2_sample(F);
    {
        pg8::Gemm g{(const bf16_t*)(F.ws + WS_MIX), (const bf16_t*)(F.ws + WS_WOUT), MTOT, 1024, 2048};
        Order3 S; S.init(F.G, F.bid);
        EpiOut E{F.in[I_XP], F.in[I_XS], F.out, (const float*)(F.ws + WS_SSQ)};
        pg8::gemm_phase<EpiOut, Order3, true, true>(F.lds, g, S, E);
    }
#if DBG_SCALE3 || DBG_ZERO
    grid.sync();
    {
        const size_t offs[13] = {O_Y, (size_t)MP * 1024, O_WKP, O_WVP, O_SSMP, O_CONVP, O_MKP, O_MVP, O_WKS, O_WVS, O_SSMS, O_CONVS, O_END};
        for (int o = 0; o < 12; ++o) {
            const bool z = (DBG_ZERO >> o) & 1, s3 = (DBG_SCALE3 >> o) & 1;
            if (!z && !s3) continue;
            for (size_t i = offs[o] + (size_t)F.bid * 512 + F.tid; i < offs[o + 1]; i += (size_t)F.G * 512) F.out[i] = z ? 0.f : F.out[i] * 3.0f;
        }
    }
#endif
}

extern "C" void kernel_launch(void* const* d_in, const int* in_sizes, int n_in, void* d_out, int out_size, void* d_ws, size_t ws_size, hipStream_t stream) {
    static int grid = 0;
    if (grid == 0) {
        if (n_in != 26 || (size_t)out_size != O_END || ws_size < WS_END) { fprintf(stderr, "kernel_launch: unexpected problem (n_in %d out %d ws %zu)\n", n_in, out_size, ws_size); grid = -1; return; }
        int dev = 0, cus = 0, per_cu = 0;
        if (hipGetDevice(&dev) != hipSuccess || hipDeviceGetAttribute(&cus, hipDeviceAttributeMultiprocessorCount, dev) != hipSuccess) { grid = -1; return; }
        if (hipFuncSetAttribute((const void*)hymba_fwd, hipFuncAttributeMaxDynamicSharedMemorySize, LDS_BYTES) != hipSuccess) { fprintf(stderr, "kernel_launch: hipFuncSetAttribute failed\n"); grid = -1; return; }
        if (hipOccupancyMaxActiveBlocksPerMultiprocessor(&per_cu, (const void*)hymba_fwd, 512, LDS_BYTES) != hipSuccess || per_cu < 1) { fprintf(stderr, "kernel_launch: occupancy query says %d\n", per_cu); (void)hipGetLastError(); grid = -1; return; }
        grid = cus;
        fprintf(stderr, "kernel_launch: %d CUs, occupancy %d per CU, grid %d\n", cus, per_cu, grid);
    }
    if (grid < 0) return;
    Args a{};
    for (int i = 0; i < 26; ++i) a.in[i] = (const float*)d_in[i];
    a.out = (float*)d_out; a.ws = (unsigned char*)d_ws;
    if (hipMemsetAsync((char*)d_ws + WS_CTL, 0, CTL_ZERO_BYTES, stream) != hipSuccess) { fprintf(stderr, "kernel_launch: memset of the barrier words failed\n"); return; }
    void* kargs[] = {&a};
    const hipError_t e = hipLaunchCooperativeKernel((const void*)hymba_fwd, dim3(grid), dim3(512), kargs, LDS_BYTES, stream);
    if (e != hipSuccess) fprintf(stderr, "kernel_launch: cooperative launch failed: %s\n", hipGetErrorString(e));
}
```

```cpp
#include <hip/hip_runtime.h>
#include <hip/hip_cooperative_groups.h>
#include <cstdio>
#include <cstdint>
namespace cg = cooperative_groups;
namespace pg8 {
#define PG8_LAS __attribute__((address_space(3)))
typedef unsigned short bf16_t;
typedef short bf16x8 __attribute__((ext_vector_type(8)));
typedef float f32x4 __attribute__((ext_vector_type(4)));
typedef unsigned u32x4 __attribute__((ext_vector_type(4)));
constexpr int BM = 256, BK = 64, HALF = 128, HTB = HALF * BK * 2  , STAGE_BYTES = 8 * HTB, NXCD = 8, WGM = 8;

__host__ __device__ __forceinline__ int lds_byte(int r, int c) { const int st = (r >> 4) * 2 + (c >> 5), rr = r & 15, cc = c & 31, ob = rr * 64 + cc * 2; return st * 1024 + (ob ^ (((ob >> 9) & 1) << 5)); }
__host__ __device__ __forceinline__ void stage_rc(int b, int& R, int& C) { const int st = b / 1024, sb = b % 1024, swz = sb ^ (((sb >> 9) & 1) << 5); R = (st >> 1) * 16 + swz / 64; C = (st & 1) * 32 + (swz % 64) / 2; }
__host__ __device__ __forceinline__ int perm32(int rho) { const int n = rho >> 4, i = rho & 15; return 8 * (i >> 2) + 4 * n + (i & 3); }

struct Unit { int pm, pn; };
struct Gemm { const bf16_t* A; const bf16_t* Bt; int M, N, K; };

struct StaticOrder {
    int nM, nN, nwg, G, c;
    __host__ __device__ void init(int M, int N, int G_, int c_) { nM = M / BM; nN = N / BM; nwg = nM * nN; G = G_; c = c_; }
    __host__ __device__ bool next(int i, Unit& u) const {
        const long L = (long)i * G + c; if (L >= nwg) return false;
        int wgid = (int)L; { const int q = nwg / NXCD, r = nwg % NXCD, xcd = wgid % NXCD, off = wgid / NXCD; wgid = (xcd < r ? xcd * (q + 1) : r * (q + 1) + (xcd - r) * q) + off; }
        const int nig = WGM * nN, gid = wgid / nig, fm = gid * WGM, gsz = (nM - fm) < WGM ? (nM - fm) : WGM;
        u.pm = fm + ((wgid % nig) % gsz); u.pn = (wgid % nig) / gsz; return true;
    }
    __device__ __forceinline__ void a_ready(const Unit&) const {}
    __device__ __forceinline__ void done(const Unit&) const {}
};

template <class Epi, class Sched, bool ALIGN_EPI = false, bool SP2 = false>
__device__ __forceinline__ void gemm_phase(PG8_LAS unsigned char* lds, const Gemm g, const Sched& S, const Epi& E) {
    int tid_ = threadIdx.x; asm volatile("" : "+v"(tid_));
    const int tid = tid_, wid = __builtin_amdgcn_readfirstlane(tid >> 6), lane = tid & 63, wr = wid >> 2, wc = wid & 3, fr = lane & 15, fq = lane >> 4;
    const int K = g.K, nt = K / BK;
    unsigned voffA[2], voffB[2];
#pragma unroll
    for (int i = 0; i < 2; ++i) { int R, C; stage_rc(tid * 16 + i * 8192, R, C); const int Rb = Epi::PERM ? ((R & ~31) + perm32(R & 31)) : R;
        voffA[i] = (unsigned)(R * K + C) * 2u; voffB[i] = (unsigned)(Rb * K + C) * 2u; }
    const size_t kstep = (size_t)(BK * 2);
    const size_t hstep = (size_t)HALF * K * 2;
    const size_t tstep = 2 * hstep;
    const unsigned ldsw = (unsigned)wid * 1024u;
    const int aoff = lds_byte(wr * 64 + fr, fq * 8), boff = lds_byte(wc * 32 + fr, fq * 8);
#define PG8_SA(b, h) (((b) * 2 + (h)) * HTB)
#define PG8_SB(b, h) ((4 + (b) * 2 + (h)) * HTB)
#define PG8_STAGE(bufoff, gbase, voff) do { _Pragma("unroll") for (int _i = 0; _i < 2; ++_i) \
        __builtin_amdgcn_global_load_lds((const unsigned*)((const char*)(gbase) + (voff)[_i]), (PG8_LAS unsigned*)(lds + (bufoff) + ldsw + _i * 8192), 16, 0, 0); } while (0)
#define PG8_LDA(dst, b, h) do { _Pragma("unroll") for (int m = 0; m < 4; ++m) _Pragma("unroll") for (int k = 0; k < 2; ++k) dst[m][k] = *(const PG8_LAS bf16x8*)(lds + PG8_SA(b, h) + aoff + m * 2048 + k * 1024); } while (0)
#define PG8_LDB(dst, b, h) do { _Pragma("unroll") for (int n = 0; n < 2; ++n) _Pragma("unroll") for (int k = 0; k < 2; ++k) dst[n][k] = *(const PG8_LAS bf16x8*)(lds + PG8_SB(b, h) + boff + n * 2048 + k * 1024); } while (0)
#define PG8_MMA(ai, bj, At, Bt) do { __builtin_amdgcn_s_setprio(1); _Pragma("unroll") for (int m = 0; m < 4; ++m) _Pragma("unroll") for (int n = 0; n < 2; ++n) _Pragma("unroll") for (int k = 0; k < 2; ++k) \
        acc[ai][bj][m][n] = __builtin_amdgcn_mfma_f32_16x16x32_bf16(Bt[n][k], At[m][k], acc[ai][bj][m][n], 0, 0, 0); __builtin_amdgcn_s_setprio(0); } while (0)
#define PG8_WAIT_V(n) asm volatile("s_waitcnt vmcnt(" #n ")" ::: "memory")
#define PG8_WAIT_L(n) asm volatile("s_waitcnt lgkmcnt(" #n ")" ::: "memory")
#define PG8_BAR __builtin_amdgcn_s_barrier()
#define PG8_SCHED __builtin_amdgcn_sched_barrier(0)
    Unit cur, nxt; int ui = 0;
    if (!S.next(0, cur)) return;
    f32x4 acc[2][2][4][2];
#pragma unroll
    for (int a = 0; a < 2; ++a)
#pragma unroll
        for (int b = 0; b < 2; ++b)
#pragma unroll
            for (int m = 0; m < 4; ++m)
#pragma unroll
                for (int n = 0; n < 2; ++n) acc[a][b][m][n] = (f32x4){0.f, 0.f, 0.f, 0.f};
    bf16x8 At[4][2], B0[2][2], B1[2][2];
    const char* cA = (const char*)g.A + (size_t)cur.pm * tstep; const char* cB = (const char*)g.Bt + (size_t)cur.pn * tstep;
    S.a_ready(cur);
    if constexpr (SP2) {
        PG8_STAGE(PG8_SB(0, 0), cB, voffB); PG8_STAGE(PG8_SB(0, 1), cB + hstep, voffB); PG8_STAGE(PG8_SA(0, 0), cA, voffA); PG8_STAGE(PG8_SA(0, 1), cA + hstep, voffA);
        if (wr == 1) PG8_BAR;
        PG8_WAIT_V(2); PG8_BAR;
        PG8_STAGE(PG8_SB(1, 0), cB + kstep, voffB); PG8_STAGE(PG8_SA(1, 0), cA + kstep, voffA); PG8_STAGE(PG8_SB(1, 1), cB + hstep + kstep, voffB);
        PG8_WAIT_V(6); PG8_BAR;
    } else {
        PG8_STAGE(PG8_SB(0, 0), cB, voffB); PG8_STAGE(PG8_SA(0, 0), cA, voffA); PG8_STAGE(PG8_SB(0, 1), cB + hstep, voffB); PG8_STAGE(PG8_SA(0, 1), cA + hstep, voffA);
        if (wr == 1) PG8_BAR;
        PG8_WAIT_V(4); PG8_BAR;
        PG8_STAGE(PG8_SB(1, 0), cB + kstep, voffB); PG8_STAGE(PG8_SA(1, 0), cA + kstep, voffA); PG8_STAGE(PG8_SB(1, 1), cB + hstep + kstep, voffB);
        PG8_WAIT_V(6); PG8_BAR;
    }
    for (;;) {
        const bool has_next = S.next(ui + 1, nxt);
        const char* nA = has_next ? (const char*)g.A + (size_t)nxt.pm * tstep : cA; const char* nB = has_next ? (const char*)g.Bt + (size_t)nxt.pn * tstep : cB;
        for (int t = 0; t < nt; t += 2) {
            const bool last = (t == nt - 2);
            const char* a1 = cA + (size_t)(t + 1) * kstep;
            const char* a2 = last ? nA : cA + (size_t)(t + 2) * kstep; const char* b2 = last ? nB : cB + (size_t)(t + 2) * kstep;
            const char* a3 = a2 + kstep; const char* b3 = b2 + kstep;
            if (last && has_next) S.a_ready(nxt);
            if constexpr (Epi::MIDK > 0) { if (t == Epi::MIDK) E.mid(acc, cur, wr, wc, fr, fq); }
            if constexpr (SP2) {
            PG8_LDB(B0, 0, 0); PG8_LDB(B1, 0, 1); PG8_SCHED; PG8_LDA(At, 0, 0); PG8_STAGE(PG8_SA(1, 1), a1 + hstep, voffA);
            PG8_WAIT_V(8); PG8_WAIT_L(0); PG8_BAR; PG8_MMA(0, 0, At, B0); PG8_MMA(0, 1, At, B1); PG8_BAR; PG8_SCHED;
            PG8_LDA(At, 0, 1); PG8_STAGE(PG8_SB(0, 0), b2, voffB); PG8_STAGE(PG8_SB(0, 1), b2 + hstep, voffB); PG8_STAGE(PG8_SA(0, 0), a2, voffA);
            PG8_WAIT_V(8); PG8_WAIT_L(0); PG8_BAR; PG8_MMA(1, 0, At, B0); PG8_MMA(1, 1, At, B1); PG8_BAR; PG8_SCHED;
            PG8_LDB(B0, 1, 0); PG8_LDB(B1, 1, 1); PG8_SCHED; PG8_LDA(At, 1, 0); PG8_STAGE(PG8_SA(0, 1), a2 + hstep, voffA);
            PG8_WAIT_V(8); PG8_WAIT_L(0); PG8_BAR; PG8_MMA(0, 0, At, B0); PG8_MMA(0, 1, At, B1); PG8_BAR; PG8_SCHED;
            PG8_LDA(At, 1, 1); PG8_STAGE(PG8_SB(1, 0), b3, voffB); PG8_STAGE(PG8_SB(1, 1), b3 + hstep, voffB); PG8_STAGE(PG8_SA(1, 0), a3, voffA);
            PG8_WAIT_V(8); PG8_WAIT_L(0); PG8_BAR; PG8_MMA(1, 0, At, B0); PG8_MMA(1, 1, At, B1); PG8_BAR; PG8_SCHED;
            } else {
            PG8_LDB(B0, 0, 0); PG8_SCHED; PG8_LDA(At, 0, 0); PG8_STAGE(PG8_SA(1, 1), a1 + hstep, voffA);
            PG8_WAIT_L(8); PG8_BAR; PG8_WAIT_L(0); PG8_MMA(0, 0, At, B0); PG8_BAR; PG8_SCHED;
            PG8_LDB(B1, 0, 1); PG8_STAGE(PG8_SB(0, 0), b2, voffB);
            PG8_BAR; PG8_WAIT_L(0); PG8_MMA(0, 1, At, B1); PG8_BAR;
            PG8_LDA(At, 0, 1); PG8_STAGE(PG8_SA(0, 0), a2, voffA);
            PG8_BAR; PG8_WAIT_L(0); PG8_MMA(1, 0, At, B0); PG8_BAR; PG8_SCHED;
            PG8_STAGE(PG8_SB(0, 1), b2 + hstep, voffB);
            PG8_WAIT_V(6); PG8_BAR; PG8_MMA(1, 1, At, B1); PG8_BAR;
            PG8_LDB(B0, 1, 0); PG8_SCHED; PG8_LDA(At, 1, 0); PG8_STAGE(PG8_SA(0, 1), a2 + hstep, voffA);
            PG8_WAIT_L(8); PG8_BAR; PG8_WAIT_L(0); PG8_MMA(0, 0, At, B0); PG8_BAR; PG8_SCHED;
            PG8_LDB(B1, 1, 1); PG8_STAGE(PG8_SB(1, 0), b3, voffB);
            PG8_BAR; PG8_WAIT_L(0); PG8_MMA(0, 1, At, B1); PG8_BAR;
            PG8_LDA(At, 1, 1); PG8_STAGE(PG8_SA(1, 0), a3, voffA);
            PG8_BAR; PG8_WAIT_L(0); PG8_MMA(1, 0, At, B0); PG8_BAR; PG8_SCHED;
            PG8_STAGE(PG8_SB(1, 1), b3 + hstep, voffB);
            PG8_WAIT_V(6); PG8_BAR; PG8_MMA(1, 1, At, B1); PG8_BAR;
            }
        }
        if constexpr (ALIGN_EPI) { if (wr == 0) PG8_BAR; }
        if constexpr (!Epi::AFTER_DRAIN) { E(acc, cur, wr, wc, fr, fq); S.done(cur); }
        if (!has_next) break;
#pragma unroll
        for (int a = 0; a < 2; ++a)
#pragma unroll
            for (int b = 0; b < 2; ++b)
#pragma unroll
                for (int m = 0; m < 4; ++m)
#pragma unroll
                    for (int n = 0; n < 2; ++n) acc[a][b][m][n] = (f32x4){0.f, 0.f, 0.f, 0.f};
        cur = nxt; cA = nA; cB = nB; ++ui;
        if constexpr (ALIGN_EPI) { if (wr == 1) PG8_BAR; }
    }
    PG8_WAIT_V(0);
    if constexpr (!ALIGN_EPI) { if (wr == 0) PG8_BAR; }
    PG8_BAR;
    if constexpr (Epi::AFTER_DRAIN) { E.fused(acc, cur, wr, wc, fr, fq, lds, wid, lane); S.done(cur); }
#undef PG8_SA
#undef PG8_SB
#undef PG8_STAGE
#undef PG8_LDA
#undef PG8_LDB
#undef PG8_MMA
#undef PG8_WAIT_V
#undef PG8_WAIT_L
#undef PG8_BAR
#undef PG8_SCHED
}
}
#ifndef DBG_SCALE3
#define DBG_SCALE3 0
#endif
#ifndef DBG_ZERO
#define DBG_ZERO 0
#endif
#ifndef LAST_PHASE
#define LAST_PHASE 4
#endif
#ifndef REP_P0
#define REP_P0 1
#endif
#ifndef REP_P1
#define REP_P1 1
#endif
#ifndef REP_P2A
#define REP_P2A 1
#endif
#ifndef REP_P0T
#define REP_P0T 1
#endif
#ifndef REP_P0R
#define REP_P0R 1
#endif
#ifndef REP_S2
#define REP_S2 1
#endif
#ifndef REP_S3
#define REP_S3 1
#endif
#ifndef REP_S4
#define REP_S4 1
#endif
#ifndef REP_ATOM
#define REP_ATOM 1
#endif
#ifndef REP_SSD
#define REP_SSD 1
#endif
#ifndef REP_WIN
#define REP_WIN 1
#endif
#ifndef REP_MEM
#define REP_MEM 1
#endif
#ifndef REP_P3
#define REP_P3 1
#endif
#define DI __device__ __forceinline__
#define LAS __attribute__((address_space(3)))
typedef unsigned short bf16_t;
typedef short bf16x8 __attribute__((ext_vector_type(8)));
typedef float f32x4 __attribute__((ext_vector_type(4)));
typedef float f32x2 __attribute__((ext_vector_type(2)));
typedef unsigned u32x4 __attribute__((ext_vector_type(4)));
typedef unsigned u32x2 __attribute__((ext_vector_type(2)));

constexpr int NB_P = 16, T_P = 4096, NB_S = 32, T_S = 64, DM = 1024;
constexpr int MP = NB_P * T_P, MS = NB_S * T_S, MTOT = MP + MS;
constexpr int MMEM = NB_P * 256, MA = MTOT + MMEM;
constexpr int NPROJ = 4864, NBT = NPROJ + 1024, INC = 4880;
constexpr int C_Q = 0, C_K = 512, C_V = 640, C_GA = 768, C_Z = 1280, C_XBC = 2304, C_MQ = 3840, C_GM = 4352;
constexpr int NCHUNK = MTOT / 64;
constexpr float EPSF = 1e-6f;
constexpr size_t O_Y = 0;
constexpr size_t O_WKP = (size_t)MTOT * 1024;
constexpr size_t O_WVP = O_WKP + (size_t)NB_P * 128 * 128;
constexpr size_t O_SSMP = O_WVP + (size_t)NB_P * 128 * 128;
constexpr size_t O_CONVP = O_SSMP + (size_t)NB_P * 16 * 64 * 128;
constexpr size_t O_MKP = O_CONVP + (size_t)NB_P * 3 * 1536;
constexpr size_t O_MVP = O_MKP + (size_t)NB_P * 256 * 512;
constexpr size_t O_WKS = O_MVP + (size_t)NB_P * 256 * 512;
constexpr size_t O_WVS = O_WKS + (size_t)NB_S * 128 * 128;
constexpr size_t O_SSMS = O_WVS + (size_t)NB_S * 128 * 128;
constexpr size_t O_CONVS = O_SSMS + (size_t)NB_S * 16 * 64 * 128;
constexpr size_t O_END = O_CONVS + (size_t)NB_S * 3 * 1536;
static_assert(O_END == 81485824, "output size");
constexpr size_t MiB = 1u << 20;
constexpr size_t WS_ROPE = 1 * MiB;
constexpr size_t WS_BT = 2 * MiB;
constexpr size_t WS_WOUT = 14 * MiB;
constexpr size_t WS_DT = 18 * MiB;
constexpr size_t WS_SSQ = 23 * MiB;
constexpr size_t WS_CTL = 0, CTL_ZERO_BYTES = 65536;
constexpr size_t WS_MEMRAW = 32 * MiB;
constexpr size_t WS_MEMK = 40 * MiB;
constexpr size_t WS_MEMVT = 52 * MiB;
constexpr size_t WS_PROJ = 64 * MiB;
constexpr size_t WS_A = 692 * MiB;
constexpr size_t WS_MIX = 692 * MiB;
constexpr size_t WS_BCC = 956 * MiB;
constexpr size_t WS_END = 1022 * MiB;
static_assert(WS_BT + (size_t)NBT * 1024 * 2 <= WS_WOUT && WS_DT + (size_t)MTOT * 64 <= WS_SSQ && WS_SSQ + (size_t)MTOT * 128 <= WS_MEMRAW, "ws map 1");
static_assert(WS_PROJ + (size_t)MTOT * NPROJ * 2 <= WS_A && WS_A + (size_t)MA * 1024 * 2 <= WS_END && WS_MIX + (size_t)MTOT * 2048 * 2 <= WS_BCC && WS_BCC + (size_t)MTOT * 512 * 2 <= WS_END, "ws map 2");
constexpr int LDS_BYTES = 147456;

DI float bf2f(unsigned short b) { return __uint_as_float((unsigned)b << 16); }
typedef __bf16 hbf2 __attribute__((ext_vector_type(2)));
DI unsigned short f2bf(float f) { return __builtin_bit_cast(unsigned short, (__bf16)f); }
DI unsigned pk2(float lo, float hi) { const f32x2 v = {lo, hi}; return __builtin_bit_cast(unsigned, __builtin_convertvector(v, hbf2)); }
DI unsigned cvt_pk_bf16(float lo, float hi) { return pk2(lo, hi); }
DI float siluf(float x) { return x * __builtin_amdgcn_rcpf(1.0f + __expf(-x)); }
DI float wave_sum(float v) {
#pragma unroll
    for (int o = 1; o < 64; o <<= 1) v += __shfl_xor(v, o);
    return v;
}
DI void unpack8(const u32x4 v, float (&o)[8]) {
#pragma unroll
    for (int i = 0; i < 4; ++i) { o[2 * i] = __uint_as_float(v[i] << 16); o[2 * i + 1] = __uint_as_float(v[i] & 0xffff0000u); }
}
DI u32x4 pack8(const float (&o)[8]) { u32x4 v; v.x = pk2(o[0], o[1]); v.y = pk2(o[2], o[3]); v.z = pk2(o[4], o[5]); v.w = pk2(o[6], o[7]); return v; }
#define LDS_WAIT() asm volatile("s_waitcnt lgkmcnt(0)" ::: "memory")
#define MFMA16(a, b, c) __builtin_amdgcn_mfma_f32_16x16x32_bf16((a), (b), (c), 0, 0, 0)

struct Args { const float* in[26]; float* out; unsigned char* ws; };
struct Ctx {
    LAS unsigned char* lds; int tid, lane, wave, G, bid;
    const float* in[26]; float* out; unsigned char* ws;
};
#define RLX_AGENT __ATOMIC_RELAXED, __HIP_MEMORY_SCOPE_AGENT
#define XB_TMO      128
#define XB_XCNT(j)  (256  + 64 * (j))
#define XB_XSUB(j)  (1280 + 64 * (j))
#define XB_XGEN(j)  (2304 + 64 * (j))
#define XB_TOP      3328
#define XB_TOPGEN   3392
#define XCD_BAR_WORDS 3456
#define XB_SPIN_CAP (1u << 18)

__device__ __forceinline__ unsigned xb_ld(unsigned* p)              { return __hip_atomic_load(p, __ATOMIC_RELAXED, __HIP_MEMORY_SCOPE_AGENT); }
__device__ __forceinline__ unsigned xb_add(unsigned* p, unsigned v) { return __hip_atomic_fetch_add(p, v, __ATOMIC_RELAXED, __HIP_MEMORY_SCOPE_AGENT); }
__device__ __forceinline__ unsigned xb_xcc_id() { return (unsigned)__builtin_amdgcn_s_getreg((3 << 11) | 20) & 0xFu; }
#define XB_SPIN(cond, bar) do { unsigned _sp = 0; while (cond) { __builtin_amdgcn_s_sleep(1); \
    if ((++_sp & 255u) == 0u) { if (xb_ld(&(bar)[XB_TMO])) break; if (_sp > XB_SPIN_CAP) { atomicAdd(&(bar)[XB_TMO], 1u); break; } } } } while (0)

struct XcdBarrier {
    unsigned* bar; unsigned x;
    volatile LAS unsigned* st;
};

__device__ __forceinline__ XcdBarrier xcd_barrier_post(unsigned* bar, volatile LAS unsigned* st) {
    XcdBarrier b; b.bar = bar; b.x = xb_xcc_id(); b.st = st;
    if (threadIdx.x == 0) (void)xb_add(&bar[XB_XCNT(b.x)], 1u);
    return b;
}
__device__ __forceinline__ void xcd_barrier_complete(unsigned* bar, unsigned x, unsigned& nloc, unsigned& nx) {
    const unsigned G = gridDim.x * gridDim.y * gridDim.z;
    unsigned sum, cnt, mine, sp = 0u;
    for (;;) {
        sum = 0u; cnt = 0u; mine = 0u;
#pragma unroll
        for (unsigned j = 0; j < 16; ++j) { const unsigned c = xb_ld(&bar[XB_XCNT(j)]); sum += c; cnt += (c > 0u) ? 1u : 0u; mine = (j == x) ? c : mine; }
        if (sum == G) break;
        __builtin_amdgcn_s_sleep(1);
        if ((++sp & 255u) == 0u) { if (xb_ld(&bar[XB_TMO])) break; if (sp > XB_SPIN_CAP) { atomicAdd(&bar[XB_TMO], 1u); break; } }
    }
    nloc = mine > 0u ? mine : 1u; nx = cnt > 0u ? cnt : 1u;
}

__device__ __forceinline__ void xcd_barrier(const XcdBarrier& b) {
    asm volatile("s_waitcnt vmcnt(0)" ::: "memory");
    __syncthreads();
    if (threadIdx.x == 0) {
        unsigned* bar = b.bar;
        __builtin_amdgcn_s_waitcnt(0);
        unsigned nloc = b.st[0], nx = b.st[1];
        if (nloc == 0u) { xcd_barrier_complete(bar, b.x, nloc, nx); b.st[0] = nloc; b.st[1] = nx; }
        const unsigned old = xb_add(&bar[XB_XSUB(b.x)], 1u);
        const unsigned gen = old / nloc;
        if (old + 1u == (gen + 1u) * nloc) {
            __builtin_amdgcn_fence(__ATOMIC_RELEASE, "agent");
            asm volatile("s_waitcnt vmcnt(0)" ::: "memory");
            const unsigned og = xb_add(&bar[XB_TOP], 1u);
            const unsigned tg = og / nx;
            if (og + 1u == (tg + 1u) * nx) xb_add(&bar[XB_TOPGEN], 1u);
            else XB_SPIN(xb_ld(&bar[XB_TOPGEN]) == tg, bar);
            __builtin_amdgcn_fence(__ATOMIC_ACQUIRE, "agent");
            xb_add(&bar[XB_XGEN(b.x)], 1u);
            asm volatile("s_waitcnt vmcnt(0)" ::: "memory");
        } else {
            XB_SPIN(xb_ld(&bar[XB_XGEN(b.x)]) == gen, bar);
            __builtin_amdgcn_fence(__ATOMIC_ACQUIRE, "agent");
            asm volatile("s_waitcnt vmcnt(0)" ::: "memory");
        }
    }
    __syncthreads();
}

enum { I_XP = 0, I_XS, I_CWK, I_CWV, I_SSM, I_SCONV, I_CMK, I_CMV, I_MEM, I_GNORM, I_WIN, I_GQ, I_GK, I_SINKS, I_CONVW, I_CONVB, I_DTB, I_ALOG, I_DSKIP, I_GSSD, I_GMEM, I_WMK, I_WMV, I_GMK, I_GMQ, I_WOUT };

DI void p0_transpose_item(const float* W, int ldw, int src_k0, int src_n0, const float* rowscale, bf16_t* WT, int ldt, int dst_n0, int dst_k0, LAS float* scr, int lane) {
#pragma unroll 8
    for (int i = 0; i < 32; ++i) { const int kk = 2 * i + (lane >> 5); float v = W[(size_t)(src_k0 + kk) * ldw + src_n0 + (lane & 31)]; if (rowscale) v *= rowscale[kk]; scr[kk * 33 + (lane & 31)] = v; }
    LDS_WAIT();
    const int c = lane & 7;
#pragma unroll
    for (int j = 0; j < 4; ++j) { const int n = (lane >> 3) + 8 * j; const LAS float* s = scr + (8 * c) * 33 + n;
        u32x4 o; o.x = pk2(s[0 * 33], s[1 * 33]); o.y = pk2(s[2 * 33], s[3 * 33]); o.z = pk2(s[4 * 33], s[5 * 33]); o.w = pk2(s[6 * 33], s[7 * 33]);
        *(u32x4*)(WT + (size_t)(dst_n0 + n) * ldt + dst_k0 + 8 * c) = o; }
    LDS_WAIT();
}

DI float reduce16_to_lane(float (&a)[16], int lane) {
#pragma unroll
    for (int j = 0; j < 16; ++j) { a[j] += __shfl_xor(a[j], 32); a[j] += __shfl_xor(a[j], 16); }
    float r8[8], r4[4], r2[2];
    const bool b3 = (lane & 8) != 0, b2 = (lane & 4) != 0, b1 = (lane & 2) != 0, b0 = (lane & 1) != 0;
#pragma unroll
    for (int j = 0; j < 8; ++j) { const float snd = b3 ? a[j] : a[j + 8], kp = b3 ? a[j + 8] : a[j]; r8[j] = kp + __shfl_xor(snd, 8); }
#pragma unroll
    for (int j = 0; j < 4; ++j) { const float snd = b2 ? r8[j] : r8[j + 4], kp = b2 ? r8[j + 4] : r8[j]; r4[j] = kp + __shfl_xor(snd, 4); }
#pragma unroll
    for (int j = 0; j < 2; ++j) { const float snd = b1 ? r4[j] : r4[j + 2], kp = b1 ? r4[j + 2] : r4[j]; r2[j] = kp + __shfl_xor(snd, 2); }
    const float snd = b0 ? r2[0] : r2[1], kp = b0 ? r2[1] : r2[0];
    return kp + __shfl_xor(snd, 1);
}

DI void p0_rows2(f32x4 (&va)[4], f32x4 (&vb)[4], const float* g, bf16_t* oa, bf16_t* ob, float* dta, float* dtb, bool want_dt, const float* dt_bias, const LAS float* wdt, int lane) {
    float sa = 0.f, sb = 0.f;
#pragma unroll
    for (int jj = 0; jj < 4; ++jj) { sa += (va[jj].x * va[jj].x + va[jj].y * va[jj].y) + (va[jj].z * va[jj].z + va[jj].w * va[jj].w); sb += (vb[jj].x * vb[jj].x + vb[jj].y * vb[jj].y) + (vb[jj].z * vb[jj].z + vb[jj].w * vb[jj].w); }
    const float ra = 1.0f / sqrtf(wave_sum(sa) * (1.0f / DM) + EPSF), rb = 1.0f / sqrtf(wave_sum(sb) * (1.0f / DM) + EPSF);
    u32x2* pa = (u32x2*)oa + lane; u32x2* pb = (u32x2*)ob + lane;
#pragma unroll
    for (int jj = 0; jj < 4; ++jj) { const f32x4 gv = ((const f32x4*)g)[64 * jj + lane]; va[jj] = va[jj] * ra * gv; vb[jj] = vb[jj] * rb * gv;
        u32x2 w; w.x = pk2(va[jj].x, va[jj].y); w.y = pk2(va[jj].z, va[jj].w); pa[64 * jj] = w; w.x = pk2(vb[jj].x, vb[jj].y); w.y = pk2(vb[jj].z, vb[jj].w); pb[64 * jj] = w; }
    if (want_dt) {
        f32x2 ab[16];
#pragma unroll
        for (int j = 0; j < 16; ++j) ab[j] = (f32x2){0.f, 0.f};
#pragma unroll
        for (int jj = 0; jj < 4; ++jj)
#pragma unroll
            for (int e = 0; e < 4; ++e) { const f32x2 hab = {va[jj][e], vb[jj][e]}; const LAS f32x4* wr = (const LAS f32x4*)(wdt + ((jj * 4 + e) * 64 + lane) * 20);
#pragma unroll
                for (int q = 0; q < 4; ++q) { const f32x4 w4 = wr[q];
                    ab[4 * q] += hab * w4.x; ab[4 * q + 1] += hab * w4.y; ab[4 * q + 2] += hab * w4.z; ab[4 * q + 3] += hab * w4.w; }
                if (e & 1) __builtin_amdgcn_sched_barrier(0); }
        float a[16], b[16];
#pragma unroll
        for (int j = 0; j < 16; ++j) { a[j] = ab[j].x; b[j] = ab[j].y; }
        const bool b5 = (lane & 32) != 0, b4 = (lane & 16) != 0, b3 = (lane & 8) != 0, b2 = (lane & 4) != 0, b1 = (lane & 2) != 0;
        float v16[16], v8[8], v4[4], v2[2];
#pragma unroll
        for (int j = 0; j < 16; ++j) { const float snd = b5 ? a[j] : b[j], kp = b5 ? b[j] : a[j]; v16[j] = kp + __shfl_xor(snd, 32); }
#pragma unroll
        for (int j = 0; j < 8; ++j) { const float snd = b4 ? v16[j] : v16[j + 8], kp = b4 ? v16[j + 8] : v16[j]; v8[j] = kp + __shfl_xor(snd, 16); }
#pragma unroll
        for (int j = 0; j < 4; ++j) { const float snd = b3 ? v8[j] : v8[j + 4], kp = b3 ? v8[j + 4] : v8[j]; v4[j] = kp + __shfl_xor(snd, 8); }
#pragma unroll
        for (int j = 0; j < 2; ++j) { const float snd = b2 ? v4[j] : v4[j + 2], kp = b2 ? v4[j + 2] : v4[j]; v2[j] = kp + __shfl_xor(snd, 4); }
        float tot; { const float snd = b1 ? v2[0] : v2[1], kp = b1 ? v2[1] : v2[0]; tot = kp + __shfl_xor(snd, 2); }
        tot += __shfl_xor(tot, 1);
        if ((lane & 1) == 0) { const int j = (lane >> 1) & 15; const float xv = tot + dt_bias[j]; float* dp = b5 ? dtb : dta;
            dp[j] = fmaxf(xv, 0.f) + log1pf(__expf(-fabsf(xv))); }
    }
}

DI void p0_row_segment(Ctx& F, const float* src, const float* g, int m0, int npair, bool tok, bf16_t* A, float* DT, const LAS float* wdt, int gw, int NGW) {
    const int lane = F.lane;
    f32x4 n0a[4], n0b[4], n1a[4], n1b[4];
#define P0_LOAD(dst_a, dst_b, pp) do { if ((pp) < npair) { _Pragma("unroll") for (int jj = 0; jj < 4; ++jj) { \
        dst_a[jj] = ((const f32x4*)(src + (size_t)(2 * (pp)) * DM))[64 * jj + lane]; dst_b[jj] = ((const f32x4*)(src + (size_t)(2 * (pp) + 1) * DM))[64 * jj + lane]; } } } while (0)
    P0_LOAD(n0a, n0b, gw); P0_LOAD(n1a, n1b, gw + NGW);
    for (int p = gw; p < npair; p += NGW) {
        f32x4 va[4], vb[4];
#pragma unroll
        for (int jj = 0; jj < 4; ++jj) { va[jj] = n0a[jj]; vb[jj] = n0b[jj]; n0a[jj] = n1a[jj]; n0b[jj] = n1b[jj]; }
        P0_LOAD(n1a, n1b, p + 2 * NGW);
        const int m = m0 + 2 * p;
        p0_rows2(va, vb, g, A + (size_t)m * DM, A + (size_t)(m + 1) * DM, DT + (size_t)(tok ? m : 0) * 16, DT + (size_t)(tok ? m + 1 : 0) * 16, tok, F.in[I_DTB], wdt, lane);
    }
#undef P0_LOAD
}

DI void p0_prologue(Ctx& F) {
    const int gw = F.bid * 8 + F.wave, NGW = F.G * 8, lane = F.lane;
    bf16_t* BT = (bf16_t*)(F.ws + WS_BT); bf16_t* WOT = (bf16_t*)(F.ws + WS_WOUT);
    for (int rep_ = 0; rep_ < REP_P0T; ++rep_) {
        LAS float* scr = (LAS float*)(F.lds + F.wave * 16384);
        constexpr int I_IN = 16 * (NPROJ / 32), I_M = 16 * 32, I_O = 32 * 32;
        for (int it = gw; it < I_IN + I_M + I_O; it += NGW) {
            int r = it;
            if (r < I_IN) { const int kb = r / (NPROJ / 32), nb = r % (NPROJ / 32); const int n0 = 32 * nb;
                p0_transpose_item(F.in[I_WIN], INC, 64 * kb, n0 + (n0 >= 3840 ? 16 : 0), nullptr, BT, 1024, n0, 64 * kb, scr, lane); continue; }
            r -= I_IN;
            if (r < I_M) { const int kb = r / 32, nb = r % 32;
                p0_transpose_item(nb < 16 ? F.in[I_WMK] : F.in[I_WMV], 512, 64 * kb, 32 * (nb & 15), nullptr, BT, 1024, NPROJ + 32 * nb, 64 * kb, scr, lane); continue; }
            r -= I_M;
            { const int kb = r / 32, nb = r % 32; const int k0 = 64 * kb;
              const int sk0 = k0 < 1024 ? 512 + k0 : (k0 < 1536 ? k0 - 1024 : k0);
              p0_transpose_item(F.in[I_WOUT], 1024, sk0, 32 * nb, k0 < 1024 ? F.in[I_GSSD] + k0 : nullptr, WOT, 2048, 32 * nb, k0, scr, lane); }
        }
    }
    { float* sq = (float*)(F.ws + WS_SSQ); for (int i = F.bid * 512 + F.tid; i < MTOT; i += F.G * 512) sq[i] = 0.f; }
    {
        f32x2* rope = (f32x2*)(F.ws + WS_ROPE);
        for (int i = F.bid * 512 + F.tid; i < 4096 * 32; i += F.G * 512) {
            const int pos = i >> 5, fi = i & 31;
            const float freq = exp2f(-(float)fi * (13.287712379549449f / 32.0f));
            double rev = (double)pos * (double)freq * 0.15915494309189535;
            rev -= __builtin_rint(rev);
            const float ang = (float)(rev * 6.283185307179586);
            rope[i] = (f32x2){cosf(ang), sinf(ang)};
        }
    }
    __syncthreads();
    for (int rep_ = 0; rep_ < REP_P0R; ++rep_) {
        if (rep_) __syncthreads();
        LAS float* wdt = (LAS float*)F.lds;
#pragma unroll 1
        for (int i0 = F.tid; i0 < 1024 * 16; i0 += 512 * 8) { float t8[8];
#pragma unroll
            for (int u = 0; u < 8; ++u) { const int i = i0 + 512 * u; t8[u] = F.in[I_WIN][(size_t)(i >> 4) * INC + 3840 + (i & 15)]; }
#pragma unroll
            for (int u = 0; u < 8; ++u) { const int i = i0 + 512 * u, k = i >> 4, j = i & 15; const int jj = k >> 8, e = k & 3, l = (k >> 2) & 63;
                wdt[((jj * 4 + e) * 64 + l) * 20 + j] = t8[u]; } }
        __syncthreads();
        bf16_t* A = (bf16_t*)(F.ws + WS_A); float* DT = (float*)(F.ws + WS_DT);
        p0_row_segment(F, F.in[I_XP], F.in[I_GNORM], 0, MP / 2, true, A, DT, wdt, gw, NGW);
        p0_row_segment(F, F.in[I_XS], F.in[I_GNORM], MP, MS / 2, true, A, DT, wdt, gw, NGW);
        p0_row_segment(F, F.in[I_MEM], F.in[I_GMEM], MTOT, MMEM / 2, false, A, DT, wdt, gw, NGW);
    }
}
struct Order1 {
    pg8::StaticOrder so; int G, c;
    __device__ void init(int G_, int c_) { so.init(MTOT, NPROJ, G_, c_); G = G_; c = c_; }
    __device__ bool next(int i, pg8::Unit& u) const {
        long L = (long)i * G + c;
        if (L >= (long)REP_P1 * (so.nwg + 64)) return false;
        L %= (so.nwg + 64);
        if (L < so.nwg) { pg8::StaticOrder t = so; t.G = 1; t.c = 0; return t.next((int)L, u); }
        const int r = (int)(L - so.nwg);
        u.pm = MTOT / 256 + (r >> 2); u.pn = NPROJ / 256 + (r & 3); return true;
    }
    __device__ __forceinline__ void a_ready(const pg8::Unit&) const {}
    __device__ __forceinline__ void done(const pg8::Unit&) const {}
};
struct Order3 {
    pg8::StaticOrder so; int G, c;
    __device__ void init(int G_, int c_) { so.init(MP, 1024, 1, 0); G = G_; c = c_; }
    __device__ bool next(int i, pg8::Unit& u) const {
        long L = (long)i * G + c;
        if (L >= (long)REP_P3 * so.nwg) return false;
        return so.next((int)(L % so.nwg), u);
    }
    __device__ __forceinline__ void a_ready(const pg8::Unit&) const {}
    __device__ __forceinline__ void done(const pg8::Unit&) const {}
};
struct EpiProj {
    static constexpr bool PERM = true, AFTER_DRAIN = false; static constexpr int MIDK = 0;
    bf16_t* proj; bf16_t* memraw;
    __device__ __forceinline__ void operator()(const f32x4 (&acc)[2][2][4][2], const pg8::Unit& u, int wr, int wc, int fr, int fq) const {
        bf16_t* base; int ldc, row0, col0;
        if (u.pn < NPROJ / 256) { base = proj; ldc = NPROJ; row0 = u.pm * 256; col0 = u.pn * 256; }
        else { base = memraw; ldc = 1024; row0 = (u.pm - MTOT / 256) * 256; col0 = (u.pn - NPROJ / 256) * 256; }
        row0 += wr * 64 + fr; col0 += wc * 32 + 8 * fq;
#pragma unroll
        for (int ai = 0; ai < 2; ++ai)
#pragma unroll
            for (int m = 0; m < 4; ++m) { bf16_t* rowp = base + (size_t)(row0 + ai * 128 + m * 16) * ldc + col0;
#pragma unroll
                for (int bj = 0; bj < 2; ++bj) { const f32x4 v0 = acc[ai][bj][m][0], v1 = acc[ai][bj][m][1];
                    u32x4 w; w.x = cvt_pk_bf16(v0[0], v0[1]); w.y = cvt_pk_bf16(v0[2], v0[3]); w.z = cvt_pk_bf16(v1[0], v1[1]); w.w = cvt_pk_bf16(v1[2], v1[3]);
                    *(u32x4*)(rowp + bj * 128) = w; } }
    }
};
struct EpiOut {
    static constexpr bool PERM = false, AFTER_DRAIN = false; static constexpr int MIDK = 16;
    const float* xp; const float* xs; float* out; const float* sumsq;
    __device__ __forceinline__ void mid(f32x4 (&acc)[2][2][4][2], const pg8::Unit& u, int wr, int wc, int fr, int fq) const {
        const float* sq = sumsq + (size_t)u.pm * 256 + wr * 64 + fr;
#pragma unroll
        for (int ai = 0; ai < 2; ++ai)
#pragma unroll
            for (int m = 0; m < 4; ++m) { const float r = 1.0f / sqrtf(sq[ai * 128 + m * 16] * (1.0f / 1024.0f) + EPSF);
#pragma unroll
                for (int bj = 0; bj < 2; ++bj)
#pragma unroll
                    for (int n = 0; n < 2; ++n) acc[ai][bj][m][n] = acc[ai][bj][m][n] * r; }
    }
    __device__ __forceinline__ void operator()(const f32x4 (&acc)[2][2][4][2], const pg8::Unit& u, int wr, int wc, int fr, int fq) const {
        const float* xb = u.pm < MP / 256 ? xp + (size_t)u.pm * 256 * DM : xs + (size_t)(u.pm - MP / 256) * 256 * DM;
        float* ob = out + (size_t)u.pm * 256 * DM;
        const int rl0 = wr * 64 + fr, col0 = u.pn * 256 + wc * 32 + 4 * fq;
#pragma unroll
        for (int ai = 0; ai < 2; ++ai) {
            f32x4 xv[4][2][2];
#pragma unroll
            for (int m = 0; m < 4; ++m)
#pragma unroll
                for (int bj = 0; bj < 2; ++bj)
#pragma unroll
                    for (int n = 0; n < 2; ++n) xv[m][bj][n] = *(const f32x4*)(xb + (size_t)(rl0 + ai * 128 + m * 16) * DM + col0 + bj * 128 + n * 16);
#pragma unroll
            for (int m = 0; m < 4; ++m)
#pragma unroll
                for (int bj = 0; bj < 2; ++bj)
#pragma unroll
                    for (int n = 0; n < 2; ++n) *(f32x4*)(ob + (size_t)(rl0 + ai * 128 + m * 16) * DM + col0 + bj * 128 + n * 16) = acc[ai][bj][m][n] + xv[m][bj][n];
            asm volatile("" ::: "memory"); }
    }
};

constexpr int SS_X = 0, SS_XD = 9216, SS_BM = 18432, SS_CM = 35840, SS_SB = 53248, SS_WM = 70656, SS_SM = 79872;
constexpr int LD64 = 144, LD128 = 272;
typedef short s16x4 __attribute__((ext_vector_type(4)));

DI bf16x8 lds_frag(const LAS unsigned char* tile, int ld, int row0, int k0, int lane) {
    return *(const LAS bf16x8*)(tile + (row0 + (lane & 15)) * ld + (k0 + 8 * (lane >> 4)) * 2);
}
DI bf16x8 lds_frag_tr(const LAS unsigned char* tile, int ld, int k0, int c0, int lane) {
    const LAS unsigned char* a = tile + (k0 + 8 * (lane >> 4) + ((lane & 15) >> 2)) * ld + (c0 + 4 * (lane & 3)) * 2;
    const s16x4 lo = __builtin_amdgcn_ds_read_tr16_b64_v4i16((LAS s16x4*)a), hi = __builtin_amdgcn_ds_read_tr16_b64_v4i16((LAS s16x4*)(a + 4 * ld));
    return (bf16x8){lo.x, lo.y, lo.z, lo.w, hi.x, hi.y, hi.z, hi.w};
}
DI bf16x8 lds_frag_tr2(const LAS unsigned char* tile, int ld, int k0, int c0, int lane) {
    const LAS unsigned char* a = tile + (k0 + 4 * (lane >> 4) + ((lane & 15) >> 2)) * ld + (c0 + 4 * (lane & 3)) * 2;
    const s16x4 lo = __builtin_amdgcn_ds_read_tr16_b64_v4i16((LAS s16x4*)a), hi = __builtin_amdgcn_ds_read_tr16_b64_v4i16((LAS s16x4*)(a + 16 * ld));
    return (bf16x8){lo.x, lo.y, lo.z, lo.w, hi.x, hi.y, hi.z, hi.w};
}
#define MFMA16T(rowsfrag, colsfrag, acc) MFMA16((colsfrag), (rowsfrag), (acc))

#define DPP_ADD_(v, ctrl, rmask) ((v) + __builtin_bit_cast(float, __builtin_amdgcn_update_dpp(0, __builtin_bit_cast(int, (v)), (ctrl), (rmask), 0xf, false)))
DI float wave_incl_scan(float v) {
    v = DPP_ADD_(v, 0x111, 0xf); v = DPP_ADD_(v, 0x112, 0xf); v = DPP_ADD_(v, 0x114, 0xf); v = DPP_ADD_(v, 0x118, 0xf);
    v = DPP_ADD_(v, 0x142, 0xa);
    v = DPP_ADD_(v, 0x143, 0xc);
    return v;
}
DI void convbc_prepass(Ctx& F) {
    const int gw = F.bid * 8 + F.wave, NGW = F.G * 8, lane = F.lane;
    const bf16_t* PROJ = (const bf16_t*)(F.ws + WS_PROJ); bf16_t* BCC = (bf16_t*)(F.ws + WS_BCC);
    const int ch0 = 1024 + lane * 8;
    float wv[4][8], bv[8];
#pragma unroll
    for (int e = 0; e < 8; ++e) { bv[e] = F.in[I_CONVB][ch0 + e];
#pragma unroll
        for (int j = 0; j < 4; ++j) wv[j][e] = F.in[I_CONVW][j * 1536 + ch0 + e]; }
    const bool bal = (F.G == 256);
    const int nmine = bal ? (F.bid < 64 ? 0 : (F.bid < 128 ? 2 : 1)) : (MTOT / 33 - gw + NGW - 1) / NGW;
    for (int ti = 0; ti < nmine; ++ti) {
        const int t = bal ? (F.bid < 128 ? ((F.bid - 64) * 8 + F.wave) * 2 + ti : 1024 + (F.bid - 128) * 8 + F.wave) : gw + ti * NGW;
        const int row0 = t * 33;
        float h0[8], h1[8], h2[8];
        { const bool smp0 = row0 >= MP; const int lrow0 = smp0 ? (row0 - MP) & 63 : row0 & (T_P - 1);
          const float* sc0 = F.in[I_SCONV] + (size_t)(smp0 ? (row0 - MP) >> 6 : 0) * 3 * 1536 + ch0;
#define CONV_HALO(dst, j) do { const int lr_ = lrow0 - 3 + (j); \
              if (lr_ >= 0) unpack8(*(const u32x4*)(PROJ + (size_t)(row0 - 3 + (j)) * NPROJ + C_XBC + ch0), dst); \
              else { _Pragma("unroll") for (int e = 0; e < 8; ++e) dst[e] = smp0 ? sc0[(3 + lr_) * 1536 + e] : 0.f; } } while (0)
          CONV_HALO(h0, 0); CONV_HALO(h1, 1); CONV_HALO(h2, 2);
#undef CONV_HALO
        }
#pragma unroll 1
        for (int bt = 0; bt < 3; ++bt) {
            u32x4 raw[11];
#pragma unroll
            for (int i = 0; i < 11; ++i) raw[i] = *(const u32x4*)(PROJ + (size_t)(row0 + 11 * bt + i) * NPROJ + C_XBC + ch0);
#pragma unroll
            for (int i = 0; i < 11; ++i) { const int row = row0 + 11 * bt + i;
                const bool smp = row >= MP; const int lrow = smp ? (row - MP) & 63 : row & (T_P - 1);
                if (lrow == 0) {
                    if (smp) { const float* sc = F.in[I_SCONV] + (size_t)((row - MP) >> 6) * 3 * 1536 + ch0;
#pragma unroll
                        for (int e = 0; e < 8; ++e) { h0[e] = sc[e]; h1[e] = sc[1536 + e]; h2[e] = sc[2 * 1536 + e]; } }
                    else {
#pragma unroll
                        for (int e = 0; e < 8; ++e) { h0[e] = 0.f; h1[e] = 0.f; h2[e] = 0.f; } } }
                float cur[8], o[8];
                unpack8(raw[i], cur);
#pragma unroll
                for (int e = 0; e < 8; ++e) { o[e] = siluf(bv[e] + wv[0][e] * h0[e] + wv[1][e] * h1[e] + wv[2][e] * h2[e] + wv[3][e] * cur[e]); h0[e] = h1[e]; h1[e] = h2[e]; h2[e] = cur[e]; }
                *(u32x4*)(BCC + (size_t)row * 512 + lane * 8) = pack8(o); }
        }
    }
}

DI void ssd_item(Ctx& F, int sq, int h, bool do_sumsq) {
    LAS unsigned char* lds = F.lds;
    const int tid = F.tid, lane = F.lane, w = F.wave, g = h >> 3;
    const bool smp = sq >= NB_P; const int sb = sq - NB_P;
    const int row_base = smp ? MP + sb * 64 : sq * T_P, nchunks = smp ? 1 : 64;
    const bf16_t* PROJ = (const bf16_t*)(F.ws + WS_PROJ); const bf16_t* BCC = (const bf16_t*)(F.ws + WS_BCC); const float* DT = (const float*)(F.ws + WS_DT);
    bf16_t* MIX = (bf16_t*)(F.ws + WS_MIX); float* SUMSQ = (float*)(F.ws + WS_SSQ);
    const float a_h = -__expf(F.in[I_ALOG][h]), d_h = F.in[I_DSKIP][h];
    const int pt = w >> 1, nh = w & 1, lt = w >> 1;
    const int xl = tid >> 3, xg = tid & 7, chx = h * 64 + 8 * xg;
    LAS float* sm_cw0 = (LAS float*)(lds + SS_SM + 1024 + 768);
    if (tid >= 192 && tid < 512) { const int i = tid - 192; const int j = i >> 6, chn = h * 64 + (i & 63); sm_cw0[i] = j < 4 ? F.in[I_CONVW][j * 1536 + chn] : F.in[I_CONVB][chn]; }
    f32x4 st[4];
#pragma unroll
    for (int q = 0; q < 4; ++q) {
        if (smp) st[q] = *(const f32x4*)(F.in[I_SSM] + ((size_t)(sb * 16 + h) * 64 + 16 * pt + (lane & 15)) * 128 + 16 * (4 * nh + q) + 4 * (lane >> 4));
        else st[q] = (f32x4){0.f, 0.f, 0.f, 0.f};
    }
    u32x4 px0[4], px1[4], pbs[2], pcs[2]; u32x2 pz0[2], pz1[2]; float pdt0, pdt1;
#define SSD_ISSUE_X(c_, PX_) do { const int row0_ = row_base + 64 * (c_); \
        _Pragma("unroll") for (int j_ = 0; j_ < 4; ++j_) { int rr_ = xl - 3 + j_; if ((c_) == 0 && rr_ < 0) rr_ = 0; PX_[j_] = *(const u32x4*)(PROJ + (size_t)(row0_ + rr_) * NPROJ + C_XBC + chx); } } while (0)
#define SSD_ISSUE_BC(c_) do { const int row0_ = row_base + 64 * (c_); \
        _Pragma("unroll") for (int i_ = 0; i_ < 2; ++i_) { const int t_ = tid + 512 * i_; \
            pbs[i_] = *(const u32x4*)(BCC + (size_t)(row0_ + (t_ >> 4)) * 512 + g * 128 + 8 * (t_ & 15)); pcs[i_] = *(const u32x4*)(BCC + (size_t)(row0_ + (t_ >> 4)) * 512 + 256 + g * 128 + 8 * (t_ & 15)); } } while (0)
#define SSD_ISSUE_ZDT(c_, PZ_, PDT_) do { const int row0_ = row_base + 64 * (c_); \
        _Pragma("unroll") for (int pi_ = 0; pi_ < 2; ++pi_) PZ_[pi_] = *(const u32x2*)(PROJ + (size_t)(row0_ + 16 * lt + (lane & 15)) * NPROJ + C_Z + h * 64 + 16 * (2 * nh + pi_) + 4 * (lane >> 4)); \
        PDT_ = DT[(size_t)(row0_ + lane) * 16 + h]; } while (0)
    LAS float* sm_init = (LAS float*)(lds + SS_SM + 1024);
    if (tid < 192) sm_init[tid] = smp ? F.in[I_SCONV][(size_t)(sb * 3 + (tid >> 6)) * 1536 + h * 64 + (tid & 63)] : 0.f;
#define SSD_STEP(c, PX_, PZ_, PDT_) do { \
        const int row0 = row_base + 64 * c; \
        LAS float* sm_ac = (LAS float*)(lds + SS_SM + (c & 1) * 512); LAS float* sm_dt = sm_ac + 64; \
        const float dtl = PDT_; \
        float ac = dtl * a_h; \
        ac = wave_incl_scan(ac); \
        const float ac_last = __builtin_bit_cast(float, __builtin_amdgcn_readlane(__builtin_bit_cast(int, ac), 63)); \
        const float wgt_l = __expf(ac_last - ac) * dtl; \
        if (w == 0) { sm_ac[lane] = ac; sm_dt[lane] = dtl; } \
        __syncthreads(); \
        { \
        { float xr[4][8], o[8], od[8]; \
_Pragma("unroll")           for (int j = 0; j < 4; ++j) unpack8(PX_[j], xr[j]); \
          if (c == 0) { \
_Pragma("unroll")               for (int j = 0; j < 3; ++j) { const int rr = xl - 3 + j; const LAS f32x4* iv = (const LAS f32x4*)(sm_init + (rr < 0 ? 3 + rr : 0) * 64 + 8 * xg); \
                  f32x4 i0 = iv[0], i1 = iv[1]; asm volatile("" : "+v"(i0), "+v"(i1)); \
_Pragma("unroll")                   for (int e = 0; e < 4; ++e) { xr[j][e] = (rr < 0) ? i0[e] : xr[j][e]; xr[j][4 + e] = (rr < 0) ? i1[e] : xr[j][4 + e]; } } } \
          const float wg = __shfl(wgt_l, xl & 63); \
          float wv[4][8], bv[8]; unsigned cwo_ = (unsigned)(8 * xg) * 4u; asm volatile("" : "+v"(cwo_)); const LAS float* sm_cw = (const LAS float*)((const LAS unsigned char*)sm_cw0 + cwo_) - 8 * xg; \
          _Pragma("unroll") for (int j_ = 0; j_ < 4; ++j_) { const f32x4 a_ = *(const LAS f32x4*)(sm_cw + j_ * 64 + 8 * xg), b_ = *(const LAS f32x4*)(sm_cw + j_ * 64 + 8 * xg + 4); \
              _Pragma("unroll") for (int e_ = 0; e_ < 4; ++e_) { wv[j_][e_] = a_[e_]; wv[j_][4 + e_] = b_[e_]; } } \
          { const f32x4 a_ = *(const LAS f32x4*)(sm_cw + 256 + 8 * xg), b_ = *(const LAS f32x4*)(sm_cw + 256 + 8 * xg + 4); _Pragma("unroll") for (int e_ = 0; e_ < 4; ++e_) { bv[e_] = a_[e_]; bv[4 + e_] = b_[e_]; } } \
_Pragma("unroll")           for (int e = 0; e < 8; ++e) { o[e] = siluf(bv[e] + wv[0][e] * xr[0][e] + wv[1][e] * xr[1][e] + wv[2][e] * xr[2][e] + wv[3][e] * xr[3][e]); od[e] = o[e] * wg; } \
          *(LAS u32x4*)(lds + SS_X + xl * LD64 + xg * 16) = pack8(o); \
          *(LAS u32x4*)(lds + SS_XD + xl * LD64 + xg * 16) = pack8(od); } \
_Pragma("unroll")         for (int i = 0; i < 2; ++i) { const int t = tid + 512 * i; \
            *(LAS u32x4*)(lds + SS_BM + (t >> 4) * LD128 + (t & 15) * 16) = pbs[i]; *(LAS u32x4*)(lds + SS_CM + (t >> 4) * LD128 + (t & 15) * 16) = pcs[i]; } \
_Pragma("unroll")         for (int q = 0; q < 4; ++q) { u32x2 v; v.x = pk2(st[q][0], st[q][1]); v.y = pk2(st[q][2], st[q][3]); \
            *(LAS u32x2*)(lds + SS_SB + (16 * pt + (lane & 15)) * LD128 + (16 * (4 * nh + q) + 4 * (lane >> 4)) * 2) = v; } \
        } \
        if (c + 2 < nchunks) SSD_ISSUE_X(c + 2, PX_); if (c + 1 < nchunks) SSD_ISSUE_BC(c + 1); \
        __syncthreads(); \
        { const float acl = sm_ac[16 * lt + (lane & 15)]; const int l = 16 * lt + (lane & 15); \
_Pragma("unroll")           for (int si = 0; si < 2; ++si) { const int stl = 2 * nh + si; f32x4 gacc = {0.f, 0.f, 0.f, 0.f}; \
              if (stl <= lt) { \
_Pragma("unroll")                   for (int ks = 0; ks < 4; ++ks) gacc = MFMA16T(lds_frag(lds + SS_CM, LD128, 16 * lt, 32 * ks, lane), lds_frag(lds + SS_BM, LD128, 16 * stl, 32 * ks, lane), gacc); } \
              const int s0 = 16 * stl + 4 * (lane >> 4); \
              const f32x4 acs = *(const LAS f32x4*)(sm_ac + s0), dts = *(const LAS f32x4*)(sm_dt + s0); \
              float v[4]; \
_Pragma("unroll")               for (int r = 0; r < 4; ++r) { v[r] = gacc[r] * __expf(fminf(acl - acs[r], 0.f)) * dts[r]; v[r] = (l >= s0 + r) ? v[r] : 0.f; } \
              u32x2 pk; pk.x = pk2(v[0], v[1]); pk.y = pk2(v[2], v[3]); \
              *(LAS u32x2*)(lds + SS_WM + l * LD64 + s0 * 2) = pk; } } \
        __syncthreads(); \
        { \
        { const int l = 16 * lt + (lane & 15); const float eal = __expf(sm_ac[l]); \
          float ssq = 0.f; \
_Pragma("unroll")           for (int pi = 0; pi < 2; ++pi) { const int ptl = 2 * nh + pi; const int p0 = 16 * ptl + 4 * (lane >> 4); \
              f32x4 y = {0.f, 0.f, 0.f, 0.f}; \
_Pragma("unroll")               for (int ks = 0; ks < 4; ++ks) y = MFMA16T(lds_frag(lds + SS_CM, LD128, 16 * lt, 32 * ks, lane), lds_frag(lds + SS_SB, LD128, 16 * ptl, 32 * ks, lane), y); \
              y = y * eal; \
_Pragma("unroll")               for (int ks = 0; ks < 2; ++ks) y = MFMA16T(lds_frag(lds + SS_WM, LD64, 16 * lt, 32 * ks, lane), lds_frag_tr(lds + SS_X, LD64, 32 * ks, 16 * ptl, lane), y); \
              const u32x2 xraw = *(const LAS u32x2*)(lds + SS_X + l * LD64 + p0 * 2); \
              const float xv[4] = {__uint_as_float(xraw.x << 16), __uint_as_float(xraw.x & 0xffff0000u), __uint_as_float(xraw.y << 16), __uint_as_float(xraw.y & 0xffff0000u)}; \
              const float zv[4] = {__uint_as_float(PZ_[pi].x << 16), __uint_as_float(PZ_[pi].x & 0xffff0000u), __uint_as_float(PZ_[pi].y << 16), __uint_as_float(PZ_[pi].y & 0xffff0000u)}; \
              float gv[4]; \
_Pragma("unroll")               for (int r = 0; r < 4; ++r) { gv[r] = (y[r] + d_h * xv[r]) * siluf(zv[r]); ssq += gv[r] * gv[r]; } \
              u32x2 pk; pk.x = pk2(gv[0], gv[1]); pk.y = pk2(gv[2], gv[3]); \
              *(u32x2*)(MIX + (size_t)(row0 + l) * 2048 + h * 64 + p0) = pk; } \
          ssq += __shfl_xor(ssq, 16); ssq += __shfl_xor(ssq, 32); \
          if (lane < 16 && do_sumsq) unsafeAtomicAdd(SUMSQ + row0 + l, ssq); } \
        } \
        { const float cd = __expf(ac_last); \
          bf16x8 xa[2]; \
_Pragma("unroll")           for (int ks = 0; ks < 2; ++ks) xa[ks] = lds_frag_tr(lds + SS_XD, LD64, 32 * ks, 16 * pt, lane); \
_Pragma("unroll")           for (int q = 0; q < 4; ++q) { f32x4 s = st[q] * cd; \
_Pragma("unroll")               for (int ks = 0; ks < 2; ++ks) s = MFMA16T(xa[ks], lds_frag_tr(lds + SS_BM, LD128, 32 * ks, 16 * (4 * nh + q), lane), s); \
              st[q] = s; } } \
        if (c + 2 < nchunks) SSD_ISSUE_ZDT(c + 2, PZ_, PDT_); \
    } while (0)
    SSD_ISSUE_X(0, px0); SSD_ISSUE_BC(0); SSD_ISSUE_ZDT(0, pz0, pdt0);
    if (nchunks > 1) { SSD_ISSUE_X(1, px1); SSD_ISSUE_ZDT(1, pz1, pdt1); }
#pragma unroll 1
    for (int c2 = 0; c2 < nchunks; c2 += 2) {
        { const int c = c2; SSD_STEP(c, px0, pz0, pdt0); }
        if (c2 + 1 < nchunks) { const int c = c2 + 1; SSD_STEP(c, px1, pz1, pdt1); }
    }
#undef SSD_STEP
#undef SSD_ISSUE_X
#undef SSD_ISSUE_BC
#undef SSD_ISSUE_ZDT
    { float* so = F.out + (smp ? O_SSMS + ((size_t)(sb * 16 + h) * 64) * 128 : O_SSMP + ((size_t)(sq * 16 + h) * 64) * 128);
#pragma unroll
      for (int q = 0; q < 4; ++q) *(f32x4*)(so + (16 * pt + (lane & 15)) * 128 + 16 * (4 * nh + q) + 4 * (lane >> 4)) = st[q]; }
    __syncthreads();
}
DI void p2a_phase(Ctx& F) {
    convbc_prepass(F);
    {
        const bf16_t* PROJ = (const bf16_t*)(F.ws + WS_PROJ);
        for (int i = F.bid * 512 + F.tid; i < 48 * 3 * 1536; i += F.G * 512) {
            const int ch = i % 1536, j = (i / 1536) % 3, sq = i / (3 * 1536);
            if (sq < NB_P) F.out[O_CONVP + (size_t)(sq * 3 + j) * 1536 + ch] = bf2f(PROJ[(size_t)(sq * T_P + T_P - 3 + j) * NPROJ + C_XBC + ch]);
            else F.out[O_CONVS + (size_t)((sq - NB_P) * 3 + j) * 1536 + ch] = bf2f(PROJ[(size_t)(MP + (sq - NB_P) * 64 + 61 + j) * NPROJ + C_XBC + ch]);
        }
    }
}
constexpr int WR_SLOT = 19456, WR_V = 9216, LDKW = 144, LDVW = 160;

DI void wa_write_k(Ctx& F, LAS unsigned char* slot, int kvh, const u32x4 ra, const u32x4 rb, int pos, float* ko) {
    const int i = F.tid >> 2, q4 = F.tid & 3;
    float a[8], bb[8], o1[8], o2[8];
    unpack8(ra, a); unpack8(rb, bb);
    float s = 0.f;
#pragma unroll
    for (int e = 0; e < 8; ++e) s += a[e] * a[e] + bb[e] * bb[e];
    s += __shfl_xor(s, 1); s += __shfl_xor(s, 2);
    const float rstd = 1.0f / sqrtf(s * (1.0f / 64.0f) + EPSF);
    const f32x2* ROPE = (const f32x2*)(F.ws + WS_ROPE);
#pragma unroll
    for (int e = 0; e < 8; ++e) { const float an = a[e] * rstd * F.in[I_GK][8 * q4 + e], bn = bb[e] * rstd * F.in[I_GK][32 + 8 * q4 + e];
        const f32x2 cs = ROPE[pos * 32 + 8 * q4 + e]; o1[e] = an * cs.x - bn * cs.y; o2[e] = bn * cs.x + an * cs.y; }
    *(LAS u32x4*)(slot + i * LDKW + (8 * q4) * 2) = pack8(o1);
    *(LAS u32x4*)(slot + i * LDKW + (32 + 8 * q4) * 2) = pack8(o2);
    if (ko) { float* p = ko + ((size_t)i * 2 + kvh) * 64;
        *(f32x4*)(p + 8 * q4) = (f32x4){o1[0], o1[1], o1[2], o1[3]}; *(f32x4*)(p + 8 * q4 + 4) = (f32x4){o1[4], o1[5], o1[6], o1[7]};
        *(f32x4*)(p + 32 + 8 * q4) = (f32x4){o2[0], o2[1], o2[2], o2[3]}; *(f32x4*)(p + 32 + 8 * q4 + 4) = (f32x4){o2[4], o2[5], o2[6], o2[7]}; }
}
DI void wa_write_v(Ctx& F, LAS unsigned char* slot, int kvh, const u32x4 rv, float* vo) {
    const int i = F.tid >> 3, q8 = F.tid & 7;
    *(LAS u32x4*)(slot + WR_V + i * LDVW + q8 * 16) = rv;
    if (vo) { float v[8]; unpack8(rv, v); float* p = vo + ((size_t)i * 2 + kvh) * 64 + 8 * q8;
        *(f32x4*)p = (f32x4){v[0], v[1], v[2], v[3]}; *(f32x4*)(p + 4) = (f32x4){v[4], v[5], v[6], v[7]}; }
}
DI void wa_stage_cache(Ctx& F, LAS unsigned char* slot, int kvh, const float* ck, const float* cv, float* ko, float* vo) {
    if (F.tid < 256) { const int i = F.tid >> 2, q4 = F.tid & 3; const float* src = ck + ((size_t)i * 2 + kvh) * 64;
        const f32x4 a0 = *(const f32x4*)(src + 8 * q4), a1 = *(const f32x4*)(src + 8 * q4 + 4), b0 = *(const f32x4*)(src + 32 + 8 * q4), b1 = *(const f32x4*)(src + 32 + 8 * q4 + 4);
        u32x4 pa, pb; pa.x = pk2(a0.x, a0.y); pa.y = pk2(a0.z, a0.w); pa.z = pk2(a1.x, a1.y); pa.w = pk2(a1.z, a1.w); pb.x = pk2(b0.x, b0.y); pb.y = pk2(b0.z, b0.w); pb.z = pk2(b1.x, b1.y); pb.w = pk2(b1.z, b1.w);
        *(LAS u32x4*)(slot + i * LDKW + (8 * q4) * 2) = pa; *(LAS u32x4*)(slot + i * LDKW + (32 + 8 * q4) * 2) = pb;
        if (ko) { float* p = ko + ((size_t)i * 2 + kvh) * 64; *(f32x4*)(p + 8 * q4) = a0; *(f32x4*)(p + 8 * q4 + 4) = a1; *(f32x4*)(p + 32 + 8 * q4) = b0; *(f32x4*)(p + 32 + 8 * q4 + 4) = b1; } }
    { const int i = F.tid >> 3, q8 = F.tid & 7; const float* src = cv + ((size_t)i * 2 + kvh) * 64 + 8 * q8; const f32x4 v0 = *(const f32x4*)src, v1 = *(const f32x4*)(src + 4);
      u32x4 pv; pv.x = pk2(v0.x, v0.y); pv.y = pk2(v0.z, v0.w); pv.z = pk2(v1.x, v1.y); pv.w = pk2(v1.z, v1.w);
      *(LAS u32x4*)(slot + WR_V + i * LDVW + q8 * 16) = pv;
      if (vo) { float* p = vo + ((size_t)i * 2 + kvh) * 64 + 8 * q8; *(f32x4*)p = v0; *(f32x4*)(p + 4) = v1; } }
}
DI void wa_compute(Ctx& F, int kvh, size_t crow0, int pos0, int sl0, int sl1, int sl2, int ninv) {
    LAS unsigned char* lds = F.lds;
    const int lane = F.lane, w = F.wave, g4 = lane >> 4;
    const bf16_t* PROJ = (const bf16_t*)(F.ws + WS_PROJ); const f32x2* ROPE = (const f32x2*)(F.ws + WS_ROPE); bf16_t* MIX = (bf16_t*)(F.ws + WS_MIX);
    const int hq = kvh * 4 + (w >> 1); const float sink = F.in[I_SINKS][hq] * 1.4426950408889634f;
    u32x2 graw[2][4]; u32x4 qraw[2][2];
#pragma unroll
    for (int rg = 0; rg < 2; ++rg) { const size_t row = crow0 + 32 * (w & 1) + 16 * rg + (lane & 15);
#pragma unroll
        for (int dt = 0; dt < 4; ++dt) graw[rg][dt] = *(const u32x2*)(PROJ + row * NPROJ + C_GA + hq * 64 + 16 * dt + 4 * g4);
        qraw[rg][0] = *(const u32x4*)(PROJ + row * NPROJ + C_Q + hq * 64 + 8 * g4); qraw[rg][1] = *(const u32x4*)(PROJ + row * NPROJ + C_Q + hq * 64 + 32 + 8 * g4); }
    bf16x8 qa[2][2];
#pragma unroll
    for (int rg = 0; rg < 2; ++rg) {
        const int d0 = 8 * g4; float a[8], bb[8];
        unpack8(qraw[rg][0], a);
        unpack8(qraw[rg][1], bb);
        float s = 0.f;
#pragma unroll
        for (int e = 0; e < 8; ++e) s += a[e] * a[e] + bb[e] * bb[e];
        s += __shfl_xor(s, 16); s += __shfl_xor(s, 32);
        const float rstd = 0.18033688011112042f / sqrtf(s * (1.0f / 64.0f) + EPSF);
        const int pos = pos0 + 32 * (w & 1) + 16 * rg + (lane & 15);
        float o1[8], o2[8];
#pragma unroll
        for (int e = 0; e < 8; ++e) { const float an = a[e] * rstd * F.in[I_GQ][d0 + e], bn = bb[e] * rstd * F.in[I_GQ][32 + d0 + e];
            const f32x2 cs = ROPE[pos * 32 + d0 + e]; o1[e] = an * cs.x - bn * cs.y; o2[e] = bn * cs.x + an * cs.y; }
        qa[rg][0] = __builtin_bit_cast(bf16x8, pack8(o1)); qa[rg][1] = __builtin_bit_cast(bf16x8, pack8(o2)); }
    f32x4 s[2][12];
#pragma unroll
    for (int jt = 0; jt < 12; ++jt) { const int j = jt >> 2; const LAS unsigned char* kt = lds + (j == 0 ? sl0 : (j == 1 ? sl1 : sl2)) * WR_SLOT;
        const bf16x8 k0 = lds_frag(kt, LDKW, 16 * (jt & 3), 0, lane), k1 = lds_frag(kt, LDKW, 16 * (jt & 3), 32, lane);
#pragma unroll
        for (int rg = 0; rg < 2; ++rg) { f32x4 acc = {0.f, 0.f, 0.f, 0.f};
            acc = MFMA16T(qa[rg][0], k0, acc); acc = MFMA16T(qa[rg][1], k1, acc);
            s[rg][jt] = acc; }
        if ((jt & 3) == 3) __builtin_amdgcn_sched_barrier(0); }
    if (ninv > 0) {
#pragma unroll
        for (int jt = 0; jt < 8; ++jt) if ((jt >> 2) < ninv) { s[0][jt] = (f32x4){-1e30f, -1e30f, -1e30f, -1e30f}; s[1][jt] = (f32x4){-1e30f, -1e30f, -1e30f, -1e30f}; } }
    float inv[2]; bf16x8 pa[2][6];
#pragma unroll
    for (int rg = 0; rg < 2; ++rg) {
        float m = sink;
#pragma unroll
        for (int jt = 0; jt < 12; ++jt)
#pragma unroll
            for (int r = 0; r < 4; ++r) m = fmaxf(m, s[rg][jt][r]);
        m = fmaxf(m, __shfl_xor(m, 16)); m = fmaxf(m, __shfl_xor(m, 32));
        float sum = 0.f;
#pragma unroll
        for (int jt = 0; jt < 12; ++jt)
#pragma unroll
            for (int r = 0; r < 4; ++r) { const float e = __builtin_amdgcn_exp2f(s[rg][jt][r] - m); s[rg][jt][r] = e; sum += e; }
        sum += __shfl_xor(sum, 16); sum += __shfl_xor(sum, 32);
        inv[rg] = 1.0f / (sum + __builtin_amdgcn_exp2f(sink - m));
#pragma unroll
        for (int k2 = 0; k2 < 6; ++k2) { u32x4 t; t.x = pk2(s[rg][2 * k2][0], s[rg][2 * k2][1]); t.y = pk2(s[rg][2 * k2][2], s[rg][2 * k2][3]);
            t.z = pk2(s[rg][2 * k2 + 1][0], s[rg][2 * k2 + 1][1]); t.w = pk2(s[rg][2 * k2 + 1][2], s[rg][2 * k2 + 1][3]);
            pa[rg][k2] = __builtin_bit_cast(bf16x8, t); } }
#pragma unroll
    for (int dt = 0; dt < 4; ++dt) { f32x4 o[2] = {{0.f, 0.f, 0.f, 0.f}, {0.f, 0.f, 0.f, 0.f}};
#pragma unroll
        for (int k2 = 0; k2 < 6; ++k2) { const int j = k2 >> 1; const LAS unsigned char* vt = lds + (j == 0 ? sl0 : (j == 1 ? sl1 : sl2)) * WR_SLOT + WR_V;
            const bf16x8 vf = lds_frag_tr2(vt, LDVW, 32 * (k2 & 1), 16 * dt, lane);
            o[0] = MFMA16T(pa[0][k2], vf, o[0]); o[1] = MFMA16T(pa[1][k2], vf, o[1]); }
#pragma unroll
        for (int rg = 0; rg < 2; ++rg) { const size_t row = crow0 + 32 * (w & 1) + 16 * rg + (lane & 15);
            const float gv[4] = {__uint_as_float(graw[rg][dt].x << 16), __uint_as_float(graw[rg][dt].x & 0xffff0000u), __uint_as_float(graw[rg][dt].y << 16), __uint_as_float(graw[rg][dt].y & 0xffff0000u)};
            u32x2 pk; pk.x = pk2(o[rg][0] * inv[rg] * siluf(gv[0]), o[rg][1] * inv[rg] * siluf(gv[1])); pk.y = pk2(o[rg][2] * inv[rg] * siluf(gv[2]), o[rg][3] * inv[rg] * siluf(gv[3]));
            *(u32x2*)(MIX + row * 2048 + 1024 + hq * 64 + 16 * dt + 4 * g4) = pk; }
        __builtin_amdgcn_sched_barrier(0); }
}
DI void winattn_item(Ctx& F, int item) {
    LAS unsigned char* lds = F.lds;
    const int tid = F.tid;
    const bf16_t* PROJ = (const bf16_t*)(F.ws + WS_PROJ);
    if (item >= 256) {
        const int sb = (item - 256) >> 1, kvh = item & 1; const size_t row0 = (size_t)MP + sb * 64;
        const float* ck = F.in[I_CWK] + (size_t)sb * 128 * 128; const float* cv = F.in[I_CWV] + (size_t)sb * 128 * 128;
        float* ko = F.out + O_WKS + (size_t)sb * 128 * 128; float* vo = F.out + O_WVS + (size_t)sb * 128 * 128;
        wa_stage_cache(F, lds + 0 * WR_SLOT, kvh, ck, cv, nullptr, nullptr);
        wa_stage_cache(F, lds + 1 * WR_SLOT, kvh, ck + 64 * 128, cv + 64 * 128, ko, vo);
        if (tid < 256) { const int i = tid >> 2, q4 = tid & 3; const bf16_t* p = PROJ + (row0 + i) * NPROJ + C_K + kvh * 64 + 8 * q4;
            wa_write_k(F, lds + 2 * WR_SLOT, kvh, *(const u32x4*)p, *(const u32x4*)(p + 32), 2048 + i, ko + 64 * 128); }
        { const int i = tid >> 3, q8 = tid & 7; wa_write_v(F, lds + 2 * WR_SLOT, kvh, *(const u32x4*)(PROJ + (row0 + i) * NPROJ + C_V + kvh * 64 + 8 * q8), vo + 64 * 128); }
        __syncthreads();
        wa_compute(F, kvh, row0, 2048, 0, 1, 2, 0);
        __syncthreads();
        return;
    }
    const int b = item >> 4, kvh = (item >> 3) & 1, c0 = (item & 7) * 8;
    const size_t seq0 = (size_t)b * T_P;
#pragma unroll 1
    for (int kc = c0 - 2; kc <= c0; ++kc) { LAS unsigned char* slot = lds + (kc & 3) * WR_SLOT;
        if (kc < 0) { for (int t = tid; t < WR_SLOT / 16; t += 512) *(LAS u32x4*)(slot + t * 16) = (u32x4){0u, 0u, 0u, 0u}; }
        else { const size_t row0 = seq0 + (size_t)kc * 64;
            if (tid < 256) { const int i = tid >> 2, q4 = tid & 3; const bf16_t* p = PROJ + (row0 + i) * NPROJ + C_K + kvh * 64 + 8 * q4;
                wa_write_k(F, slot, kvh, *(const u32x4*)p, *(const u32x4*)(p + 32), kc * 64 + i, nullptr); }
            { const int i = tid >> 3, q8 = tid & 7; wa_write_v(F, slot, kvh, *(const u32x4*)(PROJ + (row0 + i) * NPROJ + C_V + kvh * 64 + 8 * q8), nullptr); } } }
    __syncthreads();
#pragma unroll 1
    for (int c = c0; c < c0 + 8; ++c) {
        const bool more = c + 1 < c0 + 8;
        u32x4 ra = {0u, 0u, 0u, 0u}, rb = {0u, 0u, 0u, 0u}, rv = {0u, 0u, 0u, 0u};
        const size_t nrow0 = seq0 + (size_t)(c + 1) * 64;
        if (more) {
            if (tid < 256) { const bf16_t* p = PROJ + (nrow0 + (tid >> 2)) * NPROJ + C_K + kvh * 64 + 8 * (tid & 3); ra = *(const u32x4*)p; rb = *(const u32x4*)(p + 32); }
            rv = *(const u32x4*)(PROJ + (nrow0 + (tid >> 3)) * NPROJ + C_V + kvh * 64 + 8 * (tid & 7)); }
        wa_compute(F, kvh, seq0 + (size_t)c * 64, c * 64, (c - 2) & 3, (c - 1) & 3, c & 3, c >= 2 ? 0 : 2 - c);
        if (more) { LAS unsigned char* slot = lds + ((c + 1) & 3) * WR_SLOT; const int kc = c + 1;
            float* ko = nullptr; float* vo = nullptr;
            if (kc >= 62) { ko = F.out + O_WKP + ((size_t)b * 128 + (kc - 62) * 64) * 128; vo = F.out + O_WVP + ((size_t)b * 128 + (kc - 62) * 64) * 128; }
            if (tid < 256) wa_write_k(F, slot, kvh, ra, rb, kc * 64 + (tid >> 2), ko);
            wa_write_v(F, slot, kvh, rv, vo); }
        __syncthreads();
    }
}

constexpr int MA_K = 0, MA_V = 69632, MA_RS = 143360, LDKM = 272, LDVM = 288;
DI void memattn_item(Ctx& F, int item) {
    LAS unsigned char* lds = F.lds;
    const int tid = F.tid, lane = F.lane, w = F.wave, g4 = lane >> 4;
    const bool smp = item >= 256; const int sidx = item - 256;
    const int bb = smp ? (sidx >> 2) : (item >> 4), h = smp ? (sidx & 3) : ((item >> 2) & 3), qt = item & 3;
    const bf16_t* PROJ = (const bf16_t*)(F.ws + WS_PROJ); bf16_t* MIX = (bf16_t*)(F.ws + WS_MIX); const bf16_t* RAW = (const bf16_t*)(F.ws + WS_MEMRAW);
#pragma unroll 1
    for (int ib = 0; ib < 2; ++ib) {
      u32x4 rk[4], rvv[4]; f32x4 fk[4][2], fv[4][2];
#pragma unroll
      for (int u = 0; u < 4; ++u) { const int t = tid + 512 * (4 * ib + u), key = t >> 4, ch = t & 15;
        if (smp) { const float* ks = F.in[I_CMK] + ((size_t)(bb * 256 + key) * 4 + h) * 128 + 8 * ch; const float* vs = F.in[I_CMV] + ((size_t)(bb * 256 + key) * 4 + h) * 128 + 8 * ch;
            fk[u][0] = *(const f32x4*)ks; fk[u][1] = *(const f32x4*)(ks + 4); fv[u][0] = *(const f32x4*)vs; fv[u][1] = *(const f32x4*)(vs + 4); }
        else { rk[u] = *(const u32x4*)(RAW + (size_t)(bb * 256 + key) * 1024 + h * 128 + 8 * ch); rvv[u] = *(const u32x4*)(RAW + (size_t)(bb * 256 + key) * 1024 + 512 + h * 128 + 8 * ch); } }
#pragma unroll
      for (int u = 0; u < 4; ++u) { const int t = tid + 512 * (4 * ib + u), key = t >> 4, ch = t & 15;
        float k[8], v[8];
        if (smp) {
#pragma unroll
            for (int e = 0; e < 4; ++e) { k[e] = fk[u][0][e]; k[4 + e] = fk[u][1][e]; v[e] = fv[u][0][e]; v[4 + e] = fv[u][1][e]; } }
        else { unpack8(rk[u], k); unpack8(rvv[u], v); }
        float s = 0.f;
#pragma unroll
        for (int e = 0; e < 8; ++e) s += k[e] * k[e];
        s += __shfl_xor(s, 1); s += __shfl_xor(s, 2); s += __shfl_xor(s, 4); s += __shfl_xor(s, 8);
        if (!smp) { const float rstd = 1.0f / sqrtf(s * (1.0f / 128.0f) + EPSF);
#pragma unroll
            for (int e = 0; e < 8; ++e) k[e] = k[e] * rstd * F.in[I_GMK][8 * ch + e]; }
        { float kq[8];
#pragma unroll
          for (int e = 0; e < 8; ++e) kq[e] = k[e] * F.in[I_GMQ][8 * ch + e];
          *(LAS u32x4*)(lds + MA_K + key * LDKM + ch * 16) = pack8(kq); }
        *(LAS u32x4*)(lds + MA_V + key * LDVM + ch * 16) = pack8(v);
        if (!smp && qt == 0) {
            float* ko = F.out + O_MKP + ((size_t)(bb * 256 + key) * 4 + h) * 128 + 8 * ch; float* vo = F.out + O_MVP + ((size_t)(bb * 256 + key) * 4 + h) * 128 + 8 * ch;
            *(f32x4*)ko = (f32x4){k[0], k[1], k[2], k[3]}; *(f32x4*)(ko + 4) = (f32x4){k[4], k[5], k[6], k[7]};
            *(f32x4*)vo = (f32x4){v[0], v[1], v[2], v[3]}; *(f32x4*)(vo + 4) = (f32x4){v[4], v[5], v[6], v[7]}; }
      }
    }
    __syncthreads();
    const int ngr = smp ? 4 : 64;
    const size_t qbase = smp ? (size_t)MP + bb * 64 : (size_t)bb * T_P + qt * 1024;
    u32x4 nq[4]; u32x2 ng[8];
#define MA_LOAD(rg_) do { const size_t r_ = qbase + 16 * (rg_) + (lane & 15); \
        _Pragma("unroll") for (int ks = 0; ks < 4; ++ks) nq[ks] = *(const u32x4*)(PROJ + r_ * NPROJ + C_MQ + h * 128 + 32 * ks + 8 * g4); \
        _Pragma("unroll") for (int dt = 0; dt < 8; ++dt) ng[dt] = *(const u32x2*)(PROJ + r_ * NPROJ + C_GM + h * 128 + 16 * dt + 4 * g4); } while (0)
    if (w < ngr) MA_LOAD(w);
#pragma unroll 1
    for (int rg = w; rg < ngr; rg += 8) {
        u32x4 cq[4]; u32x2 cg[8];
#pragma unroll
        for (int ks = 0; ks < 4; ++ks) cq[ks] = nq[ks];
#pragma unroll
        for (int dt = 0; dt < 8; ++dt) cg[dt] = ng[dt];
        if (rg + 8 < ngr) MA_LOAD(rg + 8);
        bf16x8 qa[4];
        { float q[4][8]; float s = 0.f;
#pragma unroll
          for (int ks = 0; ks < 4; ++ks) { unpack8(cq[ks], q[ks]);
#pragma unroll
              for (int e = 0; e < 8; ++e) s += q[ks][e] * q[ks][e]; }
          s += __shfl_xor(s, 16); s += __shfl_xor(s, 32);
          const float rstd = 0.12751743082459868f / sqrtf(s * (1.0f / 128.0f) + EPSF);
#pragma unroll
          for (int ks = 0; ks < 4; ++ks) {
#pragma unroll
              for (int e = 0; e < 8; ++e) q[ks][e] = q[ks][e] * rstd;
              qa[ks] = __builtin_bit_cast(bf16x8, pack8(q[ks])); } }
        f32x4 s[16];
#pragma unroll
        for (int jt = 0; jt < 16; ++jt) { f32x4 acc = {0.f, 0.f, 0.f, 0.f};
#pragma unroll
            for (int ks = 0; ks < 4; ++ks) acc = MFMA16T(qa[ks], lds_frag(lds + MA_K, LDKM, 16 * jt, 32 * ks, lane), acc);
            s[jt] = acc;
            if ((jt & 3) == 3) __builtin_amdgcn_sched_barrier(0); }
        float m = s[0][0];
#pragma unroll
        for (int jt = 0; jt < 16; ++jt)
#pragma unroll
            for (int r = 0; r < 4; ++r) m = fmaxf(m, s[jt][r]);
        m = fmaxf(m, __shfl_xor(m, 16)); m = fmaxf(m, __shfl_xor(m, 32));
        float sum = 0.f;
#pragma unroll
        for (int jt = 0; jt < 16; ++jt)
#pragma unroll
            for (int r = 0; r < 4; ++r) { const float e = __builtin_amdgcn_exp2f(s[jt][r] - m); s[jt][r] = e; sum += e; }
        sum += __shfl_xor(sum, 16); sum += __shfl_xor(sum, 32);
        const float inv = 1.0f / sum;
        bf16x8 pa[8];
#pragma unroll
        for (int k2 = 0; k2 < 8; ++k2) { u32x4 t; t.x = pk2(s[2 * k2][0], s[2 * k2][1]); t.y = pk2(s[2 * k2][2], s[2 * k2][3]); t.z = pk2(s[2 * k2 + 1][0], s[2 * k2 + 1][1]); t.w = pk2(s[2 * k2 + 1][2], s[2 * k2 + 1][3]);
            pa[k2] = __builtin_bit_cast(bf16x8, t); }
        const size_t orow = qbase + 16 * rg + (lane & 15);
#pragma unroll
        for (int dt = 0; dt < 8; ++dt) { f32x4 o = {0.f, 0.f, 0.f, 0.f};
#pragma unroll
            for (int k2 = 0; k2 < 8; ++k2) o = MFMA16T(pa[k2], lds_frag_tr2(lds + MA_V, LDVM, 32 * k2, 16 * dt, lane), o);
            __builtin_amdgcn_sched_barrier(0);
            const int col = h * 128 + 16 * dt + 4 * g4;
            const u32x2 gr = cg[dt];
            const float gv[4] = {__uint_as_float(gr.x << 16), __uint_as_float(gr.x & 0xffff0000u), __uint_as_float(gr.y << 16), __uint_as_float(gr.y & 0xffff0000u)};
            u32x2 pk; pk.x = pk2(o[0] * inv * siluf(gv[0]), o[1] * inv * siluf(gv[1])); pk.y = pk2(o[2] * inv * siluf(gv[2]), o[3] * inv * siluf(gv[3]));
            *(u32x2*)(MIX + orow * 2048 + 1536 + col) = pk; }
    }
#undef MA_LOAD
    __syncthreads();
}

DI void p2a_attn(Ctx& F) {
    for (int rep = 0; rep < REP_WIN; ++rep)
    for (int it = F.bid; it < 320; it += F.G) winattn_item(F, it);
    __syncthreads();
    for (int rep = 0; rep < REP_MEM; ++rep)
    { for (int it = F.bid; it < 256; it += F.G) memattn_item(F, it);
      for (int s = (F.bid + F.G - (128 % F.G)) % F.G; s < 128; s += F.G) memattn_item(F, 256 + s); }
}
DI void p2b_phase(Ctx& F) {
    for (int rep = 0; rep < REP_SSD; ++rep)
    for (int it = F.bid; it < 48 * 16; it += F.G) ssd_item(F, it >> 4, it & 15, rep == 0);
}

constexpr int G2_A = 0, G2_B = 9216, G2_SET = 27648;
DI void gemm2_sample(Ctx& F) {
    LAS unsigned char* lds = F.lds;
    const int tid = F.tid, lane = F.lane, w = F.wave, g4 = lane >> 4;
    const bf16_t* MIX = (const bf16_t*)(F.ws + WS_MIX); const bf16_t* WOT = (const bf16_t*)(F.ws + WS_WOUT); const float* SUMSQ = (const float*)(F.ws + WS_SSQ);
    for (int tile = F.bid; tile < 256; tile += F.G) {
        const int r0 = MP + 64 * (tile >> 3), c0 = 128 * (tile & 7);
        const bf16_t* asrc = MIX + (size_t)(r0 + (tid >> 3)) * 2048 + 8 * (tid & 7);
        const bf16_t* bsrc0 = WOT + (size_t)(c0 + (tid >> 3)) * 2048 + 8 * (tid & 7);
        const bf16_t* bsrc1 = bsrc0 + (size_t)64 * 2048;
        const int aoff = G2_A + (tid >> 3) * 144 + (tid & 7) * 16, boff0 = G2_B + (tid >> 3) * 144 + (tid & 7) * 16, boff1 = boff0 + 64 * 144;
        f32x4 acc[4] = {{0.f, 0.f, 0.f, 0.f}, {0.f, 0.f, 0.f, 0.f}, {0.f, 0.f, 0.f, 0.f}, {0.f, 0.f, 0.f, 0.f}};
        u32x4 ra[4], rb0[4], rb1[4];
#pragma unroll
        for (int j = 0; j < 4; ++j) { ra[j] = *(const u32x4*)(asrc + 64 * j); rb0[j] = *(const u32x4*)(bsrc0 + 64 * j); rb1[j] = *(const u32x4*)(bsrc1 + 64 * j); }
        *(LAS u32x4*)(lds + aoff) = ra[0]; *(LAS u32x4*)(lds + boff0) = rb0[0]; *(LAS u32x4*)(lds + boff1) = rb1[0];
        ra[0] = *(const u32x4*)(asrc + 64 * 4); rb0[0] = *(const u32x4*)(bsrc0 + 64 * 4); rb1[0] = *(const u32x4*)(bsrc1 + 64 * 4);
        __syncthreads();
#pragma unroll 1
        for (int kt4 = 0; kt4 < 32; kt4 += 4) {
#pragma unroll
            for (int u = 0; u < 4; ++u) { const int kt = kt4 + u;
                const LAS unsigned char* cs = lds + (u & 1) * G2_SET; LAS unsigned char* ns = lds + ((u + 1) & 1) * G2_SET;
                if (kt == 16) { const float r = 1.0f / sqrtf(SUMSQ[r0 + 16 * (w >> 1) + (lane & 15)] * (1.0f / 1024.0f) + EPSF);
#pragma unroll
                    for (int t = 0; t < 4; ++t) acc[t] = acc[t] * r; }
#pragma unroll
                for (int ks = 0; ks < 2; ++ks) { const bf16x8 a = lds_frag(cs + G2_A, 144, 16 * (w >> 1), 32 * ks, lane);
#pragma unroll
                    for (int t = 0; t < 4; ++t) acc[t] = MFMA16T(a, lds_frag(cs + G2_B, 144, 64 * (w & 1) + 16 * t, 32 * ks, lane), acc[t]); }
                constexpr int dummy_ = 0; (void)dummy_;
                const int rs = (u + 1) & 3;
                if (kt + 1 < 32) { *(LAS u32x4*)(ns + aoff) = ra[rs]; *(LAS u32x4*)(ns + boff0) = rb0[rs]; *(LAS u32x4*)(ns + boff1) = rb1[rs]; }
                if (kt + 5 < 32) { ra[rs] = *(const u32x4*)(asrc + 64 * (kt + 5)); rb0[rs] = *(const u32x4*)(bsrc0 + 64 * (kt + 5)); rb1[rs] = *(const u32x4*)(bsrc1 + 64 * (kt + 5)); }
                __syncthreads();
            }
        }
        const int row = r0 + 16 * (w >> 1) + (lane & 15), cw = c0 + 64 * (w & 1) + 4 * g4;
        const float* xr = F.in[I_XS] + (size_t)(row - MP) * DM + cw; float* orow = F.out + (size_t)row * DM + cw;
#pragma unroll
        for (int t = 0; t < 4; ++t) *(f32x4*)(orow + 16 * t) = acc[t] + *(const f32x4*)(xr + 16 * t);
    }
}
__global__ void __launch_bounds__(512, 2) hymba_fwd(Args args) {
    extern __shared__ __attribute__((aligned(16))) unsigned char lds_raw[];
    cg::grid_group grid = cg::this_grid();
    Ctx F;
    F.lds = (LAS unsigned char*)lds_raw; F.tid = threadIdx.x; F.lane = F.tid & 63; F.wave = __builtin_amdgcn_readfirstlane(F.tid >> 6); F.G = gridDim.x; F.bid = blockIdx.x;
#pragma unroll
    for (int i = 0; i < 26; ++i) F.in[i] = args.in[i];
    F.out = args.out; F.ws = args.ws;
    volatile LAS unsigned* bst = (volatile LAS unsigned*)(F.lds + LDS_BYTES - 64);
    if (F.tid < 16) bst[F.tid] = 0u;
    __syncthreads();
    const XcdBarrier xbar = xcd_barrier_post((unsigned*)(F.ws + WS_CTL), bst);
#define GRID_BAR() xcd_barrier(xbar)

#define PHASE_FENCE() do { int t_ = threadIdx.x; asm volatile("" : "+v"(t_)); F.tid = t_; F.lane = t_ & 63; F.wave = __builtin_amdgcn_readfirstlane(t_ >> 6); } while (0)
    for (int rep = 0; rep < REP_P0; ++rep) { if (rep) __syncthreads(); p0_prologue(F); }
    grid.sync(); PHASE_FENCE();
    {
        pg8::Gemm g{(const bf16_t*)(F.ws + WS_A), (const bf16_t*)(F.ws + WS_BT), MA, NBT, 1024};
        Order1 S; S.init(F.G, F.bid);
        EpiProj E{(bf16_t*)(F.ws + WS_PROJ), (bf16_t*)(F.ws + WS_MEMRAW)};
        pg8::gemm_phase<EpiProj, Order1, true, true>(F.lds, g, S, E);
    }
    GRID_BAR(); PHASE_FENCE();
    for (int rep = 0; rep < REP_P2A; ++rep) p2a_phase(F);
    __syncthreads();
    p2a_attn(F);
    GRID_BAR(); PHASE_FENCE();
    p2b_phase(F);
    GRID_BAR(); PHASE_FENCE();
    gemm2_sample(F);
    {
        pg8::Gemm g{(const bf16_t*)(F.ws + WS_MIX), (const bf16_t*)(F.ws + WS_WOUT), MTOT, 1024, 2048};
        Order3 S; S.init(F.G, F.bid);
        EpiOut E{F.in[I_XP], F.in[I_XS], F.out, (const float*)(F.ws + WS_SSQ)};
        pg8::gemm_phase<EpiOut, Order3, true, true>(F.lds, g, S, E);
    }
#if DBG_SCALE3 || DBG_ZERO
    grid.sync();
    {
        const size_t offs[13] = {O_Y, (size_t)MP * 1024, O_WKP, O_WVP, O_SSMP, O_CONVP, O_MKP, O_MVP, O_WKS, O_WVS, O_SSMS, O_CONVS, O_END};
        for (int o = 0; o < 12; ++o) {
            const bool z = (DBG_ZERO >> o) & 1, s3 = (DBG_SCALE3 >> o) & 1;
            if (!z && !s3) continue;
            for (size_t i = offs[o] + (size_t)F.bid * 512 + F.tid; i < offs[o + 1]; i += (size_t)F.G * 512) F.out[i] = z ? 0.f : F.out[i] * 3.0f;
        }
    }
#endif
}

extern "C" void kernel_launch(void* const* d_in, const int* in_sizes, int n_in, void* d_out, int out_size, void* d_ws, size_t ws_size, hipStream_t stream) {
    static int grid = 0;
    if (grid == 0) {
        if (n_in != 26 || (size_t)out_size != O_END || ws_size < WS_END) { fprintf(stderr, "kernel_launch: unexpected problem (n_in %d out %d ws %zu)\n", n_in, out_size, ws_size); grid = -1; return; }
        int dev = 0, cus = 0, per_cu = 0;
        if (hipGetDevice(&dev) != hipSuccess || hipDeviceGetAttribute(&cus, hipDeviceAttributeMultiprocessorCount, dev) != hipSuccess) { grid = -1; return; }
        if (hipFuncSetAttribute((const void*)hymba_fwd, hipFuncAttributeMaxDynamicSharedMemorySize, LDS_BYTES) != hipSuccess) { fprintf(stderr, "kernel_launch: hipFuncSetAttribute failed\n"); grid = -1; return; }
        if (hipOccupancyMaxActiveBlocksPerMultiprocessor(&per_cu, (const void*)hymba_fwd, 512, LDS_BYTES) != hipSuccess || per_cu < 1) { fprintf(stderr, "kernel_launch: occupancy query says %d\n", per_cu); (void)hipGetLastError(); grid = -1; return; }
        grid = cus;
        fprintf(stderr, "kernel_launch: %d CUs, occupancy %d per CU, grid %d\n", cus, per_cu, grid);
    }
    if (grid < 0) return;
    Args a{};
    for (int i = 0; i < 26; ++i) a.in[i] = (const float*)d_in[i];
    a.out = (float*)d_out; a.ws = (unsigned char*)d_ws;
    if (hipMemsetAsync((char*)d_ws + WS_CTL, 0, CTL_ZERO_BYTES, stream) != hipSuccess) { fprintf(stderr, "kernel_launch: memset of the barrier words failed\n"); return; }
    void* kargs[] = {&a};
    const hipError_t e = hipLaunchCooperativeKernel((const void*)hymba_fwd, dim3(grid), dim3(512), kargs, LDS_BYTES, stream);
    if (e != hipSuccess) fprintf(stderr, "kernel_launch: cooperative launch failed: %s\n", hipGetErrorString(e));
}
```

```cpp
#include <hip/hip_runtime.h>
#include <hip/hip_cooperative_groups.h>
#include <cstdio>
#include <cstdint>
namespace cg = cooperative_groups;
namespace pg8 {
#define PG8_LAS __attribute__((address_space(3)))
typedef unsigned short bf16_t;
typedef short bf16x8 __attribute__((ext_vector_type(8)));
typedef float f32x4 __attribute__((ext_vector_type(4)));
typedef unsigned u32x4 __attribute__((ext_vector_type(4)));
constexpr int BM = 256, BK = 64, HALF = 128, HTB = HALF * BK * 2  , STAGE_BYTES = 8 * HTB, NXCD = 8, WGM = 8;

__host__ __device__ __forceinline__ int lds_byte(int r, int c) { const int st = (r >> 4) * 2 + (c >> 5), rr = r & 15, cc = c & 31, ob = rr * 64 + cc * 2; return st * 1024 + (ob ^ (((ob >> 9) & 1) << 5)); }
__host__ __device__ __forceinline__ void stage_rc(int b, int& R, int& C) { const int st = b / 1024, sb = b % 1024, swz = sb ^ (((sb >> 9) & 1) << 5); R = (st >> 1) * 16 + swz / 64; C = (st & 1) * 32 + (swz % 64) / 2; }
__host__ __device__ __forceinline__ int perm32(int rho) { const int n = rho >> 4, i = rho & 15; return 8 * (i >> 2) + 4 * n + (i & 3); }

struct Unit { int pm, pn; };
struct Gemm { const bf16_t* A; const bf16_t* Bt; int M, N, K; };

struct StaticOrder {
    int nM, nN, nwg, G, c;
    __host__ __device__ void init(int M, int N, int G_, int c_) { nM = M / BM; nN = N / BM; nwg = nM * nN; G = G_; c = c_; }
    __host__ __device__ bool next(int i, Unit& u) const {
        const long L = (long)i * G + c; if (L >= nwg) return false;
        int wgid = (int)L; { const int q = nwg / NXCD, r = nwg % NXCD, xcd = wgid % NXCD, off = wgid / NXCD; wgid = (xcd < r ? xcd * (q + 1) : r * (q + 1) + (xcd - r) * q) + off; }
        const int nig = WGM * nN, gid = wgid / nig, fm = gid * WGM, gsz = (nM - fm) < WGM ? (nM - fm) : WGM;
        u.pm = fm + ((wgid % nig) % gsz); u.pn = (wgid % nig) / gsz; return true;
    }
    __device__ __forceinline__ void a_ready(const Unit&) const {}
    __device__ __forceinline__ void done(const Unit&) const {}
};

template <class Epi, class Sched, bool ALIGN_EPI = false, bool SP2 = false>
__device__ __forceinline__ void gemm_phase(PG8_LAS unsigned char* lds, const Gemm g, const Sched& S, const Epi& E) {
    int tid_ = threadIdx.x; asm volatile("" : "+v"(tid_));
    const int tid = tid_, wid = __builtin_amdgcn_readfirstlane(tid >> 6), lane = tid & 63, wr = wid >> 2, wc = wid & 3, fr = lane & 15, fq = lane >> 4;
    const int K = g.K, nt = K / BK;
    unsigned voffA[2], voffB[2];
#pragma unroll
    for (int i = 0; i < 2; ++i) { int R, C; stage_rc(tid * 16 + i * 8192, R, C); const int Rb = Epi::PERM ? ((R & ~31) + perm32(R & 31)) : R;
        voffA[i] = (unsigned)(R * K + C) * 2u; voffB[i] = (unsigned)(Rb * K + C) * 2u; }
    const size_t kstep = (size_t)(BK * 2);
    const size_t hstep = (size_t)HALF * K * 2;
    const size_t tstep = 2 * hstep;
    const unsigned ldsw = (unsigned)wid * 1024u;
    const int aoff = lds_byte(wr * 64 + fr, fq * 8), boff = lds_byte(wc * 32 + fr, fq * 8);
#define PG8_SA(b, h) (((b) * 2 + (h)) * HTB)
#define PG8_SB(b, h) ((4 + (b) * 2 + (h)) * HTB)
#define PG8_STAGE(bufoff, gbase, voff) do { _Pragma("unroll") for (int _i = 0; _i < 2; ++_i) \
        __builtin_amdgcn_global_load_lds((const unsigned*)((const char*)(gbase) + (voff)[_i]), (PG8_LAS unsigned*)(lds + (bufoff) + ldsw + _i * 8192), 16, 0, 0); } while (0)
#define PG8_LDA(dst, b, h) do { _Pragma("unroll") for (int m = 0; m < 4; ++m) _Pragma("unroll") for (int k = 0; k < 2; ++k) dst[m][k] = *(const PG8_LAS bf16x8*)(lds + PG8_SA(b, h) + aoff + m * 2048 + k * 1024); } while (0)
#define PG8_LDB(dst, b, h) do { _Pragma("unroll") for (int n = 0; n < 2; ++n) _Pragma("unroll") for (int k = 0; k < 2; ++k) dst[n][k] = *(const PG8_LAS bf16x8*)(lds + PG8_SB(b, h) + boff + n * 2048 + k * 1024); } while (0)
#define PG8_MMA(ai, bj, At, Bt) do { __builtin_amdgcn_s_setprio(1); _Pragma("unroll") for (int m = 0; m < 4; ++m) _Pragma("unroll") for (int n = 0; n < 2; ++n) _Pragma("unroll") for (int k = 0; k < 2; ++k) \
        acc[ai][bj][m][n] = __builtin_amdgcn_mfma_f32_16x16x32_bf16(Bt[n][k], At[m][k], acc[ai][bj][m][n], 0, 0, 0); __builtin_amdgcn_s_setprio(0); } while (0)
#define PG8_WAIT_V(n) asm volatile("s_waitcnt vmcnt(" #n ")" ::: "memory")
#define PG8_WAIT_L(n) asm volatile("s_waitcnt lgkmcnt(" #n ")" ::: "memory")
#define PG8_BAR __builtin_amdgcn_s_barrier()
#define PG8_SCHED __builtin_amdgcn_sched_barrier(0)
    Unit cur, nxt; int ui = 0;
    if (!S.next(0, cur)) return;
    f32x4 acc[2][2][4][2];
#pragma unroll
    for (int a = 0; a < 2; ++a)
#pragma unroll
        for (int b = 0; b < 2; ++b)
#pragma unroll
            for (int m = 0; m < 4; ++m)
#pragma unroll
                for (int n = 0; n < 2; ++n) acc[a][b][m][n] = (f32x4){0.f, 0.f, 0.f, 0.f};
    bf16x8 At[4][2], B0[2][2], B1[2][2];
    const char* cA = (const char*)g.A + (size_t)cur.pm * tstep; const char* cB = (const char*)g.Bt + (size_t)cur.pn * tstep;
    S.a_ready(cur);
    if constexpr (SP2) {
        PG8_STAGE(PG8_SB(0, 0), cB, voffB); PG8_STAGE(PG8_SB(0, 1), cB + hstep, voffB); PG8_STAGE(PG8_SA(0, 0), cA, voffA); PG8_STAGE(PG8_SA(0, 1), cA + hstep, voffA);
        if (wr == 1) PG8_BAR;
        PG8_WAIT_V(2); PG8_BAR;
        PG8_STAGE(PG8_SB(1, 0), cB + kstep, voffB); PG8_STAGE(PG8_SA(1, 0), cA + kstep, voffA); PG8_STAGE(PG8_SB(1, 1), cB + hstep + kstep, voffB);
        PG8_WAIT_V(6); PG8_BAR;
    } else {
        PG8_STAGE(PG8_SB(0, 0), cB, voffB); PG8_STAGE(PG8_SA(0, 0), cA, voffA); PG8_STAGE(PG8_SB(0, 1), cB + hstep, voffB); PG8_STAGE(PG8_SA(0, 1), cA + hstep, voffA);
        if (wr == 1) PG8_BAR;
        PG8_WAIT_V(4); PG8_BAR;
        PG8_STAGE(PG8_SB(1, 0), cB + kstep, voffB); PG8_STAGE(PG8_SA(1, 0), cA + kstep, voffA); PG8_STAGE(PG8_SB(1, 1), cB + hstep + kstep, voffB);
        PG8_WAIT_V(6); PG8_BAR;
    }
    for (;;) {
        const bool has_next = S.next(ui + 1, nxt);
        const char* nA = has_next ? (const char*)g.A + (size_t)nxt.pm * tstep : cA; const char* nB = has_next ? (const char*)g.Bt + (size_t)nxt.pn * tstep : cB;
        for (int t = 0; t < nt; t += 2) {
            const bool last = (t == nt - 2);
            const char* a1 = cA + (size_t)(t + 1) * kstep;
            const char* a2 = last ? nA : cA + (size_t)(t + 2) * kstep; const char* b2 = last ? nB : cB + (size_t)(t + 2) * kstep;
            const char* a3 = a2 + kstep; const char* b3 = b2 + kstep;
            if (last && has_next) S.a_ready(nxt);
            if constexpr (Epi::MIDK > 0) { if (t == Epi::MIDK) E.mid(acc, cur, wr, wc, fr, fq); }
            if constexpr (SP2) {
            PG8_LDB(B0, 0, 0); PG8_LDB(B1, 0, 1); PG8_SCHED; PG8_LDA(At, 0, 0); PG8_STAGE(PG8_SA(1, 1), a1 + hstep, voffA);
            PG8_WAIT_V(8); PG8_WAIT_L(0); PG8_BAR; PG8_MMA(0, 0, At, B0); PG8_MMA(0, 1, At, B1); PG8_BAR; PG8_SCHED;
            PG8_LDA(At, 0, 1); PG8_STAGE(PG8_SB(0, 0), b2, voffB); PG8_STAGE(PG8_SB(0, 1), b2 + hstep, voffB); PG8_STAGE(PG8_SA(0, 0), a2, voffA);
            PG8_WAIT_V(8); PG8_WAIT_L(0); PG8_BAR; PG8_MMA(1, 0, At, B0); PG8_MMA(1, 1, At, B1); PG8_BAR; PG8_SCHED;
            PG8_LDB(B0, 1, 0); PG8_LDB(B1, 1, 1); PG8_SCHED; PG8_LDA(At, 1, 0); PG8_STAGE(PG8_SA(0, 1), a2 + hstep, voffA);
            PG8_WAIT_V(8); PG8_WAIT_L(0); PG8_BAR; PG8_MMA(0, 0, At, B0); PG8_MMA(0, 1, At, B1); PG8_BAR; PG8_SCHED;
            PG8_LDA(At, 1, 1); PG8_STAGE(PG8_SB(1, 0), b3, voffB); PG8_STAGE(PG8_SB(1, 1), b3 + hstep, voffB); PG8_STAGE(PG8_SA(1, 0), a3, voffA);
            PG8_WAIT_V(8); PG8_WAIT_L(0); PG8_BAR; PG8_MMA(1, 0, At, B0); PG8_MMA(1, 1, At, B1); PG8_BAR; PG8_SCHED;
            } else {
            PG8_LDB(B0, 0, 0); PG8_SCHED; PG8_LDA(At, 0, 0); PG8_STAGE(PG8_SA(1, 1), a1 + hstep, voffA);
            PG8_WAIT_L(8); PG8_BAR; PG8_WAIT_L(0); PG8_MMA(0, 0, At, B0); PG8_BAR; PG8_SCHED;
            PG8_LDB(B1, 0, 1); PG8_STAGE(PG8_SB(0, 0), b2, voffB);
            PG8_BAR; PG8_WAIT_L(0); PG8_MMA(0, 1, At, B1); PG8_BAR;
            PG8_LDA(At, 0, 1); PG8_STAGE(PG8_SA(0, 0), a2, voffA);
            PG8_BAR; PG8_WAIT_L(0); PG8_MMA(1, 0, At, B0); PG8_BAR; PG8_SCHED;
            PG8_STAGE(PG8_SB(0, 1), b2 + hstep, voffB);
            PG8_WAIT_V(6); PG8_BAR; PG8_MMA(1, 1, At, B1); PG8_BAR;
            PG8_LDB(B0, 1, 0); PG8_SCHED; PG8_LDA(At, 1, 0); PG8_STAGE(PG8_SA(0, 1), a2 + hstep, voffA);
            PG8_WAIT_L(8); PG8_BAR; PG8_WAIT_L(0); PG8_MMA(0, 0, At, B0); PG8_BAR; PG8_SCHED;
            PG8_LDB(B1, 1, 1); PG8_STAGE(PG8_SB(1, 0), b3, voffB);
            PG8_BAR; PG8_WAIT_L(0); PG8_MMA(0, 1, At, B1); PG8_BAR;
            PG8_LDA(At, 1, 1); PG8_STAGE(PG8_SA(1, 0), a3, voffA);
            PG8_BAR; PG8_WAIT_L(0); PG8_MMA(1, 0, At, B0); PG8_BAR; PG8_SCHED;
            PG8_STAGE(PG8_SB(1, 1), b3 + hstep, voffB);
            PG8_WAIT_V(6); PG8_BAR; PG8_MMA(1, 1, At, B1); PG8_BAR;
            }
        }
        if constexpr (ALIGN_EPI) { if (wr == 0) PG8_BAR; }
        if constexpr (!Epi::AFTER_DRAIN) { E(acc, cur, wr, wc, fr, fq); S.done(cur); }
        if (!has_next) break;
#pragma unroll
        for (int a = 0; a < 2; ++a)
#pragma unroll
            for (int b = 0; b < 2; ++b)
#pragma unroll
                for (int m = 0; m < 4; ++m)
#pragma unroll
                    for (int n = 0; n < 2; ++n) acc[a][b][m][n] = (f32x4){0.f, 0.f, 0.f, 0.f};
        cur = nxt; cA = nA; cB = nB; ++ui;
        if constexpr (ALIGN_EPI) { if (wr == 1) PG8_BAR; }
    }
    PG8_WAIT_V(0);
    if constexpr (!ALIGN_EPI) { if (wr == 0) PG8_BAR; }
    PG8_BAR;
    if constexpr (Epi::AFTER_DRAIN) { E.fused(acc, cur, wr, wc, fr, fq, lds, wid, lane); S.done(cur); }
#undef PG8_SA
#undef PG8_SB
#undef PG8_STAGE
#undef PG8_LDA
#undef PG8_LDB
#undef PG8_MMA
#undef PG8_WAIT_V
#undef PG8_WAIT_L
#undef PG8_BAR
#undef PG8_SCHED
}
}
#ifndef DBG_SCALE3
#define DBG_SCALE3 0
#endif
#ifndef DBG_ZERO
#define DBG_ZERO 0
#endif
#ifndef LAST_PHASE
#define LAST_PHASE 4
#endif
#ifndef REP_P0
#define REP_P0 1
#endif
#ifndef REP_P1
#define REP_P1 1
#endif
#ifndef REP_P2A
#define REP_P2A 1
#endif
#ifndef REP_P0T
#define REP_P0T 1
#endif
#ifndef REP_P0R
#define REP_P0R 1
#endif
#ifndef REP_S2
#define REP_S2 1
#endif
#ifndef REP_S3
#define REP_S3 1
#endif
#ifndef REP_S4
#define REP_S4 1
#endif
#ifndef REP_ATOM
#define REP_ATOM 1
#endif
#ifndef REP_SSD
#define REP_SSD 1
#endif
#ifndef REP_WIN
#define REP_WIN 1
#endif
#ifndef REP_MEM
#define REP_MEM 1
#endif
#ifndef REP_P3
#define REP_P3 1
#endif
#define DI __device__ __forceinline__
#define LAS __attribute__((address_space(3)))
typedef unsigned short bf16_t;
typedef short bf16x8 __attribute__((ext_vector_type(8)));
typedef float f32x4 __attribute__((ext_vector_type(4)));
typedef float f32x2 __attribute__((ext_vector_type(2)));
typedef unsigned u32x4 __attribute__((ext_vector_type(4)));
typedef unsigned u32x2 __attribute__((ext_vector_type(2)));

constexpr int NB_P = 16, T_P = 4096, NB_S = 32, T_S = 64, DM = 1024;
constexpr int MP = NB_P * T_P, MS = NB_S * T_S, MTOT = MP + MS;
constexpr int MMEM = NB_P * 256, MA = MTOT + MMEM;
constexpr int NPROJ = 4864, NBT = NPROJ + 1024, INC = 4880;
constexpr int C_Q = 0, C_K = 512, C_V = 640, C_GA = 768, C_Z = 1280, C_XBC = 2304, C_MQ = 3840, C_GM = 4352;
constexpr int NCHUNK = MTOT / 64;
constexpr float EPSF = 1e-6f;
constexpr size_t O_Y = 0;
constexpr size_t O_WKP = (size_t)MTOT * 1024;
constexpr size_t O_WVP = O_WKP + (size_t)NB_P * 128 * 128;
constexpr size_t O_SSMP = O_WVP + (size_t)NB_P * 128 * 128;
constexpr size_t O_CONVP = O_SSMP + (size_t)NB_P * 16 * 64 * 128;
constexpr size_t O_MKP = O_CONVP + (size_t)NB_P * 3 * 1536;
constexpr size_t O_MVP = O_MKP + (size_t)NB_P * 256 * 512;
constexpr size_t O_WKS = O_MVP + (size_t)NB_P * 256 * 512;
constexpr size_t O_WVS = O_WKS + (size_t)NB_S * 128 * 128;
constexpr size_t O_SSMS = O_WVS + (size_t)NB_S * 128 * 128;
constexpr size_t O_CONVS = O_SSMS + (size_t)NB_S * 16 * 64 * 128;
constexpr size_t O_END = O_CONVS + (size_t)NB_S * 3 * 1536;
static_assert(O_END == 81485824, "output size");
constexpr size_t MiB = 1u << 20;
constexpr size_t WS_ROPE = 1 * MiB;
constexpr size_t WS_BT = 2 * MiB;
constexpr size_t WS_WOUT = 14 * MiB;
constexpr size_t WS_DT = 18 * MiB;
constexpr size_t WS_SSQ = 23 * MiB;
constexpr size_t WS_CTL = 0, CTL_ZERO_BYTES = 65536;
constexpr size_t WS_MEMRAW = 32 * MiB;
constexpr size_t WS_MEMK = 40 * MiB;
constexpr size_t WS_MEMVT = 52 * MiB;
constexpr size_t WS_PROJ = 64 * MiB;
constexpr size_t WS_A = 692 * MiB;
constexpr size_t WS_MIX = 692 * MiB;
constexpr size_t WS_BCC = 956 * MiB;
constexpr size_t WS_END = 1022 * MiB;
static_assert(WS_BT + (size_t)NBT * 1024 * 2 <= WS_WOUT && WS_DT + (size_t)MTOT * 64 <= WS_SSQ && WS_SSQ + (size_t)MTOT * 128 <= WS_MEMRAW, "ws map 1");
static_assert(WS_PROJ + (size_t)MTOT * NPROJ * 2 <= WS_A && WS_A + (size_t)MA * 1024 * 2 <= WS_END && WS_MIX + (size_t)MTOT * 2048 * 2 <= WS_BCC && WS_BCC + (size_t)MTOT * 512 * 2 <= WS_END, "ws map 2");
constexpr int LDS_BYTES = 147456;

DI float bf2f(unsigned short b) { return __uint_as_float((unsigned)b << 16); }
typedef __bf16 hbf2 __attribute__((ext_vector_type(2)));
DI unsigned short f2bf(float f) { return __builtin_bit_cast(unsigned short, (__bf16)f); }
DI unsigned pk2(float lo, float hi) { const f32x2 v = {lo, hi}; return __builtin_bit_cast(unsigned, __builtin_convertvector(v, hbf2)); }
DI unsigned cvt_pk_bf16(float lo, float hi) { return pk2(lo, hi); }
DI float siluf(float x) { return x * __builtin_amdgcn_rcpf(1.0f + __expf(-x)); }
DI float wave_sum(float v) {
#pragma unroll
    for (int o = 1; o < 64; o <<= 1) v += __shfl_xor(v, o);
    return v;
}
DI void unpack8(const u32x4 v, float (&o)[8]) {
#pragma unroll
    for (int i = 0; i < 4; ++i) { o[2 * i] = __uint_as_float(v[i] << 16); o[2 * i + 1] = __uint_as_float(v[i] & 0xffff0000u); }
}
DI u32x4 pack8(const float (&o)[8]) { u32x4 v; v.x = pk2(o[0], o[1]); v.y = pk2(o[2], o[3]); v.z = pk2(o[4], o[5]); v.w = pk2(o[6], o[7]); return v; }
#define LDS_WAIT() asm volatile("s_waitcnt lgkmcnt(0)" ::: "memory")
#define MFMA16(a, b, c) __builtin_amdgcn_mfma_f32_16x16x32_bf16((a), (b), (c), 0, 0, 0)

struct Args { const float* in[26]; float* out; unsigned char* ws; };
struct Ctx {
    LAS unsigned char* lds; int tid, lane, wave, G, bid;
    const float* in[26]; float* out; unsigned char* ws;
};
#define RLX_AGENT __ATOMIC_RELAXED, __HIP_MEMORY_SCOPE_AGENT
#define XB_TMO      128
#define XB_XCNT(j)  (256  + 64 * (j))
#define XB_XSUB(j)  (1280 + 64 * (j))
#define XB_XGEN(j)  (2304 + 64 * (j))
#define XB_TOP      3328
#define XB_TOPGEN   3392
#define XCD_BAR_WORDS 3456
#define XB_SPIN_CAP (1u << 18)

__device__ __forceinline__ unsigned xb_ld(unsigned* p)              { return __hip_atomic_load(p, __ATOMIC_RELAXED, __HIP_MEMORY_SCOPE_AGENT); }
__device__ __forceinline__ unsigned xb_add(unsigned* p, unsigned v) { return __hip_atomic_fetch_add(p, v, __ATOMIC_RELAXED, __HIP_MEMORY_SCOPE_AGENT); }
__device__ __forceinline__ unsigned xb_xcc_id() { return (unsigned)__builtin_amdgcn_s_getreg((3 << 11) | 20) & 0xFu; }
#define XB_SPIN(cond, bar) do { unsigned _sp = 0; while (cond) { __builtin_amdgcn_s_sleep(1); \
    if ((++_sp & 255u) == 0u) { if (xb_ld(&(bar)[XB_TMO])) break; if (_sp > XB_SPIN_CAP) { atomicAdd(&(bar)[XB_TMO], 1u); break; } } } } while (0)

struct XcdBarrier {
    unsigned* bar; unsigned x;
    volatile LAS unsigned* st;
};

__device__ __forceinline__ XcdBarrier xcd_barrier_post(unsigned* bar, volatile LAS unsigned* st) {
    XcdBarrier b; b.bar = bar; b.x = xb_xcc_id(); b.st = st;
    if (threadIdx.x == 0) (void)xb_add(&bar[XB_XCNT(b.x)], 1u);
    return b;
}
__device__ __forceinline__ void xcd_barrier_complete(unsigned* bar, unsigned x, unsigned& nloc, unsigned& nx) {
    const unsigned G = gridDim.x * gridDim.y * gridDim.z;
    unsigned sum, cnt, mine, sp = 0u;
    for (;;) {
        sum = 0u; cnt = 0u; mine = 0u;
#pragma unroll
        for (unsigned j = 0; j < 16; ++j) { const unsigned c = xb_ld(&bar[XB_XCNT(j)]); sum += c; cnt += (c > 0u) ? 1u : 0u; mine = (j == x) ? c : mine; }
        if (sum == G) break;
        __builtin_amdgcn_s_sleep(1);
        if ((++sp & 255u) == 0u) { if (xb_ld(&bar[XB_TMO])) break; if (sp > XB_SPIN_CAP) { atomicAdd(&bar[XB_TMO], 1u); break; } }
    }
    nloc = mine > 0u ? mine : 1u; nx = cnt > 0u ? cnt : 1u;
}

__device__ __forceinline__ void xcd_barrier(const XcdBarrier& b) {
    asm volatile("s_waitcnt vmcnt(0)" ::: "memory");
    __syncthreads();
    if (threadIdx.x == 0) {
        unsigned* bar = b.bar;
        __builtin_amdgcn_s_waitcnt(0);
        unsigned nloc = b.st[0], nx = b.st[1];
        if (nloc == 0u) { xcd_barrier_complete(bar, b.x, nloc, nx); b.st[0] = nloc; b.st[1] = nx; }
        const unsigned old = xb_add(&bar[XB_XSUB(b.x)], 1u);
        const unsigned gen = old / nloc;
        if (old + 1u == (gen + 1u) * nloc) {
            __builtin_amdgcn_fence(__ATOMIC_RELEASE, "agent");
            asm volatile("s_waitcnt vmcnt(0)" ::: "memory");
            const unsigned og = xb_add(&bar[XB_TOP], 1u);
            const unsigned tg = og / nx;
            if (og + 1u == (tg + 1u) * nx) xb_add(&bar[XB_TOPGEN], 1u);
            else XB_SPIN(xb_ld(&bar[XB_TOPGEN]) == tg, bar);
            __builtin_amdgcn_fence(__ATOMIC_ACQUIRE, "agent");
            xb_add(&bar[XB_XGEN(b.x)], 1u);
            asm volatile("s_waitcnt vmcnt(0)" ::: "memory");
        } else {
            XB_SPIN(xb_ld(&bar[XB_XGEN(b.x)]) == gen, bar);
            __builtin_amdgcn_fence(__ATOMIC_ACQUIRE, "agent");
            asm volatile("s_waitcnt vmcnt(0)" ::: "memory");
        }
    }
    __syncthreads();
}

enum { I_XP = 0, I_XS, I_CWK, I_CWV, I_SSM, I_SCONV, I_CMK, I_CMV, I_MEM, I_GNORM, I_WIN, I_GQ, I_GK, I_SINKS, I_CONVW, I_CONVB, I_DTB, I_ALOG, I_DSKIP, I_GSSD, I_GMEM, I_WMK, I_WMV, I_GMK, I_GMQ, I_WOUT };

DI void p0_transpose_item(const float* W, int ldw, int src_k0, int src_n0, const float* rowscale, bf16_t* WT, int ldt, int dst_n0, int dst_k0, LAS float* scr, int lane) {
#pragma unroll 8
    for (int i = 0; i < 32; ++i) { const int kk = 2 * i + (lane >> 5); float v = W[(size_t)(src_k0 + kk) * ldw + src_n0 + (lane & 31)]; if (rowscale) v *= rowscale[kk]; scr[kk * 33 + (lane & 31)] = v; }
    LDS_WAIT();
    const int c = lane & 7;
#pragma unroll
    for (int j = 0; j < 4; ++j) { const int n = (lane >> 3) + 8 * j; const LAS float* s = scr + (8 * c) * 33 + n;
        u32x4 o; o.x = pk2(s[0 * 33], s[1 * 33]); o.y = pk2(s[2 * 33], s[3 * 33]); o.z = pk2(s[4 * 33], s[5 * 33]); o.w = pk2(s[6 * 33], s[7 * 33]);
        *(u32x4*)(WT + (size_t)(dst_n0 + n) * ldt + dst_k0 + 8 * c) = o; }
    LDS_WAIT();
}

DI float reduce16_to_lane(float (&a)[16], int lane) {
#pragma unroll
    for (int j = 0; j < 16; ++j) { a[j] += __shfl_xor(a[j], 32); a[j] += __shfl_xor(a[j], 16); }
    float r8[8], r4[4], r2[2];
    const bool b3 = (lane & 8) != 0, b2 = (lane & 4) != 0, b1 = (lane & 2) != 0, b0 = (lane & 1) != 0;
#pragma unroll
    for (int j = 0; j < 8; ++j) { const float snd = b3 ? a[j] : a[j + 8], kp = b3 ? a[j + 8] : a[j]; r8[j] = kp + __shfl_xor(snd, 8); }
#pragma unroll
    for (int j = 0; j < 4; ++j) { const float snd = b2 ? r8[j] : r8[j + 4], kp = b2 ? r8[j + 4] : r8[j]; r4[j] = kp + __shfl_xor(snd, 4); }
#pragma unroll
    for (int j = 0; j < 2; ++j) { const float snd = b1 ? r4[j] : r4[j + 2], kp = b1 ? r4[j + 2] : r4[j]; r2[j] = kp + __shfl_xor(snd, 2); }
    const float snd = b0 ? r2[0] : r2[1], kp = b0 ? r2[1] : r2[0];
    return kp + __shfl_xor(snd, 1);
}

DI void p0_rows2(f32x4 (&va)[4], f32x4 (&vb)[4], const float* g, bf16_t* oa, bf16_t* ob, float* dta, float* dtb, bool want_dt, const float* dt_bias, const LAS float* wdt, int lane) {
    float sa = 0.f, sb = 0.f;
#pragma unroll
    for (int jj = 0; jj < 4; ++jj) { sa += (va[jj].x * va[jj].x + va[jj].y * va[jj].y) + (va[jj].z * va[jj].z + va[jj].w * va[jj].w); sb += (vb[jj].x * vb[jj].x + vb[jj].y * vb[jj].y) + (vb[jj].z * vb[jj].z + vb[jj].w * vb[jj].w); }
    const float ra = 1.0f / sqrtf(wave_sum(sa) * (1.0f / DM) + EPSF), rb = 1.0f / sqrtf(wave_sum(sb) * (1.0f / DM) + EPSF);
    u32x2* pa = (u32x2*)oa + lane; u32x2* pb = (u32x2*)ob + lane;
#pragma unroll
    for (int jj = 0; jj < 4; ++jj) { const f32x4 gv = ((const f32x4*)g)[64 * jj + lane]; va[jj] = va[jj] * ra * gv; vb[jj] = vb[jj] * rb * gv;
        u32x2 w; w.x = pk2(va[jj].x, va[jj].y); w.y = pk2(va[jj].z, va[jj].w); pa[64 * jj] = w; w.x = pk2(vb[jj].x, vb[jj].y); w.y = pk2(vb[jj].z, vb[jj].w); pb[64 * jj] = w; }
    if (want_dt) {
        f32x2 ab[16];
#pragma unroll
        for (int j = 0; j < 16; ++j) ab[j] = (f32x2){0.f, 0.f};
#pragma unroll
        for (int jj = 0; jj < 4; ++jj)
#pragma unroll
            for (int e = 0; e < 4; ++e) { const f32x2 hab = {va[jj][e], vb[jj][e]}; const LAS f32x4* wr = (const LAS f32x4*)(wdt + ((jj * 4 + e) * 64 + lane) * 20);
#pragma unroll
                for (int q = 0; q < 4; ++q) { const f32x4 w4 = wr[q];
                    ab[4 * q] += hab * w4.x; ab[4 * q + 1] += hab * w4.y; ab[4 * q + 2] += hab * w4.z; ab[4 * q + 3] += hab * w4.w; }
                if (e & 1) __builtin_amdgcn_sched_barrier(0); }
        float a[16], b[16];
#pragma unroll
        for (int j = 0; j < 16; ++j) { a[j] = ab[j].x; b[j] = ab[j].y; }
        const bool b5 = (lane & 32) != 0, b4 = (lane & 16) != 0, b3 = (lane & 8) != 0, b2 = (lane & 4) != 0, b1 = (lane & 2) != 0;
        float v16[16], v8[8], v4[4], v2[2];
#pragma unroll
        for (int j = 0; j < 16; ++j) { const float snd = b5 ? a[j] : b[j], kp = b5 ? b[j] : a[j]; v16[j] = kp + __shfl_xor(snd, 32); }
#pragma unroll
        for (int j = 0; j < 8; ++j) { const float snd = b4 ? v16[j] : v16[j + 8], kp = b4 ? v16[j + 8] : v16[j]; v8[j] = kp + __shfl_xor(snd, 16); }
#pragma unroll
        for (int j = 0; j < 4; ++j) { const float snd = b3 ? v8[j] : v8[j + 4], kp = b3 ? v8[j + 4] : v8[j]; v4[j] = kp + __shfl_xor(snd, 8); }
#pragma unroll
        for (int j = 0; j < 2; ++j) { const float snd = b2 ? v4[j] : v4[j + 2], kp = b2 ? v4[j + 2] : v4[j]; v2[j] = kp + __shfl_xor(snd, 4); }
        float tot; { const float snd = b1 ? v2[0] : v2[1], kp = b1 ? v2[1] : v2[0]; tot = kp + __shfl_xor(snd, 2); }
        tot += __shfl_xor(tot, 1);
        if ((lane & 1) == 0) { const int j = (lane >> 1) & 15; const float xv = tot + dt_bias[j]; float* dp = b5 ? dtb : dta;
            dp[j] = fmaxf(xv, 0.f) + log1pf(__expf(-fabsf(xv))); }
    }
}

DI void p0_row_segment(Ctx& F, const float* src, const float* g, int m0, int npair, bool tok, bf16_t* A, float* DT, const LAS float* wdt, int gw, int NGW) {
    const int lane = F.lane;
    f32x4 n0a[4], n0b[4], n1a[4], n1b[4];
#define P0_LOAD(dst_a, dst_b, pp) do { if ((pp) < npair) { _Pragma("unroll") for (int jj = 0; jj < 4; ++jj) { \
        dst_a[jj] = ((const f32x4*)(src + (size_t)(2 * (pp)) * DM))[64 * jj + lane]; dst_b[jj] = ((const f32x4*)(src + (size_t)(2 * (pp) + 1) * DM))[64 * jj + lane]; } } } while (0)
    P0_LOAD(n0a, n0b, gw); P0_LOAD(n1a, n1b, gw + NGW);
    for (int p = gw; p < npair; p += NGW) {
        f32x4 va[4], vb[4];
#pragma unroll
        for (int jj = 0; jj < 4; ++jj) { va[jj] = n0a[jj]; vb[jj] = n0b[jj]; n0a[jj] = n1a[jj]; n0b[jj] = n1b[jj]; }
        P0_LOAD(n1a, n1b, p + 2 * NGW);
        const int m = m0 + 2 * p;
        p0_rows2(va, vb, g, A + (size_t)m * DM, A + (size_t)(m + 1) * DM, DT + (size_t)(tok ? m : 0) * 16, DT + (size_t)(tok ? m + 1 : 0) * 16, tok, F.in[I_DTB], wdt, lane);
    }
#undef P0_LOAD
}

DI void p0_prologue(Ctx& F) {
    const int gw = F.bid * 8 + F.wave, NGW = F.G * 8, lane = F.lane;
    bf16_t* BT = (bf16_t*)(F.ws + WS_BT); bf16_t* WOT = (bf16_t*)(F.ws + WS_WOUT);
    for (int rep_ = 0; rep_ < REP_P0T; ++rep_) {
        LAS float* scr = (LAS float*)(F.lds + F.wave * 16384);
        constexpr int I_IN = 16 * (NPROJ / 32), I_M = 16 * 32, I_O = 32 * 32;
        for (int it = gw; it < I_IN + I_M + I_O; it += NGW) {
            int r = it;
            if (r < I_IN) { const int kb = r / (NPROJ / 32), nb = r % (NPROJ / 32); const int n0 = 32 * nb;
                p0_transpose_item(F.in[I_WIN], INC, 64 * kb, n0 + (n0 >= 3840 ? 16 : 0), nullptr, BT, 1024, n0, 64 * kb, scr, lane); continue; }
            r -= I_IN;
            if (r < I_M) { const int kb = r / 32, nb = r % 32;
                p0_transpose_item(nb < 16 ? F.in[I_WMK] : F.in[I_WMV], 512, 64 * kb, 32 * (nb & 15), nullptr, BT, 1024, NPROJ + 32 * nb, 64 * kb, scr, lane); continue; }
            r -= I_M;
            { const int kb = r / 32, nb = r % 32; const int k0 = 64 * kb;
              const int sk0 = k0 < 1024 ? 512 + k0 : (k0 < 1536 ? k0 - 1024 : k0);
              p0_transpose_item(F.in[I_WOUT], 1024, sk0, 32 * nb, k0 < 1024 ? F.in[I_GSSD] + k0 : nullptr, WOT, 2048, 32 * nb, k0, scr, lane); }
        }
    }
    { float* sq = (float*)(F.ws + WS_SSQ); for (int i = F.bid * 512 + F.tid; i < MTOT; i += F.G * 512) sq[i] = 0.f; }
    {
        f32x2* rope = (f32x2*)(F.ws + WS_ROPE);
        for (int i = F.bid * 512 + F.tid; i < 4096 * 32; i += F.G * 512) {
            const int pos = i >> 5, fi = i & 31;
            const float freq = exp2f(-(float)fi * (13.287712379549449f / 32.0f));
            double rev = (double)pos * (double)freq * 0.15915494309189535;
            rev -= __builtin_rint(rev);
            const float ang = (float)(rev * 6.283185307179586);
            rope[i] = (f32x2){cosf(ang), sinf(ang)};
        }
    }
    __syncthreads();
    for (int rep_ = 0; rep_ < REP_P0R; ++rep_) {
        if (rep_) __syncthreads();
        LAS float* wdt = (LAS float*)F.lds;
#pragma unroll 1
        for (int i0 = F.tid; i0 < 1024 * 16; i0 += 512 * 8) { float t8[8];
#pragma unroll
            for (int u = 0; u < 8; ++u) { const int i = i0 + 512 * u; t8[u] = F.in[I_WIN][(size_t)(i >> 4) * INC + 3840 + (i & 15)]; }
#pragma unroll
            for (int u = 0; u < 8; ++u) { const int i = i0 + 512 * u, k = i >> 4, j = i & 15; const int jj = k >> 8, e = k & 3, l = (k >> 2) & 63;
                wdt[((jj * 4 + e) * 64 + l) * 20 + j] = t8[u]; } }
        __syncthreads();
        bf16_t* A = (bf16_t*)(F.ws + WS_A); float* DT = (float*)(F.ws + WS_DT);
        p0_row_segment(F, F.in[I_XP], F.in[I_GNORM], 0, MP / 2, true, A, DT, wdt, gw, NGW);
        p0_row_segment(F, F.in[I_XS], F.in[I_GNORM], MP, MS / 2, true, A, DT, wdt, gw, NGW);
        p0_row_segment(F, F.in[I_MEM], F.in[I_GMEM], MTOT, MMEM / 2, false, A, DT, wdt, gw, NGW);
    }
}
struct Order1 {
    pg8::StaticOrder so; int G, c;
    __device__ void init(int G_, int c_) { so.init(MTOT, NPROJ, G_, c_); G = G_; c = c_; }
    __device__ bool next(int i, pg8::Unit& u) const {
        long L = (long)i * G + c;
        if (L >= (long)REP_P1 * (so.nwg + 64)) return false;
        L %= (so.nwg + 64);
        if (L < so.nwg) { pg8::StaticOrder t = so; t.G = 1; t.c = 0; return t.next((int)L, u); }
        const int r = (int)(L - so.nwg);
        u.pm = MTOT / 256 + (r >> 2); u.pn = NPROJ / 256 + (r & 3); return true;
    }
    __device__ __forceinline__ void a_ready(const pg8::Unit&) const {}
    __device__ __forceinline__ void done(const pg8::Unit&) const {}
};
struct Order3 {
    pg8::StaticOrder so; int G, c;
    __device__ void init(int G_, int c_) { so.init(MP, 1024, 1, 0); G = G_; c = c_; }
    __device__ bool next(int i, pg8::Unit& u) const {
        long L = (long)i * G + c;
        if (L >= (long)REP_P3 * so.nwg) return false;
        return so.next((int)(L % so.nwg), u);
    }
    __device__ __forceinline__ void a_ready(const pg8::Unit&) const {}
    __device__ __forceinline__ void done(const pg8::Unit&) const {}
};
struct EpiProj {
    static constexpr bool PERM = true, AFTER_DRAIN = false; static constexpr int MIDK = 0;
    bf16_t* proj; bf16_t* memraw;
    __device__ __forceinline__ void operator()(const f32x4 (&acc)[2][2][4][2], const pg8::Unit& u, int wr, int wc, int fr, int fq) const {
        bf16_t* base; int ldc, row0, col0;
        if (u.pn < NPROJ / 256) { base = proj; ldc = NPROJ; row0 = u.pm * 256; col0 = u.pn * 256; }
        else { base = memraw; ldc = 1024; row0 = (u.pm - MTOT / 256) * 256; col0 = (u.pn - NPROJ / 256) * 256; }
        row0 += wr * 64 + fr; col0 += wc * 32 + 8 * fq;
#pragma unroll
        for (int ai = 0; ai < 2; ++ai)
#pragma unroll
            for (int m = 0; m < 4; ++m) { bf16_t* rowp = base + (size_t)(row0 + ai * 128 + m * 16) * ldc + col0;
#pragma unroll
                for (int bj = 0; bj < 2; ++bj) { const f32x4 v0 = acc[ai][bj][m][0], v1 = acc[ai][bj][m][1];
                    u32x4 w; w.x = cvt_pk_bf16(v0[0], v0[1]); w.y = cvt_pk_bf16(v0[2], v0[3]); w.z = cvt_pk_bf16(v1[0], v1[1]); w.w = cvt_pk_bf16(v1[2], v1[3]);
                    *(u32x4*)(rowp + bj * 128) = w; } }
    }
};
struct EpiOut {
    static constexpr bool PERM = false, AFTER_DRAIN = false; static constexpr int MIDK = 16;
    const float* xp; const float* xs; float* out; const float* sumsq;
    __device__ __forceinline__ void mid(f32x4 (&acc)[2][2][4][2], const pg8::Unit& u, int wr, int wc, int fr, int fq) const {
        const float* sq = sumsq + (size_t)u.pm * 256 + wr * 64 + fr;
#pragma unroll
        for (int ai = 0; ai < 2; ++ai)
#pragma unroll
            for (int m = 0; m < 4; ++m) { const float r = 1.0f / sqrtf(sq[ai * 128 + m * 16] * (1.0f / 1024.0f) + EPSF);
#pragma unroll
                for (int bj = 0; bj < 2; ++bj)
#pragma unroll
                    for (int n = 0; n < 2; ++n) acc[ai][bj][m][n] = acc[ai][bj][m][n] * r; }
    }
    __device__ __forceinline__ void operator()(const f32x4 (&acc)[2][2][4][2], const pg8::Unit& u, int wr, int wc, int fr, int fq) const {
        const float* xb = u.pm < MP / 256 ? xp + (size_t)u.pm * 256 * DM : xs + (size_t)(u.pm - MP / 256) * 256 * DM;
        float* ob = out + (size_t)u.pm * 256 * DM;
        const int rl0 = wr * 64 + fr, col0 = u.pn * 256 + wc * 32 + 4 * fq;
#pragma unroll
        for (int ai = 0; ai < 2; ++ai) {
            f32x4 xv[4][2][2];
#pragma unroll
            for (int m = 0; m < 4; ++m)
#pragma unroll
                for (int bj = 0; bj < 2; ++bj)
#pragma unroll
                    for (int n = 0; n < 2; ++n) xv[m][bj][n] = *(const f32x4*)(xb + (size_t)(rl0 + ai * 128 + m * 16) * DM + col0 + bj * 128 + n * 16);
#pragma unroll
            for (int m = 0; m < 4; ++m)
#pragma unroll
                for (int bj = 0; bj < 2; ++bj)
#pragma unroll
                    for (int n = 0; n < 2; ++n) *(f32x4*)(ob + (size_t)(rl0 + ai * 128 + m * 16) * DM + col0 + bj * 128 + n * 16) = acc[ai][bj][m][n] + xv[m][bj][n];
            asm volatile("" ::: "memory"); }
    }
};

constexpr int SS_X = 0, SS_XD = 9216, SS_BM = 18432, SS_CM = 35840, SS_SET = 53248;
constexpr int SS_SB = 2 * SS_SET, SS_WM = SS_SB + 17408, SS_SM = SS_WM + 9216;
constexpr int LD64 = 144, LD128 = 272;
typedef short s16x4 __attribute__((ext_vector_type(4)));

DI bf16x8 lds_frag(const LAS unsigned char* tile, int ld, int row0, int k0, int lane) {
    return *(const LAS bf16x8*)(tile + (row0 + (lane & 15)) * ld + (k0 + 8 * (lane >> 4)) * 2);
}
DI bf16x8 lds_frag_tr(const LAS unsigned char* tile, int ld, int k0, int c0, int lane) {
    const LAS unsigned char* a = tile + (k0 + 8 * (lane >> 4) + ((lane & 15) >> 2)) * ld + (c0 + 4 * (lane & 3)) * 2;
    const s16x4 lo = __builtin_amdgcn_ds_read_tr16_b64_v4i16((LAS s16x4*)a), hi = __builtin_amdgcn_ds_read_tr16_b64_v4i16((LAS s16x4*)(a + 4 * ld));
    return (bf16x8){lo.x, lo.y, lo.z, lo.w, hi.x, hi.y, hi.z, hi.w};
}
DI bf16x8 lds_frag_tr2(const LAS unsigned char* tile, int ld, int k0, int c0, int lane) {
    const LAS unsigned char* a = tile + (k0 + 4 * (lane >> 4) + ((lane & 15) >> 2)) * ld + (c0 + 4 * (lane & 3)) * 2;
    const s16x4 lo = __builtin_amdgcn_ds_read_tr16_b64_v4i16((LAS s16x4*)a), hi = __builtin_amdgcn_ds_read_tr16_b64_v4i16((LAS s16x4*)(a + 16 * ld));
    return (bf16x8){lo.x, lo.y, lo.z, lo.w, hi.x, hi.y, hi.z, hi.w};
}
#define MFMA16T(rowsfrag, colsfrag, acc) MFMA16((colsfrag), (rowsfrag), (acc))

#define DPP_ADD_(v, ctrl, rmask) ((v) + __builtin_bit_cast(float, __builtin_amdgcn_update_dpp(0, __builtin_bit_cast(int, (v)), (ctrl), (rmask), 0xf, false)))
DI float wave_incl_scan(float v) {
    v = DPP_ADD_(v, 0x111, 0xf); v = DPP_ADD_(v, 0x112, 0xf); v = DPP_ADD_(v, 0x114, 0xf); v = DPP_ADD_(v, 0x118, 0xf);
    v = DPP_ADD_(v, 0x142, 0xa);
    v = DPP_ADD_(v, 0x143, 0xc);
    return v;
}
DI void convbc_prepass(Ctx& F) {
    const int gw = F.bid * 8 + F.wave, NGW = F.G * 8, lane = F.lane;
    const bf16_t* PROJ = (const bf16_t*)(F.ws + WS_PROJ); bf16_t* BCC = (bf16_t*)(F.ws + WS_BCC);
    const int ch0 = 1024 + lane * 8;
    float wv[4][8], bv[8];
#pragma unroll
    for (int e = 0; e < 8; ++e) { bv[e] = F.in[I_CONVB][ch0 + e];
#pragma unroll
        for (int j = 0; j < 4; ++j) wv[j][e] = F.in[I_CONVW][j * 1536 + ch0 + e]; }
    const bool bal = (F.G == 256);
    const int nmine = bal ? (F.bid < 64 ? 0 : (F.bid < 128 ? 2 : 1)) : (MTOT / 33 - gw + NGW - 1) / NGW;
    for (int ti = 0; ti < nmine; ++ti) {
        const int t = bal ? (F.bid < 128 ? ((F.bid - 64) * 8 + F.wave) * 2 + ti : 1024 + (F.bid - 128) * 8 + F.wave) : gw + ti * NGW;
        const int row0 = t * 33;
        float h0[8], h1[8], h2[8];
        { const bool smp0 = row0 >= MP; const int lrow0 = smp0 ? (row0 - MP) & 63 : row0 & (T_P - 1);
          const float* sc0 = F.in[I_SCONV] + (size_t)(smp0 ? (row0 - MP) >> 6 : 0) * 3 * 1536 + ch0;
#define CONV_HALO(dst, j) do { const int lr_ = lrow0 - 3 + (j); \
              if (lr_ >= 0) unpack8(*(const u32x4*)(PROJ + (size_t)(row0 - 3 + (j)) * NPROJ + C_XBC + ch0), dst); \
              else { _Pragma("unroll") for (int e = 0; e < 8; ++e) dst[e] = smp0 ? sc0[(3 + lr_) * 1536 + e] : 0.f; } } while (0)
          CONV_HALO(h0, 0); CONV_HALO(h1, 1); CONV_HALO(h2, 2);
#undef CONV_HALO
        }
#pragma unroll 1
        for (int bt = 0; bt < 3; ++bt) {
            u32x4 raw[11];
#pragma unroll
            for (int i = 0; i < 11; ++i) raw[i] = *(const u32x4*)(PROJ + (size_t)(row0 + 11 * bt + i) * NPROJ + C_XBC + ch0);
#pragma unroll
            for (int i = 0; i < 11; ++i) { const int row = row0 + 11 * bt + i;
                const bool smp = row >= MP; const int lrow = smp ? (row - MP) & 63 : row & (T_P - 1);
                if (lrow == 0) {
                    if (smp) { const float* sc = F.in[I_SCONV] + (size_t)((row - MP) >> 6) * 3 * 1536 + ch0;
#pragma unroll
                        for (int e = 0; e < 8; ++e) { h0[e] = sc[e]; h1[e] = sc[1536 + e]; h2[e] = sc[2 * 1536 + e]; } }
                    else {
#pragma unroll
                        for (int e = 0; e < 8; ++e) { h0[e] = 0.f; h1[e] = 0.f; h2[e] = 0.f; } } }
                float cur[8], o[8];
                unpack8(raw[i], cur);
#pragma unroll
                for (int e = 0; e < 8; ++e) { o[e] = siluf(bv[e] + wv[0][e] * h0[e] + wv[1][e] * h1[e] + wv[2][e] * h2[e] + wv[3][e] * cur[e]); h0[e] = h1[e]; h1[e] = h2[e]; h2[e] = cur[e]; }
                *(u32x4*)(BCC + (size_t)row * 512 + lane * 8) = pack8(o); }
        }
    }
}

DI void ssd_item(Ctx& F, int sq, int h, bool do_sumsq) {
    LAS unsigned char* lds = F.lds;
    const int tid = F.tid, lane = F.lane, w = F.wave, g = h >> 3;
    const bool smp = sq >= NB_P; const int sb = sq - NB_P;
    const int row_base = smp ? MP + sb * 64 : sq * T_P, nchunks = smp ? 1 : 64;
    const bf16_t* PROJ = (const bf16_t*)(F.ws + WS_PROJ); const bf16_t* BCC = (const bf16_t*)(F.ws + WS_BCC); const float* DT = (const float*)(F.ws + WS_DT);
    bf16_t* MIX = (bf16_t*)(F.ws + WS_MIX); float* SUMSQ = (float*)(F.ws + WS_SSQ);
    const float a_h = -__expf(F.in[I_ALOG][h]), d_h = F.in[I_DSKIP][h];
    const int pt = w >> 1, nh = w & 1, lt = w >> 1;
    const int xl = tid >> 3, xg = tid & 7, chx = h * 64 + 8 * xg;
    LAS float* sm_cw0 = (LAS float*)(lds + SS_SM + 1024 + 768);
    if (tid >= 192 && tid < 512) { const int i = tid - 192; const int j = i >> 6, chn = h * 64 + (i & 63); sm_cw0[i] = j < 4 ? F.in[I_CONVW][j * 1536 + chn] : F.in[I_CONVB][chn]; }
    f32x4 st[4];
#pragma unroll
    for (int q = 0; q < 4; ++q) {
        if (smp) st[q] = *(const f32x4*)(F.in[I_SSM] + ((size_t)(sb * 16 + h) * 64 + 16 * pt + (lane & 15)) * 128 + 16 * (4 * nh + q) + 4 * (lane >> 4));
        else st[q] = (f32x4){0.f, 0.f, 0.f, 0.f};
    }
    u32x4 px0[4], px1[4], pbs[2], pcs[2]; u32x2 pz0[2], pz1[2]; float pdt0, pdt1;
#define SSD_ISSUE_X(c_, PX_) do { const int row0_ = row_base + 64 * (c_); \
        _Pragma("unroll") for (int j_ = 0; j_ < 4; ++j_) { int rr_ = xl - 3 + j_; if ((c_) == 0 && rr_ < 0) rr_ = 0; PX_[j_] = *(const u32x4*)(PROJ + (size_t)(row0_ + rr_) * NPROJ + C_XBC + chx); } } while (0)
#define SSD_ISSUE_BC(c_) do { const int row0_ = row_base + 64 * (c_); \
        _Pragma("unroll") for (int i_ = 0; i_ < 2; ++i_) { const int t_ = tid + 512 * i_; \
            pbs[i_] = *(const u32x4*)(BCC + (size_t)(row0_ + (t_ >> 4)) * 512 + g * 128 + 8 * (t_ & 15)); pcs[i_] = *(const u32x4*)(BCC + (size_t)(row0_ + (t_ >> 4)) * 512 + 256 + g * 128 + 8 * (t_ & 15)); } } while (0)
#define SSD_ISSUE_ZDT(c_, PZ_, PDT_) do { const int row0_ = row_base + 64 * (c_); \
        _Pragma("unroll") for (int pi_ = 0; pi_ < 2; ++pi_) PZ_[pi_] = *(const u32x2*)(PROJ + (size_t)(row0_ + 16 * lt + (lane & 15)) * NPROJ + C_Z + h * 64 + 16 * (2 * nh + pi_) + 4 * (lane >> 4)); \
        PDT_ = DT[(size_t)(row0_ + lane) * 16 + h]; } while (0)
    LAS float* sm_init = (LAS float*)(lds + SS_SM + 1024);
    if (tid < 192) sm_init[tid] = smp ? F.in[I_SCONV][(size_t)(sb * 3 + (tid >> 6)) * 1536 + h * 64 + (tid & 63)] : 0.f;
#define SSD_STEP(c, PX_, PZ_, PDT_) do { \
        const int row0 = row_base + 64 * c; LAS unsigned char* ts = lds + (c & 1) * SS_SET; \
        LAS float* sm_ac = (LAS float*)(lds + SS_SM + (c & 1) * 512); LAS float* sm_dt = sm_ac + 64; \
        const float dtl = PDT_; \
        float ac = dtl * a_h; \
        ac = wave_incl_scan(ac); \
        const float ac_last = __builtin_bit_cast(float, __builtin_amdgcn_readlane(__builtin_bit_cast(int, ac), 63)); \
        const float wgt_l = __expf(ac_last - ac) * dtl; \
        if (w == 0) { sm_ac[lane] = ac; sm_dt[lane] = dtl; } \
        { \
        { float xr[4][8], o[8], od[8]; \
_Pragma("unroll")           for (int j = 0; j < 4; ++j) unpack8(PX_[j], xr[j]); \
          if (c == 0) { \
_Pragma("unroll")               for (int j = 0; j < 3; ++j) { const int rr = xl - 3 + j; const LAS f32x4* iv = (const LAS f32x4*)(sm_init + (rr < 0 ? 3 + rr : 0) * 64 + 8 * xg); \
                  f32x4 i0 = iv[0], i1 = iv[1]; asm volatile("" : "+v"(i0), "+v"(i1)); \
_Pragma("unroll")                   for (int e = 0; e < 4; ++e) { xr[j][e] = (rr < 0) ? i0[e] : xr[j][e]; xr[j][4 + e] = (rr < 0) ? i1[e] : xr[j][4 + e]; } } } \
          const float wg = __shfl(wgt_l, xl & 63); \
          float wv[4][8], bv[8]; unsigned cwo_ = (unsigned)(8 * xg) * 4u; asm volatile("" : "+v"(cwo_)); const LAS float* sm_cw = (const LAS float*)((const LAS unsigned char*)sm_cw0 + cwo_) - 8 * xg; \
          _Pragma("unroll") for (int j_ = 0; j_ < 4; ++j_) { const f32x4 a_ = *(const LAS f32x4*)(sm_cw + j_ * 64 + 8 * xg), b_ = *(const LAS f32x4*)(sm_cw + j_ * 64 + 8 * xg + 4); \
              _Pragma("unroll") for (int e_ = 0; e_ < 4; ++e_) { wv[j_][e_] = a_[e_]; wv[j_][4 + e_] = b_[e_]; } } \
          { const f32x4 a_ = *(const LAS f32x4*)(sm_cw + 256 + 8 * xg), b_ = *(const LAS f32x4*)(sm_cw + 256 + 8 * xg + 4); _Pragma("unroll") for (int e_ = 0; e_ < 4; ++e_) { bv[e_] = a_[e_]; bv[4 + e_] = b_[e_]; } } \
_Pragma("unroll")           for (int e = 0; e < 8; ++e) { o[e] = siluf(bv[e] + wv[0][e] * xr[0][e] + wv[1][e] * xr[1][e] + wv[2][e] * xr[2][e] + wv[3][e] * xr[3][e]); od[e] = o[e] * wg; } \
          *(LAS u32x4*)(ts + SS_X + xl * LD64 + xg * 16) = pack8(o); \
          *(LAS u32x4*)(ts + SS_XD + xl * LD64 + xg * 16) = pack8(od); } \
_Pragma("unroll")         for (int i = 0; i < 2; ++i) { const int t = tid + 512 * i; \
            *(LAS u32x4*)(ts + SS_BM + (t >> 4) * LD128 + (t & 15) * 16) = pbs[i]; *(LAS u32x4*)(ts + SS_CM + (t >> 4) * LD128 + (t & 15) * 16) = pcs[i]; } \
        } \
        if (c + 2 < nchunks) SSD_ISSUE_X(c + 2, PX_); if (c + 1 < nchunks) SSD_ISSUE_BC(c + 1); \
        __syncthreads(); \
_Pragma("unroll")         for (int q = 0; q < 4; ++q) { u32x2 v; v.x = pk2(st[q][0], st[q][1]); v.y = pk2(st[q][2], st[q][3]); \
            *(LAS u32x2*)(lds + SS_SB + (16 * pt + (lane & 15)) * LD128 + (16 * (4 * nh + q) + 4 * (lane >> 4)) * 2) = v; } \
        { const float acl = sm_ac[16 * lt + (lane & 15)]; const int l = 16 * lt + (lane & 15); \
_Pragma("unroll")           for (int si = 0; si < 2; ++si) { const int stl = 2 * nh + si; f32x4 gacc = {0.f, 0.f, 0.f, 0.f}; \
              if (stl <= lt) { \
_Pragma("unroll")                   for (int ks = 0; ks < 4; ++ks) gacc = MFMA16T(lds_frag(ts + SS_CM, LD128, 16 * lt, 32 * ks, lane), lds_frag(ts + SS_BM, LD128, 16 * stl, 32 * ks, lane), gacc); } \
              const int s0 = 16 * stl + 4 * (lane >> 4); \
              const f32x4 acs = *(const LAS f32x4*)(sm_ac + s0), dts = *(const LAS f32x4*)(sm_dt + s0); \
              float v[4]; \
_Pragma("unroll")               for (int r = 0; r < 4; ++r) { v[r] = gacc[r] * __expf(fminf(acl - acs[r], 0.f)) * dts[r]; v[r] = (l >= s0 + r) ? v[r] : 0.f; } \
              u32x2 pk; pk.x = pk2(v[0], v[1]); pk.y = pk2(v[2], v[3]); \
              *(LAS u32x2*)(lds + SS_WM + l * LD64 + s0 * 2) = pk; } } \
        __syncthreads(); \
        { \
        { const int l = 16 * lt + (lane & 15); const float eal = __expf(sm_ac[l]); \
          float ssq = 0.f; \
_Pragma("unroll")           for (int pi = 0; pi < 2; ++pi) { const int ptl = 2 * nh + pi; const int p0 = 16 * ptl + 4 * (lane >> 4); \
              f32x4 y = {0.f, 0.f, 0.f, 0.f}; \
_Pragma("unroll")               for (int ks = 0; ks < 4; ++ks) y = MFMA16T(lds_frag(ts + SS_CM, LD128, 16 * lt, 32 * ks, lane), lds_frag(lds + SS_SB, LD128, 16 * ptl, 32 * ks, lane), y); \
              y = y * eal; \
_Pragma("unroll")               for (int ks = 0; ks < 2; ++ks) y = MFMA16T(lds_frag(lds + SS_WM, LD64, 16 * lt, 32 * ks, lane), lds_frag_tr(ts + SS_X, LD64, 32 * ks, 16 * ptl, lane), y); \
              const u32x2 xraw = *(const LAS u32x2*)(ts + SS_X + l * LD64 + p0 * 2); \
              const float xv[4] = {__uint_as_float(xraw.x << 16), __uint_as_float(xraw.x & 0xffff0000u), __uint_as_float(xraw.y << 16), __uint_as_float(xraw.y & 0xffff0000u)}; \
              const float zv[4] = {__uint_as_float(PZ_[pi].x << 16), __uint_as_float(PZ_[pi].x & 0xffff0000u), __uint_as_float(PZ_[pi].y << 16), __uint_as_float(PZ_[pi].y & 0xffff0000u)}; \
              float gv[4]; \
_Pragma("unroll")               for (int r = 0; r < 4; ++r) { gv[r] = (y[r] + d_h * xv[r]) * siluf(zv[r]); ssq += gv[r] * gv[r]; } \
              u32x2 pk; pk.x = pk2(gv[0], gv[1]); pk.y = pk2(gv[2], gv[3]); \
              *(u32x2*)(MIX + (size_t)(row0 + l) * 2048 + h * 64 + p0) = pk; } \
          ssq += __shfl_xor(ssq, 16); ssq += __shfl_xor(ssq, 32); \
          if (lane < 16 && do_sumsq) unsafeAtomicAdd(SUMSQ + row0 + l, ssq); } \
        } \
        { const float cd = __expf(ac_last); \
          bf16x8 xa[2]; \
_Pragma("unroll")           for (int ks = 0; ks < 2; ++ks) xa[ks] = lds_frag_tr(ts + SS_XD, LD64, 32 * ks, 16 * pt, lane); \
_Pragma("unroll")           for (int q = 0; q < 4; ++q) { f32x4 s = st[q] * cd; \
_Pragma("unroll")               for (int ks = 0; ks < 2; ++ks) s = MFMA16T(xa[ks], lds_frag_tr(ts + SS_BM, LD128, 32 * ks, 16 * (4 * nh + q), lane), s); \
              st[q] = s; } } \
        if (c + 2 < nchunks) SSD_ISSUE_ZDT(c + 2, PZ_, PDT_); \
    } while (0)
    SSD_ISSUE_X(0, px0); SSD_ISSUE_BC(0); SSD_ISSUE_ZDT(0, pz0, pdt0);
    __syncthreads();
    if (nchunks > 1) { SSD_ISSUE_X(1, px1); SSD_ISSUE_ZDT(1, pz1, pdt1); }
#pragma unroll 1
    for (int c2 = 0; c2 < nchunks; c2 += 2) {
        { const int c = c2; SSD_STEP(c, px0, pz0, pdt0); }
        if (c2 + 1 < nchunks) { const int c = c2 + 1; SSD_STEP(c, px1, pz1, pdt1); }
    }
#undef SSD_STEP
#undef SSD_ISSUE_X
#undef SSD_ISSUE_BC
#undef SSD_ISSUE_ZDT
    { float* so = F.out + (smp ? O_SSMS + ((size_t)(sb * 16 + h) * 64) * 128 : O_SSMP + ((size_t)(sq * 16 + h) * 64) * 128);
#pragma unroll
      for (int q = 0; q < 4; ++q) *(f32x4*)(so + (16 * pt + (lane & 15)) * 128 + 16 * (4 * nh + q) + 4 * (lane >> 4)) = st[q]; }
    __syncthreads();
}
DI void p2a_phase(Ctx& F) {
    convbc_prepass(F);
    {
        const bf16_t* PROJ = (const bf16_t*)(F.ws + WS_PROJ);
        for (int i = F.bid * 512 + F.tid; i < 48 * 3 * 1536; i += F.G * 512) {
            const int ch = i % 1536, j = (i / 1536) % 3, sq = i / (3 * 1536);
            if (sq < NB_P) F.out[O_CONVP + (size_t)(sq * 3 + j) * 1536 + ch] = bf2f(PROJ[(size_t)(sq * T_P + T_P - 3 + j) * NPROJ + C_XBC + ch]);
            else F.out[O_CONVS + (size_t)((sq - NB_P) * 3 + j) * 1536 + ch] = bf2f(PROJ[(size_t)(MP + (sq - NB_P) * 64 + 61 + j) * NPROJ + C_XBC + ch]);
        }
    }
}
constexpr int WR_SLOT = 19456, WR_V = 9216, LDKW = 144, LDVW = 160;

DI void wa_write_k(Ctx& F, LAS unsigned char* slot, int kvh, const u32x4 ra, const u32x4 rb, int pos, float* ko) {
    const int i = F.tid >> 2, q4 = F.tid & 3;
    float a[8], bb[8], o1[8], o2[8];
    unpack8(ra, a); unpack8(rb, bb);
    float s = 0.f;
#pragma unroll
    for (int e = 0; e < 8; ++e) s += a[e] * a[e] + bb[e] * bb[e];
    s += __shfl_xor(s, 1); s += __shfl_xor(s, 2);
    const float rstd = 1.0f / sqrtf(s * (1.0f / 64.0f) + EPSF);
    const f32x2* ROPE = (const f32x2*)(F.ws + WS_ROPE);
#pragma unroll
    for (int e = 0; e < 8; ++e) { const float an = a[e] * rstd * F.in[I_GK][8 * q4 + e], bn = bb[e] * rstd * F.in[I_GK][32 + 8 * q4 + e];
        const f32x2 cs = ROPE[pos * 32 + 8 * q4 + e]; o1[e] = an * cs.x - bn * cs.y; o2[e] = bn * cs.x + an * cs.y; }
    *(LAS u32x4*)(slot + i * LDKW + (8 * q4) * 2) = pack8(o1);
    *(LAS u32x4*)(slot + i * LDKW + (32 + 8 * q4) * 2) = pack8(o2);
    if (ko) { float* p = ko + ((size_t)i * 2 + kvh) * 64;
        *(f32x4*)(p + 8 * q4) = (f32x4){o1[0], o1[1], o1[2], o1[3]}; *(f32x4*)(p + 8 * q4 + 4) = (f32x4){o1[4], o1[5], o1[6], o1[7]};
        *(f32x4*)(p + 32 + 8 * q4) = (f32x4){o2[0], o2[1], o2[2], o2[3]}; *(f32x4*)(p + 32 + 8 * q4 + 4) = (f32x4){o2[4], o2[5], o2[6], o2[7]}; }
}
DI void wa_write_v(Ctx& F, LAS unsigned char* slot, int kvh, const u32x4 rv, float* vo) {
    const int i = F.tid >> 3, q8 = F.tid & 7;
    *(LAS u32x4*)(slot + WR_V + i * LDVW + q8 * 16) = rv;
    if (vo) { float v[8]; unpack8(rv, v); float* p = vo + ((size_t)i * 2 + kvh) * 64 + 8 * q8;
        *(f32x4*)p = (f32x4){v[0], v[1], v[2], v[3]}; *(f32x4*)(p + 4) = (f32x4){v[4], v[5], v[6], v[7]}; }
}
DI void wa_stage_cache(Ctx& F, LAS unsigned char* slot, int kvh, const float* ck, const float* cv, float* ko, float* vo) {
    if (F.tid < 256) { const int i = F.tid >> 2, q4 = F.tid & 3; const float* src = ck + ((size_t)i * 2 + kvh) * 64;
        const f32x4 a0 = *(const f32x4*)(src + 8 * q4), a1 = *(const f32x4*)(src + 8 * q4 + 4), b0 = *(const f32x4*)(src + 32 + 8 * q4), b1 = *(const f32x4*)(src + 32 + 8 * q4 + 4);
        u32x4 pa, pb; pa.x = pk2(a0.x, a0.y); pa.y = pk2(a0.z, a0.w); pa.z = pk2(a1.x, a1.y); pa.w = pk2(a1.z, a1.w); pb.x = pk2(b0.x, b0.y); pb.y = pk2(b0.z, b0.w); pb.z = pk2(b1.x, b1.y); pb.w = pk2(b1.z, b1.w);
        *(LAS u32x4*)(slot + i * LDKW + (8 * q4) * 2) = pa; *(LAS u32x4*)(slot + i * LDKW + (32 + 8 * q4) * 2) = pb;
        if (ko) { float* p = ko + ((size_t)i * 2 + kvh) * 64; *(f32x4*)(p + 8 * q4) = a0; *(f32x4*)(p + 8 * q4 + 4) = a1; *(f32x4*)(p + 32 + 8 * q4) = b0; *(f32x4*)(p + 32 + 8 * q4 + 4) = b1; } }
    { const int i = F.tid >> 3, q8 = F.tid & 7; const float* src = cv + ((size_t)i * 2 + kvh) * 64 + 8 * q8; const f32x4 v0 = *(const f32x4*)src, v1 = *(const f32x4*)(src + 4);
      u32x4 pv; pv.x = pk2(v0.x, v0.y); pv.y = pk2(v0.z, v0.w); pv.z = pk2(v1.x, v1.y); pv.w = pk2(v1.z, v1.w);
      *(LAS u32x4*)(slot + WR_V + i * LDVW + q8 * 16) = pv;
      if (vo) { float* p = vo + ((size_t)i * 2 + kvh) * 64 + 8 * q8; *(f32x4*)p = v0; *(f32x4*)(p + 4) = v1; } }
}
DI void wa_compute(Ctx& F, int kvh, size_t crow0, int pos0, int sl0, int sl1, int sl2, int ninv) {
    LAS unsigned char* lds = F.lds;
    const int lane = F.lane, w = F.wave, g4 = lane >> 4;
    const bf16_t* PROJ = (const bf16_t*)(F.ws + WS_PROJ); const f32x2* ROPE = (const f32x2*)(F.ws + WS_ROPE); bf16_t* MIX = (bf16_t*)(F.ws + WS_MIX);
    const int hq = kvh * 4 + (w >> 1); const float sink = F.in[I_SINKS][hq] * 1.4426950408889634f;
    u32x2 graw[2][4]; u32x4 qraw[2][2];
#pragma unroll
    for (int rg = 0; rg < 2; ++rg) { const size_t row = crow0 + 32 * (w & 1) + 16 * rg + (lane & 15);
#pragma unroll
        for (int dt = 0; dt < 4; ++dt) graw[rg][dt] = *(const u32x2*)(PROJ + row * NPROJ + C_GA + hq * 64 + 16 * dt + 4 * g4);
        qraw[rg][0] = *(const u32x4*)(PROJ + row * NPROJ + C_Q + hq * 64 + 8 * g4); qraw[rg][1] = *(const u32x4*)(PROJ + row * NPROJ + C_Q + hq * 64 + 32 + 8 * g4); }
    bf16x8 qa[2][2];
#pragma unroll
    for (int rg = 0; rg < 2; ++rg) {
        const int d0 = 8 * g4; float a[8], bb[8];
        unpack8(qraw[rg][0], a);
        unpack8(qraw[rg][1], bb);
        float s = 0.f;
#pragma unroll
        for (int e = 0; e < 8; ++e) s += a[e] * a[e] + bb[e] * bb[e];
        s += __shfl_xor(s, 16); s += __shfl_xor(s, 32);
        const float rstd = 0.18033688011112042f / sqrtf(s * (1.0f / 64.0f) + EPSF);
        const int pos = pos0 + 32 * (w & 1) + 16 * rg + (lane & 15);
        float o1[8], o2[8];
#pragma unroll
        for (int e = 0; e < 8; ++e) { const float an = a[e] * rstd * F.in[I_GQ][d0 + e], bn = bb[e] * rstd * F.in[I_GQ][32 + d0 + e];
            const f32x2 cs = ROPE[pos * 32 + d0 + e]; o1[e] = an * cs.x - bn * cs.y; o2[e] = bn * cs.x + an * cs.y; }
        qa[rg][0] = __builtin_bit_cast(bf16x8, pack8(o1)); qa[rg][1] = __builtin_bit_cast(bf16x8, pack8(o2)); }
    f32x4 s[2][12];
#pragma unroll
    for (int jt = 0; jt < 12; ++jt) { const int j = jt >> 2; const LAS unsigned char* kt = lds + (j == 0 ? sl0 : (j == 1 ? sl1 : sl2)) * WR_SLOT;
        const bf16x8 k0 = lds_frag(kt, LDKW, 16 * (jt & 3), 0, lane), k1 = lds_frag(kt, LDKW, 16 * (jt & 3), 32, lane);
#pragma unroll
        for (int rg = 0; rg < 2; ++rg) { f32x4 acc = {0.f, 0.f, 0.f, 0.f};
            acc = MFMA16T(qa[rg][0], k0, acc); acc = MFMA16T(qa[rg][1], k1, acc);
            s[rg][jt] = acc; }
        if ((jt & 3) == 3) __builtin_amdgcn_sched_barrier(0); }
    if (ninv > 0) {
#pragma unroll
        for (int jt = 0; jt < 8; ++jt) if ((jt >> 2) < ninv) { s[0][jt] = (f32x4){-1e30f, -1e30f, -1e30f, -1e30f}; s[1][jt] = (f32x4){-1e30f, -1e30f, -1e30f, -1e30f}; } }
    float inv[2]; bf16x8 pa[2][6];
#pragma unroll
    for (int rg = 0; rg < 2; ++rg) {
        float m = sink;
#pragma unroll
        for (int jt = 0; jt < 12; ++jt)
#pragma unroll
            for (int r = 0; r < 4; ++r) m = fmaxf(m, s[rg][jt][r]);
        m = fmaxf(m, __shfl_xor(m, 16)); m = fmaxf(m, __shfl_xor(m, 32));
        float sum = 0.f;
#pragma unroll
        for (int jt = 0; jt < 12; ++jt)
#pragma unroll
            for (int r = 0; r < 4; ++r) { const float e = __builtin_amdgcn_exp2f(s[rg][jt][r] - m); s[rg][jt][r] = e; sum += e; }
        sum += __shfl_xor(sum, 16); sum += __shfl_xor(sum, 32);
        inv[rg] = 1.0f / (sum + __builtin_amdgcn_exp2f(sink - m));
#pragma unroll
        for (int k2 = 0; k2 < 6; ++k2) { u32x4 t; t.x = pk2(s[rg][2 * k2][0], s[rg][2 * k2][1]); t.y = pk2(s[rg][2 * k2][2], s[rg][2 * k2][3]);
            t.z = pk2(s[rg][2 * k2 + 1][0], s[rg][2 * k2 + 1][1]); t.w = pk2(s[rg][2 * k2 + 1][2], s[rg][2 * k2 + 1][3]);
            pa[rg][k2] = __builtin_bit_cast(bf16x8, t); } }
#pragma unroll
    for (int dt = 0; dt < 4; ++dt) { f32x4 o[2] = {{0.f, 0.f, 0.f, 0.f}, {0.f, 0.f, 0.f, 0.f}};
#pragma unroll
        for (int k2 = 0; k2 < 6; ++k2) { const int j = k2 >> 1; const LAS unsigned char* vt = lds + (j == 0 ? sl0 : (j == 1 ? sl1 : sl2)) * WR_SLOT + WR_V;
            const bf16x8 vf = lds_frag_tr2(vt, LDVW, 32 * (k2 & 1), 16 * dt, lane);
            o[0] = MFMA16T(pa[0][k2], vf, o[0]); o[1] = MFMA16T(pa[1][k2], vf, o[1]); }
#pragma unroll
        for (int rg = 0; rg < 2; ++rg) { const size_t row = crow0 + 32 * (w & 1) + 16 * rg + (lane & 15);
            const float gv[4] = {__uint_as_float(graw[rg][dt].x << 16), __uint_as_float(graw[rg][dt].x & 0xffff0000u), __uint_as_float(graw[rg][dt].y << 16), __uint_as_float(graw[rg][dt].y & 0xffff0000u)};
            u32x2 pk; pk.x = pk2(o[rg][0] * inv[rg] * siluf(gv[0]), o[rg][1] * inv[rg] * siluf(gv[1])); pk.y = pk2(o[rg][2] * inv[rg] * siluf(gv[2]), o[rg][3] * inv[rg] * siluf(gv[3]));
            *(u32x2*)(MIX + row * 2048 + 1024 + hq * 64 + 16 * dt + 4 * g4) = pk; }
        __builtin_amdgcn_sched_barrier(0); }
}
DI void winattn_item(Ctx& F, int item) {
    LAS unsigned char* lds = F.lds;
    const int tid = F.tid;
    const bf16_t* PROJ = (const bf16_t*)(F.ws + WS_PROJ);
    if (item >= 256) {
        const int sb = (item - 256) >> 1, kvh = item & 1; const size_t row0 = (size_t)MP + sb * 64;
        const float* ck = F.in[I_CWK] + (size_t)sb * 128 * 128; const float* cv = F.in[I_CWV] + (size_t)sb * 128 * 128;
        float* ko = F.out + O_WKS + (size_t)sb * 128 * 128; float* vo = F.out + O_WVS + (size_t)sb * 128 * 128;
        wa_stage_cache(F, lds + 0 * WR_SLOT, kvh, ck, cv, nullptr, nullptr);
        wa_stage_cache(F, lds + 1 * WR_SLOT, kvh, ck + 64 * 128, cv + 64 * 128, ko, vo);
        if (tid < 256) { const int i = tid >> 2, q4 = tid & 3; const bf16_t* p = PROJ + (row0 + i) * NPROJ + C_K + kvh * 64 + 8 * q4;
            wa_write_k(F, lds + 2 * WR_SLOT, kvh, *(const u32x4*)p, *(const u32x4*)(p + 32), 2048 + i, ko + 64 * 128); }
        { const int i = tid >> 3, q8 = tid & 7; wa_write_v(F, lds + 2 * WR_SLOT, kvh, *(const u32x4*)(PROJ + (row0 + i) * NPROJ + C_V + kvh * 64 + 8 * q8), vo + 64 * 128); }
        __syncthreads();
        wa_compute(F, kvh, row0, 2048, 0, 1, 2, 0);
        __syncthreads();
        return;
    }
    const int b = item >> 4, kvh = (item >> 3) & 1, c0 = (item & 7) * 8;
    const size_t seq0 = (size_t)b * T_P;
#pragma unroll 1
    for (int kc = c0 - 2; kc <= c0; ++kc) { LAS unsigned char* slot = lds + (kc & 3) * WR_SLOT;
        if (kc < 0) { for (int t = tid; t < WR_SLOT / 16; t += 512) *(LAS u32x4*)(slot + t * 16) = (u32x4){0u, 0u, 0u, 0u}; }
        else { const size_t row0 = seq0 + (size_t)kc * 64;
            if (tid < 256) { const int i = tid >> 2, q4 = tid & 3; const bf16_t* p = PROJ + (row0 + i) * NPROJ + C_K + kvh * 64 + 8 * q4;
                wa_write_k(F, slot, kvh, *(const u32x4*)p, *(const u32x4*)(p + 32), kc * 64 + i, nullptr); }
            { const int i = tid >> 3, q8 = tid & 7; wa_write_v(F, slot, kvh, *(const u32x4*)(PROJ + (row0 + i) * NPROJ + C_V + kvh * 64 + 8 * q8), nullptr); } } }
    __syncthreads();
#pragma unroll 1
    for (int c = c0; c < c0 + 8; ++c) {
        const bool more = c + 1 < c0 + 8;
        u32x4 ra = {0u, 0u, 0u, 0u}, rb = {0u, 0u, 0u, 0u}, rv = {0u, 0u, 0u, 0u};
        const size_t nrow0 = seq0 + (size_t)(c + 1) * 64;
        if (more) {
            if (tid < 256) { const bf16_t* p = PROJ + (nrow0 + (tid >> 2)) * NPROJ + C_K + kvh * 64 + 8 * (tid & 3); ra = *(const u32x4*)p; rb = *(const u32x4*)(p + 32); }
            rv = *(const u32x4*)(PROJ + (nrow0 + (tid >> 3)) * NPROJ + C_V + kvh * 64 + 8 * (tid & 7)); }
        wa_compute(F, kvh, seq0 + (size_t)c * 64, c * 64, (c - 2) & 3, (c - 1) & 3, c & 3, c >= 2 ? 0 : 2 - c);
        if (more) { LAS unsigned char* slot = lds + ((c + 1) & 3) * WR_SLOT; const int kc = c + 1;
            float* ko = nullptr; float* vo = nullptr;
            if (kc >= 62) { ko = F.out + O_WKP + ((size_t)b * 128 + (kc - 62) * 64) * 128; vo = F.out + O_WVP + ((size_t)b * 128 + (kc - 62) * 64) * 128; }
            if (tid < 256) wa_write_k(F, slot, kvh, ra, rb, kc * 64 + (tid >> 2), ko);
            wa_write_v(F, slot, kvh, rv, vo); }
        __syncthreads();
    }
}

constexpr int MA_K = 0, MA_V = 69632, MA_RS = 143360, LDKM = 272, LDVM = 288;
DI void memattn_item(Ctx& F, int item) {
    LAS unsigned char* lds = F.lds;
    const int tid = F.tid, lane = F.lane, w = F.wave, g4 = lane >> 4;
    const bool smp = item >= 256; const int sidx = item - 256;
    const int bb = smp ? (sidx >> 2) : (item >> 4), h = smp ? (sidx & 3) : ((item >> 2) & 3), qt = item & 3;
    const bf16_t* PROJ = (const bf16_t*)(F.ws + WS_PROJ); bf16_t* MIX = (bf16_t*)(F.ws + WS_MIX); const bf16_t* RAW = (const bf16_t*)(F.ws + WS_MEMRAW);
#pragma unroll 1
    for (int ib = 0; ib < 2; ++ib) {
      u32x4 rk[4], rvv[4]; f32x4 fk[4][2], fv[4][2];
#pragma unroll
      for (int u = 0; u < 4; ++u) { const int t = tid + 512 * (4 * ib + u), key = t >> 4, ch = t & 15;
        if (smp) { const float* ks = F.in[I_CMK] + ((size_t)(bb * 256 + key) * 4 + h) * 128 + 8 * ch; const float* vs = F.in[I_CMV] + ((size_t)(bb * 256 + key) * 4 + h) * 128 + 8 * ch;
            fk[u][0] = *(const f32x4*)ks; fk[u][1] = *(const f32x4*)(ks + 4); fv[u][0] = *(const f32x4*)vs; fv[u][1] = *(const f32x4*)(vs + 4); }
        else { rk[u] = *(const u32x4*)(RAW + (size_t)(bb * 256 + key) * 1024 + h * 128 + 8 * ch); rvv[u] = *(const u32x4*)(RAW + (size_t)(bb * 256 + key) * 1024 + 512 + h * 128 + 8 * ch); } }
#pragma unroll
      for (int u = 0; u < 4; ++u) { const int t = tid + 512 * (4 * ib + u), key = t >> 4, ch = t & 15;
        float k[8], v[8];
        if (smp) {
#pragma unroll
            for (int e = 0; e < 4; ++e) { k[e] = fk[u][0][e]; k[4 + e] = fk[u][1][e]; v[e] = fv[u][0][e]; v[4 + e] = fv[u][1][e]; } }
        else { unpack8(rk[u], k); unpack8(rvv[u], v); }
        float s = 0.f;
#pragma unroll
        for (int e = 0; e < 8; ++e) s += k[e] * k[e];
        s += __shfl_xor(s, 1); s += __shfl_xor(s, 2); s += __shfl_xor(s, 4); s += __shfl_xor(s, 8);
        if (!smp) { const float rstd = 1.0f / sqrtf(s * (1.0f / 128.0f) + EPSF);
#pragma unroll
            for (int e = 0; e < 8; ++e) k[e] = k[e] * rstd * F.in[I_GMK][8 * ch + e]; }
        { float kq[8];
#pragma unroll
          for (int e = 0; e < 8; ++e) kq[e] = k[e] * F.in[I_GMQ][8 * ch + e];
          *(LAS u32x4*)(lds + MA_K + key * LDKM + ch * 16) = pack8(kq); }
        *(LAS u32x4*)(lds + MA_V + key * LDVM + ch * 16) = pack8(v);
        if (!smp && qt == 0) {
            float* ko = F.out + O_MKP + ((size_t)(bb * 256 + key) * 4 + h) * 128 + 8 * ch; float* vo = F.out + O_MVP + ((size_t)(bb * 256 + key) * 4 + h) * 128 + 8 * ch;
            *(f32x4*)ko = (f32x4){k[0], k[1], k[2], k[3]}; *(f32x4*)(ko + 4) = (f32x4){k[4], k[5], k[6], k[7]};
            *(f32x4*)vo = (f32x4){v[0], v[1], v[2], v[3]}; *(f32x4*)(vo + 4) = (f32x4){v[4], v[5], v[6], v[7]}; }
      }
    }
    __syncthreads();
    const int ngr = smp ? 4 : 64;
    const size_t qbase = smp ? (size_t)MP + bb * 64 : (size_t)bb * T_P + qt * 1024;
    u32x4 nq[4]; u32x2 ng[8];
#define MA_LOAD(rg_) do { const size_t r_ = qbase + 16 * (rg_) + (lane & 15); \
        _Pragma("unroll") for (int ks = 0; ks < 4; ++ks) nq[ks] = *(const u32x4*)(PROJ + r_ * NPROJ + C_MQ + h * 128 + 32 * ks + 8 * g4); \
        _Pragma("unroll") for (int dt = 0; dt < 8; ++dt) ng[dt] = *(const u32x2*)(PROJ + r_ * NPROJ + C_GM + h * 128 + 16 * dt + 4 * g4); } while (0)
    if (w < ngr) MA_LOAD(w);
#pragma unroll 1
    for (int rg = w; rg < ngr; rg += 8) {
        u32x4 cq[4]; u32x2 cg[8];
#pragma unroll
        for (int ks = 0; ks < 4; ++ks) cq[ks] = nq[ks];
#pragma unroll
        for (int dt = 0; dt < 8; ++dt) cg[dt] = ng[dt];
        if (rg + 8 < ngr) MA_LOAD(rg + 8);
        bf16x8 qa[4];
        { float q[4][8]; float s = 0.f;
#pragma unroll
          for (int ks = 0; ks < 4; ++ks) { unpack8(cq[ks], q[ks]);
#pragma unroll
              for (int e = 0; e < 8; ++e) s += q[ks][e] * q[ks][e]; }
          s += __shfl_xor(s, 16); s += __shfl_xor(s, 32);
          const float rstd = 0.12751743082459868f / sqrtf(s * (1.0f / 128.0f) + EPSF);
#pragma unroll
          for (int ks = 0; ks < 4; ++ks) {
#pragma unroll
              for (int e = 0; e < 8; ++e) q[ks][e] = q[ks][e] * rstd;
              qa[ks] = __builtin_bit_cast(bf16x8, pack8(q[ks])); } }
        f32x4 s[16];
#pragma unroll
        for (int jt = 0; jt < 16; ++jt) { f32x4 acc = {0.f, 0.f, 0.f, 0.f};
#pragma unroll
            for (int ks = 0; ks < 4; ++ks) acc = MFMA16T(qa[ks], lds_frag(lds + MA_K, LDKM, 16 * jt, 32 * ks, lane), acc);
            s[jt] = acc;
            if ((jt & 3) == 3) __builtin_amdgcn_sched_barrier(0); }
        float m = s[0][0];
#pragma unroll
        for (int jt = 0; jt < 16; ++jt)
#pragma unroll
            for (int r = 0; r < 4; ++r) m = fmaxf(m, s[jt][r]);
        m = fmaxf(m, __shfl_xor(m, 16)); m = fmaxf(m, __shfl_xor(m, 32));
        float sum = 0.f;
#pragma unroll
        for (int jt = 0; jt < 16; ++jt)
#pragma unroll
            for (int r = 0; r < 4; ++r) { const float e = __builtin_amdgcn_exp2f(s[jt][r] - m); s[jt][r] = e; sum += e; }
        sum += __shfl_xor(sum, 16); sum += __shfl_xor(sum, 32);
        const float inv = 1.0f / sum;
        bf16x8 pa[8];
#pragma unroll
        for (int k2 = 0; k2 < 8; ++k2) { u32x4 t; t.x = pk2(s[2 * k2][0], s[2 * k2][1]); t.y = pk2(s[2 * k2][2], s[2 * k2][3]); t.z = pk2(s[2 * k2 + 1][0], s[2 * k2 + 1][1]); t.w = pk2(s[2 * k2 + 1][2], s[2 * k2 + 1][3]);
            pa[k2] = __builtin_bit_cast(bf16x8, t); }
        const size_t orow = qbase + 16 * rg + (lane & 15);
#pragma unroll
        for (int dt = 0; dt < 8; ++dt) { f32x4 o = {0.f, 0.f, 0.f, 0.f};
#pragma unroll
            for (int k2 = 0; k2 < 8; ++k2) o = MFMA16T(pa[k2], lds_frag_tr2(lds + MA_V, LDVM, 32 * k2, 16 * dt, lane), o);
            __builtin_amdgcn_sched_barrier(0);
            const int col = h * 128 + 16 * dt + 4 * g4;
            const u32x2 gr = cg[dt];
            const float gv[4] = {__uint_as_float(gr.x << 16), __uint_as_float(gr.x & 0xffff0000u), __uint_as_float(gr.y << 16), __uint_as_float(gr.y & 0xffff0000u)};
            u32x2 pk; pk.x = pk2(o[0] * inv * siluf(gv[0]), o[1] * inv * siluf(gv[1])); pk.y = pk2(o[2] * inv * siluf(gv[2]), o[3] * inv * siluf(gv[3]));
            *(u32x2*)(MIX + orow * 2048 + 1536 + col) = pk; }
    }
#undef MA_LOAD
    __syncthreads();
}

DI void p2a_attn(Ctx& F) {
    for (int rep = 0; rep < REP_WIN; ++rep)
    for (int it = F.bid; it < 320; it += F.G) winattn_item(F, it);
    __syncthreads();
    for (int rep = 0; rep < REP_MEM; ++rep)
    { for (int it = F.bid; it < 256; it += F.G) memattn_item(F, it);
      for (int s = (F.bid + F.G - (128 % F.G)) % F.G; s < 128; s += F.G) memattn_item(F, 256 + s); }
}
DI void p2b_phase(Ctx& F) {
    for (int rep = 0; rep < REP_SSD; ++rep)
    for (int it = F.bid; it < 48 * 16; it += F.G) ssd_item(F, it >> 4, it & 15, rep == 0);
}

constexpr int G2_A = 0, G2_B = 9216, G2_SET = 27648;
DI void gemm2_sample(Ctx& F) {
    LAS unsigned char* lds = F.lds;
    const int tid = F.tid, lane = F.lane, w = F.wave, g4 = lane >> 4;
    const bf16_t* MIX = (const bf16_t*)(F.ws + WS_MIX); const bf16_t* WOT = (const bf16_t*)(F.ws + WS_WOUT); const float* SUMSQ = (const float*)(F.ws + WS_SSQ);
    for (int tile = F.bid; tile < 256; tile += F.G) {
        const int r0 = MP + 64 * (tile >> 3), c0 = 128 * (tile & 7);
        const bf16_t* asrc = MIX + (size_t)(r0 + (tid >> 3)) * 2048 + 8 * (tid & 7);
        const bf16_t* bsrc0 = WOT + (size_t)(c0 + (tid >> 3)) * 2048 + 8 * (tid & 7);
        const bf16_t* bsrc1 = bsrc0 + (size_t)64 * 2048;
        const int aoff = G2_A + (tid >> 3) * 144 + (tid & 7) * 16, boff0 = G2_B + (tid >> 3) * 144 + (tid & 7) * 16, boff1 = boff0 + 64 * 144;
        f32x4 acc[4] = {{0.f, 0.f, 0.f, 0.f}, {0.f, 0.f, 0.f, 0.f}, {0.f, 0.f, 0.f, 0.f}, {0.f, 0.f, 0.f, 0.f}};
        u32x4 ra[4], rb0[4], rb1[4];
#pragma unroll
        for (int j = 0; j < 4; ++j) { ra[j] = *(const u32x4*)(asrc + 64 * j); rb0[j] = *(const u32x4*)(bsrc0 + 64 * j); rb1[j] = *(const u32x4*)(bsrc1 + 64 * j); }
        *(LAS u32x4*)(lds + aoff) = ra[0]; *(LAS u32x4*)(lds + boff0) = rb0[0]; *(LAS u32x4*)(lds + boff1) = rb1[0];
        ra[0] = *(const u32x4*)(asrc + 64 * 4); rb0[0] = *(const u32x4*)(bsrc0 + 64 * 4); rb1[0] = *(const u32x4*)(bsrc1 + 64 * 4);
        __syncthreads();
#pragma unroll 1
        for (int kt4 = 0; kt4 < 32; kt4 += 4) {
#pragma unroll
            for (int u = 0; u < 4; ++u) { const int kt = kt4 + u;
                const LAS unsigned char* cs = lds + (u & 1) * G2_SET; LAS unsigned char* ns = lds + ((u + 1) & 1) * G2_SET;
                if (kt == 16) { const float r = 1.0f / sqrtf(SUMSQ[r0 + 16 * (w >> 1) + (lane & 15)] * (1.0f / 1024.0f) + EPSF);
#pragma unroll
                    for (int t = 0; t < 4; ++t) acc[t] = acc[t] * r; }
#pragma unroll
                for (int ks = 0; ks < 2; ++ks) { const bf16x8 a = lds_frag(cs + G2_A, 144, 16 * (w >> 1), 32 * ks, lane);
#pragma unroll
                    for (int t = 0; t < 4; ++t) acc[t] = MFMA16T(a, lds_frag(cs + G2_B, 144, 64 * (w & 1) + 16 * t, 32 * ks, lane), acc[t]); }
                constexpr int dummy_ = 0; (void)dummy_;
                const int rs = (u + 1) & 3;
                if (kt + 1 < 32) { *(LAS u32x4*)(ns + aoff) = ra[rs]; *(LAS u32x4*)(ns + boff0) = rb0[rs]; *(LAS u32x4*)(ns + boff1) = rb1[rs]; }
                if (kt + 5 < 32) { ra[rs] = *(const u32x4*)(asrc + 64 * (kt + 5)); rb0[rs] = *(const u32x4*)(bsrc0 + 64 * (kt + 5)); rb1[rs] = *(const u32x4*)(bsrc1 + 64 * (kt + 5)); }
                __syncthreads();
            }
        }
        const int row = r0 + 16 * (w >> 1) + (lane & 15), cw = c0 + 64 * (w & 1) + 4 * g4;
        const float* xr = F.in[I_XS] + (size_t)(row - MP) * DM + cw; float* orow = F.out + (size_t)row * DM + cw;
#pragma unroll
        for (int t = 0; t < 4; ++t) *(f32x4*)(orow + 16 * t) = acc[t] + *(const f32x4*)(xr + 16 * t);
    }
}
__global__ void __launch_bounds__(512, 2) hymba_fwd(Args args) {
    extern __shared__ __attribute__((aligned(16))) unsigned char lds_raw[];
    cg::grid_group grid = cg::this_grid();
    Ctx F;
    F.lds = (LAS unsigned char*)lds_raw; F.tid = threadIdx.x; F.lane = F.tid & 63; F.wave = __builtin_amdgcn_readfirstlane(F.tid >> 6); F.G = gridDim.x; F.bid = blockIdx.x;
#pragma unroll
    for (int i = 0; i < 26; ++i) F.in[i] = args.in[i];
    F.out = args.out; F.ws = args.ws;
    volatile LAS unsigned* bst = (volatile LAS unsigned*)(F.lds + LDS_BYTES - 64);
    if (F.tid < 16) bst[F.tid] = 0u;
    __syncthreads();
    const XcdBarrier xbar = xcd_barrier_post((unsigned*)(F.ws + WS_CTL), bst);
#define GRID_BAR() xcd_barrier(xbar)

#define PHASE_FENCE() do { int t_ = threadIdx.x; asm volatile("" : "+v"(t_)); F.tid = t_; F.lane = t_ & 63; F.wave = __builtin_amdgcn_readfirstlane(t_ >> 6); } while (0)
    for (int rep = 0; rep < REP_P0; ++rep) { if (rep) __syncthreads(); p0_prologue(F); }
    grid.sync(); PHASE_FENCE();
    {
        pg8::Gemm g{(const bf16_t*)(F.ws + WS_A), (const bf16_t*)(F.ws + WS_BT), MA, NBT, 1024};
        Order1 S; S.init(F.G, F.bid);
        EpiProj E{(bf16_t*)(F.ws + WS_PROJ), (bf16_t*)(F.ws + WS_MEMRAW)};
        pg8::gemm_phase<EpiProj, Order1, true, true>(F.lds, g, S, E);
    }
    GRID_BAR(); PHASE_FENCE();
    for (int rep = 0; rep < REP_P2A; ++rep) p2a_phase(F);
    __syncthreads();
    p2a_attn(F);
    GRID_BAR(); PHASE_FENCE();
    p2b_phase(F);
    GRID_BAR(); PHASE_FENCE();
    gemm2_sample(F);
    {
        pg8::Gemm g{(const bf16_t*)(F.ws + WS_MIX), (const bf16_t*)(F.ws + WS_WOUT), MTOT, 1024, 2048};
        Order3 S; S.init(F.G, F.bid);
        EpiOut E{F.in[I_XP], F.in[I_XS], F.out, (const float*)(F.ws + WS_SSQ)};
        pg8::gemm_phase<EpiOut, Order3, true, true>(F.lds, g, S, E);
    }
#if DBG_SCALE3 || DBG_ZERO
    grid.sync();
    {
        const size_t offs[13] = {O_Y, (size_t)MP * 1024, O_WKP, O_WVP, O_SSMP, O_CONVP, O_MKP, O_MVP, O_WKS, O_WVS, O_SSMS, O_CONVS, O_END};
        for (int o = 0; o < 12; ++o) {
            const bool z = (DBG_ZERO >> o) & 1, s3 = (DBG_SCALE3 >> o) & 1;
            if (!z && !s3) continue;
            for (size_t i = offs[o] + (size_t)F.bid * 512 + F.tid; i < offs[o + 1]; i += (size_t)F.G * 512) F.out[i] = z ? 0.f : F.out[i] * 3.0f;
        }
    }
#endif
}

extern "C" void kernel_launch(void* const* d_in, const int* in_sizes, int n_in, void* d_out, int out_size, void* d_ws, size_t ws_size, hipStream_t stream) {
    static int grid = 0;
    if (grid == 0) {
        if (n_in != 26 || (size_t)out_size != O_END || ws_size < WS_END) { fprintf(stderr, "kernel_launch: unexpected problem (n_in %d out %d ws %zu)\n", n_in, out_size, ws_size); grid = -1; return; }
        int dev = 0, cus = 0, per_cu = 0;
        if (hipGetDevice(&dev) != hipSuccess || hipDeviceGetAttribute(&cus, hipDeviceAttributeMultiprocessorCount, dev) != hipSuccess) { grid = -1; return; }
        if (hipFuncSetAttribute((const void*)hymba_fwd, hipFuncAttributeMaxDynamicSharedMemorySize, LDS_BYTES) != hipSuccess) { fprintf(stderr, "kernel_launch: hipFuncSetAttribute failed\n"); grid = -1; return; }
        if (hipOccupancyMaxActiveBlocksPerMultiprocessor(&per_cu, (const void*)hymba_fwd, 512, LDS_BYTES) != hipSuccess || per_cu < 1) { fprintf(stderr, "kernel_launch: occupancy query says %d\n", per_cu); (void)hipGetLastError(); grid = -1; return; }
        grid = cus;
        fprintf(stderr, "kernel_launch: %d CUs, occupancy %d per CU, grid %d\n", cus, per_cu, grid);
    }
    if (grid < 0) return;
    Args a{};
    for (int i = 0; i < 26; ++i) a.in[i] = (const float*)d_in[i];
    a.out = (float*)d_out; a.ws = (unsigned char*)d_ws;
    if (hipMemsetAsync((char*)d_ws + WS_CTL, 0, CTL_ZERO_BYTES, stream) != hipSuccess) { fprintf(stderr, "kernel_launch: memset of the barrier words failed\n"); return; }
    void* kargs[] = {&a};
    const hipError_t e = hipLaunchCooperativeKernel((const void*)hymba_fwd, dim3(grid), dim3(512), kargs, LDS_BYTES, stream);
    if (e != hipSuccess) fprintf(stderr, "kernel_launch: cooperative launch failed: %s\n", hipGetErrorString(e));
}
```

```cpp
#include <hip/hip_runtime.h>
#include <hip/hip_cooperative_groups.h>
#include <cstdio>
#include <cstdint>
namespace cg = cooperative_groups;
namespace pg8 {
#define PG8_LAS __attribute__((address_space(3)))
typedef unsigned short bf16_t;
typedef short bf16x8 __attribute__((ext_vector_type(8)));
typedef float f32x4 __attribute__((ext_vector_type(4)));
typedef unsigned u32x4 __attribute__((ext_vector_type(4)));
constexpr int BM = 256, BK = 64, HALF = 128, HTB = HALF * BK * 2  , STAGE_BYTES = 8 * HTB, NXCD = 8, WGM = 8;

__host__ __device__ __forceinline__ int lds_byte(int r, int c) { const int st = (r >> 4) * 2 + (c >> 5), rr = r & 15, cc = c & 31, ob = rr * 64 + cc * 2; return st * 1024 + (ob ^ (((ob >> 9) & 1) << 5)); }
__host__ __device__ __forceinline__ void stage_rc(int b, int& R, int& C) { const int st = b / 1024, sb = b % 1024, swz = sb ^ (((sb >> 9) & 1) << 5); R = (st >> 1) * 16 + swz / 64; C = (st & 1) * 32 + (swz % 64) / 2; }
__host__ __device__ __forceinline__ int perm32(int rho) { const int n = rho >> 4, i = rho & 15; return 8 * (i >> 2) + 4 * n + (i & 3); }

struct Unit { int pm, pn; };
struct Gemm { const bf16_t* A; const bf16_t* Bt; int M, N, K; };

struct StaticOrder {
    int nM, nN, nwg, G, c;
    __host__ __device__ void init(int M, int N, int G_, int c_) { nM = M / BM; nN = N / BM; nwg = nM * nN; G = G_; c = c_; }
    __host__ __device__ bool next(int i, Unit& u) const {
        const long L = (long)i * G + c; if (L >= nwg) return false;
        int wgid = (int)L; { const int q = nwg / NXCD, r = nwg % NXCD, xcd = wgid % NXCD, off = wgid / NXCD; wgid = (xcd < r ? xcd * (q + 1) : r * (q + 1) + (xcd - r) * q) + off; }
        const int nig = WGM * nN, gid = wgid / nig, fm = gid * WGM, gsz = (nM - fm) < WGM ? (nM - fm) : WGM;
        u.pm = fm + ((wgid % nig) % gsz); u.pn = (wgid % nig) / gsz; return true;
    }
    __device__ __forceinline__ void a_ready(const Unit&) const {}
    __device__ __forceinline__ void done(const Unit&) const {}
};

template <class Epi, class Sched, bool ALIGN_EPI = false, bool SP2 = false>
__device__ __forceinline__ void gemm_phase(PG8_LAS unsigned char* lds, const Gemm g, const Sched& S, const Epi& E) {
    int tid_ = threadIdx.x; asm volatile("" : "+v"(tid_));
    const int tid = tid_, wid = __builtin_amdgcn_readfirstlane(tid >> 6), lane = tid & 63, wr = wid >> 2, wc = wid & 3, fr = lane & 15, fq = lane >> 4;
    const int K = g.K, nt = K / BK;
    unsigned voffA[2], voffB[2];
#pragma unroll
    for (int i = 0; i < 2; ++i) { int R, C; stage_rc(tid * 16 + i * 8192, R, C); const int Rb = Epi::PERM ? ((R & ~31) + perm32(R & 31)) : R;
        voffA[i] = (unsigned)(R * K + C) * 2u; voffB[i] = (unsigned)(Rb * K + C) * 2u; }
    const size_t kstep = (size_t)(BK * 2);
    const size_t hstep = (size_t)HALF * K * 2;
    const size_t tstep = 2 * hstep;
    const unsigned ldsw = (unsigned)wid * 1024u;
    const int aoff = lds_byte(wr * 64 + fr, fq * 8), boff = lds_byte(wc * 32 + fr, fq * 8);
#define PG8_SA(b, h) (((b) * 2 + (h)) * HTB)
#define PG8_SB(b, h) ((4 + (b) * 2 + (h)) * HTB)
#define PG8_STAGE(bufoff, gbase, voff) do { _Pragma("unroll") for (int _i = 0; _i < 2; ++_i) \
        __builtin_amdgcn_global_load_lds((const unsigned*)((const char*)(gbase) + (voff)[_i]), (PG8_LAS unsigned*)(lds + (bufoff) + ldsw + _i * 8192), 16, 0, 0); } while (0)
#define PG8_LDA(dst, b, h) do { _Pragma("unroll") for (int m = 0; m < 4; ++m) _Pragma("unroll") for (int k = 0; k < 2; ++k) dst[m][k] = *(const PG8_LAS bf16x8*)(lds + PG8_SA(b, h) + aoff + m * 2048 + k * 1024); } while (0)
#define PG8_LDB(dst, b, h) do { _Pragma("unroll") for (int n = 0; n < 2; ++n) _Pragma("unroll") for (int k = 0; k < 2; ++k) dst[n][k] = *(const PG8_LAS bf16x8*)(lds + PG8_SB(b, h) + boff + n * 2048 + k * 1024); } while (0)
#define PG8_MMA(ai, bj, At, Bt) do { __builtin_amdgcn_s_setprio(1); _Pragma("unroll") for (int m = 0; m < 4; ++m) _Pragma("unroll") for (int n = 0; n < 2; ++n) _Pragma("unroll") for (int k = 0; k < 2; ++k) \
        acc[ai][bj][m][n] = __builtin_amdgcn_mfma_f32_16x16x32_bf16(Bt[n][k], At[m][k], acc[ai][bj][m][n], 0, 0, 0); __builtin_amdgcn_s_setprio(0); } while (0)
#define PG8_WAIT_V(n) asm volatile("s_waitcnt vmcnt(" #n ")" ::: "memory")
#define PG8_WAIT_L(n) asm volatile("s_waitcnt lgkmcnt(" #n ")" ::: "memory")
#define PG8_BAR __builtin_amdgcn_s_barrier()
#define PG8_SCHED __builtin_amdgcn_sched_barrier(0)
    Unit cur, nxt; int ui = 0;
    if (!S.next(0, cur)) return;
    f32x4 acc[2][2][4][2];
#pragma unroll
    for (int a = 0; a < 2; ++a)
#pragma unroll
        for (int b = 0; b < 2; ++b)
#pragma unroll
            for (int m = 0; m < 4; ++m)
#pragma unroll
                for (int n = 0; n < 2; ++n) acc[a][b][m][n] = (f32x4){0.f, 0.f, 0.f, 0.f};
    bf16x8 At[4][2], B0[2][2], B1[2][2];
    const char* cA = (const char*)g.A + (size_t)cur.pm * tstep; const char* cB = (const char*)g.Bt + (size_t)cur.pn * tstep;
    S.a_ready(cur);
    if constexpr (SP2) {
        PG8_STAGE(PG8_SB(0, 0), cB, voffB); PG8_STAGE(PG8_SB(0, 1), cB + hstep, voffB); PG8_STAGE(PG8_SA(0, 0), cA, voffA); PG8_STAGE(PG8_SA(0, 1), cA + hstep, voffA);
        if (wr == 1) PG8_BAR;
        PG8_WAIT_V(2); PG8_BAR;
        PG8_STAGE(PG8_SB(1, 0), cB + kstep, voffB); PG8_STAGE(PG8_SA(1, 0), cA + kstep, voffA); PG8_STAGE(PG8_SB(1, 1), cB + hstep + kstep, voffB);
        PG8_WAIT_V(6); PG8_BAR;
    } else {
        PG8_STAGE(PG8_SB(0, 0), cB, voffB); PG8_STAGE(PG8_SA(0, 0), cA, voffA); PG8_STAGE(PG8_SB(0, 1), cB + hstep, voffB); PG8_STAGE(PG8_SA(0, 1), cA + hstep, voffA);
        if (wr == 1) PG8_BAR;
        PG8_WAIT_V(4); PG8_BAR;
        PG8_STAGE(PG8_SB(1, 0), cB + kstep, voffB); PG8_STAGE(PG8_SA(1, 0), cA + kstep, voffA); PG8_STAGE(PG8_SB(1, 1), cB + hstep + kstep, voffB);
        PG8_WAIT_V(6); PG8_BAR;
    }
    for (;;) {
        const bool has_next = S.next(ui + 1, nxt);
        const char* nA = has_next ? (const char*)g.A + (size_t)nxt.pm * tstep : cA; const char* nB = has_next ? (const char*)g.Bt + (size_t)nxt.pn * tstep : cB;
        for (int t = 0; t < nt; t += 2) {
            const bool last = (t == nt - 2);
            const char* a1 = cA + (size_t)(t + 1) * kstep;
            const char* a2 = last ? nA : cA + (size_t)(t + 2) * kstep; const char* b2 = last ? nB : cB + (size_t)(t + 2) * kstep;
            const char* a3 = a2 + kstep; const char* b3 = b2 + kstep;
            if (last && has_next) S.a_ready(nxt);
            if constexpr (Epi::MIDK > 0) { if (t == Epi::MIDK) E.mid(acc, cur, wr, wc, fr, fq); }
            if constexpr (SP2) {
            PG8_LDB(B0, 0, 0); PG8_LDB(B1, 0, 1); PG8_SCHED; PG8_LDA(At, 0, 0); PG8_STAGE(PG8_SA(1, 1), a1 + hstep, voffA);
            PG8_WAIT_V(8); PG8_WAIT_L(0); PG8_BAR; PG8_MMA(0, 0, At, B0); PG8_MMA(0, 1, At, B1); PG8_BAR; PG8_SCHED;
            PG8_LDA(At, 0, 1); PG8_STAGE(PG8_SB(0, 0), b2, voffB); PG8_STAGE(PG8_SB(0, 1), b2 + hstep, voffB); PG8_STAGE(PG8_SA(0, 0), a2, voffA);
            PG8_WAIT_V(8); PG8_WAIT_L(0); PG8_BAR; PG8_MMA(1, 0, At, B0); PG8_MMA(1, 1, At, B1); PG8_BAR; PG8_SCHED;
            PG8_LDB(B0, 1, 0); PG8_LDB(B1, 1, 1); PG8_SCHED; PG8_LDA(At, 1, 0); PG8_STAGE(PG8_SA(0, 1), a2 + hstep, voffA);
            PG8_WAIT_V(8); PG8_WAIT_L(0); PG8_BAR; PG8_MMA(0, 0, At, B0); PG8_MMA(0, 1, At, B1); PG8_BAR; PG8_SCHED;
            PG8_LDA(At, 1, 1); PG8_STAGE(PG8_SB(1, 0), b3, voffB); PG8_STAGE(PG8_SB(1, 1), b3 + hstep, voffB); PG8_STAGE(PG8_SA(1, 0), a3, voffA);
            PG8_WAIT_V(8); PG8_WAIT_L(0); PG8_BAR; PG8_MMA(1, 0, At, B0); PG8_MMA(1, 1, At, B1); PG8_BAR; PG8_SCHED;
            } else {
            PG8_LDB(B0, 0, 0); PG8_SCHED; PG8_LDA(At, 0, 0); PG8_STAGE(PG8_SA(1, 1), a1 + hstep, voffA);
            PG8_WAIT_L(8); PG8_BAR; PG8_WAIT_L(0); PG8_MMA(0, 0, At, B0); PG8_BAR; PG8_SCHED;
            PG8_LDB(B1, 0, 1); PG8_STAGE(PG8_SB(0, 0), b2, voffB);
            PG8_BAR; PG8_WAIT_L(0); PG8_MMA(0, 1, At, B1); PG8_BAR;
            PG8_LDA(At, 0, 1); PG8_STAGE(PG8_SA(0, 0), a2, voffA);
            PG8_BAR; PG8_WAIT_L(0); PG8_MMA(1, 0, At, B0); PG8_BAR; PG8_SCHED;
            PG8_STAGE(PG8_SB(0, 1), b2 + hstep, voffB);
            PG8_WAIT_V(6); PG8_BAR; PG8_MMA(1, 1, At, B1); PG8_BAR;
            PG8_LDB(B0, 1, 0); PG8_SCHED; PG8_LDA(At, 1, 0); PG8_STAGE(PG8_SA(0, 1), a2 + hstep, voffA);
            PG8_WAIT_L(8); PG8_BAR; PG8_WAIT_L(0); PG8_MMA(0, 0, At, B0); PG8_BAR; PG8_SCHED;
            PG8_LDB(B1, 1, 1); PG8_STAGE(PG8_SB(1, 0), b3, voffB);
            PG8_BAR; PG8_WAIT_L(0); PG8_MMA(0, 1, At, B1); PG8_BAR;
            PG8_LDA(At, 1, 1); PG8_STAGE(PG8_SA(1, 0), a3, voffA);
            PG8_BAR; PG8_WAIT_L(0); PG8_MMA(1, 0, At, B0); PG8_BAR; PG8_SCHED;
            PG8_STAGE(PG8_SB(1, 1), b3 + hstep, voffB);
            PG8_WAIT_V(6); PG8_BAR; PG8_MMA(1, 1, At, B1); PG8_BAR;
            }
        }
        if constexpr (ALIGN_EPI) { if (wr == 0) PG8_BAR; }
        if constexpr (!Epi::AFTER_DRAIN) { E(acc, cur, wr, wc, fr, fq); S.done(cur); }
        if (!has_next) break;
#pragma unroll
        for (int a = 0; a < 2; ++a)
#pragma unroll
            for (int b = 0; b < 2; ++b)
#pragma unroll
                for (int m = 0; m < 4; ++m)
#pragma unroll
                    for (int n = 0; n < 2; ++n) acc[a][b][m][n] = (f32x4){0.f, 0.f, 0.f, 0.f};
        cur = nxt; cA = nA; cB = nB; ++ui;
        if constexpr (ALIGN_EPI) { if (wr == 1) PG8_BAR; }
    }
    PG8_WAIT_V(0);
    if constexpr (!ALIGN_EPI) { if (wr == 0) PG8_BAR; }
    PG8_BAR;
    if constexpr (Epi::AFTER_DRAIN) { E.fused(acc, cur, wr, wc, fr, fq, lds, wid, lane); S.done(cur); }
#undef PG8_SA
#undef PG8_SB
#undef PG8_STAGE
#undef PG8_LDA
#undef PG8_LDB
#undef PG8_MMA
#undef PG8_WAIT_V
#undef PG8_WAIT_L
#undef PG8_BAR
#undef PG8_SCHED
}
}
#ifndef DBG_SCALE3
#define DBG_SCALE3 0
#endif
#ifndef DBG_ZERO
#define DBG_ZERO 0
#endif
#ifndef LAST_PHASE
#define LAST_PHASE 4
#endif
#ifndef REP_P0
#define REP_P0 1
#endif
#ifndef REP_P1
#define REP_P1 1
#endif
#ifndef REP_P2A
#define REP_P2A 1
#endif
#ifndef REP_P0T
#define REP_P0T 1
#endif
#ifndef REP_P0R
#define REP_P0R 1
#endif
#ifndef REP_S2
#define REP_S2 1
#endif
#ifndef REP_S3
#define REP_S3 1
#endif
#ifndef REP_S4
#define REP_S4 1
#endif
#ifndef REP_ATOM
#define REP_ATOM 1
#endif
#ifndef REP_SSD
#define REP_SSD 1
#endif
#ifndef REP_WIN
#define REP_WIN 1
#endif
#ifndef REP_MEM
#define REP_MEM 1
#endif
#ifndef REP_P3
#define REP_P3 1
#endif
#define DI __device__ __forceinline__
#define LAS __attribute__((address_space(3)))
typedef unsigned short bf16_t;
typedef short bf16x8 __attribute__((ext_vector_type(8)));
typedef float f32x4 __attribute__((ext_vector_type(4)));
typedef float f32x2 __attribute__((ext_vector_type(2)));
typedef unsigned u32x4 __attribute__((ext_vector_type(4)));
typedef unsigned u32x2 __attribute__((ext_vector_type(2)));

constexpr int NB_P = 16, T_P = 4096, NB_S = 32, T_S = 64, DM = 1024;
constexpr int MP = NB_P * T_P, MS = NB_S * T_S, MTOT = MP + MS;
constexpr int MMEM = NB_P * 256, MA = MTOT + MMEM;
constexpr int NPROJ = 4864, NBT = NPROJ + 1024, INC = 4880;
constexpr int C_Q = 0, C_K = 512, C_V = 640, C_GA = 768, C_Z = 1280, C_XBC = 2304, C_MQ = 3840, C_GM = 4352;
constexpr int NCHUNK = MTOT / 64;
constexpr float EPSF = 1e-6f;
constexpr size_t O_Y = 0;
constexpr size_t O_WKP = (size_t)MTOT * 1024;
constexpr size_t O_WVP = O_WKP + (size_t)NB_P * 128 * 128;
constexpr size_t O_SSMP = O_WVP + (size_t)NB_P * 128 * 128;
constexpr size_t O_CONVP = O_SSMP + (size_t)NB_P * 16 * 64 * 128;
constexpr size_t O_MKP = O_CONVP + (size_t)NB_P * 3 * 1536;
constexpr size_t O_MVP = O_MKP + (size_t)NB_P * 256 * 512;
constexpr size_t O_WKS = O_MVP + (size_t)NB_P * 256 * 512;
constexpr size_t O_WVS = O_WKS + (size_t)NB_S * 128 * 128;
constexpr size_t O_SSMS = O_WVS + (size_t)NB_S * 128 * 128;
constexpr size_t O_CONVS = O_SSMS + (size_t)NB_S * 16 * 64 * 128;
constexpr size_t O_END = O_CONVS + (size_t)NB_S * 3 * 1536;
static_assert(O_END == 81485824, "output size");
constexpr size_t MiB = 1u << 20;
constexpr size_t WS_ROPE = 1 * MiB;
constexpr size_t WS_BT = 2 * MiB;
constexpr size_t WS_WOUT = 14 * MiB;
constexpr size_t WS_DT = 18 * MiB;
constexpr size_t WS_SSQ = 23 * MiB;
constexpr size_t WS_CTL = 0, CTL_ZERO_BYTES = 65536;
constexpr size_t WS_MEMRAW = 32 * MiB;
constexpr size_t WS_MEMK = 40 * MiB;
constexpr size_t WS_MEMVT = 52 * MiB;
constexpr size_t WS_PROJ = 64 * MiB;
constexpr size_t WS_A = 692 * MiB;
constexpr size_t WS_MIX = 692 * MiB;
constexpr size_t WS_BCC = 956 * MiB;
constexpr size_t WS_END = 1022 * MiB;
static_assert(WS_BT + (size_t)NBT * 1024 * 2 <= WS_WOUT && WS_DT + (size_t)MTOT * 64 <= WS_SSQ && WS_SSQ + (size_t)MTOT * 128 <= WS_MEMRAW, "ws map 1");
static_assert(WS_PROJ + (size_t)MTOT * NPROJ * 2 <= WS_A && WS_A + (size_t)MA * 1024 * 2 <= WS_END && WS_MIX + (size_t)MTOT * 2048 * 2 <= WS_BCC && WS_BCC + (size_t)MTOT * 512 * 2 <= WS_END, "ws map 2");
constexpr int LDS_BYTES = 147456;

DI float bf2f(unsigned short b) { return __uint_as_float((unsigned)b << 16); }
typedef __bf16 hbf2 __attribute__((ext_vector_type(2)));
DI unsigned short f2bf(float f) { return __builtin_bit_cast(unsigned short, (__bf16)f); }
DI unsigned pk2(float lo, float hi) { const f32x2 v = {lo, hi}; return __builtin_bit_cast(unsigned, __builtin_convertvector(v, hbf2)); }
DI unsigned cvt_pk_bf16(float lo, float hi) { return pk2(lo, hi); }
DI float siluf(float x) { return x * __builtin_amdgcn_rcpf(1.0f + __expf(-x)); }
DI float xor32_sum(float x) { unsigned u = __builtin_bit_cast(unsigned, x); unsigned u2 = u; asm volatile("" : "+v"(u2)); auto r = __builtin_amdgcn_permlane32_swap(u, u2, false, false); unsigned r0 = r[0], r1 = r[1]; return __builtin_bit_cast(float, r0) + __builtin_bit_cast(float, r1); }
DI float xor16_sum(float x) { unsigned u = __builtin_bit_cast(unsigned, x); unsigned u2 = u; asm volatile("" : "+v"(u2)); auto r = __builtin_amdgcn_permlane16_swap(u, u2, false, false); unsigned r0 = r[0], r1 = r[1]; return __builtin_bit_cast(float, r0) + __builtin_bit_cast(float, r1); }
DI float xor32_max(float x) { unsigned u = __builtin_bit_cast(unsigned, x); unsigned u2 = u; asm volatile("" : "+v"(u2)); auto r = __builtin_amdgcn_permlane32_swap(u, u2, false, false); unsigned r0 = r[0], r1 = r[1]; return fmaxf(__builtin_bit_cast(float, r0), __builtin_bit_cast(float, r1)); }
DI float xor16_max(float x) { unsigned u = __builtin_bit_cast(unsigned, x); unsigned u2 = u; asm volatile("" : "+v"(u2)); auto r = __builtin_amdgcn_permlane16_swap(u, u2, false, false); unsigned r0 = r[0], r1 = r[1]; return fmaxf(__builtin_bit_cast(float, r0), __builtin_bit_cast(float, r1)); }
#define DPP_ROR_(v, n) __builtin_bit_cast(float, __builtin_amdgcn_update_dpp(0, __builtin_bit_cast(int, (v)), 0x120 + (n), 0xf, 0xf, false))
DI float row16_sum(float v) { v += DPP_ROR_(v, 8); v += DPP_ROR_(v, 4); v += DPP_ROR_(v, 2); v += DPP_ROR_(v, 1); return v; }
DI float wave_sum(float v) { return xor32_sum(xor16_sum(row16_sum(v))); }
DI void unpack8(const u32x4 v, float (&o)[8]) {
#pragma unroll
    for (int i = 0; i < 4; ++i) { o[2 * i] = __uint_as_float(v[i] << 16); o[2 * i + 1] = __uint_as_float(v[i] & 0xffff0000u); }
}
DI u32x4 pack8(const float (&o)[8]) { u32x4 v; v.x = pk2(o[0], o[1]); v.y = pk2(o[2], o[3]); v.z = pk2(o[4], o[5]); v.w = pk2(o[6], o[7]); return v; }
#define LDS_WAIT() asm volatile("s_waitcnt lgkmcnt(0)" ::: "memory")
#define MFMA16(a, b, c) __builtin_amdgcn_mfma_f32_16x16x32_bf16((a), (b), (c), 0, 0, 0)

struct Args { const float* in[26]; float* out; unsigned char* ws; };
struct Ctx {
    LAS unsigned char* lds; int tid, lane, wave, G, bid;
    const float* in[26]; float* out; unsigned char* ws;
};
#define RLX_AGENT __ATOMIC_RELAXED, __HIP_MEMORY_SCOPE_AGENT
#define XB_TMO      128
#define XB_XCNT(j)  (256  + 64 * (j))
#define XB_XSUB(j)  (1280 + 64 * (j))
#define XB_XGEN(j)  (2304 + 64 * (j))
#define XB_TOP      3328
#define XB_TOPGEN   3392
#define XCD_BAR_WORDS 3456
#define XB_SPIN_CAP (1u << 18)

__device__ __forceinline__ unsigned xb_ld(unsigned* p)              { return __hip_atomic_load(p, __ATOMIC_RELAXED, __HIP_MEMORY_SCOPE_AGENT); }
__device__ __forceinline__ unsigned xb_add(unsigned* p, unsigned v) { return __hip_atomic_fetch_add(p, v, __ATOMIC_RELAXED, __HIP_MEMORY_SCOPE_AGENT); }
__device__ __forceinline__ unsigned xb_xcc_id() { return (unsigned)__builtin_amdgcn_s_getreg((3 << 11) | 20) & 0xFu; }
#define XB_SPIN(cond, bar) do { unsigned _sp = 0; while (cond) { __builtin_amdgcn_s_sleep(1); \
    if ((++_sp & 255u) == 0u) { if (xb_ld(&(bar)[XB_TMO])) break; if (_sp > XB_SPIN_CAP) { atomicAdd(&(bar)[XB_TMO], 1u); break; } } } } while (0)

struct XcdBarrier {
    unsigned* bar; unsigned x;
    volatile LAS unsigned* st;
};

__device__ __forceinline__ XcdBarrier xcd_barrier_post(unsigned* bar, volatile LAS unsigned* st) {
    XcdBarrier b; b.bar = bar; b.x = xb_xcc_id(); b.st = st;
    if (threadIdx.x == 0) (void)xb_add(&bar[XB_XCNT(b.x)], 1u);
    return b;
}
__device__ __forceinline__ void xcd_barrier_complete(unsigned* bar, unsigned x, unsigned& nloc, unsigned& nx) {
    const unsigned G = gridDim.x * gridDim.y * gridDim.z;
    unsigned sum, cnt, mine, sp = 0u;
    for (;;) {
        sum = 0u; cnt = 0u; mine = 0u;
#pragma unroll
        for (unsigned j = 0; j < 16; ++j) { const unsigned c = xb_ld(&bar[XB_XCNT(j)]); sum += c; cnt += (c > 0u) ? 1u : 0u; mine = (j == x) ? c : mine; }
        if (sum == G) break;
        __builtin_amdgcn_s_sleep(1);
        if ((++sp & 255u) == 0u) { if (xb_ld(&bar[XB_TMO])) break; if (sp > XB_SPIN_CAP) { atomicAdd(&bar[XB_TMO], 1u); break; } }
    }
    nloc = mine > 0u ? mine : 1u; nx = cnt > 0u ? cnt : 1u;
}

__device__ __forceinline__ void xcd_barrier(const XcdBarrier& b) {
    asm volatile("s_waitcnt vmcnt(0)" ::: "memory");
    __syncthreads();
    if (threadIdx.x == 0) {
        unsigned* bar = b.bar;
        __builtin_amdgcn_s_waitcnt(0);
        unsigned nloc = b.st[0], nx = b.st[1];
        if (nloc == 0u) { xcd_barrier_complete(bar, b.x, nloc, nx); b.st[0] = nloc; b.st[1] = nx; }
        const unsigned old = xb_add(&bar[XB_XSUB(b.x)], 1u);
        const unsigned gen = old / nloc;
        if (old + 1u == (gen + 1u) * nloc) {
            __builtin_amdgcn_fence(__ATOMIC_RELEASE, "agent");
            asm volatile("s_waitcnt vmcnt(0)" ::: "memory");
            const unsigned og = xb_add(&bar[XB_TOP], 1u);
            const unsigned tg = og / nx;
            if (og + 1u == (tg + 1u) * nx) xb_add(&bar[XB_TOPGEN], 1u);
            else XB_SPIN(xb_ld(&bar[XB_TOPGEN]) == tg, bar);
            __builtin_amdgcn_fence(__ATOMIC_ACQUIRE, "agent");
            xb_add(&bar[XB_XGEN(b.x)], 1u);
            asm volatile("s_waitcnt vmcnt(0)" ::: "memory");
        } else {
            XB_SPIN(xb_ld(&bar[XB_XGEN(b.x)]) == gen, bar);
            __builtin_amdgcn_fence(__ATOMIC_ACQUIRE, "agent");
            asm volatile("s_waitcnt vmcnt(0)" ::: "memory");
        }
    }
    __syncthreads();
}

enum { I_XP = 0, I_XS, I_CWK, I_CWV, I_SSM, I_SCONV, I_CMK, I_CMV, I_MEM, I_GNORM, I_WIN, I_GQ, I_GK, I_SINKS, I_CONVW, I_CONVB, I_DTB, I_ALOG, I_DSKIP, I_GSSD, I_GMEM, I_WMK, I_WMV, I_GMK, I_GMQ, I_WOUT };

DI void p0_transpose_item(const float* W, int ldw, int src_k0, int src_n0, const float* rowscale, bf16_t* WT, int ldt, int dst_n0, int dst_k0, LAS float* scr, int lane) {
#pragma unroll 8
    for (int i = 0; i < 32; ++i) { const int kk = 2 * i + (lane >> 5); float v = W[(size_t)(src_k0 + kk) * ldw + src_n0 + (lane & 31)]; if (rowscale) v *= rowscale[kk]; scr[kk * 33 + (lane & 31)] = v; }
    LDS_WAIT();
    const int c = lane & 7;
#pragma unroll
    for (int j = 0; j < 4; ++j) { const int n = (lane >> 3) + 8 * j; const LAS float* s = scr + (8 * c) * 33 + n;
        u32x4 o; o.x = pk2(s[0 * 33], s[1 * 33]); o.y = pk2(s[2 * 33], s[3 * 33]); o.z = pk2(s[4 * 33], s[5 * 33]); o.w = pk2(s[6 * 33], s[7 * 33]);
        *(u32x4*)(WT + (size_t)(dst_n0 + n) * ldt + dst_k0 + 8 * c) = o; }
    LDS_WAIT();
}

DI float reduce16_to_lane(float (&a)[16], int lane) {
#pragma unroll
    for (int j = 0; j < 16; ++j) { a[j] += __shfl_xor(a[j], 32); a[j] += __shfl_xor(a[j], 16); }
    float r8[8], r4[4], r2[2];
    const bool b3 = (lane & 8) != 0, b2 = (lane & 4) != 0, b1 = (lane & 2) != 0, b0 = (lane & 1) != 0;
#pragma unroll
    for (int j = 0; j < 8; ++j) { const float snd = b3 ? a[j] : a[j + 8], kp = b3 ? a[j + 8] : a[j]; r8[j] = kp + __shfl_xor(snd, 8); }
#pragma unroll
    for (int j = 0; j < 4; ++j) { const float snd = b2 ? r8[j] : r8[j + 4], kp = b2 ? r8[j + 4] : r8[j]; r4[j] = kp + __shfl_xor(snd, 4); }
#pragma unroll
    for (int j = 0; j < 2; ++j) { const float snd = b1 ? r4[j] : r4[j + 2], kp = b1 ? r4[j + 2] : r4[j]; r2[j] = kp + __shfl_xor(snd, 2); }
    const float snd = b0 ? r2[0] : r2[1], kp = b0 ? r2[1] : r2[0];
    return kp + __shfl_xor(snd, 1);
}

DI void p0_rows2(f32x4 (&va)[4], f32x4 (&vb)[4], const float* g, bf16_t* oa, bf16_t* ob, float* dta, float* dtb, bool want_dt, const float* dt_bias, const LAS float* wdt, int lane) {
    float sa = 0.f, sb = 0.f;
#pragma unroll
    for (int jj = 0; jj < 4; ++jj) { sa += (va[jj].x * va[jj].x + va[jj].y * va[jj].y) + (va[jj].z * va[jj].z + va[jj].w * va[jj].w); sb += (vb[jj].x * vb[jj].x + vb[jj].y * vb[jj].y) + (vb[jj].z * vb[jj].z + vb[jj].w * vb[jj].w); }
    const float ra = 1.0f / sqrtf(wave_sum(sa) * (1.0f / DM) + EPSF), rb = 1.0f / sqrtf(wave_sum(sb) * (1.0f / DM) + EPSF);
    u32x2* pa = (u32x2*)oa + lane; u32x2* pb = (u32x2*)ob + lane;
#pragma unroll
    for (int jj = 0; jj < 4; ++jj) { const f32x4 gv = ((const f32x4*)g)[64 * jj + lane]; va[jj] = va[jj] * ra * gv; vb[jj] = vb[jj] * rb * gv;
        u32x2 w; w.x = pk2(va[jj].x, va[jj].y); w.y = pk2(va[jj].z, va[jj].w); pa[64 * jj] = w; w.x = pk2(vb[jj].x, vb[jj].y); w.y = pk2(vb[jj].z, vb[jj].w); pb[64 * jj] = w; }
    if (want_dt) {
        f32x2 ab[16];
#pragma unroll
        for (int j = 0; j < 16; ++j) ab[j] = (f32x2){0.f, 0.f};
#pragma unroll
        for (int jj = 0; jj < 4; ++jj)
#pragma unroll
            for (int e = 0; e < 4; ++e) { const f32x2 hab = {va[jj][e], vb[jj][e]}; const LAS f32x4* wr = (const LAS f32x4*)(wdt + ((jj * 4 + e) * 64 + lane) * 20);
#pragma unroll
                for (int q = 0; q < 4; ++q) { const f32x4 w4 = wr[q];
                    ab[4 * q] += hab * w4.x; ab[4 * q + 1] += hab * w4.y; ab[4 * q + 2] += hab * w4.z; ab[4 * q + 3] += hab * w4.w; }
                if (e & 1) __builtin_amdgcn_sched_barrier(0); }
        float a[16], b[16];
#pragma unroll
        for (int j = 0; j < 16; ++j) { a[j] = ab[j].x; b[j] = ab[j].y; }
        const bool b5 = (lane & 32) != 0, b4 = (lane & 16) != 0, b3 = (lane & 8) != 0, b2 = (lane & 4) != 0, b1 = (lane & 2) != 0;
        float v16[16], v8[8], v4[4], v2[2];
#pragma unroll
        for (int j = 0; j < 16; ++j) { const float snd = b5 ? a[j] : b[j], kp = b5 ? b[j] : a[j]; v16[j] = kp + __shfl_xor(snd, 32); }
#pragma unroll
        for (int j = 0; j < 8; ++j) { const float snd = b4 ? v16[j] : v16[j + 8], kp = b4 ? v16[j + 8] : v16[j]; v8[j] = kp + __shfl_xor(snd, 16); }
#pragma unroll
        for (int j = 0; j < 4; ++j) { const float snd = b3 ? v8[j] : v8[j + 4], kp = b3 ? v8[j + 4] : v8[j]; v4[j] = kp + __shfl_xor(snd, 8); }
#pragma unroll
        for (int j = 0; j < 2; ++j) { const float snd = b2 ? v4[j] : v4[j + 2], kp = b2 ? v4[j + 2] : v4[j]; v2[j] = kp + __shfl_xor(snd, 4); }
        float tot; { const float snd = b1 ? v2[0] : v2[1], kp = b1 ? v2[1] : v2[0]; tot = kp + __shfl_xor(snd, 2); }
        tot += __shfl_xor(tot, 1);
        if ((lane & 1) == 0) { const int j = (lane >> 1) & 15; const float xv = tot + dt_bias[j]; float* dp = b5 ? dtb : dta;
            dp[j] = fmaxf(xv, 0.f) + log1pf(__expf(-fabsf(xv))); }
    }
}

DI void p0_row_segment(Ctx& F, const float* src, const float* g, int m0, int npair, bool tok, bf16_t* A, float* DT, const LAS float* wdt, int gw, int NGW) {
    const int lane = F.lane;
    f32x4 n0a[4], n0b[4], n1a[4], n1b[4];
#define P0_LOAD(dst_a, dst_b, pp) do { if ((pp) < npair) { _Pragma("unroll") for (int jj = 0; jj < 4; ++jj) { \
        dst_a[jj] = ((const f32x4*)(src + (size_t)(2 * (pp)) * DM))[64 * jj + lane]; dst_b[jj] = ((const f32x4*)(src + (size_t)(2 * (pp) + 1) * DM))[64 * jj + lane]; } } } while (0)
    P0_LOAD(n0a, n0b, gw); P0_LOAD(n1a, n1b, gw + NGW);
    for (int p = gw; p < npair; p += NGW) {
        f32x4 va[4], vb[4];
#pragma unroll
        for (int jj = 0; jj < 4; ++jj) { va[jj] = n0a[jj]; vb[jj] = n0b[jj]; n0a[jj] = n1a[jj]; n0b[jj] = n1b[jj]; }
        P0_LOAD(n1a, n1b, p + 2 * NGW);
        const int m = m0 + 2 * p;
        p0_rows2(va, vb, g, A + (size_t)m * DM, A + (size_t)(m + 1) * DM, DT + (size_t)(tok ? m : 0) * 16, DT + (size_t)(tok ? m + 1 : 0) * 16, tok, F.in[I_DTB], wdt, lane);
    }
#undef P0_LOAD
}

DI void p0_prologue(Ctx& F) {
    const int gw = F.bid * 8 + F.wave, NGW = F.G * 8, lane = F.lane;
    bf16_t* BT = (bf16_t*)(F.ws + WS_BT); bf16_t* WOT = (bf16_t*)(F.ws + WS_WOUT);
    for (int rep_ = 0; rep_ < REP_P0T; ++rep_) {
        LAS float* scr = (LAS float*)(F.lds + F.wave * 16384);
        constexpr int I_IN = 16 * (NPROJ / 32), I_M = 16 * 32, I_O = 32 * 32;
        for (int it = gw; it < I_IN + I_M + I_O; it += NGW) {
            int r = it;
            if (r < I_IN) { const int kb = r / (NPROJ / 32), nb = r % (NPROJ / 32); const int n0 = 32 * nb;
                p0_transpose_item(F.in[I_WIN], INC, 64 * kb, n0 + (n0 >= 3840 ? 16 : 0), nullptr, BT, 1024, n0, 64 * kb, scr, lane); continue; }
            r -= I_IN;
            if (r < I_M) { const int kb = r / 32, nb = r % 32;
                p0_transpose_item(nb < 16 ? F.in[I_WMK] : F.in[I_WMV], 512, 64 * kb, 32 * (nb & 15), nullptr, BT, 1024, NPROJ + 32 * nb, 64 * kb, scr, lane); continue; }
            r -= I_M;
            { const int kb = r / 32, nb = r % 32; const int k0 = 64 * kb;
              const int sk0 = k0 < 1024 ? 512 + k0 : (k0 < 1536 ? k0 - 1024 : k0);
              p0_transpose_item(F.in[I_WOUT], 1024, sk0, 32 * nb, k0 < 1024 ? F.in[I_GSSD] + k0 : nullptr, WOT, 2048, 32 * nb, k0, scr, lane); }
        }
    }
    { float* sq = (float*)(F.ws + WS_SSQ); for (int i = F.bid * 512 + F.tid; i < MTOT; i += F.G * 512) sq[i] = 0.f; }
    {
        f32x2* rope = (f32x2*)(F.ws + WS_ROPE);
        for (int i = F.bid * 512 + F.tid; i < 4096 * 32; i += F.G * 512) {
            const int pos = i >> 5, fi = i & 31;
            const float freq = exp2f(-(float)fi * (13.287712379549449f / 32.0f));
            double rev = (double)pos * (double)freq * 0.15915494309189535;
            rev -= __builtin_rint(rev);
            const float ang = (float)(rev * 6.283185307179586);
            rope[i] = (f32x2){cosf(ang), sinf(ang)};
        }
    }
    __syncthreads();
    for (int rep_ = 0; rep_ < REP_P0R; ++rep_) {
        if (rep_) __syncthreads();
        LAS float* wdt = (LAS float*)F.lds;
#pragma unroll 1
        for (int i0 = F.tid; i0 < 1024 * 16; i0 += 512 * 8) { float t8[8];
#pragma unroll
            for (int u = 0; u < 8; ++u) { const int i = i0 + 512 * u; t8[u] = F.in[I_WIN][(size_t)(i >> 4) * INC + 3840 + (i & 15)]; }
#pragma unroll
            for (int u = 0; u < 8; ++u) { const int i = i0 + 512 * u, k = i >> 4, j = i & 15; const int jj = k >> 8, e = k & 3, l = (k >> 2) & 63;
                wdt[((jj * 4 + e) * 64 + l) * 20 + j] = t8[u]; } }
        __syncthreads();
        bf16_t* A = (bf16_t*)(F.ws + WS_A); float* DT = (float*)(F.ws + WS_DT);
        p0_row_segment(F, F.in[I_XP], F.in[I_GNORM], 0, MP / 2, true, A, DT, wdt, gw, NGW);
        p0_row_segment(F, F.in[I_XS], F.in[I_GNORM], MP, MS / 2, true, A, DT, wdt, gw, NGW);
        p0_row_segment(F, F.in[I_MEM], F.in[I_GMEM], MTOT, MMEM / 2, false, A, DT, wdt, gw, NGW);
    }
}
struct Order1 {
    pg8::StaticOrder so; int G, c;
    __device__ void init(int G_, int c_) { so.init(MTOT, NPROJ, G_, c_); G = G_; c = c_; }
    __device__ bool next(int i, pg8::Unit& u) const {
        long L = (long)i * G + c;
        if (L >= (long)REP_P1 * (so.nwg + 64)) return false;
        L %= (so.nwg + 64);
        if (L < so.nwg) { pg8::StaticOrder t = so; t.G = 1; t.c = 0; return t.next((int)L, u); }
        const int r = (int)(L - so.nwg);
        u.pm = MTOT / 256 + (r >> 2); u.pn = NPROJ / 256 + (r & 3); return true;
    }
    __device__ __forceinline__ void a_ready(const pg8::Unit&) const {}
    __device__ __forceinline__ void done(const pg8::Unit&) const {}
};
struct Order3 {
    pg8::StaticOrder so; int G, c;
    __device__ void init(int G_, int c_) { so.init(MP, 1024, 1, 0); G = G_; c = c_; }
    __device__ bool next(int i, pg8::Unit& u) const {
        long L = (long)i * G + c;
        if (L >= (long)REP_P3 * so.nwg) return false;
        return so.next((int)(L % so.nwg), u);
    }
    __device__ __forceinline__ void a_ready(const pg8::Unit&) const {}
    __device__ __forceinline__ void done(const pg8::Unit&) const {}
};
struct EpiProj {
    static constexpr bool PERM = true, AFTER_DRAIN = false; static constexpr int MIDK = 0;
    bf16_t* proj; bf16_t* memraw;
    __device__ __forceinline__ void operator()(const f32x4 (&acc)[2][2][4][2], const pg8::Unit& u, int wr, int wc, int fr, int fq) const {
        bf16_t* base; int ldc, row0, col0;
        if (u.pn < NPROJ / 256) { base = proj; ldc = NPROJ; row0 = u.pm * 256; col0 = u.pn * 256; }
        else { base = memraw; ldc = 1024; row0 = (u.pm - MTOT / 256) * 256; col0 = (u.pn - NPROJ / 256) * 256; }
        row0 += wr * 64 + fr; col0 += wc * 32 + 8 * fq;
#pragma unroll
        for (int ai = 0; ai < 2; ++ai)
#pragma unroll
            for (int m = 0; m < 4; ++m) { bf16_t* rowp = base + (size_t)(row0 + ai * 128 + m * 16) * ldc + col0;
#pragma unroll
                for (int bj = 0; bj < 2; ++bj) { const f32x4 v0 = acc[ai][bj][m][0], v1 = acc[ai][bj][m][1];
                    u32x4 w; w.x = cvt_pk_bf16(v0[0], v0[1]); w.y = cvt_pk_bf16(v0[2], v0[3]); w.z = cvt_pk_bf16(v1[0], v1[1]); w.w = cvt_pk_bf16(v1[2], v1[3]);
                    *(u32x4*)(rowp + bj * 128) = w; } }
    }
};
struct EpiOut {
    static constexpr bool PERM = false, AFTER_DRAIN = false; static constexpr int MIDK = 16;
    const float* xp; const float* xs; float* out; const float* sumsq;
    __device__ __forceinline__ void mid(f32x4 (&acc)[2][2][4][2], const pg8::Unit& u, int wr, int wc, int fr, int fq) const {
        const float* sq = sumsq + (size_t)u.pm * 256 + wr * 64 + fr;
#pragma unroll
        for (int ai = 0; ai < 2; ++ai)
#pragma unroll
            for (int m = 0; m < 4; ++m) { const float r = 1.0f / sqrtf(sq[ai * 128 + m * 16] * (1.0f / 1024.0f) + EPSF);
#pragma unroll
                for (int bj = 0; bj < 2; ++bj)
#pragma unroll
                    for (int n = 0; n < 2; ++n) acc[ai][bj][m][n] = acc[ai][bj][m][n] * r; }
    }
    __device__ __forceinline__ void operator()(const f32x4 (&acc)[2][2][4][2], const pg8::Unit& u, int wr, int wc, int fr, int fq) const {
        const float* xb = u.pm < MP / 256 ? xp + (size_t)u.pm * 256 * DM : xs + (size_t)(u.pm - MP / 256) * 256 * DM;
        float* ob = out + (size_t)u.pm * 256 * DM;
        const int rl0 = wr * 64 + fr, col0 = u.pn * 256 + wc * 32 + 4 * fq;
#pragma unroll
        for (int ai = 0; ai < 2; ++ai) {
            f32x4 xv[4][2][2];
#pragma unroll
            for (int m = 0; m < 4; ++m)
#pragma unroll
                for (int bj = 0; bj < 2; ++bj)
#pragma unroll
                    for (int n = 0; n < 2; ++n) xv[m][bj][n] = *(const f32x4*)(xb + (size_t)(rl0 + ai * 128 + m * 16) * DM + col0 + bj * 128 + n * 16);
#pragma unroll
            for (int m = 0; m < 4; ++m)
#pragma unroll
                for (int bj = 0; bj < 2; ++bj)
#pragma unroll
                    for (int n = 0; n < 2; ++n) *(f32x4*)(ob + (size_t)(rl0 + ai * 128 + m * 16) * DM + col0 + bj * 128 + n * 16) = acc[ai][bj][m][n] + xv[m][bj][n];
            asm volatile("" ::: "memory"); }
    }
};

constexpr int SS_X = 0, SS_XD = 9216, SS_BM = 18432, SS_CM = 35840, SS_SET = 53248;
constexpr int SS_SB = 2 * SS_SET, SS_WM = SS_SB + 17408, SS_SM = SS_WM + 9216;
constexpr int LD64 = 144, LD128 = 272;
typedef short s16x4 __attribute__((ext_vector_type(4)));

DI bf16x8 lds_frag(const LAS unsigned char* tile, int ld, int row0, int k0, int lane) {
    return *(const LAS bf16x8*)(tile + (row0 + (lane & 15)) * ld + (k0 + 8 * (lane >> 4)) * 2);
}
DI bf16x8 lds_frag_tr(const LAS unsigned char* tile, int ld, int k0, int c0, int lane) {
    const LAS unsigned char* a = tile + (k0 + 8 * (lane >> 4) + ((lane & 15) >> 2)) * ld + (c0 + 4 * (lane & 3)) * 2;
    const s16x4 lo = __builtin_amdgcn_ds_read_tr16_b64_v4i16((LAS s16x4*)a), hi = __builtin_amdgcn_ds_read_tr16_b64_v4i16((LAS s16x4*)(a + 4 * ld));
    return (bf16x8){lo.x, lo.y, lo.z, lo.w, hi.x, hi.y, hi.z, hi.w};
}
DI bf16x8 lds_frag_tr2(const LAS unsigned char* tile, int ld, int k0, int c0, int lane) {
    const LAS unsigned char* a = tile + (k0 + 4 * (lane >> 4) + ((lane & 15) >> 2)) * ld + (c0 + 4 * (lane & 3)) * 2;
    const s16x4 lo = __builtin_amdgcn_ds_read_tr16_b64_v4i16((LAS s16x4*)a), hi = __builtin_amdgcn_ds_read_tr16_b64_v4i16((LAS s16x4*)(a + 16 * ld));
    return (bf16x8){lo.x, lo.y, lo.z, lo.w, hi.x, hi.y, hi.z, hi.w};
}
#define MFMA16T(rowsfrag, colsfrag, acc) MFMA16((colsfrag), (rowsfrag), (acc))

#define DPP_ADD_(v, ctrl, rmask) ((v) + __builtin_bit_cast(float, __builtin_amdgcn_update_dpp(0, __builtin_bit_cast(int, (v)), (ctrl), (rmask), 0xf, false)))
DI float wave_incl_scan(float v) {
    v = DPP_ADD_(v, 0x111, 0xf); v = DPP_ADD_(v, 0x112, 0xf); v = DPP_ADD_(v, 0x114, 0xf); v = DPP_ADD_(v, 0x118, 0xf);
    v = DPP_ADD_(v, 0x142, 0xa);
    v = DPP_ADD_(v, 0x143, 0xc);
    return v;
}
DI void convbc_prepass(Ctx& F) {
    const int gw = F.bid * 8 + F.wave, NGW = F.G * 8, lane = F.lane;
    const bf16_t* PROJ = (const bf16_t*)(F.ws + WS_PROJ); bf16_t* BCC = (bf16_t*)(F.ws + WS_BCC);
    const int ch0 = 1024 + lane * 8;
    float wv[4][8], bv[8];
#pragma unroll
    for (int e = 0; e < 8; ++e) { bv[e] = F.in[I_CONVB][ch0 + e];
#pragma unroll
        for (int j = 0; j < 4; ++j) wv[j][e] = F.in[I_CONVW][j * 1536 + ch0 + e]; }
    const bool bal = (F.G == 256);
    const int nmine = bal ? (F.bid < 64 ? 0 : (F.bid < 128 ? 2 : 1)) : (MTOT / 33 - gw + NGW - 1) / NGW;
    for (int ti = 0; ti < nmine; ++ti) {
        const int t = bal ? (F.bid < 128 ? ((F.bid - 64) * 8 + F.wave) * 2 + ti : 1024 + (F.bid - 128) * 8 + F.wave) : gw + ti * NGW;
        const int row0 = t * 33;
        float h0[8], h1[8], h2[8];
        { const bool smp0 = row0 >= MP; const int lrow0 = smp0 ? (row0 - MP) & 63 : row0 & (T_P - 1);
          const float* sc0 = F.in[I_SCONV] + (size_t)(smp0 ? (row0 - MP) >> 6 : 0) * 3 * 1536 + ch0;
#define CONV_HALO(dst, j) do { const int lr_ = lrow0 - 3 + (j); \
              if (lr_ >= 0) unpack8(*(const u32x4*)(PROJ + (size_t)(row0 - 3 + (j)) * NPROJ + C_XBC + ch0), dst); \
              else { _Pragma("unroll") for (int e = 0; e < 8; ++e) dst[e] = smp0 ? sc0[(3 + lr_) * 1536 + e] : 0.f; } } while (0)
          CONV_HALO(h0, 0); CONV_HALO(h1, 1); CONV_HALO(h2, 2);
#undef CONV_HALO
        }
#pragma unroll 1
        for (int bt = 0; bt < 3; ++bt) {
            u32x4 raw[11];
#pragma unroll
            for (int i = 0; i < 11; ++i) raw[i] = *(const u32x4*)(PROJ + (size_t)(row0 + 11 * bt + i) * NPROJ + C_XBC + ch0);
#pragma unroll
            for (int i = 0; i < 11; ++i) { const int row = row0 + 11 * bt + i;
                const bool smp = row >= MP; const int lrow = smp ? (row - MP) & 63 : row & (T_P - 1);
                if (lrow == 0) {
                    if (smp) { const float* sc = F.in[I_SCONV] + (size_t)((row - MP) >> 6) * 3 * 1536 + ch0;
#pragma unroll
                        for (int e = 0; e < 8; ++e) { h0[e] = sc[e]; h1[e] = sc[1536 + e]; h2[e] = sc[2 * 1536 + e]; } }
                    else {
#pragma unroll
                        for (int e = 0; e < 8; ++e) { h0[e] = 0.f; h1[e] = 0.f; h2[e] = 0.f; } } }
                float cur[8], o[8];
                unpack8(raw[i], cur);
#pragma unroll
                for (int e = 0; e < 8; ++e) { o[e] = siluf(bv[e] + wv[0][e] * h0[e] + wv[1][e] * h1[e] + wv[2][e] * h2[e] + wv[3][e] * cur[e]); h0[e] = h1[e]; h1[e] = h2[e]; h2[e] = cur[e]; }
                *(u32x4*)(BCC + (size_t)row * 512 + lane * 8) = pack8(o); }
        }
    }
}

DI void ssd_item(Ctx& F, int sq, int h, bool do_sumsq) {
    LAS unsigned char* lds = F.lds;
    const int tid = F.tid, lane = F.lane, w = F.wave, g = h >> 3;
    const bool smp = sq >= NB_P; const int sb = sq - NB_P;
    const int row_base = smp ? MP + sb * 64 : sq * T_P, nchunks = smp ? 1 : 64;
    const bf16_t* PROJ = (const bf16_t*)(F.ws + WS_PROJ); const bf16_t* BCC = (const bf16_t*)(F.ws + WS_BCC); const float* DT = (const float*)(F.ws + WS_DT);
    bf16_t* MIX = (bf16_t*)(F.ws + WS_MIX); float* SUMSQ = (float*)(F.ws + WS_SSQ);
    const float a_h = -__expf(F.in[I_ALOG][h]), d_h = F.in[I_DSKIP][h];
    const int pt = w >> 1, nh = w & 1, lt = w >> 1;
    const int xl = tid >> 3, xg = tid & 7, chx = h * 64 + 8 * xg;
    LAS float* sm_cw0 = (LAS float*)(lds + SS_SM + 1024 + 768);
    if (tid >= 192 && tid < 512) { const int i = tid - 192; const int j = i >> 6, chn = h * 64 + (i & 63); sm_cw0[i] = j < 4 ? F.in[I_CONVW][j * 1536 + chn] : F.in[I_CONVB][chn]; }
    f32x4 st[4];
#pragma unroll
    for (int q = 0; q < 4; ++q) {
        if (smp) st[q] = *(const f32x4*)(F.in[I_SSM] + ((size_t)(sb * 16 + h) * 64 + 16 * pt + (lane & 15)) * 128 + 16 * (4 * nh + q) + 4 * (lane >> 4));
        else st[q] = (f32x4){0.f, 0.f, 0.f, 0.f};
    }
    u32x4 px0[4], px1[4], pbs[2], pcs[2]; u32x2 pz0[2], pz1[2]; float pdt0, pdt1;
#define SSD_ISSUE_X(c_, PX_) do { const int row0_ = row_base + 64 * (c_); \
        _Pragma("unroll") for (int j_ = 0; j_ < 4; ++j_) { int rr_ = xl - 3 + j_; if ((c_) == 0 && rr_ < 0) rr_ = 0; PX_[j_] = *(const u32x4*)(PROJ + (size_t)(row0_ + rr_) * NPROJ + C_XBC + chx); } } while (0)
#define SSD_ISSUE_BC(c_) do { const int row0_ = row_base + 64 * (c_); \
        _Pragma("unroll") for (int i_ = 0; i_ < 2; ++i_) { const int t_ = tid + 512 * i_; \
            pbs[i_] = *(const u32x4*)(BCC + (size_t)(row0_ + (t_ >> 4)) * 512 + g * 128 + 8 * (t_ & 15)); pcs[i_] = *(const u32x4*)(BCC + (size_t)(row0_ + (t_ >> 4)) * 512 + 256 + g * 128 + 8 * (t_ & 15)); } } while (0)
#define SSD_ISSUE_ZDT(c_, PZ_, PDT_) do { const int row0_ = row_base + 64 * (c_); \
        _Pragma("unroll") for (int pi_ = 0; pi_ < 2; ++pi_) PZ_[pi_] = *(const u32x2*)(PROJ + (size_t)(row0_ + 16 * lt + (lane & 15)) * NPROJ + C_Z + h * 64 + 16 * (2 * nh + pi_) + 4 * (lane >> 4)); \
        PDT_ = DT[(size_t)(row0_ + lane) * 16 + h]; } while (0)
    LAS float* sm_init = (LAS float*)(lds + SS_SM + 1024);
    if (tid < 192) sm_init[tid] = smp ? F.in[I_SCONV][(size_t)(sb * 3 + (tid >> 6)) * 1536 + h * 64 + (tid & 63)] : 0.f;
#define SSD_STEP(c, PX_, PZ_, PDT_) do { \
        const int row0 = row_base + 64 * c; LAS unsigned char* ts = lds + (c & 1) * SS_SET; \
        LAS float* sm_ac = (LAS float*)(lds + SS_SM + (c & 1) * 512); LAS float* sm_dt = sm_ac + 64; \
        const float dtl = PDT_; \
        float ac = dtl * a_h; \
        ac = wave_incl_scan(ac); \
        const float ac_last = __builtin_bit_cast(float, __builtin_amdgcn_readlane(__builtin_bit_cast(int, ac), 63)); \
        const float wgt_l = __expf(ac_last - ac) * dtl; \
        if (w == 0) { sm_ac[lane] = ac; sm_dt[lane] = dtl; } \
        { \
        { float xr[4][8], o[8], od[8]; \
_Pragma("unroll")           for (int j = 0; j < 4; ++j) unpack8(PX_[j], xr[j]); \
          if (c == 0) { \
_Pragma("unroll")               for (int j = 0; j < 3; ++j) { const int rr = xl - 3 + j; const LAS f32x4* iv = (const LAS f32x4*)(sm_init + (rr < 0 ? 3 + rr : 0) * 64 + 8 * xg); \
                  f32x4 i0 = iv[0], i1 = iv[1]; asm volatile("" : "+v"(i0), "+v"(i1)); \
_Pragma("unroll")                   for (int e = 0; e < 4; ++e) { xr[j][e] = (rr < 0) ? i0[e] : xr[j][e]; xr[j][4 + e] = (rr < 0) ? i1[e] : xr[j][4 + e]; } } } \
          const float wg = __shfl(wgt_l, xl & 63); \
          float wv[4][8], bv[8]; unsigned cwo_ = (unsigned)(8 * xg) * 4u; asm volatile("" : "+v"(cwo_)); const LAS float* sm_cw = (const LAS float*)((const LAS unsigned char*)sm_cw0 + cwo_) - 8 * xg; \
          _Pragma("unroll") for (int j_ = 0; j_ < 4; ++j_) { const f32x4 a_ = *(const LAS f32x4*)(sm_cw + j_ * 64 + 8 * xg), b_ = *(const LAS f32x4*)(sm_cw + j_ * 64 + 8 * xg + 4); \
              _Pragma("unroll") for (int e_ = 0; e_ < 4; ++e_) { wv[j_][e_] = a_[e_]; wv[j_][4 + e_] = b_[e_]; } } \
          { const f32x4 a_ = *(const LAS f32x4*)(sm_cw + 256 + 8 * xg), b_ = *(const LAS f32x4*)(sm_cw + 256 + 8 * xg + 4); _Pragma("unroll") for (int e_ = 0; e_ < 4; ++e_) { bv[e_] = a_[e_]; bv[4 + e_] = b_[e_]; } } \
_Pragma("unroll")           for (int e = 0; e < 8; ++e) { o[e] = siluf(bv[e] + wv[0][e] * xr[0][e] + wv[1][e] * xr[1][e] + wv[2][e] * xr[2][e] + wv[3][e] * xr[3][e]); od[e] = o[e] * wg; } \
          *(LAS u32x4*)(ts + SS_X + xl * LD64 + xg * 16) = pack8(o); \
          *(LAS u32x4*)(ts + SS_XD + xl * LD64 + xg * 16) = pack8(od); } \
_Pragma("unroll")         for (int i = 0; i < 2; ++i) { const int t = tid + 512 * i; \
            *(LAS u32x4*)(ts + SS_BM + (t >> 4) * LD128 + (t & 15) * 16) = pbs[i]; *(LAS u32x4*)(ts + SS_CM + (t >> 4) * LD128 + (t & 15) * 16) = pcs[i]; } \
        } \
        if (c + 2 < nchunks) SSD_ISSUE_X(c + 2, PX_); if (c + 1 < nchunks) SSD_ISSUE_BC(c + 1); \
        __syncthreads(); \
_Pragma("unroll")         for (int q = 0; q < 4; ++q) { u32x2 v; v.x = pk2(st[q][0], st[q][1]); v.y = pk2(st[q][2], st[q][3]); \
            *(LAS u32x2*)(lds + SS_SB + (16 * pt + (lane & 15)) * LD128 + (16 * (4 * nh + q) + 4 * (lane >> 4)) * 2) = v; } \
        { const float acl = sm_ac[16 * lt + (lane & 15)]; const int l = 16 * lt + (lane & 15); \
_Pragma("unroll")           for (int si = 0; si < 2; ++si) { const int stl = 2 * nh + si; f32x4 gacc = {0.f, 0.f, 0.f, 0.f}; \
              if (stl <= lt) { \
_Pragma("unroll")                   for (int ks = 0; ks < 4; ++ks) gacc = MFMA16T(lds_frag(ts + SS_CM, LD128, 16 * lt, 32 * ks, lane), lds_frag(ts + SS_BM, LD128, 16 * stl, 32 * ks, lane), gacc); } \
              const int s0 = 16 * stl + 4 * (lane >> 4); \
              const f32x4 acs = *(const LAS f32x4*)(sm_ac + s0), dts = *(const LAS f32x4*)(sm_dt + s0); \
              float v[4]; \
_Pragma("unroll")               for (int r = 0; r < 4; ++r) { v[r] = gacc[r] * __expf(fminf(acl - acs[r], 0.f)) * dts[r]; v[r] = (l >= s0 + r) ? v[r] : 0.f; } \
              u32x2 pk; pk.x = pk2(v[0], v[1]); pk.y = pk2(v[2], v[3]); \
              *(LAS u32x2*)(lds + SS_WM + l * LD64 + s0 * 2) = pk; } } \
        __syncthreads(); \
        { \
        { const int l = 16 * lt + (lane & 15); const float eal = __expf(sm_ac[l]); \
          float ssq = 0.f; \
_Pragma("unroll")           for (int pi = 0; pi < 2; ++pi) { const int ptl = 2 * nh + pi; const int p0 = 16 * ptl + 4 * (lane >> 4); \
              f32x4 y = {0.f, 0.f, 0.f, 0.f}; \
_Pragma("unroll")               for (int ks = 0; ks < 4; ++ks) y = MFMA16T(lds_frag(ts + SS_CM, LD128, 16 * lt, 32 * ks, lane), lds_frag(lds + SS_SB, LD128, 16 * ptl, 32 * ks, lane), y); \
              y = y * eal; \
_Pragma("unroll")               for (int ks = 0; ks < 2; ++ks) y = MFMA16T(lds_frag(lds + SS_WM, LD64, 16 * lt, 32 * ks, lane), lds_frag_tr(ts + SS_X, LD64, 32 * ks, 16 * ptl, lane), y); \
              const u32x2 xraw = *(const LAS u32x2*)(ts + SS_X + l * LD64 + p0 * 2); \
              const float xv[4] = {__uint_as_float(xraw.x << 16), __uint_as_float(xraw.x & 0xffff0000u), __uint_as_float(xraw.y << 16), __uint_as_float(xraw.y & 0xffff0000u)}; \
              const float zv[4] = {__uint_as_float(PZ_[pi].x << 16), __uint_as_float(PZ_[pi].x & 0xffff0000u), __uint_as_float(PZ_[pi].y << 16), __uint_as_float(PZ_[pi].y & 0xffff0000u)}; \
              float gv[4]; \
_Pragma("unroll")               for (int r = 0; r < 4; ++r) { gv[r] = (y[r] + d_h * xv[r]) * siluf(zv[r]); ssq += gv[r] * gv[r]; } \
              u32x2 pk; pk.x = pk2(gv[0], gv[1]); pk.y = pk2(gv[2], gv[3]); \
              *(u32x2*)(MIX + (size_t)(row0 + l) * 2048 + h * 64 + p0) = pk; } \
          ssq = xor32_sum(xor16_sum(ssq)); \
          if (lane < 16 && do_sumsq) unsafeAtomicAdd(SUMSQ + row0 + l, ssq); } \
        } \
        { const float cd = __expf(ac_last); \
          bf16x8 xa[2]; \
_Pragma("unroll")           for (int ks = 0; ks < 2; ++ks) xa[ks] = lds_frag_tr(ts + SS_XD, LD64, 32 * ks, 16 * pt, lane); \
_Pragma("unroll")           for (int q = 0; q < 4; ++q) { f32x4 s = st[q] * cd; \
_Pragma("unroll")               for (int ks = 0; ks < 2; ++ks) s = MFMA16T(xa[ks], lds_frag_tr(ts + SS_BM, LD128, 32 * ks, 16 * (4 * nh + q), lane), s); \
              st[q] = s; } } \
        if (c + 2 < nchunks) SSD_ISSUE_ZDT(c + 2, PZ_, PDT_); \
    } while (0)
    SSD_ISSUE_X(0, px0); SSD_ISSUE_BC(0); SSD_ISSUE_ZDT(0, pz0, pdt0);
    __syncthreads();
    if (nchunks > 1) { SSD_ISSUE_X(1, px1); SSD_ISSUE_ZDT(1, pz1, pdt1); }
#pragma unroll 1
    for (int c2 = 0; c2 < nchunks; c2 += 2) {
        { const int c = c2; SSD_STEP(c, px0, pz0, pdt0); }
        if (c2 + 1 < nchunks) { const int c = c2 + 1; SSD_STEP(c, px1, pz1, pdt1); }
    }
#undef SSD_STEP
#undef SSD_ISSUE_X
#undef SSD_ISSUE_BC
#undef SSD_ISSUE_ZDT
    { float* so = F.out + (smp ? O_SSMS + ((size_t)(sb * 16 + h) * 64) * 128 : O_SSMP + ((size_t)(sq * 16 + h) * 64) * 128);
#pragma unroll
      for (int q = 0; q < 4; ++q) *(f32x4*)(so + (16 * pt + (lane & 15)) * 128 + 16 * (4 * nh + q) + 4 * (lane >> 4)) = st[q]; }
    __syncthreads();
}
DI void p2a_phase(Ctx& F) {
    convbc_prepass(F);
    {
        const bf16_t* PROJ = (const bf16_t*)(F.ws + WS_PROJ);
        for (int i = F.bid * 512 + F.tid; i < 48 * 3 * 1536; i += F.G * 512) {
            const int ch = i % 1536, j = (i / 1536) % 3, sq = i / (3 * 1536);
            if (sq < NB_P) F.out[O_CONVP + (size_t)(sq * 3 + j) * 1536 + ch] = bf2f(PROJ[(size_t)(sq * T_P + T_P - 3 + j) * NPROJ + C_XBC + ch]);
            else F.out[O_CONVS + (size_t)((sq - NB_P) * 3 + j) * 1536 + ch] = bf2f(PROJ[(size_t)(MP + (sq - NB_P) * 64 + 61 + j) * NPROJ + C_XBC + ch]);
        }
    }
}
constexpr int WR_SLOT = 19456, WR_V = 9216, LDKW = 144, LDVW = 160;

DI void wa_write_k(Ctx& F, LAS unsigned char* slot, int kvh, const u32x4 ra, const u32x4 rb, int pos, float* ko) {
    const int i = F.tid >> 2, q4 = F.tid & 3;
    float a[8], bb[8], o1[8], o2[8];
    unpack8(ra, a); unpack8(rb, bb);
    float s = 0.f;
#pragma unroll
    for (int e = 0; e < 8; ++e) s += a[e] * a[e] + bb[e] * bb[e];
    s += __shfl_xor(s, 1); s += __shfl_xor(s, 2);
    const float rstd = 1.0f / sqrtf(s * (1.0f / 64.0f) + EPSF);
    const f32x2* ROPE = (const f32x2*)(F.ws + WS_ROPE);
#pragma unroll
    for (int e = 0; e < 8; ++e) { const float an = a[e] * rstd * F.in[I_GK][8 * q4 + e], bn = bb[e] * rstd * F.in[I_GK][32 + 8 * q4 + e];
        const f32x2 cs = ROPE[pos * 32 + 8 * q4 + e]; o1[e] = an * cs.x - bn * cs.y; o2[e] = bn * cs.x + an * cs.y; }
    *(LAS u32x4*)(slot + i * LDKW + (8 * q4) * 2) = pack8(o1);
    *(LAS u32x4*)(slot + i * LDKW + (32 + 8 * q4) * 2) = pack8(o2);
    if (ko) { float* p = ko + ((size_t)i * 2 + kvh) * 64;
        *(f32x4*)(p + 8 * q4) = (f32x4){o1[0], o1[1], o1[2], o1[3]}; *(f32x4*)(p + 8 * q4 + 4) = (f32x4){o1[4], o1[5], o1[6], o1[7]};
        *(f32x4*)(p + 32 + 8 * q4) = (f32x4){o2[0], o2[1], o2[2], o2[3]}; *(f32x4*)(p + 32 + 8 * q4 + 4) = (f32x4){o2[4], o2[5], o2[6], o2[7]}; }
}
DI void wa_write_v(Ctx& F, LAS unsigned char* slot, int kvh, const u32x4 rv, float* vo) {
    const int i = F.tid >> 3, q8 = F.tid & 7;
    *(LAS u32x4*)(slot + WR_V + i * LDVW + q8 * 16) = rv;
    if (vo) { float v[8]; unpack8(rv, v); float* p = vo + ((size_t)i * 2 + kvh) * 64 + 8 * q8;
        *(f32x4*)p = (f32x4){v[0], v[1], v[2], v[3]}; *(f32x4*)(p + 4) = (f32x4){v[4], v[5], v[6], v[7]}; }
}
DI void wa_stage_cache(Ctx& F, LAS unsigned char* slot, int kvh, const float* ck, const float* cv, float* ko, float* vo) {
    if (F.tid < 256) { const int i = F.tid >> 2, q4 = F.tid & 3; const float* src = ck + ((size_t)i * 2 + kvh) * 64;
        const f32x4 a0 = *(const f32x4*)(src + 8 * q4), a1 = *(const f32x4*)(src + 8 * q4 + 4), b0 = *(const f32x4*)(src + 32 + 8 * q4), b1 = *(const f32x4*)(src + 32 + 8 * q4 + 4);
        u32x4 pa, pb; pa.x = pk2(a0.x, a0.y); pa.y = pk2(a0.z, a0.w); pa.z = pk2(a1.x, a1.y); pa.w = pk2(a1.z, a1.w); pb.x = pk2(b0.x, b0.y); pb.y = pk2(b0.z, b0.w); pb.z = pk2(b1.x, b1.y); pb.w = pk2(b1.z, b1.w);
        *(LAS u32x4*)(slot + i * LDKW + (8 * q4) * 2) = pa; *(LAS u32x4*)(slot + i * LDKW + (32 + 8 * q4) * 2) = pb;
        if (ko) { float* p = ko + ((size_t)i * 2 + kvh) * 64; *(f32x4*)(p + 8 * q4) = a0; *(f32x4*)(p + 8 * q4 + 4) = a1; *(f32x4*)(p + 32 + 8 * q4) = b0; *(f32x4*)(p + 32 + 8 * q4 + 4) = b1; } }
    { const int i = F.tid >> 3, q8 = F.tid & 7; const float* src = cv + ((size_t)i * 2 + kvh) * 64 + 8 * q8; const f32x4 v0 = *(const f32x4*)src, v1 = *(const f32x4*)(src + 4);
      u32x4 pv; pv.x = pk2(v0.x, v0.y); pv.y = pk2(v0.z, v0.w); pv.z = pk2(v1.x, v1.y); pv.w = pk2(v1.z, v1.w);
      *(LAS u32x4*)(slot + WR_V + i * LDVW + q8 * 16) = pv;
      if (vo) { float* p = vo + ((size_t)i * 2 + kvh) * 64 + 8 * q8; *(f32x4*)p = v0; *(f32x4*)(p + 4) = v1; } }
}
DI void wa_compute(Ctx& F, int kvh, size_t crow0, int pos0, int sl0, int sl1, int sl2, int ninv) {
    LAS unsigned char* lds = F.lds;
    const int lane = F.lane, w = F.wave, g4 = lane >> 4;
    const bf16_t* PROJ = (const bf16_t*)(F.ws + WS_PROJ); const f32x2* ROPE = (const f32x2*)(F.ws + WS_ROPE); bf16_t* MIX = (bf16_t*)(F.ws + WS_MIX);
    const int hq = kvh * 4 + (w >> 1); const float sink = F.in[I_SINKS][hq] * 1.4426950408889634f;
    u32x2 graw[2][4]; u32x4 qraw[2][2];
#pragma unroll
    for (int rg = 0; rg < 2; ++rg) { const size_t row = crow0 + 32 * (w & 1) + 16 * rg + (lane & 15);
#pragma unroll
        for (int dt = 0; dt < 4; ++dt) graw[rg][dt] = *(const u32x2*)(PROJ + row * NPROJ + C_GA + hq * 64 + 16 * dt + 4 * g4);
        qraw[rg][0] = *(const u32x4*)(PROJ + row * NPROJ + C_Q + hq * 64 + 8 * g4); qraw[rg][1] = *(const u32x4*)(PROJ + row * NPROJ + C_Q + hq * 64 + 32 + 8 * g4); }
    bf16x8 qa[2][2];
#pragma unroll
    for (int rg = 0; rg < 2; ++rg) {
        const int d0 = 8 * g4; float a[8], bb[8];
        unpack8(qraw[rg][0], a);
        unpack8(qraw[rg][1], bb);
        float s = 0.f;
#pragma unroll
        for (int e = 0; e < 8; ++e) s += a[e] * a[e] + bb[e] * bb[e];
        s = xor32_sum(xor16_sum(s));
        const float rstd = 0.18033688011112042f / sqrtf(s * (1.0f / 64.0f) + EPSF);
        const int pos = pos0 + 32 * (w & 1) + 16 * rg + (lane & 15);
        float o1[8], o2[8];
#pragma unroll
        for (int e = 0; e < 8; ++e) { const float an = a[e] * rstd * F.in[I_GQ][d0 + e], bn = bb[e] * rstd * F.in[I_GQ][32 + d0 + e];
            const f32x2 cs = ROPE[pos * 32 + d0 + e]; o1[e] = an * cs.x - bn * cs.y; o2[e] = bn * cs.x + an * cs.y; }
        qa[rg][0] = __builtin_bit_cast(bf16x8, pack8(o1)); qa[rg][1] = __builtin_bit_cast(bf16x8, pack8(o2)); }
    f32x4 s[2][12];
#pragma unroll
    for (int jt = 0; jt < 12; ++jt) { const int j = jt >> 2; const LAS unsigned char* kt = lds + (j == 0 ? sl0 : (j == 1 ? sl1 : sl2)) * WR_SLOT;
        const bf16x8 k0 = lds_frag(kt, LDKW, 16 * (jt & 3), 0, lane), k1 = lds_frag(kt, LDKW, 16 * (jt & 3), 32, lane);
#pragma unroll
        for (int rg = 0; rg < 2; ++rg) { f32x4 acc = {0.f, 0.f, 0.f, 0.f};
            acc = MFMA16T(qa[rg][0], k0, acc); acc = MFMA16T(qa[rg][1], k1, acc);
            s[rg][jt] = acc; }
        if ((jt & 3) == 3) __builtin_amdgcn_sched_barrier(0); }
    if (ninv > 0) {
#pragma unroll
        for (int jt = 0; jt < 8; ++jt) if ((jt >> 2) < ninv) { s[0][jt] = (f32x4){-1e30f, -1e30f, -1e30f, -1e30f}; s[1][jt] = (f32x4){-1e30f, -1e30f, -1e30f, -1e30f}; } }
    float inv[2]; bf16x8 pa[2][6];
#pragma unroll
    for (int rg = 0; rg < 2; ++rg) {
        float m = sink;
#pragma unroll
        for (int jt = 0; jt < 12; ++jt)
#pragma unroll
            for (int r = 0; r < 4; ++r) m = fmaxf(m, s[rg][jt][r]);
        m = xor32_max(xor16_max(m));
        float sum = 0.f;
#pragma unroll
        for (int jt = 0; jt < 12; ++jt)
#pragma unroll
            for (int r = 0; r < 4; ++r) { const float e = __builtin_amdgcn_exp2f(s[rg][jt][r] - m); s[rg][jt][r] = e; sum += e; }
        sum = xor32_sum(xor16_sum(sum));
        inv[rg] = 1.0f / (sum + __builtin_amdgcn_exp2f(sink - m));
#pragma unroll
        for (int k2 = 0; k2 < 6; ++k2) { u32x4 t; t.x = pk2(s[rg][2 * k2][0], s[rg][2 * k2][1]); t.y = pk2(s[rg][2 * k2][2], s[rg][2 * k2][3]);
            t.z = pk2(s[rg][2 * k2 + 1][0], s[rg][2 * k2 + 1][1]); t.w = pk2(s[rg][2 * k2 + 1][2], s[rg][2 * k2 + 1][3]);
            pa[rg][k2] = __builtin_bit_cast(bf16x8, t); } }
#pragma unroll
    for (int dt = 0; dt < 4; ++dt) { f32x4 o[2] = {{0.f, 0.f, 0.f, 0.f}, {0.f, 0.f, 0.f, 0.f}};
#pragma unroll
        for (int k2 = 0; k2 < 6; ++k2) { const int j = k2 >> 1; const LAS unsigned char* vt = lds + (j == 0 ? sl0 : (j == 1 ? sl1 : sl2)) * WR_SLOT + WR_V;
            const bf16x8 vf = lds_frag_tr2(vt, LDVW, 32 * (k2 & 1), 16 * dt, lane);
            o[0] = MFMA16T(pa[0][k2], vf, o[0]); o[1] = MFMA16T(pa[1][k2], vf, o[1]); }
#pragma unroll
        for (int rg = 0; rg < 2; ++rg) { const size_t row = crow0 + 32 * (w & 1) + 16 * rg + (lane & 15);
            const float gv[4] = {__uint_as_float(graw[rg][dt].x << 16), __uint_as_float(graw[rg][dt].x & 0xffff0000u), __uint_as_float(graw[rg][dt].y << 16), __uint_as_float(graw[rg][dt].y & 0xffff0000u)};
            u32x2 pk; pk.x = pk2(o[rg][0] * inv[rg] * siluf(gv[0]), o[rg][1] * inv[rg] * siluf(gv[1])); pk.y = pk2(o[rg][2] * inv[rg] * siluf(gv[2]), o[rg][3] * inv[rg] * siluf(gv[3]));
            *(u32x2*)(MIX + row * 2048 + 1024 + hq * 64 + 16 * dt + 4 * g4) = pk; }
        __builtin_amdgcn_sched_barrier(0); }
}
DI void winattn_item(Ctx& F, int item) {
    LAS unsigned char* lds = F.lds;
    const int tid = F.tid;
    const bf16_t* PROJ = (const bf16_t*)(F.ws + WS_PROJ);
    if (item >= 256) {
        const int sb = (item - 256) >> 1, kvh = item & 1; const size_t row0 = (size_t)MP + sb * 64;
        const float* ck = F.in[I_CWK] + (size_t)sb * 128 * 128; const float* cv = F.in[I_CWV] + (size_t)sb * 128 * 128;
        float* ko = F.out + O_WKS + (size_t)sb * 128 * 128; float* vo = F.out + O_WVS + (size_t)sb * 128 * 128;
        wa_stage_cache(F, lds + 0 * WR_SLOT, kvh, ck, cv, nullptr, nullptr);
        wa_stage_cache(F, lds + 1 * WR_SLOT, kvh, ck + 64 * 128, cv + 64 * 128, ko, vo);
        if (tid < 256) { const int i = tid >> 2, q4 = tid & 3; const bf16_t* p = PROJ + (row0 + i) * NPROJ + C_K + kvh * 64 + 8 * q4;
            wa_write_k(F, lds + 2 * WR_SLOT, kvh, *(const u32x4*)p, *(const u32x4*)(p + 32), 2048 + i, ko + 64 * 128); }
        { const int i = tid >> 3, q8 = tid & 7; wa_write_v(F, lds + 2 * WR_SLOT, kvh, *(const u32x4*)(PROJ + (row0 + i) * NPROJ + C_V + kvh * 64 + 8 * q8), vo + 64 * 128); }
        __syncthreads();
        wa_compute(F, kvh, row0, 2048, 0, 1, 2, 0);
        __syncthreads();
        return;
    }
    const int b = item >> 4, kvh = (item >> 3) & 1, c0 = (item & 7) * 8;
    const size_t seq0 = (size_t)b * T_P;
#pragma unroll 1
    for (int kc = c0 - 2; kc <= c0; ++kc) { LAS unsigned char* slot = lds + (kc & 3) * WR_SLOT;
        if (kc < 0) { for (int t = tid; t < WR_SLOT / 16; t += 512) *(LAS u32x4*)(slot + t * 16) = (u32x4){0u, 0u, 0u, 0u}; }
        else { const size_t row0 = seq0 + (size_t)kc * 64;
            if (tid < 256) { const int i = tid >> 2, q4 = tid & 3; const bf16_t* p = PROJ + (row0 + i) * NPROJ + C_K + kvh * 64 + 8 * q4;
                wa_write_k(F, slot, kvh, *(const u32x4*)p, *(const u32x4*)(p + 32), kc * 64 + i, nullptr); }
            { const int i = tid >> 3, q8 = tid & 7; wa_write_v(F, slot, kvh, *(const u32x4*)(PROJ + (row0 + i) * NPROJ + C_V + kvh * 64 + 8 * q8), nullptr); } } }
    __syncthreads();
#pragma unroll 1
    for (int c = c0; c < c0 + 8; ++c) {
        const bool more = c + 1 < c0 + 8;
        u32x4 ra = {0u, 0u, 0u, 0u}, rb = {0u, 0u, 0u, 0u}, rv = {0u, 0u, 0u, 0u};
        const size_t nrow0 = seq0 + (size_t)(c + 1) * 64;
        if (more) {
            if (tid < 256) { const bf16_t* p = PROJ + (nrow0 + (tid >> 2)) * NPROJ + C_K + kvh * 64 + 8 * (tid & 3); ra = *(const u32x4*)p; rb = *(const u32x4*)(p + 32); }
            rv = *(const u32x4*)(PROJ + (nrow0 + (tid >> 3)) * NPROJ + C_V + kvh * 64 + 8 * (tid & 7)); }
        wa_compute(F, kvh, seq0 + (size_t)c * 64, c * 64, (c - 2) & 3, (c - 1) & 3, c & 3, c >= 2 ? 0 : 2 - c);
        if (more) { LAS unsigned char* slot = lds + ((c + 1) & 3) * WR_SLOT; const int kc = c + 1;
            float* ko = nullptr; float* vo = nullptr;
            if (kc >= 62) { ko = F.out + O_WKP + ((size_t)b * 128 + (kc - 62) * 64) * 128; vo = F.out + O_WVP + ((size_t)b * 128 + (kc - 62) * 64) * 128; }
            if (tid < 256) wa_write_k(F, slot, kvh, ra, rb, kc * 64 + (tid >> 2), ko);
            wa_write_v(F, slot, kvh, rv, vo); }
        __syncthreads();
    }
}

constexpr int MA_K = 0, MA_V = 69632, MA_RS = 143360, LDKM = 272, LDVM = 288;
DI void memattn_item(Ctx& F, int item) {
    LAS unsigned char* lds = F.lds;
    const int tid = F.tid, lane = F.lane, w = F.wave, g4 = lane >> 4;
    const bool smp = item >= 256; const int sidx = item - 256;
    const int bb = smp ? (sidx >> 2) : (item >> 4), h = smp ? (sidx & 3) : ((item >> 2) & 3), qt = item & 3;
    const bf16_t* PROJ = (const bf16_t*)(F.ws + WS_PROJ); bf16_t* MIX = (bf16_t*)(F.ws + WS_MIX); const bf16_t* RAW = (const bf16_t*)(F.ws + WS_MEMRAW);
#pragma unroll 1
    for (int ib = 0; ib < 2; ++ib) {
      u32x4 rk[4], rvv[4]; f32x4 fk[4][2], fv[4][2];
#pragma unroll
      for (int u = 0; u < 4; ++u) { const int t = tid + 512 * (4 * ib + u), key = t >> 4, ch = t & 15;
        if (smp) { const float* ks = F.in[I_CMK] + ((size_t)(bb * 256 + key) * 4 + h) * 128 + 8 * ch; const float* vs = F.in[I_CMV] + ((size_t)(bb * 256 + key) * 4 + h) * 128 + 8 * ch;
            fk[u][0] = *(const f32x4*)ks; fk[u][1] = *(const f32x4*)(ks + 4); fv[u][0] = *(const f32x4*)vs; fv[u][1] = *(const f32x4*)(vs + 4); }
        else { rk[u] = *(const u32x4*)(RAW + (size_t)(bb * 256 + key) * 1024 + h * 128 + 8 * ch); rvv[u] = *(const u32x4*)(RAW + (size_t)(bb * 256 + key) * 1024 + 512 + h * 128 + 8 * ch); } }
#pragma unroll
      for (int u = 0; u < 4; ++u) { const int t = tid + 512 * (4 * ib + u), key = t >> 4, ch = t & 15;
        float k[8], v[8];
        if (smp) {
#pragma unroll
            for (int e = 0; e < 4; ++e) { k[e] = fk[u][0][e]; k[4 + e] = fk[u][1][e]; v[e] = fv[u][0][e]; v[4 + e] = fv[u][1][e]; } }
        else { unpack8(rk[u], k); unpack8(rvv[u], v); }
        float s = 0.f;
#pragma unroll
        for (int e = 0; e < 8; ++e) s += k[e] * k[e];
        s = row16_sum(s);
        if (!smp) { const float rstd = 1.0f / sqrtf(s * (1.0f / 128.0f) + EPSF);
#pragma unroll
            for (int e = 0; e < 8; ++e) k[e] = k[e] * rstd * F.in[I_GMK][8 * ch + e]; }
        { float kq[8];
#pragma unroll
          for (int e = 0; e < 8; ++e) kq[e] = k[e] * F.in[I_GMQ][8 * ch + e];
          *(LAS u32x4*)(lds + MA_K + key * LDKM + ch * 16) = pack8(kq); }
        *(LAS u32x4*)(lds + MA_V + key * LDVM + ch * 16) = pack8(v);
        if (!smp && qt == 0) {
            float* ko = F.out + O_MKP + ((size_t)(bb * 256 + key) * 4 + h) * 128 + 8 * ch; float* vo = F.out + O_MVP + ((size_t)(bb * 256 + key) * 4 + h) * 128 + 8 * ch;
            *(f32x4*)ko = (f32x4){k[0], k[1], k[2], k[3]}; *(f32x4*)(ko + 4) = (f32x4){k[4], k[5], k[6], k[7]};
            *(f32x4*)vo = (f32x4){v[0], v[1], v[2], v[3]}; *(f32x4*)(vo + 4) = (f32x4){v[4], v[5], v[6], v[7]}; }
      }
    }
    __syncthreads();
    const int ngr = smp ? 4 : 64;
    const size_t qbase = smp ? (size_t)MP + bb * 64 : (size_t)bb * T_P + qt * 1024;
    u32x4 nq[4]; u32x2 ng[8];
#define MA_LOAD(rg_) do { const size_t r_ = qbase + 16 * (rg_) + (lane & 15); \
        _Pragma("unroll") for (int ks = 0; ks < 4; ++ks) nq[ks] = *(const u32x4*)(PROJ + r_ * NPROJ + C_MQ + h * 128 + 32 * ks + 8 * g4); \
        _Pragma("unroll") for (int dt = 0; dt < 8; ++dt) ng[dt] = *(const u32x2*)(PROJ + r_ * NPROJ + C_GM + h * 128 + 16 * dt + 4 * g4); } while (0)
    if (w < ngr) MA_LOAD(w);
#pragma unroll 1
    for (int rg = w; rg < ngr; rg += 8) {
        u32x4 cq[4]; u32x2 cg[8];
#pragma unroll
        for (int ks = 0; ks < 4; ++ks) cq[ks] = nq[ks];
#pragma unroll
        for (int dt = 0; dt < 8; ++dt) cg[dt] = ng[dt];
        if (rg + 8 < ngr) MA_LOAD(rg + 8);
        bf16x8 qa[4];
        { float q[4][8]; float s = 0.f;
#pragma unroll
          for (int ks = 0; ks < 4; ++ks) { unpack8(cq[ks], q[ks]);
#pragma unroll
              for (int e = 0; e < 8; ++e) s += q[ks][e] * q[ks][e]; }
          s = xor32_sum(xor16_sum(s));
          const float rstd = 0.12751743082459868f / sqrtf(s * (1.0f / 128.0f) + EPSF);
#pragma unroll
          for (int ks = 0; ks < 4; ++ks) {
#pragma unroll
              for (int e = 0; e < 8; ++e) q[ks][e] = q[ks][e] * rstd;
              qa[ks] = __builtin_bit_cast(bf16x8, pack8(q[ks])); } }
        f32x4 s[16];
#pragma unroll
        for (int jt = 0; jt < 16; ++jt) { f32x4 acc = {0.f, 0.f, 0.f, 0.f};
#pragma unroll
            for (int ks = 0; ks < 4; ++ks) acc = MFMA16T(qa[ks], lds_frag(lds + MA_K, LDKM, 16 * jt, 32 * ks, lane), acc);
            s[jt] = acc;
            if ((jt & 3) == 3) __builtin_amdgcn_sched_barrier(0); }
        float m = s[0][0];
#pragma unroll
        for (int jt = 0; jt < 16; ++jt)
#pragma unroll
            for (int r = 0; r < 4; ++r) m = fmaxf(m, s[jt][r]);
        m = xor32_max(xor16_max(m));
        float sum = 0.f;
#pragma unroll
        for (int jt = 0; jt < 16; ++jt)
#pragma unroll
            for (int r = 0; r < 4; ++r) { const float e = __builtin_amdgcn_exp2f(s[jt][r] - m); s[jt][r] = e; sum += e; }
        sum = xor32_sum(xor16_sum(sum));
        const float inv = 1.0f / sum;
        bf16x8 pa[8];
#pragma unroll
        for (int k2 = 0; k2 < 8; ++k2) { u32x4 t; t.x = pk2(s[2 * k2][0], s[2 * k2][1]); t.y = pk2(s[2 * k2][2], s[2 * k2][3]); t.z = pk2(s[2 * k2 + 1][0], s[2 * k2 + 1][1]); t.w = pk2(s[2 * k2 + 1][2], s[2 * k2 + 1][3]);
            pa[k2] = __builtin_bit_cast(bf16x8, t); }
        const size_t orow = qbase + 16 * rg + (lane & 15);
#pragma unroll
        for (int dt = 0; dt < 8; ++dt) { f32x4 o = {0.f, 0.f, 0.f, 0.f};
#pragma unroll
            for (int k2 = 0; k2 < 8; ++k2) o = MFMA16T(pa[k2], lds_frag_tr2(lds + MA_V, LDVM, 32 * k2, 16 * dt, lane), o);
            __builtin_amdgcn_sched_barrier(0);
            const int col = h * 128 + 16 * dt + 4 * g4;
            const u32x2 gr = cg[dt];
            const float gv[4] = {__uint_as_float(gr.x << 16), __uint_as_float(gr.x & 0xffff0000u), __uint_as_float(gr.y << 16), __uint_as_float(gr.y & 0xffff0000u)};
            u32x2 pk; pk.x = pk2(o[0] * inv * siluf(gv[0]), o[1] * inv * siluf(gv[1])); pk.y = pk2(o[2] * inv * siluf(gv[2]), o[3] * inv * siluf(gv[3]));
            *(u32x2*)(MIX + orow * 2048 + 1536 + col) = pk; }
    }
#undef MA_LOAD
    __syncthreads();
}

DI void p2a_attn(Ctx& F) {
    for (int rep = 0; rep < REP_WIN; ++rep)
    for (int it = F.bid; it < 320; it += F.G) winattn_item(F, it);
    __syncthreads();
    for (int rep = 0; rep < REP_MEM; ++rep)
    { for (int it = F.bid; it < 256; it += F.G) memattn_item(F, it);
      for (int s = (F.bid + F.G - (128 % F.G)) % F.G; s < 128; s += F.G) memattn_item(F, 256 + s); }
}
DI void p2b_phase(Ctx& F) {
    for (int rep = 0; rep < REP_SSD; ++rep)
    for (int it = F.bid; it < 48 * 16; it += F.G) ssd_item(F, it >> 4, it & 15, rep == 0);
}

constexpr int G2_A = 0, G2_B = 9216, G2_SET = 27648;
DI void gemm2_sample(Ctx& F) {
    LAS unsigned char* lds = F.lds;
    const int tid = F.tid, lane = F.lane, w = F.wave, g4 = lane >> 4;
    const bf16_t* MIX = (const bf16_t*)(F.ws + WS_MIX); const bf16_t* WOT = (const bf16_t*)(F.ws + WS_WOUT); const float* SUMSQ = (const float*)(F.ws + WS_SSQ);
    for (int tile = F.bid; tile < 256; tile += F.G) {
        const int r0 = MP + 64 * (tile >> 3), c0 = 128 * (tile & 7);
        const bf16_t* asrc = MIX + (size_t)(r0 + (tid >> 3)) * 2048 + 8 * (tid & 7);
        const bf16_t* bsrc0 = WOT + (size_t)(c0 + (tid >> 3)) * 2048 + 8 * (tid & 7);
        const bf16_t* bsrc1 = bsrc0 + (size_t)64 * 2048;
        const int aoff = G2_A + (tid >> 3) * 144 + (tid & 7) * 16, boff0 = G2_B + (tid >> 3) * 144 + (tid & 7) * 16, boff1 = boff0 + 64 * 144;
        f32x4 acc[4] = {{0.f, 0.f, 0.f, 0.f}, {0.f, 0.f, 0.f, 0.f}, {0.f, 0.f, 0.f, 0.f}, {0.f, 0.f, 0.f, 0.f}};
        u32x4 ra[4], rb0[4], rb1[4];
#pragma unroll
        for (int j = 0; j < 4; ++j) { ra[j] = *(const u32x4*)(asrc + 64 * j); rb0[j] = *(const u32x4*)(bsrc0 + 64 * j); rb1[j] = *(const u32x4*)(bsrc1 + 64 * j); }
        *(LAS u32x4*)(lds + aoff) = ra[0]; *(LAS u32x4*)(lds + boff0) = rb0[0]; *(LAS u32x4*)(lds + boff1) = rb1[0];
        ra[0] = *(const u32x4*)(asrc + 64 * 4); rb0[0] = *(const u32x4*)(bsrc0 + 64 * 4); rb1[0] = *(const u32x4*)(bsrc1 + 64 * 4);
        __syncthreads();
#pragma unroll 1
        for (int kt4 = 0; kt4 < 32; kt4 += 4) {
#pragma unroll
            for (int u = 0; u < 4; ++u) { const int kt = kt4 + u;
                const LAS unsigned char* cs = lds + (u & 1) * G2_SET; LAS unsigned char* ns = lds + ((u + 1) & 1) * G2_SET;
                if (kt == 16) { const float r = 1.0f / sqrtf(SUMSQ[r0 + 16 * (w >> 1) + (lane & 15)] * (1.0f / 1024.0f) + EPSF);
#pragma unroll
                    for (int t = 0; t < 4; ++t) acc[t] = acc[t] * r; }
#pragma unroll
                for (int ks = 0; ks < 2; ++ks) { const bf16x8 a = lds_frag(cs + G2_A, 144, 16 * (w >> 1), 32 * ks, lane);
#pragma unroll
                    for (int t = 0; t < 4; ++t) acc[t] = MFMA16T(a, lds_frag(cs + G2_B, 144, 64 * (w & 1) + 16 * t, 32 * ks, lane), acc[t]); }
                constexpr int dummy_ = 0; (void)dummy_;
                const int rs = (u + 1) & 3;
                if (kt + 1 < 32) { *(LAS u32x4*)(ns + aoff) = ra[rs]; *(LAS u32x4*)(ns + boff0) = rb0[rs]; *(LAS u32x4*)(ns + boff1) = rb1[rs]; }
                if (kt + 5 < 32) { ra[rs] = *(const u32x4*)(asrc + 64 * (kt + 5)); rb0[rs] = *(const u32x4*)(bsrc0 + 64 * (kt + 5)); rb1[rs] = *(const u32x4*)(bsrc1 + 64 * (kt + 5)); }
                __syncthreads();
            }
        }
        const int row = r0 + 16 * (w >> 1) + (lane & 15), cw = c0 + 64 * (w & 1) + 4 * g4;
        const float* xr = F.in[I_XS] + (size_t)(row - MP) * DM + cw; float* orow = F.out + (size_t)row * DM + cw;
#pragma unroll
        for (int t = 0; t < 4; ++t) *(f32x4*)(orow + 16 * t) = acc[t] + *(const f32x4*)(xr + 16 * t);
    }
}
__global__ void __launch_bounds__(512, 2) hymba_fwd(Args args) {
    extern __shared__ __attribute__((aligned(16))) unsigned char lds_raw[];
    cg::grid_group grid = cg::this_grid();
    Ctx F;
    F.lds = (LAS unsigned char*)lds_raw; F.tid = threadIdx.x; F.lane = F.tid & 63; F.wave = __builtin_amdgcn_readfirstlane(F.tid >> 6); F.G = gridDim.x; F.bid = blockIdx.x;
#pragma unroll
    for (int i = 0; i < 26; ++i) F.in[i] = args.in[i];
    F.out = args.out; F.ws = args.ws;
    volatile LAS unsigned* bst = (volatile LAS unsigned*)(F.lds + LDS_BYTES - 64);
    if (F.tid < 16) bst[F.tid] = 0u;
    __syncthreads();
    const XcdBarrier xbar = xcd_barrier_post((unsigned*)(F.ws + WS_CTL), bst);
#define GRID_BAR() xcd_barrier(xbar)

#define PHASE_FENCE() do { int t_ = threadIdx.x; asm volatile("" : "+v"(t_)); F.tid = t_; F.lane = t_ & 63; F.wave = __builtin_amdgcn_readfirstlane(t_ >> 6); } while (0)
    for (int rep = 0; rep < REP_P0; ++rep) { if (rep) __syncthreads(); p0_prologue(F); }
    grid.sync(); PHASE_FENCE();
    {
        pg8::Gemm g{(const bf16_t*)(F.ws + WS_A), (const bf16_t*)(F.ws + WS_BT), MA, NBT, 1024};
        Order1 S; S.init(F.G, F.bid);
        EpiProj E{(bf16_t*)(F.ws + WS_PROJ), (bf16_t*)(F.ws + WS_MEMRAW)};
        pg8::gemm_phase<EpiProj, Order1, true, true>(F.lds, g, S, E);
    }
    GRID_BAR(); PHASE_FENCE();
    for (int rep = 0; rep < REP_P2A; ++rep) p2a_phase(F);
    __syncthreads();
    p2a_attn(F);
    GRID_BAR(); PHASE_FENCE();
    p2b_phase(F);
    GRID_BAR(); PHASE_FENCE();
    gemm2_sample(F);
    {
        pg8::Gemm g{(const bf16_t*)(F.ws + WS_MIX), (const bf16_t*)(F.ws + WS_WOUT), MTOT, 1024, 2048};
        Order3 S; S.init(F.G, F.bid);
        EpiOut E{F.in[I_XP], F.in[I_XS], F.out, (const float*)(F.ws + WS_SSQ)};
        pg8::gemm_phase<EpiOut, Order3, true, true>(F.lds, g, S, E);
    }
#if DBG_SCALE3 || DBG_ZERO
    grid.sync();
    {
        const size_t offs[13] = {O_Y, (size_t)MP * 1024, O_WKP, O_WVP, O_SSMP, O_CONVP, O_MKP, O_MVP, O_WKS, O_WVS, O_SSMS, O_CONVS, O_END};
        for (int o = 0; o < 12; ++o) {
            const bool z = (DBG_ZERO >> o) & 1, s3 = (DBG_SCALE3 >> o) & 1;
            if (!z && !s3) continue;
            for (size_t i = offs[o] + (size_t)F.bid * 512 + F.tid; i < offs[o + 1]; i += (size_t)F.G * 512) F.out[i] = z ? 0.f : F.out[i] * 3.0f;
        }
    }
#endif
}

extern "C" void kernel_launch(void* const* d_in, const int* in_sizes, int n_in, void* d_out, int out_size, void* d_ws, size_t ws_size, hipStream_t stream) {
    static int grid = 0;
    if (grid == 0) {
        if (n_in != 26 || (size_t)out_size != O_END || ws_size < WS_END) { fprintf(stderr, "kernel_launch: unexpected problem (n_in %d out %d ws %zu)\n", n_in, out_size, ws_size); grid = -1; return; }
        int dev = 0, cus = 0, per_cu = 0;
        if (hipGetDevice(&dev) != hipSuccess || hipDeviceGetAttribute(&cus, hipDeviceAttributeMultiprocessorCount, dev) != hipSuccess) { grid = -1; return; }
        if (hipFuncSetAttribute((const void*)hymba_fwd, hipFuncAttributeMaxDynamicSharedMemorySize, LDS_BYTES) != hipSuccess) { fprintf(stderr, "kernel_launch: hipFuncSetAttribute failed\n"); grid = -1; return; }
        if (hipOccupancyMaxActiveBlocksPerMultiprocessor(&per_cu, (const void*)hymba_fwd, 512, LDS_BYTES) != hipSuccess || per_cu < 1) { fprintf(stderr, "kernel_launch: occupancy query says %d\n", per_cu); (void)hipGetLastError(); grid = -1; return; }
        grid = cus;
        fprintf(stderr, "kernel_launch: %d CUs, occupancy %d per CU, grid %d\n", cus, per_cu, grid);
    }
    if (grid < 0) return;
    Args a{};
    for (int i = 0; i < 26; ++i) a.in[i] = (const float*)d_in[i];
    a.out = (float*)d_out; a.ws = (unsigned char*)d_ws;
    if (hipMemsetAsync((char*)d_ws + WS_CTL, 0, CTL_ZERO_BYTES, stream) != hipSuccess) { fprintf(stderr, "kernel_launch: memset of the barrier words failed\n"); return; }
    void* kargs[] = {&a};
    const hipError_t e = hipLaunchCooperativeKernel((const void*)hymba_fwd, dim3(grid), dim3(512), kargs, LDS_BYTES, stream);
    if (e != hipSuccess) fprintf(stderr, "kernel_launch: cooperative launch failed: %s\n", hipGetErrorString(e));
}
```

```cpp
#include <hip/hip_runtime.h>
#include <hip/hip_cooperative_groups.h>
#include <cstdio>
#include <cstdint>
namespace cg = cooperative_groups;
namespace pg8 {
#define PG8_LAS __attribute__((address_space(3)))
typedef unsigned short bf16_t;
typedef short bf16x8 __attribute__((ext_vector_type(8)));
typedef float f32x4 __attribute__((ext_vector_type(4)));
typedef unsigned u32x4 __attribute__((ext_vector_type(4)));
constexpr int BM = 256, BK = 64, HALF = 128, HTB = HALF * BK * 2  , STAGE_BYTES = 8 * HTB, NXCD = 8, WGM = 8;

__host__ __device__ __forceinline__ int lds_byte(int r, int c) { const int st = (r >> 4) * 2 + (c >> 5), rr = r & 15, cc = c & 31, ob = rr * 64 + cc * 2; return st * 1024 + (ob ^ (((ob >> 9) & 1) << 5)); }
__host__ __device__ __forceinline__ void stage_rc(int b, int& R, int& C) { const int st = b / 1024, sb = b % 1024, swz = sb ^ (((sb >> 9) & 1) << 5); R = (st >> 1) * 16 + swz / 64; C = (st & 1) * 32 + (swz % 64) / 2; }
__host__ __device__ __forceinline__ int perm32(int rho) { const int n = rho >> 4, i = rho & 15; return 8 * (i >> 2) + 4 * n + (i & 3); }

struct Unit { int pm, pn; };
struct Gemm { const bf16_t* A; const bf16_t* Bt; int M, N, K; };

struct StaticOrder {
    int nM, nN, nwg, G, c;
    __host__ __device__ void init(int M, int N, int G_, int c_) { nM = M / BM; nN = N / BM; nwg = nM * nN; G = G_; c = c_; }
    __host__ __device__ bool next(int i, Unit& u) const {
        const long L = (long)i * G + c; if (L >= nwg) return false;
        int wgid = (int)L; { const int q = nwg / NXCD, r = nwg % NXCD, xcd = wgid % NXCD, off = wgid / NXCD; wgid = (xcd < r ? xcd * (q + 1) : r * (q + 1) + (xcd - r) * q) + off; }
        const int nig = WGM * nN, gid = wgid / nig, fm = gid * WGM, gsz = (nM - fm) < WGM ? (nM - fm) : WGM;
        u.pm = fm + ((wgid % nig) % gsz); u.pn = (wgid % nig) / gsz; return true;
    }
    __device__ __forceinline__ void a_ready(const Unit&) const {}
    __device__ __forceinline__ void done(const Unit&) const {}
};

template <class Epi, class Sched, bool ALIGN_EPI = false, bool SP2 = false>
__device__ __forceinline__ void gemm_phase(PG8_LAS unsigned char* lds, const Gemm g, const Sched& S, const Epi& E) {
    int tid_ = threadIdx.x; asm volatile("" : "+v"(tid_));
    const int tid = tid_, wid = __builtin_amdgcn_readfirstlane(tid >> 6), lane = tid & 63, wr = wid >> 2, wc = wid & 3, fr = lane & 15, fq = lane >> 4;
    const int K = g.K, nt = K / BK;
    unsigned voffA[2], voffB[2];
#pragma unroll
    for (int i = 0; i < 2; ++i) { int R, C; stage_rc(tid * 16 + i * 8192, R, C); const int Rb = Epi::PERM ? ((R & ~31) + perm32(R & 31)) : R;
        voffA[i] = (unsigned)(R * K + C) * 2u; voffB[i] = (unsigned)(Rb * K + C) * 2u; }
    const size_t kstep = (size_t)(BK * 2);
    const size_t hstep = (size_t)HALF * K * 2;
    const size_t tstep = 2 * hstep;
    const unsigned ldsw = (unsigned)wid * 1024u;
    const int aoff = lds_byte(wr * 64 + fr, fq * 8), boff = lds_byte(wc * 32 + fr, fq * 8);
#define PG8_SA(b, h) (((b) * 2 + (h)) * HTB)
#define PG8_SB(b, h) ((4 + (b) * 2 + (h)) * HTB)
#define PG8_STAGE(bufoff, gbase, voff) do { _Pragma("unroll") for (int _i = 0; _i < 2; ++_i) \
        __builtin_amdgcn_global_load_lds((const unsigned*)((const char*)(gbase) + (voff)[_i]), (PG8_LAS unsigned*)(lds + (bufoff) + ldsw + _i * 8192), 16, 0, 0); } while (0)
#define PG8_LDA(dst, b, h) do { _Pragma("unroll") for (int m = 0; m < 4; ++m) _Pragma("unroll") for (int k = 0; k < 2; ++k) dst[m][k] = *(const PG8_LAS bf16x8*)(lds + PG8_SA(b, h) + aoff + m * 2048 + k * 1024); } while (0)
#define PG8_LDB(dst, b, h) do { _Pragma("unroll") for (int n = 0; n < 2; ++n) _Pragma("unroll") for (int k = 0; k < 2; ++k) dst[n][k] = *(const PG8_LAS bf16x8*)(lds + PG8_SB(b, h) + boff + n * 2048 + k * 1024); } while (0)
#define PG8_MMA(ai, bj, At, Bt) do { __builtin_amdgcn_s_setprio(1); _Pragma("unroll") for (int m = 0; m < 4; ++m) _Pragma("unroll") for (int n = 0; n < 2; ++n) _Pragma("unroll") for (int k = 0; k < 2; ++k) \
        acc[ai][bj][m][n] = __builtin_amdgcn_mfma_f32_16x16x32_bf16(Bt[n][k], At[m][k], acc[ai][bj][m][n], 0, 0, 0); __builtin_amdgcn_s_setprio(0); } while (0)
#define PG8_WAIT_V(n) asm volatile("s_waitcnt vmcnt(" #n ")" ::: "memory")
#define PG8_WAIT_L(n) asm volatile("s_waitcnt lgkmcnt(" #n ")" ::: "memory")
#define PG8_BAR __builtin_amdgcn_s_barrier()
#define PG8_SCHED __builtin_amdgcn_sched_barrier(0)
    Unit cur, nxt; int ui = 0;
    if (!S.next(0, cur)) return;
    f32x4 acc[2][2][4][2];
#pragma unroll
    for (int a = 0; a < 2; ++a)
#pragma unroll
        for (int b = 0; b < 2; ++b)
#pragma unroll
            for (int m = 0; m < 4; ++m)
#pragma unroll
                for (int n = 0; n < 2; ++n) acc[a][b][m][n] = (f32x4){0.f, 0.f, 0.f, 0.f};
    bf16x8 At[4][2], B0[2][2], B1[2][2];
    const char* cA = (const char*)g.A + (size_t)cur.pm * tstep; const char* cB = (const char*)g.Bt + (size_t)cur.pn * tstep;
    S.a_ready(cur);
    if constexpr (SP2) {
        PG8_STAGE(PG8_SB(0, 0), cB, voffB); PG8_STAGE(PG8_SB(0, 1), cB + hstep, voffB); PG8_STAGE(PG8_SA(0, 0), cA, voffA); PG8_STAGE(PG8_SA(0, 1), cA + hstep, voffA);
        if (wr == 1) PG8_BAR;
        PG8_WAIT_V(2); PG8_BAR;
        PG8_STAGE(PG8_SB(1, 0), cB + kstep, voffB); PG8_STAGE(PG8_SA(1, 0), cA + kstep, voffA); PG8_STAGE(PG8_SB(1, 1), cB + hstep + kstep, voffB);
        PG8_WAIT_V(6); PG8_BAR;
    } else {
        PG8_STAGE(PG8_SB(0, 0), cB, voffB); PG8_STAGE(PG8_SA(0, 0), cA, voffA); PG8_STAGE(PG8_SB(0, 1), cB + hstep, voffB); PG8_STAGE(PG8_SA(0, 1), cA + hstep, voffA);
        if (wr == 1) PG8_BAR;
        PG8_WAIT_V(4); PG8_BAR;
        PG8_STAGE(PG8_SB(1, 0), cB + kstep, voffB); PG8_STAGE(PG8_SA(1, 0), cA + kstep, voffA); PG8_STAGE(PG8_SB(1, 1), cB + hstep + kstep, voffB);
        PG8_WAIT_V(6); PG8_BAR;
    }
    for (;;) {
        const bool has_next = S.next(ui + 1, nxt);
        const char* nA = has_next ? (const char*)g.A + (size_t)nxt.pm * tstep : cA; const char* nB = has_next ? (const char*)g.Bt + (size_t)nxt.pn * tstep : cB;
        for (int t = 0; t < nt; t += 2) {
            const bool last = (t == nt - 2);
            const char* a1 = cA + (size_t)(t + 1) * kstep;
            const char* a2 = last ? nA : cA + (size_t)(t + 2) * kstep; const char* b2 = last ? nB : cB + (size_t)(t + 2) * kstep;
            const char* a3 = a2 + kstep; const char* b3 = b2 + kstep;
            if (last && has_next) S.a_ready(nxt);
            if constexpr (Epi::MIDK > 0) { if (t == Epi::MIDK) E.mid(acc, cur, wr, wc, fr, fq); }
            if constexpr (SP2) {
            PG8_LDB(B0, 0, 0); PG8_LDB(B1, 0, 1); PG8_SCHED; PG8_LDA(At, 0, 0); PG8_STAGE(PG8_SA(1, 1), a1 + hstep, voffA);
            PG8_WAIT_V(8); PG8_WAIT_L(0); PG8_BAR; PG8_MMA(0, 0, At, B0); PG8_MMA(0, 1, At, B1); PG8_BAR; PG8_SCHED;
            PG8_LDA(At, 0, 1); PG8_STAGE(PG8_SB(0, 0), b2, voffB); PG8_STAGE(PG8_SB(0, 1), b2 + hstep, voffB); PG8_STAGE(PG8_SA(0, 0), a2, voffA);
            PG8_WAIT_V(8); PG8_WAIT_L(0); PG8_BAR; PG8_MMA(1, 0, At, B0); PG8_MMA(1, 1, At, B1); PG8_BAR; PG8_SCHED;
            PG8_LDB(B0, 1, 0); PG8_LDB(B1, 1, 1); PG8_SCHED; PG8_LDA(At, 1, 0); PG8_STAGE(PG8_SA(0, 1), a2 + hstep, voffA);
            PG8_WAIT_V(8); PG8_WAIT_L(0); PG8_BAR; PG8_MMA(0, 0, At, B0); PG8_MMA(0, 1, At, B1); PG8_BAR; PG8_SCHED;
            PG8_LDA(At, 1, 1); PG8_STAGE(PG8_SB(1, 0), b3, voffB); PG8_STAGE(PG8_SB(1, 1), b3 + hstep, voffB); PG8_STAGE(PG8_SA(1, 0), a3, voffA);
            PG8_WAIT_V(8); PG8_WAIT_L(0); PG8_BAR; PG8_MMA(1, 0, At, B0); PG8_MMA(1, 1, At, B1); PG8_BAR; PG8_SCHED;
            } else {
            PG8_LDB(B0, 0, 0); PG8_SCHED; PG8_LDA(At, 0, 0); PG8_STAGE(PG8_SA(1, 1), a1 + hstep, voffA);
            PG8_WAIT_L(8); PG8_BAR; PG8_WAIT_L(0); PG8_MMA(0, 0, At, B0); PG8_BAR; PG8_SCHED;
            PG8_LDB(B1, 0, 1); PG8_STAGE(PG8_SB(0, 0), b2, voffB);
            PG8_BAR; PG8_WAIT_L(0); PG8_MMA(0, 1, At, B1); PG8_BAR;
            PG8_LDA(At, 0, 1); PG8_STAGE(PG8_SA(0, 0), a2, voffA);
            PG8_BAR; PG8_WAIT_L(0); PG8_MMA(1, 0, At, B0); PG8_BAR; PG8_SCHED;
            PG8_STAGE(PG8_SB(0, 1), b2 + hstep, voffB);
            PG8_WAIT_V(6); PG8_BAR; PG8_MMA(1, 1, At, B1); PG8_BAR;
            PG8_LDB(B0, 1, 0); PG8_SCHED; PG8_LDA(At, 1, 0); PG8_STAGE(PG8_SA(0, 1), a2 + hstep, voffA);
            PG8_WAIT_L(8); PG8_BAR; PG8_WAIT_L(0); PG8_MMA(0, 0, At, B0); PG8_BAR; PG8_SCHED;
            PG8_LDB(B1, 1, 1); PG8_STAGE(PG8_SB(1, 0), b3, voffB);
            PG8_BAR; PG8_WAIT_L(0); PG8_MMA(0, 1, At, B1); PG8_BAR;
            PG8_LDA(At, 1, 1); PG8_STAGE(PG8_SA(1, 0), a3, voffA);
            PG8_BAR; PG8_WAIT_L(0); PG8_MMA(1, 0, At, B0); PG8_BAR; PG8_SCHED;
            PG8_STAGE(PG8_SB(1, 1), b3 + hstep, voffB);
            PG8_WAIT_V(6); PG8_BAR; PG8_MMA(1, 1, At, B1); PG8_BAR;
            }
        }
        if constexpr (ALIGN_EPI) { if (wr == 0) PG8_BAR; }
        if constexpr (!Epi::AFTER_DRAIN) { E(acc, cur, wr, wc, fr, fq); S.done(cur); }
        if (!has_next) break;
#pragma unroll
        for (int a = 0; a < 2; ++a)
#pragma unroll
            for (int b = 0; b < 2; ++b)
#pragma unroll
                for (int m = 0; m < 4; ++m)
#pragma unroll
                    for (int n = 0; n < 2; ++n) acc[a][b][m][n] = (f32x4){0.f, 0.f, 0.f, 0.f};
        cur = nxt; cA = nA; cB = nB; ++ui;
        if constexpr (ALIGN_EPI) { if (wr == 1) PG8_BAR; }
    }
    PG8_WAIT_V(0);
    if constexpr (!ALIGN_EPI) { if (wr == 0) PG8_BAR; }
    PG8_BAR;
    if constexpr (Epi::AFTER_DRAIN) { E.fused(acc, cur, wr, wc, fr, fq, lds, wid, lane); S.done(cur); }
#undef PG8_SA
#undef PG8_SB
#undef PG8_STAGE
#undef PG8_LDA
#undef PG8_LDB
#undef PG8_MMA
#undef PG8_WAIT_V
#undef PG8_WAIT_L
#undef PG8_BAR
#undef PG8_SCHED
}
}
#ifndef DBG_SCALE3
#define DBG_SCALE3 0
#endif
#ifndef DBG_ZERO
#define DBG_ZERO 0
#endif
#ifndef LAST_PHASE
#define LAST_PHASE 4
#endif
#ifndef REP_P0
#define REP_P0 1
#endif
#ifndef REP_P1
#define REP_P1 1
#endif
#ifndef REP_P2A
#define REP_P2A 1
#endif
#ifndef REP_P0T
#define REP_P0T 1
#endif
#ifndef REP_P0R
#define REP_P0R 1
#endif
#ifndef REP_S2
#define REP_S2 1
#endif
#ifndef REP_S3
#define REP_S3 1
#endif
#ifndef REP_S4
#define REP_S4 1
#endif
#ifndef REP_ATOM
#define REP_ATOM 1
#endif
#ifndef REP_SSD
#define REP_SSD 1
#endif
#ifndef REP_WIN
#define REP_WIN 1
#endif
#ifndef REP_MEM
#define REP_MEM 1
#endif
#ifndef REP_P3
#define REP_P3 1
#endif
#define DI __device__ __forceinline__
#define LAS __attribute__((address_space(3)))
typedef unsigned short bf16_t;
typedef short bf16x8 __attribute__((ext_vector_type(8)));
typedef float f32x4 __attribute__((ext_vector_type(4)));
typedef float f32x2 __attribute__((ext_vector_type(2)));
typedef unsigned u32x4 __attribute__((ext_vector_type(4)));
typedef unsigned u32x2 __attribute__((ext_vector_type(2)));

constexpr int NB_P = 16, T_P = 4096, NB_S = 32, T_S = 64, DM = 1024;
constexpr int MP = NB_P * T_P, MS = NB_S * T_S, MTOT = MP + MS;
constexpr int MMEM = NB_P * 256, MA = MTOT + MMEM;
constexpr int NPROJ = 4864, NBT = NPROJ + 1024, INC = 4880;
constexpr int C_Q = 0, C_K = 512, C_V = 640, C_GA = 768, C_Z = 1280, C_XBC = 2304, C_MQ = 3840, C_GM = 4352;
constexpr int NCHUNK = MTOT / 64;
constexpr float EPSF = 1e-6f;
constexpr size_t O_Y = 0;
constexpr size_t O_WKP = (size_t)MTOT * 1024;
constexpr size_t O_WVP = O_WKP + (size_t)NB_P * 128 * 128;
constexpr size_t O_SSMP = O_WVP + (size_t)NB_P * 128 * 128;
constexpr size_t O_CONVP = O_SSMP + (size_t)NB_P * 16 * 64 * 128;
constexpr size_t O_MKP = O_CONVP + (size_t)NB_P * 3 * 1536;
constexpr size_t O_MVP = O_MKP + (size_t)NB_P * 256 * 512;
constexpr size_t O_WKS = O_MVP + (size_t)NB_P * 256 * 512;
constexpr size_t O_WVS = O_WKS + (size_t)NB_S * 128 * 128;
constexpr size_t O_SSMS = O_WVS + (size_t)NB_S * 128 * 128;
constexpr size_t O_CONVS = O_SSMS + (size_t)NB_S * 16 * 64 * 128;
constexpr size_t O_END = O_CONVS + (size_t)NB_S * 3 * 1536;
static_assert(O_END == 81485824, "output size");
constexpr size_t MiB = 1u << 20;
constexpr size_t WS_ROPE = 1 * MiB;
constexpr size_t WS_BT = 2 * MiB;
constexpr size_t WS_WOUT = 14 * MiB;
constexpr size_t WS_DT = 18 * MiB;
constexpr size_t WS_SSQ = 23 * MiB;
constexpr size_t WS_CTL = 0, CTL_ZERO_BYTES = 65536;
constexpr size_t WS_MEMRAW = 32 * MiB;
constexpr size_t WS_MEMK = 40 * MiB;
constexpr size_t WS_MEMVT = 52 * MiB;
constexpr size_t WS_PROJ = 64 * MiB;
constexpr size_t WS_A = 692 * MiB;
constexpr size_t WS_MIX = 692 * MiB;
constexpr size_t WS_BCC = 956 * MiB;
constexpr size_t WS_END = 1022 * MiB;
static_assert(WS_BT + (size_t)NBT * 1024 * 2 <= WS_WOUT && WS_DT + (size_t)MTOT * 64 <= WS_SSQ && WS_SSQ + (size_t)MTOT * 128 <= WS_MEMRAW, "ws map 1");
static_assert(WS_PROJ + (size_t)MTOT * NPROJ * 2 <= WS_A && WS_A + (size_t)MA * 1024 * 2 <= WS_END && WS_MIX + (size_t)MTOT * 2048 * 2 <= WS_BCC && WS_BCC + (size_t)MTOT * 512 * 2 <= WS_END, "ws map 2");
constexpr int LDS_BYTES = 147456;

DI float bf2f(unsigned short b) { return __uint_as_float((unsigned)b << 16); }
typedef __bf16 hbf2 __attribute__((ext_vector_type(2)));
DI unsigned short f2bf(float f) { return __builtin_bit_cast(unsigned short, (__bf16)f); }
DI unsigned pk2(float lo, float hi) { const f32x2 v = {lo, hi}; return __builtin_bit_cast(unsigned, __builtin_convertvector(v, hbf2)); }
DI unsigned cvt_pk_bf16(float lo, float hi) { return pk2(lo, hi); }
DI float siluf(float x) { return x * __builtin_amdgcn_rcpf(1.0f + __expf(-x)); }
DI float xor32_sum(float x) { unsigned u = __builtin_bit_cast(unsigned, x); unsigned u2 = u; asm volatile("" : "+v"(u2)); auto r = __builtin_amdgcn_permlane32_swap(u, u2, false, false); unsigned r0 = r[0], r1 = r[1]; return __builtin_bit_cast(float, r0) + __builtin_bit_cast(float, r1); }
DI float xor16_sum(float x) { unsigned u = __builtin_bit_cast(unsigned, x); unsigned u2 = u; asm volatile("" : "+v"(u2)); auto r = __builtin_amdgcn_permlane16_swap(u, u2, false, false); unsigned r0 = r[0], r1 = r[1]; return __builtin_bit_cast(float, r0) + __builtin_bit_cast(float, r1); }
DI float xor32_max(float x) { unsigned u = __builtin_bit_cast(unsigned, x); unsigned u2 = u; asm volatile("" : "+v"(u2)); auto r = __builtin_amdgcn_permlane32_swap(u, u2, false, false); unsigned r0 = r[0], r1 = r[1]; return fmaxf(__builtin_bit_cast(float, r0), __builtin_bit_cast(float, r1)); }
DI float xor16_max(float x) { unsigned u = __builtin_bit_cast(unsigned, x); unsigned u2 = u; asm volatile("" : "+v"(u2)); auto r = __builtin_amdgcn_permlane16_swap(u, u2, false, false); unsigned r0 = r[0], r1 = r[1]; return fmaxf(__builtin_bit_cast(float, r0), __builtin_bit_cast(float, r1)); }
#define DPP_ROR_(v, n) __builtin_bit_cast(float, __builtin_amdgcn_update_dpp(0, __builtin_bit_cast(int, (v)), 0x120 + (n), 0xf, 0xf, false))
DI float row16_sum(float v) { v += DPP_ROR_(v, 8); v += DPP_ROR_(v, 4); v += DPP_ROR_(v, 2); v += DPP_ROR_(v, 1); return v; }
DI float wave_sum(float v) { return xor32_sum(xor16_sum(row16_sum(v))); }
#define DPP_MOV_(v, ctrl) __builtin_bit_cast(float, __builtin_amdgcn_update_dpp(0, __builtin_bit_cast(int, (v)), (ctrl), 0xf, 0xf, false))
DI float lane_xor1(float v) { return DPP_MOV_(v, 0xB1); }
DI float lane_xor2(float v) { return DPP_MOV_(v, 0x4E); }
DI float lane_xor4(float v) { const float t = DPP_MOV_(v, 0x141); return DPP_MOV_(t, 0x1B); }
DI float lane_xor8(float v) { const float t = DPP_MOV_(v, 0x140); return DPP_MOV_(t, 0x141); }
DI float swap32_sum(float a, float b) { unsigned ua = __builtin_bit_cast(unsigned, a), ub = __builtin_bit_cast(unsigned, b); auto r = __builtin_amdgcn_permlane32_swap(ua, ub, false, false); unsigned r0 = r[0], r1 = r[1]; return __builtin_bit_cast(float, r0) + __builtin_bit_cast(float, r1); }
DI float swap16_sum(float a, float b) { unsigned ua = __builtin_bit_cast(unsigned, a), ub = __builtin_bit_cast(unsigned, b); auto r = __builtin_amdgcn_permlane16_swap(ua, ub, false, false); unsigned r0 = r[0], r1 = r[1]; return __builtin_bit_cast(float, r0) + __builtin_bit_cast(float, r1); }
DI void unpack8(const u32x4 v, float (&o)[8]) {
#pragma unroll
    for (int i = 0; i < 4; ++i) { o[2 * i] = __uint_as_float(v[i] << 16); o[2 * i + 1] = __uint_as_float(v[i] & 0xffff0000u); }
}
DI u32x4 pack8(const float (&o)[8]) { u32x4 v; v.x = pk2(o[0], o[1]); v.y = pk2(o[2], o[3]); v.z = pk2(o[4], o[5]); v.w = pk2(o[6], o[7]); return v; }
#define LDS_WAIT() asm volatile("s_waitcnt lgkmcnt(0)" ::: "memory")
#define MFMA16(a, b, c) __builtin_amdgcn_mfma_f32_16x16x32_bf16((a), (b), (c), 0, 0, 0)

struct Args { const float* in[26]; float* out; unsigned char* ws; };
struct Ctx {
    LAS unsigned char* lds; int tid, lane, wave, G, bid;
    const float* in[26]; float* out; unsigned char* ws;
};
#define RLX_AGENT __ATOMIC_RELAXED, __HIP_MEMORY_SCOPE_AGENT
#define XB_TMO      128
#define XB_XCNT(j)  (256  + 64 * (j))
#define XB_XSUB(j)  (1280 + 64 * (j))
#define XB_XGEN(j)  (2304 + 64 * (j))
#define XB_TOP      3328
#define XB_TOPGEN   3392
#define XCD_BAR_WORDS 3456
#define XB_SPIN_CAP (1u << 18)

__device__ __forceinline__ unsigned xb_ld(unsigned* p)              { return __hip_atomic_load(p, __ATOMIC_RELAXED, __HIP_MEMORY_SCOPE_AGENT); }
__device__ __forceinline__ unsigned xb_add(unsigned* p, unsigned v) { return __hip_atomic_fetch_add(p, v, __ATOMIC_RELAXED, __HIP_MEMORY_SCOPE_AGENT); }
__device__ __forceinline__ unsigned xb_xcc_id() { return (unsigned)__builtin_amdgcn_s_getreg((3 << 11) | 20) & 0xFu; }
#define XB_SPIN(cond, bar) do { unsigned _sp = 0; while (cond) { __builtin_amdgcn_s_sleep(1); \
    if ((++_sp & 255u) == 0u) { if (xb_ld(&(bar)[XB_TMO])) break; if (_sp > XB_SPIN_CAP) { atomicAdd(&(bar)[XB_TMO], 1u); break; } } } } while (0)

struct XcdBarrier {
    unsigned* bar; unsigned x;
    volatile LAS unsigned* st;
};

__device__ __forceinline__ XcdBarrier xcd_barrier_post(unsigned* bar, volatile LAS unsigned* st) {
    XcdBarrier b; b.bar = bar; b.x = xb_xcc_id(); b.st = st;
    if (threadIdx.x == 0) (void)xb_add(&bar[XB_XCNT(b.x)], 1u);
    return b;
}
__device__ __forceinline__ void xcd_barrier_complete(unsigned* bar, unsigned x, unsigned& nloc, unsigned& nx) {
    const unsigned G = gridDim.x * gridDim.y * gridDim.z;
    unsigned sum, cnt, mine, sp = 0u;
    for (;;) {
        sum = 0u; cnt = 0u; mine = 0u;
#pragma unroll
        for (unsigned j = 0; j < 16; ++j) { const unsigned c = xb_ld(&bar[XB_XCNT(j)]); sum += c; cnt += (c > 0u) ? 1u : 0u; mine = (j == x) ? c : mine; }
        if (sum == G) break;
        __builtin_amdgcn_s_sleep(1);
        if ((++sp & 255u) == 0u) { if (xb_ld(&bar[XB_TMO])) break; if (sp > XB_SPIN_CAP) { atomicAdd(&bar[XB_TMO], 1u); break; } }
    }
    nloc = mine > 0u ? mine : 1u; nx = cnt > 0u ? cnt : 1u;
}

__device__ __forceinline__ void xcd_barrier(const XcdBarrier& b) {
    asm volatile("s_waitcnt vmcnt(0)" ::: "memory");
    __syncthreads();
    if (threadIdx.x == 0) {
        unsigned* bar = b.bar;
        __builtin_amdgcn_s_waitcnt(0);
        unsigned nloc = b.st[0], nx = b.st[1];
        if (nloc == 0u) { xcd_barrier_complete(bar, b.x, nloc, nx); b.st[0] = nloc; b.st[1] = nx; }
        const unsigned old = xb_add(&bar[XB_XSUB(b.x)], 1u);
        const unsigned gen = old / nloc;
        if (old + 1u == (gen + 1u) * nloc) {
            __builtin_amdgcn_fence(__ATOMIC_RELEASE, "agent");
            asm volatile("s_waitcnt vmcnt(0)" ::: "memory");
            const unsigned og = xb_add(&bar[XB_TOP], 1u);
            const unsigned tg = og / nx;
            if (og + 1u == (tg + 1u) * nx) xb_add(&bar[XB_TOPGEN], 1u);
            else XB_SPIN(xb_ld(&bar[XB_TOPGEN]) == tg, bar);
            __builtin_amdgcn_fence(__ATOMIC_ACQUIRE, "agent");
            xb_add(&bar[XB_XGEN(b.x)], 1u);
            asm volatile("s_waitcnt vmcnt(0)" ::: "memory");
        } else {
            XB_SPIN(xb_ld(&bar[XB_XGEN(b.x)]) == gen, bar);
            __builtin_amdgcn_fence(__ATOMIC_ACQUIRE, "agent");
            asm volatile("s_waitcnt vmcnt(0)" ::: "memory");
        }
    }
    __syncthreads();
}

enum { I_XP = 0, I_XS, I_CWK, I_CWV, I_SSM, I_SCONV, I_CMK, I_CMV, I_MEM, I_GNORM, I_WIN, I_GQ, I_GK, I_SINKS, I_CONVW, I_CONVB, I_DTB, I_ALOG, I_DSKIP, I_GSSD, I_GMEM, I_WMK, I_WMV, I_GMK, I_GMQ, I_WOUT };

DI void p0_transpose_item(const float* W, int ldw, int src_k0, int src_n0, const float* rowscale, bf16_t* WT, int ldt, int dst_n0, int dst_k0, LAS float* scr, int lane) {
#pragma unroll 8
    for (int i = 0; i < 32; ++i) { const int kk = 2 * i + (lane >> 5); float v = W[(size_t)(src_k0 + kk) * ldw + src_n0 + (lane & 31)]; if (rowscale) v *= rowscale[kk]; scr[kk * 33 + (lane & 31)] = v; }
    LDS_WAIT();
    const int c = lane & 7;
#pragma unroll
    for (int j = 0; j < 4; ++j) { const int n = (lane >> 3) + 8 * j; const LAS float* s = scr + (8 * c) * 33 + n;
        u32x4 o; o.x = pk2(s[0 * 33], s[1 * 33]); o.y = pk2(s[2 * 33], s[3 * 33]); o.z = pk2(s[4 * 33], s[5 * 33]); o.w = pk2(s[6 * 33], s[7 * 33]);
        *(u32x4*)(WT + (size_t)(dst_n0 + n) * ldt + dst_k0 + 8 * c) = o; }
    LDS_WAIT();
}

DI float reduce16_to_lane(float (&a)[16], int lane) {
#pragma unroll
    for (int j = 0; j < 16; ++j) { a[j] += __shfl_xor(a[j], 32); a[j] += __shfl_xor(a[j], 16); }
    float r8[8], r4[4], r2[2];
    const bool b3 = (lane & 8) != 0, b2 = (lane & 4) != 0, b1 = (lane & 2) != 0, b0 = (lane & 1) != 0;
#pragma unroll
    for (int j = 0; j < 8; ++j) { const float snd = b3 ? a[j] : a[j + 8], kp = b3 ? a[j + 8] : a[j]; r8[j] = kp + __shfl_xor(snd, 8); }
#pragma unroll
    for (int j = 0; j < 4; ++j) { const float snd = b2 ? r8[j] : r8[j + 4], kp = b2 ? r8[j + 4] : r8[j]; r4[j] = kp + __shfl_xor(snd, 4); }
#pragma unroll
    for (int j = 0; j < 2; ++j) { const float snd = b1 ? r4[j] : r4[j + 2], kp = b1 ? r4[j + 2] : r4[j]; r2[j] = kp + __shfl_xor(snd, 2); }
    const float snd = b0 ? r2[0] : r2[1], kp = b0 ? r2[1] : r2[0];
    return kp + __shfl_xor(snd, 1);
}

DI void p0_rows2(f32x4 (&va)[4], f32x4 (&vb)[4], const float* g, bf16_t* oa, bf16_t* ob, float* dta, float* dtb, bool want_dt, const float* dt_bias, const LAS float* wdt, int lane) {
    float sa = 0.f, sb = 0.f;
#pragma unroll
    for (int jj = 0; jj < 4; ++jj) { sa += (va[jj].x * va[jj].x + va[jj].y * va[jj].y) + (va[jj].z * va[jj].z + va[jj].w * va[jj].w); sb += (vb[jj].x * vb[jj].x + vb[jj].y * vb[jj].y) + (vb[jj].z * vb[jj].z + vb[jj].w * vb[jj].w); }
    const float ra = 1.0f / sqrtf(wave_sum(sa) * (1.0f / DM) + EPSF), rb = 1.0f / sqrtf(wave_sum(sb) * (1.0f / DM) + EPSF);
    u32x2* pa = (u32x2*)oa + lane; u32x2* pb = (u32x2*)ob + lane;
#pragma unroll
    for (int jj = 0; jj < 4; ++jj) { const f32x4 gv = ((const f32x4*)g)[64 * jj + lane]; va[jj] = va[jj] * ra * gv; vb[jj] = vb[jj] * rb * gv;
        u32x2 w; w.x = pk2(va[jj].x, va[jj].y); w.y = pk2(va[jj].z, va[jj].w); pa[64 * jj] = w; w.x = pk2(vb[jj].x, vb[jj].y); w.y = pk2(vb[jj].z, vb[jj].w); pb[64 * jj] = w; }
    if (want_dt) {
        f32x2 ab[16];
#pragma unroll
        for (int j = 0; j < 16; ++j) ab[j] = (f32x2){0.f, 0.f};
#pragma unroll
        for (int jj = 0; jj < 4; ++jj)
#pragma unroll
            for (int e = 0; e < 4; ++e) { const f32x2 hab = {va[jj][e], vb[jj][e]}; const LAS f32x4* wr = (const LAS f32x4*)(wdt + ((jj * 4 + e) * 64 + lane) * 20);
#pragma unroll
                for (int q = 0; q < 4; ++q) { const f32x4 w4 = wr[q];
                    ab[4 * q] += hab * w4.x; ab[4 * q + 1] += hab * w4.y; ab[4 * q + 2] += hab * w4.z; ab[4 * q + 3] += hab * w4.w; }
                if (e & 1) __builtin_amdgcn_sched_barrier(0); }
        float a[16], b[16];
#pragma unroll
        for (int j = 0; j < 16; ++j) { a[j] = ab[j].x; b[j] = ab[j].y; }
        const bool b5 = (lane & 32) != 0, b3 = (lane & 8) != 0, b2 = (lane & 4) != 0, b1 = (lane & 2) != 0;
        float v16[16], v8[8], v4[4], v2[2];
#pragma unroll
        for (int j = 0; j < 16; ++j) v16[j] = swap32_sum(a[j], b[j]);
#pragma unroll
        for (int j = 0; j < 8; ++j) v8[j] = swap16_sum(v16[j], v16[j + 8]);
#pragma unroll
        for (int j = 0; j < 4; ++j) { const float snd = b3 ? v8[j] : v8[j + 4], kp = b3 ? v8[j + 4] : v8[j]; v4[j] = kp + lane_xor8(snd); }
#pragma unroll
        for (int j = 0; j < 2; ++j) { const float snd = b2 ? v4[j] : v4[j + 2], kp = b2 ? v4[j + 2] : v4[j]; v2[j] = kp + lane_xor4(snd); }
        float tot; { const float snd = b1 ? v2[0] : v2[1], kp = b1 ? v2[1] : v2[0]; tot = kp + lane_xor2(snd); }
        tot += lane_xor1(tot);
        if ((lane & 1) == 0) { const int j = (lane >> 1) & 15; const float xv = tot + dt_bias[j]; float* dp = b5 ? dtb : dta;
            dp[j] = fmaxf(xv, 0.f) + log1pf(__expf(-fabsf(xv))); }
    }
}

DI void p0_row_segment(Ctx& F, const float* src, const float* g, int m0, int npair, bool tok, bf16_t* A, float* DT, const LAS float* wdt, int gw, int NGW) {
    const int lane = F.lane;
    f32x4 n0a[4], n0b[4], n1a[4], n1b[4];
#define P0_LOAD(dst_a, dst_b, pp) do { if ((pp) < npair) { _Pragma("unroll") for (int jj = 0; jj < 4; ++jj) { \
        dst_a[jj] = ((const f32x4*)(src + (size_t)(2 * (pp)) * DM))[64 * jj + lane]; dst_b[jj] = ((const f32x4*)(src + (size_t)(2 * (pp) + 1) * DM))[64 * jj + lane]; } } } while (0)
    P0_LOAD(n0a, n0b, gw); P0_LOAD(n1a, n1b, gw + NGW);
    for (int p = gw; p < npair; p += NGW) {
        f32x4 va[4], vb[4];
#pragma unroll
        for (int jj = 0; jj < 4; ++jj) { va[jj] = n0a[jj]; vb[jj] = n0b[jj]; n0a[jj] = n1a[jj]; n0b[jj] = n1b[jj]; }
        P0_LOAD(n1a, n1b, p + 2 * NGW);
        const int m = m0 + 2 * p;
        p0_rows2(va, vb, g, A + (size_t)m * DM, A + (size_t)(m + 1) * DM, DT + (size_t)(tok ? m : 0) * 16, DT + (size_t)(tok ? m + 1 : 0) * 16, tok, F.in[I_DTB], wdt, lane);
    }
#undef P0_LOAD
}

DI void p0_prologue(Ctx& F) {
    const int gw = F.bid * 8 + F.wave, NGW = F.G * 8, lane = F.lane;
    bf16_t* BT = (bf16_t*)(F.ws + WS_BT); bf16_t* WOT = (bf16_t*)(F.ws + WS_WOUT);
    for (int rep_ = 0; rep_ < REP_P0T; ++rep_) {
        LAS float* scr = (LAS float*)(F.lds + F.wave * 16384);
        constexpr int I_IN = 16 * (NPROJ / 32), I_M = 16 * 32, I_O = 32 * 32;
        for (int it = gw; it < I_IN + I_M + I_O; it += NGW) {
            int r = it;
            if (r < I_IN) { const int kb = r / (NPROJ / 32), nb = r % (NPROJ / 32); const int n0 = 32 * nb;
                p0_transpose_item(F.in[I_WIN], INC, 64 * kb, n0 + (n0 >= 3840 ? 16 : 0), nullptr, BT, 1024, n0, 64 * kb, scr, lane); continue; }
            r -= I_IN;
            if (r < I_M) { const int kb = r / 32, nb = r % 32;
                p0_transpose_item(nb < 16 ? F.in[I_WMK] : F.in[I_WMV], 512, 64 * kb, 32 * (nb & 15), nullptr, BT, 1024, NPROJ + 32 * nb, 64 * kb, scr, lane); continue; }
            r -= I_M;
            { const int kb = r / 32, nb = r % 32; const int k0 = 64 * kb;
              const int sk0 = k0 < 1024 ? 512 + k0 : (k0 < 1536 ? k0 - 1024 : k0);
              p0_transpose_item(F.in[I_WOUT], 1024, sk0, 32 * nb, k0 < 1024 ? F.in[I_GSSD] + k0 : nullptr, WOT, 2048, 32 * nb, k0, scr, lane); }
        }
    }
    { float* sq = (float*)(F.ws + WS_SSQ); for (int i = F.bid * 512 + F.tid; i < MTOT; i += F.G * 512) sq[i] = 0.f; }
    {
        f32x2* rope = (f32x2*)(F.ws + WS_ROPE);
        for (int i = F.bid * 512 + F.tid; i < 4096 * 32; i += F.G * 512) {
            const int pos = i >> 5, fi = i & 31;
            const float freq = exp2f(-(float)fi * (13.287712379549449f / 32.0f));
            double rev = (double)pos * (double)freq * 0.15915494309189535;
            rev -= __builtin_rint(rev);
            const float ang = (float)(rev * 6.283185307179586);
            rope[i] = (f32x2){cosf(ang), sinf(ang)};
        }
    }
    __syncthreads();
    for (int rep_ = 0; rep_ < REP_P0R; ++rep_) {
        if (rep_) __syncthreads();
        LAS float* wdt = (LAS float*)F.lds;
#pragma unroll 1
        for (int i0 = F.tid; i0 < 1024 * 16; i0 += 512 * 8) { float t8[8];
#pragma unroll
            for (int u = 0; u < 8; ++u) { const int i = i0 + 512 * u; t8[u] = F.in[I_WIN][(size_t)(i >> 4) * INC + 3840 + (i & 15)]; }
#pragma unroll
            for (int u = 0; u < 8; ++u) { const int i = i0 + 512 * u, k = i >> 4, j = i & 15; const int jj = k >> 8, e = k & 3, l = (k >> 2) & 63;
                wdt[((jj * 4 + e) * 64 + l) * 20 + j] = t8[u]; } }
        __syncthreads();
        bf16_t* A = (bf16_t*)(F.ws + WS_A); float* DT = (float*)(F.ws + WS_DT);
        p0_row_segment(F, F.in[I_XP], F.in[I_GNORM], 0, MP / 2, true, A, DT, wdt, gw, NGW);
        p0_row_segment(F, F.in[I_XS], F.in[I_GNORM], MP, MS / 2, true, A, DT, wdt, gw, NGW);
        p0_row_segment(F, F.in[I_MEM], F.in[I_GMEM], MTOT, MMEM / 2, false, A, DT, wdt, gw, NGW);
    }
}
struct Order1 {
    pg8::StaticOrder so; int G, c;
    __device__ void init(int G_, int c_) { so.init(MTOT, NPROJ, G_, c_); G = G_; c = c_; }
    __device__ bool next(int i, pg8::Unit& u) const {
        long L = (long)i * G + c;
        if (L >= (long)REP_P1 * (so.nwg + 64)) return false;
        L %= (so.nwg + 64);
        if (L < so.nwg) { pg8::StaticOrder t = so; t.G = 1; t.c = 0; return t.next((int)L, u); }
        const int r = (int)(L - so.nwg);
        u.pm = MTOT / 256 + (r >> 2); u.pn = NPROJ / 256 + (r & 3); return true;
    }
    __device__ __forceinline__ void a_ready(const pg8::Unit&) const {}
    __device__ __forceinline__ void done(const pg8::Unit&) const {}
};
struct Order3 {
    pg8::StaticOrder so; int G, c;
    __device__ void init(int G_, int c_) { so.init(MP, 1024, 1, 0); G = G_; c = c_; }
    __device__ bool next(int i, pg8::Unit& u) const {
        long L = (long)i * G + c;
        if (L >= (long)REP_P3 * so.nwg) return false;
        return so.next((int)(L % so.nwg), u);
    }
    __device__ __forceinline__ void a_ready(const pg8::Unit&) const {}
    __device__ __forceinline__ void done(const pg8::Unit&) const {}
};
struct EpiProj {
    static constexpr bool PERM = true, AFTER_DRAIN = false; static constexpr int MIDK = 0;
    bf16_t* proj; bf16_t* memraw;
    __device__ __forceinline__ void operator()(const f32x4 (&acc)[2][2][4][2], const pg8::Unit& u, int wr, int wc, int fr, int fq) const {
        bf16_t* base; int ldc, row0, col0;
        if (u.pn < NPROJ / 256) { base = proj; ldc = NPROJ; row0 = u.pm * 256; col0 = u.pn * 256; }
        else { base = memraw; ldc = 1024; row0 = (u.pm - MTOT / 256) * 256; col0 = (u.pn - NPROJ / 256) * 256; }
        row0 += wr * 64 + fr; col0 += wc * 32 + 8 * fq;
#pragma unroll
        for (int ai = 0; ai < 2; ++ai)
#pragma unroll
            for (int m = 0; m < 4; ++m) { bf16_t* rowp = base + (size_t)(row0 + ai * 128 + m * 16) * ldc + col0;
#pragma unroll
                for (int bj = 0; bj < 2; ++bj) { const f32x4 v0 = acc[ai][bj][m][0], v1 = acc[ai][bj][m][1];
                    u32x4 w; w.x = cvt_pk_bf16(v0[0], v0[1]); w.y = cvt_pk_bf16(v0[2], v0[3]); w.z = cvt_pk_bf16(v1[0], v1[1]); w.w = cvt_pk_bf16(v1[2], v1[3]);
                    *(u32x4*)(rowp + bj * 128) = w; } }
    }
};
struct EpiOut {
    static constexpr bool PERM = false, AFTER_DRAIN = false; static constexpr int MIDK = 16;
    const float* xp; const float* xs; float* out; const float* sumsq;
    __device__ __forceinline__ void mid(f32x4 (&acc)[2][2][4][2], const pg8::Unit& u, int wr, int wc, int fr, int fq) const {
        const float* sq = sumsq + (size_t)u.pm * 256 + wr * 64 + fr;
#pragma unroll
        for (int ai = 0; ai < 2; ++ai)
#pragma unroll
            for (int m = 0; m < 4; ++m) { const float r = 1.0f / sqrtf(sq[ai * 128 + m * 16] * (1.0f / 1024.0f) + EPSF);
#pragma unroll
                for (int bj = 0; bj < 2; ++bj)
#pragma unroll
                    for (int n = 0; n < 2; ++n) acc[ai][bj][m][n] = acc[ai][bj][m][n] * r; }
    }
    __device__ __forceinline__ void operator()(const f32x4 (&acc)[2][2][4][2], const pg8::Unit& u, int wr, int wc, int fr, int fq) const {
        const float* xb = u.pm < MP / 256 ? xp + (size_t)u.pm * 256 * DM : xs + (size_t)(u.pm - MP / 256) * 256 * DM;
        float* ob = out + (size_t)u.pm * 256 * DM;
        const int rl0 = wr * 64 + fr, col0 = u.pn * 256 + wc * 32 + 4 * fq;
#pragma unroll
        for (int ai = 0; ai < 2; ++ai) {
            f32x4 xv[4][2][2];
#pragma unroll
            for (int m = 0; m < 4; ++m)
#pragma unroll
                for (int bj = 0; bj < 2; ++bj)
#pragma unroll
                    for (int n = 0; n < 2; ++n) xv[m][bj][n] = *(const f32x4*)(xb + (size_t)(rl0 + ai * 128 + m * 16) * DM + col0 + bj * 128 + n * 16);
#pragma unroll
            for (int m = 0; m < 4; ++m)
#pragma unroll
                for (int bj = 0; bj < 2; ++bj)
#pragma unroll
                    for (int n = 0; n < 2; ++n) *(f32x4*)(ob + (size_t)(rl0 + ai * 128 + m * 16) * DM + col0 + bj * 128 + n * 16) = acc[ai][bj][m][n] + xv[m][bj][n];
            asm volatile("" ::: "memory"); }
    }
};

constexpr int SS_X = 0, SS_XD = 9216, SS_BM = 18432, SS_CM = 35840, SS_SET = 53248;
constexpr int SS_SB = 2 * SS_SET, SS_WM = SS_SB + 17408, SS_SM = SS_WM + 9216;
constexpr int LD64 = 144, LD128 = 272;
typedef short s16x4 __attribute__((ext_vector_type(4)));

DI bf16x8 lds_frag(const LAS unsigned char* tile, int ld, int row0, int k0, int lane) {
    return *(const LAS bf16x8*)(tile + (row0 + (lane & 15)) * ld + (k0 + 8 * (lane >> 4)) * 2);
}
DI bf16x8 lds_frag_tr(const LAS unsigned char* tile, int ld, int k0, int c0, int lane) {
    const LAS unsigned char* a = tile + (k0 + 8 * (lane >> 4) + ((lane & 15) >> 2)) * ld + (c0 + 4 * (lane & 3)) * 2;
    const s16x4 lo = __builtin_amdgcn_ds_read_tr16_b64_v4i16((LAS s16x4*)a), hi = __builtin_amdgcn_ds_read_tr16_b64_v4i16((LAS s16x4*)(a + 4 * ld));
    return (bf16x8){lo.x, lo.y, lo.z, lo.w, hi.x, hi.y, hi.z, hi.w};
}
DI bf16x8 lds_frag_tr2(const LAS unsigned char* tile, int ld, int k0, int c0, int lane) {
    const LAS unsigned char* a = tile + (k0 + 4 * (lane >> 4) + ((lane & 15) >> 2)) * ld + (c0 + 4 * (lane & 3)) * 2;
    const s16x4 lo = __builtin_amdgcn_ds_read_tr16_b64_v4i16((LAS s16x4*)a), hi = __builtin_amdgcn_ds_read_tr16_b64_v4i16((LAS s16x4*)(a + 16 * ld));
    return (bf16x8){lo.x, lo.y, lo.z, lo.w, hi.x, hi.y, hi.z, hi.w};
}
#define MFMA16T(rowsfrag, colsfrag, acc) MFMA16((colsfrag), (rowsfrag), (acc))

#define DPP_ADD_(v, ctrl, rmask) ((v) + __builtin_bit_cast(float, __builtin_amdgcn_update_dpp(0, __builtin_bit_cast(int, (v)), (ctrl), (rmask), 0xf, false)))
DI float wave_incl_scan(float v) {
    v = DPP_ADD_(v, 0x111, 0xf); v = DPP_ADD_(v, 0x112, 0xf); v = DPP_ADD_(v, 0x114, 0xf); v = DPP_ADD_(v, 0x118, 0xf);
    v = DPP_ADD_(v, 0x142, 0xa);
    v = DPP_ADD_(v, 0x143, 0xc);
    return v;
}
DI void convbc_prepass(Ctx& F) {
    const int gw = F.bid * 8 + F.wave, NGW = F.G * 8, lane = F.lane;
    const bf16_t* PROJ = (const bf16_t*)(F.ws + WS_PROJ); bf16_t* BCC = (bf16_t*)(F.ws + WS_BCC);
    const int ch0 = 1024 + lane * 8;
    float wv[4][8], bv[8];
#pragma unroll
    for (int e = 0; e < 8; ++e) { bv[e] = F.in[I_CONVB][ch0 + e];
#pragma unroll
        for (int j = 0; j < 4; ++j) wv[j][e] = F.in[I_CONVW][j * 1536 + ch0 + e]; }
    const bool bal = (F.G == 256);
    const int nmine = bal ? (F.bid < 64 ? 0 : (F.bid < 128 ? 2 : 1)) : (MTOT / 33 - gw + NGW - 1) / NGW;
    for (int ti = 0; ti < nmine; ++ti) {
        const int t = bal ? (F.bid < 128 ? ((F.bid - 64) * 8 + F.wave) * 2 + ti : 1024 + (F.bid - 128) * 8 + F.wave) : gw + ti * NGW;
        const int row0 = t * 33;
        float h0[8], h1[8], h2[8];
        { const bool smp0 = row0 >= MP; const int lrow0 = smp0 ? (row0 - MP) & 63 : row0 & (T_P - 1);
          const float* sc0 = F.in[I_SCONV] + (size_t)(smp0 ? (row0 - MP) >> 6 : 0) * 3 * 1536 + ch0;
#define CONV_HALO(dst, j) do { const int lr_ = lrow0 - 3 + (j); \
              if (lr_ >= 0) unpack8(*(const u32x4*)(PROJ + (size_t)(row0 - 3 + (j)) * NPROJ + C_XBC + ch0), dst); \
              else { _Pragma("unroll") for (int e = 0; e < 8; ++e) dst[e] = smp0 ? sc0[(3 + lr_) * 1536 + e] : 0.f; } } while (0)
          CONV_HALO(h0, 0); CONV_HALO(h1, 1); CONV_HALO(h2, 2);
#undef CONV_HALO
        }
#pragma unroll 1
        for (int bt = 0; bt < 3; ++bt) {
            u32x4 raw[11];
#pragma unroll
            for (int i = 0; i < 11; ++i) raw[i] = *(const u32x4*)(PROJ + (size_t)(row0 + 11 * bt + i) * NPROJ + C_XBC + ch0);
#pragma unroll
            for (int i = 0; i < 11; ++i) { const int row = row0 + 11 * bt + i;
                const bool smp = row >= MP; const int lrow = smp ? (row - MP) & 63 : row & (T_P - 1);
                if (lrow == 0) {
                    if (smp) { const float* sc = F.in[I_SCONV] + (size_t)((row - MP) >> 6) * 3 * 1536 + ch0;
#pragma unroll
                        for (int e = 0; e < 8; ++e) { h0[e] = sc[e]; h1[e] = sc[1536 + e]; h2[e] = sc[2 * 1536 + e]; } }
                    else {
#pragma unroll
                        for (int e = 0; e < 8; ++e) { h0[e] = 0.f; h1[e] = 0.f; h2[e] = 0.f; } } }
                float cur[8], o[8];
                unpack8(raw[i], cur);
#pragma unroll
                for (int e = 0; e < 8; ++e) { o[e] = siluf(bv[e] + wv[0][e] * h0[e] + wv[1][e] * h1[e] + wv[2][e] * h2[e] + wv[3][e] * cur[e]); h0[e] = h1[e]; h1[e] = h2[e]; h2[e] = cur[e]; }
                *(u32x4*)(BCC + (size_t)row * 512 + lane * 8) = pack8(o); }
        }
    }
}

DI void ssd_item(Ctx& F, int sq, int h, bool do_sumsq) {
    LAS unsigned char* lds = F.lds;
    const int tid = F.tid, lane = F.lane, w = F.wave, g = h >> 3;
    const bool smp = sq >= NB_P; const int sb = sq - NB_P;
    const int row_base = smp ? MP + sb * 64 : sq * T_P, nchunks = smp ? 1 : 64;
    const bf16_t* PROJ = (const bf16_t*)(F.ws + WS_PROJ); const bf16_t* BCC = (const bf16_t*)(F.ws + WS_BCC); const float* DT = (const float*)(F.ws + WS_DT);
    bf16_t* MIX = (bf16_t*)(F.ws + WS_MIX); float* SUMSQ = (float*)(F.ws + WS_SSQ);
    const float a_h = -__expf(F.in[I_ALOG][h]), d_h = F.in[I_DSKIP][h];
    const int pt = w >> 1, nh = w & 1, lt = w >> 1;
    const int xl = tid >> 3, xg = tid & 7, chx = h * 64 + 8 * xg;
    LAS float* sm_cw0 = (LAS float*)(lds + SS_SM + 1024 + 768);
    if (tid >= 192 && tid < 512) { const int i = tid - 192; const int j = i >> 6, chn = h * 64 + (i & 63); sm_cw0[i] = j < 4 ? F.in[I_CONVW][j * 1536 + chn] : F.in[I_CONVB][chn]; }
    f32x4 st[4];
#pragma unroll
    for (int q = 0; q < 4; ++q) {
        if (smp) st[q] = *(const f32x4*)(F.in[I_SSM] + ((size_t)(sb * 16 + h) * 64 + 16 * pt + (lane & 15)) * 128 + 16 * (4 * nh + q) + 4 * (lane >> 4));
        else st[q] = (f32x4){0.f, 0.f, 0.f, 0.f};
    }
    u32x4 px0[4], px1[4], pbs[2], pcs[2]; u32x2 pz0[2], pz1[2]; float pdt0, pdt1;
#define SSD_ISSUE_X(c_, PX_) do { const int row0_ = row_base + 64 * (c_); \
        _Pragma("unroll") for (int j_ = 0; j_ < 4; ++j_) { int rr_ = xl - 3 + j_; if ((c_) == 0 && rr_ < 0) rr_ = 0; PX_[j_] = *(const u32x4*)(PROJ + (size_t)(row0_ + rr_) * NPROJ + C_XBC + chx); } } while (0)
#define SSD_ISSUE_BC(c_) do { const int row0_ = row_base + 64 * (c_); \
        _Pragma("unroll") for (int i_ = 0; i_ < 2; ++i_) { const int t_ = tid + 512 * i_; \
            pbs[i_] = *(const u32x4*)(BCC + (size_t)(row0_ + (t_ >> 4)) * 512 + g * 128 + 8 * (t_ & 15)); pcs[i_] = *(const u32x4*)(BCC + (size_t)(row0_ + (t_ >> 4)) * 512 + 256 + g * 128 + 8 * (t_ & 15)); } } while (0)
#define SSD_ISSUE_ZDT(c_, PZ_, PDT_) do { const int row0_ = row_base + 64 * (c_); \
        _Pragma("unroll") for (int pi_ = 0; pi_ < 2; ++pi_) PZ_[pi_] = *(const u32x2*)(PROJ + (size_t)(row0_ + 16 * lt + (lane & 15)) * NPROJ + C_Z + h * 64 + 16 * (2 * nh + pi_) + 4 * (lane >> 4)); \
        PDT_ = DT[(size_t)(row0_ + lane) * 16 + h]; } while (0)
    LAS float* sm_init = (LAS float*)(lds + SS_SM + 1024);
    if (tid < 192) sm_init[tid] = smp ? F.in[I_SCONV][(size_t)(sb * 3 + (tid >> 6)) * 1536 + h * 64 + (tid & 63)] : 0.f;
#define SSD_STEP(c, PX_, PZ_, PDT_) do { \
        const int row0 = row_base + 64 * c; LAS unsigned char* ts = lds + (c & 1) * SS_SET; \
        LAS float* sm_ac = (LAS float*)(lds + SS_SM + (c & 1) * 512); LAS float* sm_dt = sm_ac + 64; \
        const float dtl = PDT_; \
        float ac = dtl * a_h; \
        ac = wave_incl_scan(ac); \
        const float ac_last = __builtin_bit_cast(float, __builtin_amdgcn_readlane(__builtin_bit_cast(int, ac), 63)); \
        const float wgt_l = __expf(ac_last - ac) * dtl; \
        if (w == 0) { sm_ac[lane] = ac; sm_dt[lane] = dtl; } \
        { \
        { float xr[4][8], o[8], od[8]; \
_Pragma("unroll")           for (int j = 0; j < 4; ++j) unpack8(PX_[j], xr[j]); \
          if (c == 0) { \
_Pragma("unroll")               for (int j = 0; j < 3; ++j) { const int rr = xl - 3 + j; const LAS f32x4* iv = (const LAS f32x4*)(sm_init + (rr < 0 ? 3 + rr : 0) * 64 + 8 * xg); \
                  f32x4 i0 = iv[0], i1 = iv[1]; asm volatile("" : "+v"(i0), "+v"(i1)); \
_Pragma("unroll")                   for (int e = 0; e < 4; ++e) { xr[j][e] = (rr < 0) ? i0[e] : xr[j][e]; xr[j][4 + e] = (rr < 0) ? i1[e] : xr[j][4 + e]; } } } \
          const float wg = __shfl(wgt_l, xl & 63); \
          float wv[4][8], bv[8]; unsigned cwo_ = (unsigned)(8 * xg) * 4u; asm volatile("" : "+v"(cwo_)); const LAS float* sm_cw = (const LAS float*)((const LAS unsigned char*)sm_cw0 + cwo_) - 8 * xg; \
          _Pragma("unroll") for (int j_ = 0; j_ < 4; ++j_) { const f32x4 a_ = *(const LAS f32x4*)(sm_cw + j_ * 64 + 8 * xg), b_ = *(const LAS f32x4*)(sm_cw + j_ * 64 + 8 * xg + 4); \
              _Pragma("unroll") for (int e_ = 0; e_ < 4; ++e_) { wv[j_][e_] = a_[e_]; wv[j_][4 + e_] = b_[e_]; } } \
          { const f32x4 a_ = *(const LAS f32x4*)(sm_cw + 256 + 8 * xg), b_ = *(const LAS f32x4*)(sm_cw + 256 + 8 * xg + 4); _Pragma("unroll") for (int e_ = 0; e_ < 4; ++e_) { bv[e_] = a_[e_]; bv[4 + e_] = b_[e_]; } } \
_Pragma("unroll")           for (int e = 0; e < 8; ++e) { o[e] = siluf(bv[e] + wv[0][e] * xr[0][e] + wv[1][e] * xr[1][e] + wv[2][e] * xr[2][e] + wv[3][e] * xr[3][e]); od[e] = o[e] * wg; } \
          *(LAS u32x4*)(ts + SS_X + xl * LD64 + xg * 16) = pack8(o); \
          *(LAS u32x4*)(ts + SS_XD + xl * LD64 + xg * 16) = pack8(od); } \
_Pragma("unroll")         for (int i = 0; i < 2; ++i) { const int t = tid + 512 * i; \
            *(LAS u32x4*)(ts + SS_BM + (t >> 4) * LD128 + (t & 15) * 16) = pbs[i]; *(LAS u32x4*)(ts + SS_CM + (t >> 4) * LD128 + (t & 15) * 16) = pcs[i]; } \
        } \
        if (c + 2 < nchunks) SSD_ISSUE_X(c + 2, PX_); if (c + 1 < nchunks) SSD_ISSUE_BC(c + 1); \
        __syncthreads(); \
_Pragma("unroll")         for (int q = 0; q < 4; ++q) { u32x2 v; v.x = pk2(st[q][0], st[q][1]); v.y = pk2(st[q][2], st[q][3]); \
            *(LAS u32x2*)(lds + SS_SB + (16 * pt + (lane & 15)) * LD128 + (16 * (4 * nh + q) + 4 * (lane >> 4)) * 2) = v; } \
        { const float acl = sm_ac[16 * lt + (lane & 15)]; const int l = 16 * lt + (lane & 15); \
_Pragma("unroll")           for (int si = 0; si < 2; ++si) { const int stl = 2 * nh + si; f32x4 gacc = {0.f, 0.f, 0.f, 0.f}; \
              if (stl <= lt) { \
_Pragma("unroll")                   for (int ks = 0; ks < 4; ++ks) gacc = MFMA16T(lds_frag(ts + SS_CM, LD128, 16 * lt, 32 * ks, lane), lds_frag(ts + SS_BM, LD128, 16 * stl, 32 * ks, lane), gacc); } \
              const int s0 = 16 * stl + 4 * (lane >> 4); \
              const f32x4 acs = *(const LAS f32x4*)(sm_ac + s0), dts = *(const LAS f32x4*)(sm_dt + s0); \
              float v[4]; \
_Pragma("unroll")               for (int r = 0; r < 4; ++r) { v[r] = gacc[r] * __expf(fminf(acl - acs[r], 0.f)) * dts[r]; v[r] = (l >= s0 + r) ? v[r] : 0.f; } \
              u32x2 pk; pk.x = pk2(v[0], v[1]); pk.y = pk2(v[2], v[3]); \
              *(LAS u32x2*)(lds + SS_WM + l * LD64 + s0 * 2) = pk; } } \
        __syncthreads(); \
        { \
        { const int l = 16 * lt + (lane & 15); const float eal = __expf(sm_ac[l]); \
          float ssq = 0.f; \
_Pragma("unroll")           for (int pi = 0; pi < 2; ++pi) { const int ptl = 2 * nh + pi; const int p0 = 16 * ptl + 4 * (lane >> 4); \
              f32x4 y = {0.f, 0.f, 0.f, 0.f}; \
_Pragma("unroll")               for (int ks = 0; ks < 4; ++ks) y = MFMA16T(lds_frag(ts + SS_CM, LD128, 16 * lt, 32 * ks, lane), lds_frag(lds + SS_SB, LD128, 16 * ptl, 32 * ks, lane), y); \
              y = y * eal; \
_Pragma("unroll")               for (int ks = 0; ks < 2; ++ks) y = MFMA16T(lds_frag(lds + SS_WM, LD64, 16 * lt, 32 * ks, lane), lds_frag_tr(ts + SS_X, LD64, 32 * ks, 16 * ptl, lane), y); \
              const u32x2 xraw = *(const LAS u32x2*)(ts + SS_X + l * LD64 + p0 * 2); \
              const float xv[4] = {__uint_as_float(xraw.x << 16), __uint_as_float(xraw.x & 0xffff0000u), __uint_as_float(xraw.y << 16), __uint_as_float(xraw.y & 0xffff0000u)}; \
              const float zv[4] = {__uint_as_float(PZ_[pi].x << 16), __uint_as_float(PZ_[pi].x & 0xffff0000u), __uint_as_float(PZ_[pi].y << 16), __uint_as_float(PZ_[pi].y & 0xffff0000u)}; \
              float gv[4]; \
_Pragma("unroll")               for (int r = 0; r < 4; ++r) { gv[r] = (y[r] + d_h * xv[r]) * siluf(zv[r]); ssq += gv[r] * gv[r]; } \
              u32x2 pk; pk.x = pk2(gv[0], gv[1]); pk.y = pk2(gv[2], gv[3]); \
              *(u32x2*)(MIX + (size_t)(row0 + l) * 2048 + h * 64 + p0) = pk; } \
          ssq = xor32_sum(xor16_sum(ssq)); \
          if (lane < 16 && do_sumsq) unsafeAtomicAdd(SUMSQ + row0 + l, ssq); } \
        } \
        { const float cd = __expf(ac_last); \
          bf16x8 xa[2]; \
_Pragma("unroll")           for (int ks = 0; ks < 2; ++ks) xa[ks] = lds_frag_tr(ts + SS_XD, LD64, 32 * ks, 16 * pt, lane); \
_Pragma("unroll")           for (int q = 0; q < 4; ++q) { f32x4 s = st[q] * cd; \
_Pragma("unroll")               for (int ks = 0; ks < 2; ++ks) s = MFMA16T(xa[ks], lds_frag_tr(ts + SS_BM, LD128, 32 * ks, 16 * (4 * nh + q), lane), s); \
              st[q] = s; } } \
        if (c + 2 < nchunks) SSD_ISSUE_ZDT(c + 2, PZ_, PDT_); \
    } while (0)
    SSD_ISSUE_X(0, px0); SSD_ISSUE_BC(0); SSD_ISSUE_ZDT(0, pz0, pdt0);
    __syncthreads();
    if (nchunks > 1) { SSD_ISSUE_X(1, px1); SSD_ISSUE_ZDT(1, pz1, pdt1); }
#pragma unroll 1
    for (int c2 = 0; c2 < nchunks; c2 += 2) {
        { const int c = c2; SSD_STEP(c, px0, pz0, pdt0); }
        if (c2 + 1 < nchunks) { const int c = c2 + 1; SSD_STEP(c, px1, pz1, pdt1); }
    }
#undef SSD_STEP
#undef SSD_ISSUE_X
#undef SSD_ISSUE_BC
#undef SSD_ISSUE_ZDT
    { float* so = F.out + (smp ? O_SSMS + ((size_t)(sb * 16 + h) * 64) * 128 : O_SSMP + ((size_t)(sq * 16 + h) * 64) * 128);
#pragma unroll
      for (int q = 0; q < 4; ++q) *(f32x4*)(so + (16 * pt + (lane & 15)) * 128 + 16 * (4 * nh + q) + 4 * (lane >> 4)) = st[q]; }
    __syncthreads();
}
DI void p2a_phase(Ctx& F) {
    convbc_prepass(F);
    {
        const bf16_t* PROJ = (const bf16_t*)(F.ws + WS_PROJ);
        for (int i = F.bid * 512 + F.tid; i < 48 * 3 * 1536; i += F.G * 512) {
            const int ch = i % 1536, j = (i / 1536) % 3, sq = i / (3 * 1536);
            if (sq < NB_P) F.out[O_CONVP + (size_t)(sq * 3 + j) * 1536 + ch] = bf2f(PROJ[(size_t)(sq * T_P + T_P - 3 + j) * NPROJ + C_XBC + ch]);
            else F.out[O_CONVS + (size_t)((sq - NB_P) * 3 + j) * 1536 + ch] = bf2f(PROJ[(size_t)(MP + (sq - NB_P) * 64 + 61 + j) * NPROJ + C_XBC + ch]);
        }
    }
}
constexpr int WR_SLOT = 19456, WR_V = 9216, LDKW = 144, LDVW = 160;

DI void wa_write_k(Ctx& F, LAS unsigned char* slot, int kvh, const u32x4 ra, const u32x4 rb, int pos, float* ko) {
    const int i = F.tid >> 2, q4 = F.tid & 3;
    float a[8], bb[8], o1[8], o2[8];
    unpack8(ra, a); unpack8(rb, bb);
    float s = 0.f;
#pragma unroll
    for (int e = 0; e < 8; ++e) s += a[e] * a[e] + bb[e] * bb[e];
    s += __shfl_xor(s, 1); s += __shfl_xor(s, 2);
    const float rstd = 1.0f / sqrtf(s * (1.0f / 64.0f) + EPSF);
    const f32x2* ROPE = (const f32x2*)(F.ws + WS_ROPE);
#pragma unroll
    for (int e = 0; e < 8; ++e) { const float an = a[e] * rstd * F.in[I_GK][8 * q4 + e], bn = bb[e] * rstd * F.in[I_GK][32 + 8 * q4 + e];
        const f32x2 cs = ROPE[pos * 32 + 8 * q4 + e]; o1[e] = an * cs.x - bn * cs.y; o2[e] = bn * cs.x + an * cs.y; }
    *(LAS u32x4*)(slot + i * LDKW + (8 * q4) * 2) = pack8(o1);
    *(LAS u32x4*)(slot + i * LDKW + (32 + 8 * q4) * 2) = pack8(o2);
    if (ko) { float* p = ko + ((size_t)i * 2 + kvh) * 64;
        *(f32x4*)(p + 8 * q4) = (f32x4){o1[0], o1[1], o1[2], o1[3]}; *(f32x4*)(p + 8 * q4 + 4) = (f32x4){o1[4], o1[5], o1[6], o1[7]};
        *(f32x4*)(p + 32 + 8 * q4) = (f32x4){o2[0], o2[1], o2[2], o2[3]}; *(f32x4*)(p + 32 + 8 * q4 + 4) = (f32x4){o2[4], o2[5], o2[6], o2[7]}; }
}
DI void wa_write_v(Ctx& F, LAS unsigned char* slot, int kvh, const u32x4 rv, float* vo) {
    const int i = F.tid >> 3, q8 = F.tid & 7;
    *(LAS u32x4*)(slot + WR_V + i * LDVW + q8 * 16) = rv;
    if (vo) { float v[8]; unpack8(rv, v); float* p = vo + ((size_t)i * 2 + kvh) * 64 + 8 * q8;
        *(f32x4*)p = (f32x4){v[0], v[1], v[2], v[3]}; *(f32x4*)(p + 4) = (f32x4){v[4], v[5], v[6], v[7]}; }
}
DI void wa_stage_cache(Ctx& F, LAS unsigned char* slot, int kvh, const float* ck, const float* cv, float* ko, float* vo) {
    if (F.tid < 256) { const int i = F.tid >> 2, q4 = F.tid & 3; const float* src = ck + ((size_t)i * 2 + kvh) * 64;
        const f32x4 a0 = *(const f32x4*)(src + 8 * q4), a1 = *(const f32x4*)(src + 8 * q4 + 4), b0 = *(const f32x4*)(src + 32 + 8 * q4), b1 = *(const f32x4*)(src + 32 + 8 * q4 + 4);
        u32x4 pa, pb; pa.x = pk2(a0.x, a0.y); pa.y = pk2(a0.z, a0.w); pa.z = pk2(a1.x, a1.y); pa.w = pk2(a1.z, a1.w); pb.x = pk2(b0.x, b0.y); pb.y = pk2(b0.z, b0.w); pb.z = pk2(b1.x, b1.y); pb.w = pk2(b1.z, b1.w);
        *(LAS u32x4*)(slot + i * LDKW + (8 * q4) * 2) = pa; *(LAS u32x4*)(slot + i * LDKW + (32 + 8 * q4) * 2) = pb;
        if (ko) { float* p = ko + ((size_t)i * 2 + kvh) * 64; *(f32x4*)(p + 8 * q4) = a0; *(f32x4*)(p + 8 * q4 + 4) = a1; *(f32x4*)(p + 32 + 8 * q4) = b0; *(f32x4*)(p + 32 + 8 * q4 + 4) = b1; } }
    { const int i = F.tid >> 3, q8 = F.tid & 7; const float* src = cv + ((size_t)i * 2 + kvh) * 64 + 8 * q8; const f32x4 v0 = *(const f32x4*)src, v1 = *(const f32x4*)(src + 4);
      u32x4 pv; pv.x = pk2(v0.x, v0.y); pv.y = pk2(v0.z, v0.w); pv.z = pk2(v1.x, v1.y); pv.w = pk2(v1.z, v1.w);
      *(LAS u32x4*)(slot + WR_V + i * LDVW + q8 * 16) = pv;
      if (vo) { float* p = vo + ((size_t)i * 2 + kvh) * 64 + 8 * q8; *(f32x4*)p = v0; *(f32x4*)(p + 4) = v1; } }
}
DI void wa_compute(Ctx& F, int kvh, size_t crow0, int pos0, int sl0, int sl1, int sl2, int ninv) {
    LAS unsigned char* lds = F.lds;
    const int lane = F.lane, w = F.wave, g4 = lane >> 4;
    const bf16_t* PROJ = (const bf16_t*)(F.ws + WS_PROJ); const f32x2* ROPE = (const f32x2*)(F.ws + WS_ROPE); bf16_t* MIX = (bf16_t*)(F.ws + WS_MIX);
    const int hq = kvh * 4 + (w >> 1); const float sink = F.in[I_SINKS][hq] * 1.4426950408889634f;
    u32x2 graw[2][4]; u32x4 qraw[2][2];
#pragma unroll
    for (int rg = 0; rg < 2; ++rg) { const size_t row = crow0 + 32 * (w & 1) + 16 * rg + (lane & 15);
#pragma unroll
        for (int dt = 0; dt < 4; ++dt) graw[rg][dt] = *(const u32x2*)(PROJ + row * NPROJ + C_GA + hq * 64 + 16 * dt + 4 * g4);
        qraw[rg][0] = *(const u32x4*)(PROJ + row * NPROJ + C_Q + hq * 64 + 8 * g4); qraw[rg][1] = *(const u32x4*)(PROJ + row * NPROJ + C_Q + hq * 64 + 32 + 8 * g4); }
    bf16x8 qa[2][2];
#pragma unroll
    for (int rg = 0; rg < 2; ++rg) {
        const int d0 = 8 * g4; float a[8], bb[8];
        unpack8(qraw[rg][0], a);
        unpack8(qraw[rg][1], bb);
        float s = 0.f;
#pragma unroll
        for (int e = 0; e < 8; ++e) s += a[e] * a[e] + bb[e] * bb[e];
        s = xor32_sum(xor16_sum(s));
        const float rstd = 0.18033688011112042f / sqrtf(s * (1.0f / 64.0f) + EPSF);
        const int pos = pos0 + 32 * (w & 1) + 16 * rg + (lane & 15);
        float o1[8], o2[8];
#pragma unroll
        for (int e = 0; e < 8; ++e) { const float an = a[e] * rstd * F.in[I_GQ][d0 + e], bn = bb[e] * rstd * F.in[I_GQ][32 + d0 + e];
            const f32x2 cs = ROPE[pos * 32 + d0 + e]; o1[e] = an * cs.x - bn * cs.y; o2[e] = bn * cs.x + an * cs.y; }
        qa[rg][0] = __builtin_bit_cast(bf16x8, pack8(o1)); qa[rg][1] = __builtin_bit_cast(bf16x8, pack8(o2)); }
    f32x4 s[2][12];
#pragma unroll
    for (int jt = 0; jt < 12; ++jt) { const int j = jt >> 2; const LAS unsigned char* kt = lds + (j == 0 ? sl0 : (j == 1 ? sl1 : sl2)) * WR_SLOT;
        const bf16x8 k0 = lds_frag(kt, LDKW, 16 * (jt & 3), 0, lane), k1 = lds_frag(kt, LDKW, 16 * (jt & 3), 32, lane);
#pragma unroll
        for (int rg = 0; rg < 2; ++rg) { f32x4 acc = {0.f, 0.f, 0.f, 0.f};
            acc = MFMA16T(qa[rg][0], k0, acc); acc = MFMA16T(qa[rg][1], k1, acc);
            s[rg][jt] = acc; }
        if ((jt & 3) == 3) __builtin_amdgcn_sched_barrier(0); }
    if (ninv > 0) {
#pragma unroll
        for (int jt = 0; jt < 8; ++jt) if ((jt >> 2) < ninv) { s[0][jt] = (f32x4){-1e30f, -1e30f, -1e30f, -1e30f}; s[1][jt] = (f32x4){-1e30f, -1e30f, -1e30f, -1e30f}; } }
    float inv[2]; bf16x8 pa[2][6];
#pragma unroll
    for (int rg = 0; rg < 2; ++rg) {
        float m = sink;
#pragma unroll
        for (int jt = 0; jt < 12; ++jt)
#pragma unroll
            for (int r = 0; r < 4; ++r) m = fmaxf(m, s[rg][jt][r]);
        m = xor32_max(xor16_max(m));
        float sum = 0.f;
#pragma unroll
        for (int jt = 0; jt < 12; ++jt)
#pragma unroll
            for (int r = 0; r < 4; ++r) { const float e = __builtin_amdgcn_exp2f(s[rg][jt][r] - m); s[rg][jt][r] = e; sum += e; }
        sum = xor32_sum(xor16_sum(sum));
        inv[rg] = 1.0f / (sum + __builtin_amdgcn_exp2f(sink - m));
#pragma unroll
        for (int k2 = 0; k2 < 6; ++k2) { u32x4 t; t.x = pk2(s[rg][2 * k2][0], s[rg][2 * k2][1]); t.y = pk2(s[rg][2 * k2][2], s[rg][2 * k2][3]);
            t.z = pk2(s[rg][2 * k2 + 1][0], s[rg][2 * k2 + 1][1]); t.w = pk2(s[rg][2 * k2 + 1][2], s[rg][2 * k2 + 1][3]);
            pa[rg][k2] = __builtin_bit_cast(bf16x8, t); } }
#pragma unroll
    for (int dt = 0; dt < 4; ++dt) { f32x4 o[2] = {{0.f, 0.f, 0.f, 0.f}, {0.f, 0.f, 0.f, 0.f}};
#pragma unroll
        for (int k2 = 0; k2 < 6; ++k2) { const int j = k2 >> 1; const LAS unsigned char* vt = lds + (j == 0 ? sl0 : (j == 1 ? sl1 : sl2)) * WR_SLOT + WR_V;
            const bf16x8 vf = lds_frag_tr2(vt, LDVW, 32 * (k2 & 1), 16 * dt, lane);
            o[0] = MFMA16T(pa[0][k2], vf, o[0]); o[1] = MFMA16T(pa[1][k2], vf, o[1]); }
#pragma unroll
        for (int rg = 0; rg < 2; ++rg) { const size_t row = crow0 + 32 * (w & 1) + 16 * rg + (lane & 15);
            const float gv[4] = {__uint_as_float(graw[rg][dt].x << 16), __uint_as_float(graw[rg][dt].x & 0xffff0000u), __uint_as_float(graw[rg][dt].y << 16), __uint_as_float(graw[rg][dt].y & 0xffff0000u)};
            u32x2 pk; pk.x = pk2(o[rg][0] * inv[rg] * siluf(gv[0]), o[rg][1] * inv[rg] * siluf(gv[1])); pk.y = pk2(o[rg][2] * inv[rg] * siluf(gv[2]), o[rg][3] * inv[rg] * siluf(gv[3]));
            *(u32x2*)(MIX + row * 2048 + 1024 + hq * 64 + 16 * dt + 4 * g4) = pk; }
        __builtin_amdgcn_sched_barrier(0); }
}
DI void winattn_item(Ctx& F, int item) {
    LAS unsigned char* lds = F.lds;
    const int tid = F.tid;
    const bf16_t* PROJ = (const bf16_t*)(F.ws + WS_PROJ);
    if (item >= 256) {
        const int sb = (item - 256) >> 1, kvh = item & 1; const size_t row0 = (size_t)MP + sb * 64;
        const float* ck = F.in[I_CWK] + (size_t)sb * 128 * 128; const float* cv = F.in[I_CWV] + (size_t)sb * 128 * 128;
        float* ko = F.out + O_WKS + (size_t)sb * 128 * 128; float* vo = F.out + O_WVS + (size_t)sb * 128 * 128;
        wa_stage_cache(F, lds + 0 * WR_SLOT, kvh, ck, cv, nullptr, nullptr);
        wa_stage_cache(F, lds + 1 * WR_SLOT, kvh, ck + 64 * 128, cv + 64 * 128, ko, vo);
        if (tid < 256) { const int i = tid >> 2, q4 = tid & 3; const bf16_t* p = PROJ + (row0 + i) * NPROJ + C_K + kvh * 64 + 8 * q4;
            wa_write_k(F, lds + 2 * WR_SLOT, kvh, *(const u32x4*)p, *(const u32x4*)(p + 32), 2048 + i, ko + 64 * 128); }
        { const int i = tid >> 3, q8 = tid & 7; wa_write_v(F, lds + 2 * WR_SLOT, kvh, *(const u32x4*)(PROJ + (row0 + i) * NPROJ + C_V + kvh * 64 + 8 * q8), vo + 64 * 128); }
        __syncthreads();
        wa_compute(F, kvh, row0, 2048, 0, 1, 2, 0);
        __syncthreads();
        return;
    }
    const int b = item >> 4, kvh = (item >> 3) & 1, c0 = (item & 7) * 8;
    const size_t seq0 = (size_t)b * T_P;
#pragma unroll 1
    for (int kc = c0 - 2; kc <= c0; ++kc) { LAS unsigned char* slot = lds + (kc & 3) * WR_SLOT;
        if (kc < 0) { for (int t = tid; t < WR_SLOT / 16; t += 512) *(LAS u32x4*)(slot + t * 16) = (u32x4){0u, 0u, 0u, 0u}; }
        else { const size_t row0 = seq0 + (size_t)kc * 64;
            if (tid < 256) { const int i = tid >> 2, q4 = tid & 3; const bf16_t* p = PROJ + (row0 + i) * NPROJ + C_K + kvh * 64 + 8 * q4;
                wa_write_k(F, slot, kvh, *(const u32x4*)p, *(const u32x4*)(p + 32), kc * 64 + i, nullptr); }
            { const int i = tid >> 3, q8 = tid & 7; wa_write_v(F, slot, kvh, *(const u32x4*)(PROJ + (row0 + i) * NPROJ + C_V + kvh * 64 + 8 * q8), nullptr); } } }
    __syncthreads();
#pragma unroll 1
    for (int c = c0; c < c0 + 8; ++c) {
        const bool more = c + 1 < c0 + 8;
        u32x4 ra = {0u, 0u, 0u, 0u}, rb = {0u, 0u, 0u, 0u}, rv = {0u, 0u, 0u, 0u};
        const size_t nrow0 = seq0 + (size_t)(c + 1) * 64;
        if (more) {
            if (tid < 256) { const bf16_t* p = PROJ + (nrow0 + (tid >> 2)) * NPROJ + C_K + kvh * 64 + 8 * (tid & 3); ra = *(const u32x4*)p; rb = *(const u32x4*)(p + 32); }
            rv = *(const u32x4*)(PROJ + (nrow0 + (tid >> 3)) * NPROJ + C_V + kvh * 64 + 8 * (tid & 7)); }
        wa_compute(F, kvh, seq0 + (size_t)c * 64, c * 64, (c - 2) & 3, (c - 1) & 3, c & 3, c >= 2 ? 0 : 2 - c);
        if (more) { LAS unsigned char* slot = lds + ((c + 1) & 3) * WR_SLOT; const int kc = c + 1;
            float* ko = nullptr; float* vo = nullptr;
            if (kc >= 62) { ko = F.out + O_WKP + ((size_t)b * 128 + (kc - 62) * 64) * 128; vo = F.out + O_WVP + ((size_t)b * 128 + (kc - 62) * 64) * 128; }
            if (tid < 256) wa_write_k(F, slot, kvh, ra, rb, kc * 64 + (tid >> 2), ko);
            wa_write_v(F, slot, kvh, rv, vo); }
        __syncthreads();
    }
}

constexpr int MA_K = 0, MA_V = 69632, MA_RS = 143360, LDKM = 272, LDVM = 288;
DI void memattn_item(Ctx& F, int item) {
    LAS unsigned char* lds = F.lds;
    const int tid = F.tid, lane = F.lane, w = F.wave, g4 = lane >> 4;
    const bool smp = item >= 256; const int sidx = item - 256;
    const int bb = smp ? (sidx >> 2) : (item >> 4), h = smp ? (sidx & 3) : ((item >> 2) & 3), qt = item & 3;
    const bf16_t* PROJ = (const bf16_t*)(F.ws + WS_PROJ); bf16_t* MIX = (bf16_t*)(F.ws + WS_MIX); const bf16_t* RAW = (const bf16_t*)(F.ws + WS_MEMRAW);
#pragma unroll 1
    for (int ib = 0; ib < 2; ++ib) {
      u32x4 rk[4], rvv[4]; f32x4 fk[4][2], fv[4][2];
#pragma unroll
      for (int u = 0; u < 4; ++u) { const int t = tid + 512 * (4 * ib + u), key = t >> 4, ch = t & 15;
        if (smp) { const float* ks = F.in[I_CMK] + ((size_t)(bb * 256 + key) * 4 + h) * 128 + 8 * ch; const float* vs = F.in[I_CMV] + ((size_t)(bb * 256 + key) * 4 + h) * 128 + 8 * ch;
            fk[u][0] = *(const f32x4*)ks; fk[u][1] = *(const f32x4*)(ks + 4); fv[u][0] = *(const f32x4*)vs; fv[u][1] = *(const f32x4*)(vs + 4); }
        else { rk[u] = *(const u32x4*)(RAW + (size_t)(bb * 256 + key) * 1024 + h * 128 + 8 * ch); rvv[u] = *(const u32x4*)(RAW + (size_t)(bb * 256 + key) * 1024 + 512 + h * 128 + 8 * ch); } }
#pragma unroll
      for (int u = 0; u < 4; ++u) { const int t = tid + 512 * (4 * ib + u), key = t >> 4, ch = t & 15;
        float k[8], v[8];
        if (smp) {
#pragma unroll
            for (int e = 0; e < 4; ++e) { k[e] = fk[u][0][e]; k[4 + e] = fk[u][1][e]; v[e] = fv[u][0][e]; v[4 + e] = fv[u][1][e]; } }
        else { unpack8(rk[u], k); unpack8(rvv[u], v); }
        float s = 0.f;
#pragma unroll
        for (int e = 0; e < 8; ++e) s += k[e] * k[e];
        s = row16_sum(s);
        if (!smp) { const float rstd = 1.0f / sqrtf(s * (1.0f / 128.0f) + EPSF);
#pragma unroll
            for (int e = 0; e < 8; ++e) k[e] = k[e] * rstd * F.in[I_GMK][8 * ch + e]; }
        { float kq[8];
#pragma unroll
          for (int e = 0; e < 8; ++e) kq[e] = k[e] * F.in[I_GMQ][8 * ch + e];
          *(LAS u32x4*)(lds + MA_K + key * LDKM + ch * 16) = pack8(kq); }
        *(LAS u32x4*)(lds + MA_V + key * LDVM + ch * 16) = pack8(v);
        if (!smp && qt == 0) {
            float* ko = F.out + O_MKP + ((size_t)(bb * 256 + key) * 4 + h) * 128 + 8 * ch; float* vo = F.out + O_MVP + ((size_t)(bb * 256 + key) * 4 + h) * 128 + 8 * ch;
            *(f32x4*)ko = (f32x4){k[0], k[1], k[2], k[3]}; *(f32x4*)(ko + 4) = (f32x4){k[4], k[5], k[6], k[7]};
            *(f32x4*)vo = (f32x4){v[0], v[1], v[2], v[3]}; *(f32x4*)(vo + 4) = (f32x4){v[4], v[5], v[6], v[7]}; }
      }
    }
    __syncthreads();
    const int ngr = smp ? 4 : 64;
    const size_t qbase = smp ? (size_t)MP + bb * 64 : (size_t)bb * T_P + qt * 1024;
    u32x4 nq[4]; u32x2 ng[8];
#define MA_LOAD(rg_) do { const size_t r_ = qbase + 16 * (rg_) + (lane & 15); \
        _Pragma("unroll") for (int ks = 0; ks < 4; ++ks) nq[ks] = *(const u32x4*)(PROJ + r_ * NPROJ + C_MQ + h * 128 + 32 * ks + 8 * g4); \
        _Pragma("unroll") for (int dt = 0; dt < 8; ++dt) ng[dt] = *(const u32x2*)(PROJ + r_ * NPROJ + C_GM + h * 128 + 16 * dt + 4 * g4); } while (0)
    if (w < ngr) MA_LOAD(w);
#pragma unroll 1
    for (int rg = w; rg < ngr; rg += 8) {
        u32x4 cq[4]; u32x2 cg[8];
#pragma unroll
        for (int ks = 0; ks < 4; ++ks) cq[ks] = nq[ks];
#pragma unroll
        for (int dt = 0; dt < 8; ++dt) cg[dt] = ng[dt];
        if (rg + 8 < ngr) MA_LOAD(rg + 8);
        bf16x8 qa[4];
        { float q[4][8]; float s = 0.f;
#pragma unroll
          for (int ks = 0; ks < 4; ++ks) { unpack8(cq[ks], q[ks]);
#pragma unroll
              for (int e = 0; e < 8; ++e) s += q[ks][e] * q[ks][e]; }
          s = xor32_sum(xor16_sum(s));
          const float rstd = 0.12751743082459868f / sqrtf(s * (1.0f / 128.0f) + EPSF);
#pragma unroll
          for (int ks = 0; ks < 4; ++ks) {
#pragma unroll
              for (int e = 0; e < 8; ++e) q[ks][e] = q[ks][e] * rstd;
              qa[ks] = __builtin_bit_cast(bf16x8, pack8(q[ks])); } }
        f32x4 s[16];
#pragma unroll
        for (int jt = 0; jt < 16; ++jt) { f32x4 acc = {0.f, 0.f, 0.f, 0.f};
#pragma unroll
            for (int ks = 0; ks < 4; ++ks) acc = MFMA16T(qa[ks], lds_frag(lds + MA_K, LDKM, 16 * jt, 32 * ks, lane), acc);
            s[jt] = acc;
            if ((jt & 3) == 3) __builtin_amdgcn_sched_barrier(0); }
        float m = s[0][0];
#pragma unroll
        for (int jt = 0; jt < 16; ++jt)
#pragma unroll
            for (int r = 0; r < 4; ++r) m = fmaxf(m, s[jt][r]);
        m = xor32_max(xor16_max(m));
        float sum = 0.f;
#pragma unroll
        for (int jt = 0; jt < 16; ++jt)
#pragma unroll
            for (int r = 0; r < 4; ++r) { const float e = __builtin_amdgcn_exp2f(s[jt][r] - m); s[jt][r] = e; sum += e; }
        sum = xor32_sum(xor16_sum(sum));
        const float inv = 1.0f / sum;
        bf16x8 pa[8];
#pragma unroll
        for (int k2 = 0; k2 < 8; ++k2) { u32x4 t; t.x = pk2(s[2 * k2][0], s[2 * k2][1]); t.y = pk2(s[2 * k2][2], s[2 * k2][3]); t.z = pk2(s[2 * k2 + 1][0], s[2 * k2 + 1][1]); t.w = pk2(s[2 * k2 + 1][2], s[2 * k2 + 1][3]);
            pa[k2] = __builtin_bit_cast(bf16x8, t); }
        const size_t orow = qbase + 16 * rg + (lane & 15);
#pragma unroll
        for (int dt = 0; dt < 8; ++dt) { f32x4 o = {0.f, 0.f, 0.f, 0.f};
#pragma unroll
            for (int k2 = 0; k2 < 8; ++k2) o = MFMA16T(pa[k2], lds_frag_tr2(lds + MA_V, LDVM, 32 * k2, 16 * dt, lane), o);
            __builtin_amdgcn_sched_barrier(0);
            const int col = h * 128 + 16 * dt + 4 * g4;
            const u32x2 gr = cg[dt];
            const float gv[4] = {__uint_as_float(gr.x << 16), __uint_as_float(gr.x & 0xffff0000u), __uint_as_float(gr.y << 16), __uint_as_float(gr.y & 0xffff0000u)};
            u32x2 pk; pk.x = pk2(o[0] * inv * siluf(gv[0]), o[1] * inv * siluf(gv[1])); pk.y = pk2(o[2] * inv * siluf(gv[2]), o[3] * inv * siluf(gv[3]));
            *(u32x2*)(MIX + orow * 2048 + 1536 + col) = pk; }
    }
#undef MA_LOAD
    __syncthreads();
}

DI void p2a_attn(Ctx& F) {
    for (int rep = 0; rep < REP_WIN; ++rep)
    for (int it = F.bid; it < 320; it += F.G) winattn_item(F, it);
    __syncthreads();
    for (int rep = 0; rep < REP_MEM; ++rep)
    { for (int it = F.bid; it < 256; it += F.G) memattn_item(F, it);
      for (int s = (F.bid + F.G - (128 % F.G)) % F.G; s < 128; s += F.G) memattn_item(F, 256 + s); }
}
DI void p2b_phase(Ctx& F) {
    for (int rep = 0; rep < REP_SSD; ++rep)
    for (int it = F.bid; it < 48 * 16; it += F.G) ssd_item(F, it >> 4, it & 15, rep == 0);
}

constexpr int G2_A = 0, G2_B = 9216, G2_SET = 27648;
DI void gemm2_sample(Ctx& F) {
    LAS unsigned char* lds = F.lds;
    const int tid = F.tid, lane = F.lane, w = F.wave, g4 = lane >> 4;
    const bf16_t* MIX = (const bf16_t*)(F.ws + WS_MIX); const bf16_t* WOT = (const bf16_t*)(F.ws + WS_WOUT); const float* SUMSQ = (const float*)(F.ws + WS_SSQ);
    for (int tile = F.bid; tile < 256; tile += F.G) {
        const int r0 = MP + 64 * (tile >> 3), c0 = 128 * (tile & 7);
        const bf16_t* asrc = MIX + (size_t)(r0 + (tid >> 3)) * 2048 + 8 * (tid & 7);
        const bf16_t* bsrc0 = WOT + (size_t)(c0 + (tid >> 3)) * 2048 + 8 * (tid & 7);
        const bf16_t* bsrc1 = bsrc0 + (size_t)64 * 2048;
        const int aoff = G2_A + (tid >> 3) * 144 + (tid & 7) * 16, boff0 = G2_B + (tid >> 3) * 144 + (tid & 7) * 16, boff1 = boff0 + 64 * 144;
        f32x4 acc[4] = {{0.f, 0.f, 0.f, 0.f}, {0.f, 0.f, 0.f, 0.f}, {0.f, 0.f, 0.f, 0.f}, {0.f, 0.f, 0.f, 0.f}};
        u32x4 ra[4], rb0[4], rb1[4];
#pragma unroll
        for (int j = 0; j < 4; ++j) { ra[j] = *(const u32x4*)(asrc + 64 * j); rb0[j] = *(const u32x4*)(bsrc0 + 64 * j); rb1[j] = *(const u32x4*)(bsrc1 + 64 * j); }
        *(LAS u32x4*)(lds + aoff) = ra[0]; *(LAS u32x4*)(lds + boff0) = rb0[0]; *(LAS u32x4*)(lds + boff1) = rb1[0];
        ra[0] = *(const u32x4*)(asrc + 64 * 4); rb0[0] = *(const u32x4*)(bsrc0 + 64 * 4); rb1[0] = *(const u32x4*)(bsrc1 + 64 * 4);
        __syncthreads();
#pragma unroll 1
        for (int kt4 = 0; kt4 < 32; kt4 += 4) {
#pragma unroll
            for (int u = 0; u < 4; ++u) { const int kt = kt4 + u;
                const LAS unsigned char* cs = lds + (u & 1) * G2_SET; LAS unsigned char* ns = lds + ((u + 1) & 1) * G2_SET;
                if (kt == 16) { const float r = 1.0f / sqrtf(SUMSQ[r0 + 16 * (w >> 1) + (lane & 15)] * (1.0f / 1024.0f) + EPSF);
#pragma unroll
                    for (int t = 0; t < 4; ++t) acc[t] = acc[t] * r; }
#pragma unroll
                for (int ks = 0; ks < 2; ++ks) { const bf16x8 a = lds_frag(cs + G2_A, 144, 16 * (w >> 1), 32 * ks, lane);
#pragma unroll
                    for (int t = 0; t < 4; ++t) acc[t] = MFMA16T(a, lds_frag(cs + G2_B, 144, 64 * (w & 1) + 16 * t, 32 * ks, lane), acc[t]); }
                constexpr int dummy_ = 0; (void)dummy_;
                const int rs = (u + 1) & 3;
                if (kt + 1 < 32) { *(LAS u32x4*)(ns + aoff) = ra[rs]; *(LAS u32x4*)(ns + boff0) = rb0[rs]; *(LAS u32x4*)(ns + boff1) = rb1[rs]; }
                if (kt + 5 < 32) { ra[rs] = *(const u32x4*)(asrc + 64 * (kt + 5)); rb0[rs] = *(const u32x4*)(bsrc0 + 64 * (kt + 5)); rb1[rs] = *(const u32x4*)(bsrc1 + 64 * (kt + 5)); }
                __syncthreads();
            }
        }
        const int row = r0 + 16 * (w >> 1) + (lane & 15), cw = c0 + 64 * (w & 1) + 4 * g4;
        const float* xr = F.in[I_XS] + (size_t)(row - MP) * DM + cw; float* orow = F.out + (size_t)row * DM + cw;
#pragma unroll
        for (int t = 0; t < 4; ++t) *(f32x4*)(orow + 16 * t) = acc[t] + *(const f32x4*)(xr + 16 * t);
    }
}
__global__ void __launch_bounds__(512, 2) hymba_fwd(Args args) {
    extern __shared__ __attribute__((aligned(16))) unsigned char lds_raw[];
    cg::grid_group grid = cg::this_grid();
    Ctx F;
    F.lds = (LAS unsigned char*)lds_raw; F.tid = threadIdx.x; F.lane = F.tid & 63; F.wave = __builtin_amdgcn_readfirstlane(F.tid >> 6); F.G = gridDim.x; F.bid = blockIdx.x;
#pragma unroll
    for (int i = 0; i < 26; ++i) F.in[i] = args.in[i];
    F.out = args.out; F.ws = args.ws;
    volatile LAS unsigned* bst = (volatile LAS unsigned*)(F.lds + LDS_BYTES - 64);
    if (F.tid < 16) bst[F.tid] = 0u;
    __syncthreads();
    const XcdBarrier xbar = xcd_barrier_post((unsigned*)(F.ws + WS_CTL), bst);
#define GRID_BAR() xcd_barrier(xbar)

#define PHASE_FENCE() do { int t_ = threadIdx.x; asm volatile("" : "+v"(t_)); F.tid = t_; F.lane = t_ & 63; F.wave = __builtin_amdgcn_readfirstlane(t_ >> 6); } while (0)
    for (int rep = 0; rep < REP_P0; ++rep) { if (rep) __syncthreads(); p0_prologue(F); }
    grid.sync(); PHASE_FENCE();
    {
        pg8::Gemm g{(const bf16_t*)(F.ws + WS_A), (const bf16_t*)(F.ws + WS_BT), MA, NBT, 1024};
        Order1 S; S.init(F.G, F.bid);
        EpiProj E{(bf16_t*)(F.ws + WS_PROJ), (bf16_t*)(F.ws + WS_MEMRAW)};
        pg8::gemm_phase<EpiProj, Order1, true, true>(F.lds, g, S, E);
    }
    GRID_BAR(); PHASE_FENCE();
    for (int rep = 0; rep < REP_P2A; ++rep) p2a_phase(F);
    __syncthreads();
    p2a_attn(F);
    GRID_BAR(); PHASE_FENCE();
    p2b_phase(F);
    GRID_BAR(); PHASE_FENCE();
    gemm2_sample(F);
    {
        pg8::Gemm g{(const bf16_t*)(F.ws + WS_MIX), (const bf16_t*)(F.ws + WS_WOUT), MTOT, 1024, 2048};
        Order3 S; S.init(F.G, F.bid);
        EpiOut E{F.in[I_XP], F.in[I_XS], F.out, (const float*)(F.ws + WS_SSQ)};
        pg8::gemm_phase<EpiOut, Order3, true, true>(F.lds, g, S, E);
    }
#if DBG_SCALE3 || DBG_ZERO
    grid.sync();
    {
        const size_t offs[13] = {O_Y, (size_t)MP * 1024, O_WKP, O_WVP, O_SSMP, O_CONVP, O_MKP, O_MVP, O_WKS, O_WVS, O_SSMS, O_CONVS, O_END};
        for (int o = 0; o < 12; ++o) {
            const bool z = (DBG_ZERO >> o) & 1, s3 = (DBG_SCALE3 >> o) & 1;
            if (!z && !s3) continue;
            for (size_t i = offs[o] + (size_t)F.bid * 512 + F.tid; i < offs[o + 1]; i += (size_t)F.G * 512) F.out[i] = z ? 0.f : F.out[i] * 3.0f;
        }
    }
#endif
}

extern "C" void kernel_launch(void* const* d_in, const int* in_sizes, int n_in, void* d_out, int out_size, void* d_ws, size_t ws_size, hipStream_t stream) {
    static int grid = 0;
    if (grid == 0) {
        if (n_in != 26 || (size_t)out_size != O_END || ws_size < WS_END) { fprintf(stderr, "kernel_launch: unexpected problem (n_in %d out %d ws %zu)\n", n_in, out_size, ws_size); grid = -1; return; }
        int dev = 0, cus = 0, per_cu = 0;
        if (hipGetDevice(&dev) != hipSuccess || hipDeviceGetAttribute(&cus, hipDeviceAttributeMultiprocessorCount, dev) != hipSuccess) { grid = -1; return; }
        if (hipFuncSetAttribute((const void*)hymba_fwd, hipFuncAttributeMaxDynamicSharedMemorySize, LDS_BYTES) != hipSuccess) { fprintf(stderr, "kernel_launch: hipFuncSetAttribute failed\n"); grid = -1; return; }
        if (hipOccupancyMaxActiveBlocksPerMultiprocessor(&per_cu, (const void*)hymba_fwd, 512, LDS_BYTES) != hipSuccess || per_cu < 1) { fprintf(stderr, "kernel_launch: occupancy query says %d\n", per_cu); (void)hipGetLastError(); grid = -1; return; }
        grid = cus;
        fprintf(stderr, "kernel_launch: %d CUs, occupancy %d per CU, grid %d\n", cus, per_cu, grid);
    }
    if (grid < 0) return;
    Args a{};
    for (int i = 0; i < 26; ++i) a.in[i] = (const float*)d_in[i];
    a.out = (float*)d_out; a.ws = (unsigned char*)d_ws;
    if (hipMemsetAsync((char*)d_ws + WS_CTL, 0, CTL_ZERO_BYTES, stream) != hipSuccess) { fprintf(stderr, "kernel_launch: memset of the barrier words failed\n"); return; }
    void* kargs[] = {&a};
    const hipError_t e = hipLaunchCooperativeKernel((const void*)hymba_fwd, dim3(grid), dim3(512), kargs, LDS_BYTES, stream);
    if (e != hipSuccess) fprintf(stderr, "kernel_launch: cooperative launch failed: %s\n", hipGetErrorString(e));
}
```

```cpp
#include <hip/hip_runtime.h>
#include <hip/hip_cooperative_groups.h>
#include <cstdio>
#include <cstdint>
namespace cg = cooperative_groups;
#ifndef CLKPROBE
#define CLKPROBE 0
#endif
#if CLKPROBE >= 20
__device__ long long g_dbg[1024];
#endif
namespace pg8 {
#define PG8_LAS __attribute__((address_space(3)))
typedef unsigned short bf16_t;
typedef short bf16x8 __attribute__((ext_vector_type(8)));
typedef float f32x4 __attribute__((ext_vector_type(4)));
typedef unsigned u32x4 __attribute__((ext_vector_type(4)));
constexpr int BM = 256, BK = 64, HALF = 128, HTB = HALF * BK * 2  , STAGE_BYTES = 8 * HTB, NXCD = 8, WGM = 8;

__host__ __device__ __forceinline__ int lds_byte(int r, int c) { const int st = (r >> 4) * 2 + (c >> 5), rr = r & 15, cc = c & 31, ob = rr * 64 + cc * 2; return st * 1024 + (ob ^ (((ob >> 9) & 1) << 5)); }
__host__ __device__ __forceinline__ void stage_rc(int b, int& R, int& C) { const int st = b / 1024, sb = b % 1024, swz = sb ^ (((sb >> 9) & 1) << 5); R = (st >> 1) * 16 + swz / 64; C = (st & 1) * 32 + (swz % 64) / 2; }
__host__ __device__ __forceinline__ int perm32(int rho) { const int n = rho >> 4, i = rho & 15; return 8 * (i >> 2) + 4 * n + (i & 3); }

struct Unit { int pm, pn; };
struct Gemm { const bf16_t* A; const bf16_t* Bt; int M, N, K; };

struct StaticOrder {
    int nM, nN, nwg, G, c;
    __host__ __device__ void init(int M, int N, int G_, int c_) { nM = M / BM; nN = N / BM; nwg = nM * nN; G = G_; c = c_; }
    __host__ __device__ bool next(int i, Unit& u) const {
        const long L = (long)i * G + c; if (L >= nwg) return false;
        int wgid = (int)L; { const int q = nwg / NXCD, r = nwg % NXCD, xcd = wgid % NXCD, off = wgid / NXCD; wgid = (xcd < r ? xcd * (q + 1) : r * (q + 1) + (xcd - r) * q) + off; }
        const int nig = WGM * nN, gid = wgid / nig, fm = gid * WGM, gsz = (nM - fm) < WGM ? (nM - fm) : WGM;
        u.pm = fm + ((wgid % nig) % gsz); u.pn = (wgid % nig) / gsz; return true;
    }
    __device__ __forceinline__ void a_ready(const Unit&) const {}
    __device__ __forceinline__ void done(const Unit&) const {}
};

template <class Epi, class Sched, bool ALIGN_EPI = false, bool SP2 = false>
__device__ __forceinline__ void gemm_phase(PG8_LAS unsigned char* lds, const Gemm g, const Sched& S, const Epi& E) {
    int tid_ = threadIdx.x; asm volatile("" : "+v"(tid_));
    const int tid = tid_, wid = __builtin_amdgcn_readfirstlane(tid >> 6), lane = tid & 63, wr = wid >> 2, wc = wid & 3, fr = lane & 15, fq = lane >> 4;
    const int K = g.K, nt = K / BK;
    unsigned voffA[2], voffB[2];
#pragma unroll
    for (int i = 0; i < 2; ++i) { int R, C; stage_rc(tid * 16 + i * 8192, R, C); const int Rb = Epi::PERM ? ((R & ~31) + perm32(R & 31)) : R;
        voffA[i] = (unsigned)(R * K + C) * 2u; voffB[i] = (unsigned)(Rb * K + C) * 2u; }
    const size_t kstep = (size_t)(BK * 2);
    const size_t hstep = (size_t)HALF * K * 2;
    const size_t tstep = 2 * hstep;
    const unsigned ldsw = (unsigned)wid * 1024u;
    const int aoff = lds_byte(wr * 64 + fr, fq * 8), boff = lds_byte(wc * 32 + fr, fq * 8);
#define PG8_SA(b, h) (((b) * 2 + (h)) * HTB)
#define PG8_SB(b, h) ((4 + (b) * 2 + (h)) * HTB)
#define PG8_STAGE(bufoff, gbase, voff) do { _Pragma("unroll") for (int _i = 0; _i < 2; ++_i) \
        __builtin_amdgcn_global_load_lds((const unsigned*)((const char*)(gbase) + (voff)[_i]), (PG8_LAS unsigned*)(lds + (bufoff) + ldsw + _i * 8192), 16, 0, 0); } while (0)
#define PG8_LDA(dst, b, h) do { _Pragma("unroll") for (int m = 0; m < 4; ++m) _Pragma("unroll") for (int k = 0; k < 2; ++k) dst[m][k] = *(const PG8_LAS bf16x8*)(lds + PG8_SA(b, h) + aoff + m * 2048 + k * 1024); } while (0)
#define PG8_LDB(dst, b, h) do { _Pragma("unroll") for (int n = 0; n < 2; ++n) _Pragma("unroll") for (int k = 0; k < 2; ++k) dst[n][k] = *(const PG8_LAS bf16x8*)(lds + PG8_SB(b, h) + boff + n * 2048 + k * 1024); } while (0)
#define PG8_MMA(ai, bj, At, Bt) do { __builtin_amdgcn_s_setprio(1); _Pragma("unroll") for (int m = 0; m < 4; ++m) _Pragma("unroll") for (int n = 0; n < 2; ++n) _Pragma("unroll") for (int k = 0; k < 2; ++k) \
        acc[ai][bj][m][n] = __builtin_amdgcn_mfma_f32_16x16x32_bf16(Bt[n][k], At[m][k], acc[ai][bj][m][n], 0, 0, 0); __builtin_amdgcn_s_setprio(0); } while (0)
#define PG8_WAIT_V(n) asm volatile("s_waitcnt vmcnt(" #n ")" ::: "memory")
#define PG8_WAIT_L(n) asm volatile("s_waitcnt lgkmcnt(" #n ")" ::: "memory")
#define PG8_BAR __builtin_amdgcn_s_barrier()
#define PG8_SCHED __builtin_amdgcn_sched_barrier(0)
    Unit cur, nxt; int ui = 0;
    if (!S.next(0, cur)) return;
    f32x4 acc[2][2][4][2];
    if constexpr (Epi::HAS_INIT) E.init(acc, cur, wid >> 2, wid & 3, lane & 15, lane >> 4);
    else {
#pragma unroll
    for (int a = 0; a < 2; ++a)
#pragma unroll
        for (int b = 0; b < 2; ++b)
#pragma unroll
            for (int m = 0; m < 4; ++m)
#pragma unroll
                for (int n = 0; n < 2; ++n) acc[a][b][m][n] = (f32x4){0.f, 0.f, 0.f, 0.f};
    }
    bf16x8 At[4][2], B0[2][2], B1[2][2];
    const char* cA = (const char*)g.A + (size_t)cur.pm * tstep; const char* cB = (const char*)g.Bt + (size_t)cur.pn * tstep;
    S.a_ready(cur);
    if constexpr (SP2) {
        PG8_STAGE(PG8_SB(0, 0), cB, voffB); PG8_STAGE(PG8_SB(0, 1), cB + hstep, voffB); PG8_STAGE(PG8_SA(0, 0), cA, voffA); PG8_STAGE(PG8_SA(0, 1), cA + hstep, voffA);
        if (wr == 1) PG8_BAR;
        PG8_WAIT_V(2); PG8_BAR;
        PG8_STAGE(PG8_SB(1, 0), cB + kstep, voffB); PG8_STAGE(PG8_SA(1, 0), cA + kstep, voffA); PG8_STAGE(PG8_SB(1, 1), cB + hstep + kstep, voffB);
        PG8_WAIT_V(6); PG8_BAR;
    } else {
        PG8_STAGE(PG8_SB(0, 0), cB, voffB); PG8_STAGE(PG8_SA(0, 0), cA, voffA); PG8_STAGE(PG8_SB(0, 1), cB + hstep, voffB); PG8_STAGE(PG8_SA(0, 1), cA + hstep, voffA);
        if (wr == 1) PG8_BAR;
        PG8_WAIT_V(4); PG8_BAR;
        PG8_STAGE(PG8_SB(1, 0), cB + kstep, voffB); PG8_STAGE(PG8_SA(1, 0), cA + kstep, voffA); PG8_STAGE(PG8_SB(1, 1), cB + hstep + kstep, voffB);
        PG8_WAIT_V(6); PG8_BAR;
    }
    for (;;) {
        const bool has_next = S.next(ui + 1, nxt);
        const char* nA = has_next ? (const char*)g.A + (size_t)nxt.pm * tstep : cA; const char* nB = has_next ? (const char*)g.Bt + (size_t)nxt.pn * tstep : cB;
        for (int t = 0; t < nt; t += 2) {
            const bool last = (t == nt - 2);
            const char* a1 = cA + (size_t)(t + 1) * kstep;
            const char* a2 = last ? nA : cA + (size_t)(t + 2) * kstep; const char* b2 = last ? nB : cB + (size_t)(t + 2) * kstep;
            const char* a3 = a2 + kstep; const char* b3 = b2 + kstep;
            if (last && has_next) S.a_ready(nxt);
#if CLKPROBE == 21
            if constexpr (Epi::MIDK > 0) { if (t == Epi::MIDK) { const long long t0_ = (long long)__builtin_amdgcn_s_memrealtime(); E.mid(acc, cur, wr, wc, fr, fq); asm volatile("" :: "v"(acc[0][0][0][0]));
                if (threadIdx.x == 0) g_dbg[blockIdx.x] += (long long)__builtin_amdgcn_s_memrealtime() - t0_; } }
#else
            if constexpr (Epi::MIDK > 0) { if (t == Epi::MIDK) E.mid(acc, cur, wr, wc, fr, fq); }
#endif
            if constexpr (SP2) {
            PG8_LDB(B0, 0, 0); PG8_LDB(B1, 0, 1); PG8_SCHED; PG8_LDA(At, 0, 0); PG8_STAGE(PG8_SA(1, 1), a1 + hstep, voffA);
            PG8_WAIT_V(8); PG8_WAIT_L(0); PG8_BAR; PG8_MMA(0, 0, At, B0); PG8_MMA(0, 1, At, B1); PG8_BAR; PG8_SCHED;
            PG8_LDA(At, 0, 1); PG8_STAGE(PG8_SB(0, 0), b2, voffB); PG8_STAGE(PG8_SB(0, 1), b2 + hstep, voffB); PG8_STAGE(PG8_SA(0, 0), a2, voffA);
            PG8_WAIT_V(8); PG8_WAIT_L(0); PG8_BAR; PG8_MMA(1, 0, At, B0); PG8_MMA(1, 1, At, B1); PG8_BAR; PG8_SCHED;
            PG8_LDB(B0, 1, 0); PG8_LDB(B1, 1, 1); PG8_SCHED; PG8_LDA(At, 1, 0); PG8_STAGE(PG8_SA(0, 1), a2 + hstep, voffA);
            PG8_WAIT_V(8); PG8_WAIT_L(0); PG8_BAR; PG8_MMA(0, 0, At, B0); PG8_MMA(0, 1, At, B1); PG8_BAR; PG8_SCHED;
            PG8_LDA(At, 1, 1); PG8_STAGE(PG8_SB(1, 0), b3, voffB); PG8_STAGE(PG8_SB(1, 1), b3 + hstep, voffB); PG8_STAGE(PG8_SA(1, 0), a3, voffA);
            PG8_WAIT_V(8); PG8_WAIT_L(0); PG8_BAR; PG8_MMA(1, 0, At, B0); PG8_MMA(1, 1, At, B1); PG8_BAR; PG8_SCHED;
            } else {
            PG8_LDB(B0, 0, 0); PG8_SCHED; PG8_LDA(At, 0, 0); PG8_STAGE(PG8_SA(1, 1), a1 + hstep, voffA);
            PG8_WAIT_L(8); PG8_BAR; PG8_WAIT_L(0); PG8_MMA(0, 0, At, B0); PG8_BAR; PG8_SCHED;
            PG8_LDB(B1, 0, 1); PG8_STAGE(PG8_SB(0, 0), b2, voffB);
            PG8_BAR; PG8_WAIT_L(0); PG8_MMA(0, 1, At, B1); PG8_BAR;
            PG8_LDA(At, 0, 1); PG8_STAGE(PG8_SA(0, 0), a2, voffA);
            PG8_BAR; PG8_WAIT_L(0); PG8_MMA(1, 0, At, B0); PG8_BAR; PG8_SCHED;
            PG8_STAGE(PG8_SB(0, 1), b2 + hstep, voffB);
            PG8_WAIT_V(6); PG8_BAR; PG8_MMA(1, 1, At, B1); PG8_BAR;
            PG8_LDB(B0, 1, 0); PG8_SCHED; PG8_LDA(At, 1, 0); PG8_STAGE(PG8_SA(0, 1), a2 + hstep, voffA);
            PG8_WAIT_L(8); PG8_BAR; PG8_WAIT_L(0); PG8_MMA(0, 0, At, B0); PG8_BAR; PG8_SCHED;
            PG8_LDB(B1, 1, 1); PG8_STAGE(PG8_SB(1, 0), b3, voffB);
            PG8_BAR; PG8_WAIT_L(0); PG8_MMA(0, 1, At, B1); PG8_BAR;
            PG8_LDA(At, 1, 1); PG8_STAGE(PG8_SA(1, 0), a3, voffA);
            PG8_BAR; PG8_WAIT_L(0); PG8_MMA(1, 0, At, B0); PG8_BAR; PG8_SCHED;
            PG8_STAGE(PG8_SB(1, 1), b3 + hstep, voffB);
            PG8_WAIT_V(6); PG8_BAR; PG8_MMA(1, 1, At, B1); PG8_BAR;
            }
        }
        if constexpr (ALIGN_EPI) { if (wr == 0) PG8_BAR; }
#if CLKPROBE == 20
        { const long long t0_ = (long long)__builtin_amdgcn_s_memrealtime();
#endif
        if constexpr (!Epi::AFTER_DRAIN) { E(acc, cur, wr, wc, fr, fq); S.done(cur); }
#if CLKPROBE == 20
          asm volatile("s_waitcnt vmcnt(0)" ::: "memory"); if (Epi::MIDK > 0 && threadIdx.x == 0) g_dbg[blockIdx.x] += (long long)__builtin_amdgcn_s_memrealtime() - t0_; }
#endif
        if (!has_next) break;
        if constexpr (Epi::HAS_INIT) E.init(acc, nxt, wr, wc, fr, fq);
        else {
#pragma unroll
        for (int a = 0; a < 2; ++a)
#pragma unroll
            for (int b = 0; b < 2; ++b)
#pragma unroll
                for (int m = 0; m < 4; ++m)
#pragma unroll
                    for (int n = 0; n < 2; ++n) acc[a][b][m][n] = (f32x4){0.f, 0.f, 0.f, 0.f};
        }
        cur = nxt; cA = nA; cB = nB; ++ui;
        if constexpr (ALIGN_EPI) { if (wr == 1) PG8_BAR; }
    }
    PG8_WAIT_V(0);
    if constexpr (!ALIGN_EPI) { if (wr == 0) PG8_BAR; }
    PG8_BAR;
    if constexpr (Epi::AFTER_DRAIN) { E.fused(acc, cur, wr, wc, fr, fq, lds, wid, lane); S.done(cur); }
#undef PG8_SA
#undef PG8_SB
#undef PG8_STAGE
#undef PG8_LDA
#undef PG8_LDB
#undef PG8_MMA
#undef PG8_WAIT_V
#undef PG8_WAIT_L
#undef PG8_BAR
#undef PG8_SCHED
}
}
#ifndef DBG_SCALE3
#define DBG_SCALE3 0
#endif
#ifndef DBG_ZERO
#define DBG_ZERO 0
#endif
#ifndef LAST_PHASE
#define LAST_PHASE 4
#endif
#ifndef REP_P0
#define REP_P0 1
#endif
#ifndef REP_P1
#define REP_P1 1
#endif
#ifndef REP_P2A
#define REP_P2A 1
#endif
#ifndef REP_P0T
#define REP_P0T 1
#endif
#ifndef REP_P0R
#define REP_P0R 1
#endif
#ifndef REP_S2
#define REP_S2 1
#endif
#ifndef REP_S3
#define REP_S3 1
#endif
#ifndef REP_S4
#define REP_S4 1
#endif
#ifndef REP_ATOM
#define REP_ATOM 1
#endif
#ifndef TIMESEG
#define TIMESEG 0
#endif
#ifndef TIMESEG_A
#define TIMESEG_A 0
#endif
#ifndef TIMESEG_B
#define TIMESEG_B 5
#endif
#ifndef CLKPROBE
#define CLKPROBE 0
#endif
#ifndef CLKAGG
#define CLKAGG 0
#endif
#ifndef CLKBID
#define CLKBID 0
#endif
#ifndef CLKWHAT
#define CLKWHAT 0
#endif
#ifndef TIMEWAVE
#define TIMEWAVE 0
#endif
#ifndef TIMEQ
#define TIMEQ 500
#endif
#ifndef TIMEOFF
#define TIMEOFF 0
#endif
#ifndef REP_SSD
#define REP_SSD 1
#endif
#ifndef REP_WIN
#define REP_WIN 1
#endif
#ifndef REP_MEM
#define REP_MEM 1
#endif
#ifndef REP_P3
#define REP_P3 1
#endif
#define DI __device__ __forceinline__
#define LAS __attribute__((address_space(3)))
typedef unsigned short bf16_t;
typedef short bf16x8 __attribute__((ext_vector_type(8)));
typedef float f32x4 __attribute__((ext_vector_type(4)));
typedef float f32x2 __attribute__((ext_vector_type(2)));
typedef unsigned u32x4 __attribute__((ext_vector_type(4)));
typedef unsigned u32x2 __attribute__((ext_vector_type(2)));

constexpr int NB_P = 16, T_P = 4096, NB_S = 32, T_S = 64, DM = 1024;
constexpr int MP = NB_P * T_P, MS = NB_S * T_S, MTOT = MP + MS;
constexpr int MMEM = NB_P * 256, MA = MTOT + MMEM;
constexpr int NPROJ = 4864, NBT = NPROJ + 1024, INC = 4880;
constexpr int C_Q = 0, C_K = 512, C_V = 640, C_GA = 768, C_Z = 1280, C_XBC = 2304, C_MQ = 3840, C_GM = 4352;
constexpr int NCHUNK = MTOT / 64;
constexpr float EPSF = 1e-6f;
constexpr size_t O_Y = 0;
constexpr size_t O_WKP = (size_t)MTOT * 1024;
constexpr size_t O_WVP = O_WKP + (size_t)NB_P * 128 * 128;
constexpr size_t O_SSMP = O_WVP + (size_t)NB_P * 128 * 128;
constexpr size_t O_CONVP = O_SSMP + (size_t)NB_P * 16 * 64 * 128;
constexpr size_t O_MKP = O_CONVP + (size_t)NB_P * 3 * 1536;
constexpr size_t O_MVP = O_MKP + (size_t)NB_P * 256 * 512;
constexpr size_t O_WKS = O_MVP + (size_t)NB_P * 256 * 512;
constexpr size_t O_WVS = O_WKS + (size_t)NB_S * 128 * 128;
constexpr size_t O_SSMS = O_WVS + (size_t)NB_S * 128 * 128;
constexpr size_t O_CONVS = O_SSMS + (size_t)NB_S * 16 * 64 * 128;
constexpr size_t O_END = O_CONVS + (size_t)NB_S * 3 * 1536;
static_assert(O_END == 81485824, "output size");
constexpr size_t MiB = 1u << 20;
constexpr size_t WS_ROPE = 1 * MiB;
constexpr size_t WS_BT = 2 * MiB;
constexpr size_t WS_WOUT = 14 * MiB;
constexpr size_t WS_DT = 18 * MiB;
constexpr size_t WS_SSQ = 23 * MiB;
constexpr size_t WS_CTL = 0, CTL_ZERO_BYTES = 65536;
constexpr size_t WS_MEMRAW = 32 * MiB;
constexpr size_t WS_MEMK = 40 * MiB;
constexpr size_t WS_MEMVT = 52 * MiB;
constexpr size_t WS_PROJ = 64 * MiB;
constexpr size_t WS_A = 692 * MiB;
constexpr size_t WS_MIX = 692 * MiB;
constexpr size_t WS_BCC = 956 * MiB;
constexpr size_t WS_END = 1022 * MiB;
static_assert(WS_BT + (size_t)NBT * 1024 * 2 <= WS_WOUT && WS_DT + (size_t)MTOT * 64 <= WS_SSQ && WS_SSQ + (size_t)MTOT * 128 <= WS_MEMRAW, "ws map 1");
static_assert(WS_PROJ + (size_t)MTOT * NPROJ * 2 <= WS_A && WS_A + (size_t)MA * 1024 * 2 <= WS_END && WS_MIX + (size_t)MTOT * 2048 * 2 <= WS_BCC && WS_BCC + (size_t)MTOT * 512 * 2 <= WS_END, "ws map 2");
constexpr int LDS_BYTES = 147456;

DI float bf2f(unsigned short b) { return __uint_as_float((unsigned)b << 16); }
typedef __bf16 hbf2 __attribute__((ext_vector_type(2)));
DI unsigned short f2bf(float f) { return __builtin_bit_cast(unsigned short, (__bf16)f); }
DI unsigned pk2(float lo, float hi) { const f32x2 v = {lo, hi}; return __builtin_bit_cast(unsigned, __builtin_convertvector(v, hbf2)); }
DI unsigned cvt_pk_bf16(float lo, float hi) { return pk2(lo, hi); }
DI float siluf(float x) { return x * __builtin_amdgcn_rcpf(1.0f + __expf(-x)); }
DI float xor32_sum(float x) { unsigned u = __builtin_bit_cast(unsigned, x); unsigned u2 = u; asm volatile("" : "+v"(u2)); auto r = __builtin_amdgcn_permlane32_swap(u, u2, false, false); unsigned r0 = r[0], r1 = r[1]; return __builtin_bit_cast(float, r0) + __builtin_bit_cast(float, r1); }
DI float xor16_sum(float x) { unsigned u = __builtin_bit_cast(unsigned, x); unsigned u2 = u; asm volatile("" : "+v"(u2)); auto r = __builtin_amdgcn_permlane16_swap(u, u2, false, false); unsigned r0 = r[0], r1 = r[1]; return __builtin_bit_cast(float, r0) + __builtin_bit_cast(float, r1); }
DI float xor32_max(float x) { unsigned u = __builtin_bit_cast(unsigned, x); unsigned u2 = u; asm volatile("" : "+v"(u2)); auto r = __builtin_amdgcn_permlane32_swap(u, u2, false, false); unsigned r0 = r[0], r1 = r[1]; return fmaxf(__builtin_bit_cast(float, r0), __builtin_bit_cast(float, r1)); }
DI float xor16_max(float x) { unsigned u = __builtin_bit_cast(unsigned, x); unsigned u2 = u; asm volatile("" : "+v"(u2)); auto r = __builtin_amdgcn_permlane16_swap(u, u2, false, false); unsigned r0 = r[0], r1 = r[1]; return fmaxf(__builtin_bit_cast(float, r0), __builtin_bit_cast(float, r1)); }
#define DPP_ROR_(v, n) __builtin_bit_cast(float, __builtin_amdgcn_update_dpp(0, __builtin_bit_cast(int, (v)), 0x120 + (n), 0xf, 0xf, false))
DI float row16_sum(float v) { v += DPP_ROR_(v, 8); v += DPP_ROR_(v, 4); v += DPP_ROR_(v, 2); v += DPP_ROR_(v, 1); return v; }
DI float wave_sum(float v) { return xor32_sum(xor16_sum(row16_sum(v))); }
#define DPP_MOV_(v, ctrl) __builtin_bit_cast(float, __builtin_amdgcn_update_dpp(0, __builtin_bit_cast(int, (v)), (ctrl), 0xf, 0xf, false))
DI float lane_xor1(float v) { return DPP_MOV_(v, 0xB1); }
DI float lane_xor2(float v) { return DPP_MOV_(v, 0x4E); }
DI float lane_xor4(float v) { const float t = DPP_MOV_(v, 0x141); return DPP_MOV_(t, 0x1B); }
DI float lane_xor8(float v) { const float t = DPP_MOV_(v, 0x140); return DPP_MOV_(t, 0x141); }
DI float swap32_sum(float a, float b) { unsigned ua = __builtin_bit_cast(unsigned, a), ub = __builtin_bit_cast(unsigned, b); auto r = __builtin_amdgcn_permlane32_swap(ua, ub, false, false); unsigned r0 = r[0], r1 = r[1]; return __builtin_bit_cast(float, r0) + __builtin_bit_cast(float, r1); }
DI float swap16_sum(float a, float b) { unsigned ua = __builtin_bit_cast(unsigned, a), ub = __builtin_bit_cast(unsigned, b); auto r = __builtin_amdgcn_permlane16_swap(ua, ub, false, false); unsigned r0 = r[0], r1 = r[1]; return __builtin_bit_cast(float, r0) + __builtin_bit_cast(float, r1); }
DI void unpack8(const u32x4 v, float (&o)[8]) {
#pragma unroll
    for (int i = 0; i < 4; ++i) { o[2 * i] = __uint_as_float(v[i] << 16); o[2 * i + 1] = __uint_as_float(v[i] & 0xffff0000u); }
}
DI u32x4 pack8(const float (&o)[8]) { u32x4 v; v.x = pk2(o[0], o[1]); v.y = pk2(o[2], o[3]); v.z = pk2(o[4], o[5]); v.w = pk2(o[6], o[7]); return v; }
#define LDS_WAIT() asm volatile("s_waitcnt lgkmcnt(0)" ::: "memory")
#define MFMA16(a, b, c) __builtin_amdgcn_mfma_f32_16x16x32_bf16((a), (b), (c), 0, 0, 0)

struct Args { const float* in[26]; float* out; unsigned char* ws; };
struct Ctx {
    LAS unsigned char* lds; int tid, lane, wave, G, bid;
    const float* in[26]; float* out; unsigned char* ws;
};
#define RLX_AGENT __ATOMIC_RELAXED, __HIP_MEMORY_SCOPE_AGENT
#define XB_TMO      128
#define XB_XCNT(j)  (256  + 64 * (j))
#define XB_XSUB(j)  (1280 + 64 * (j))
#define XB_XGEN(j)  (2304 + 64 * (j))
#define XB_TOP      3328
#define XB_TOPGEN   3392
#define XCD_BAR_WORDS 3456
#define XB_SPIN_CAP (1u << 18)

__device__ __forceinline__ unsigned xb_ld(unsigned* p)              { return __hip_atomic_load(p, __ATOMIC_RELAXED, __HIP_MEMORY_SCOPE_AGENT); }
__device__ __forceinline__ unsigned xb_add(unsigned* p, unsigned v) { return __hip_atomic_fetch_add(p, v, __ATOMIC_RELAXED, __HIP_MEMORY_SCOPE_AGENT); }
__device__ __forceinline__ unsigned xb_xcc_id() { return (unsigned)__builtin_amdgcn_s_getreg((3 << 11) | 20) & 0xFu; }
#define XB_SPIN(cond, bar) do { unsigned _sp = 0; while (cond) { __builtin_amdgcn_s_sleep(1); \
    if ((++_sp & 255u) == 0u) { if (xb_ld(&(bar)[XB_TMO])) break; if (_sp > XB_SPIN_CAP) { atomicAdd(&(bar)[XB_TMO], 1u); break; } } } } while (0)

struct XcdBarrier {
    unsigned* bar; unsigned x;
    volatile LAS unsigned* st;
};

__device__ __forceinline__ XcdBarrier xcd_barrier_post(unsigned* bar, volatile LAS unsigned* st) {
    XcdBarrier b; b.bar = bar; b.x = xb_xcc_id(); b.st = st;
    if (threadIdx.x == 0) (void)xb_add(&bar[XB_XCNT(b.x)], 1u);
    return b;
}
__device__ __forceinline__ void xcd_barrier_complete(unsigned* bar, unsigned x, unsigned& nloc, unsigned& nx) {
    const unsigned G = gridDim.x * gridDim.y * gridDim.z;
    unsigned sum, cnt, mine, sp = 0u;
    for (;;) {
        sum = 0u; cnt = 0u; mine = 0u;
#pragma unroll
        for (unsigned j = 0; j < 16; ++j) { const unsigned c = xb_ld(&bar[XB_XCNT(j)]); sum += c; cnt += (c > 0u) ? 1u : 0u; mine = (j == x) ? c : mine; }
        if (sum == G) break;
        __builtin_amdgcn_s_sleep(1);
        if ((++sp & 255u) == 0u) { if (xb_ld(&bar[XB_TMO])) break; if (sp > XB_SPIN_CAP) { atomicAdd(&bar[XB_TMO], 1u); break; } }
    }
    nloc = mine > 0u ? mine : 1u; nx = cnt > 0u ? cnt : 1u;
}

__device__ __forceinline__ void xcd_barrier(const XcdBarrier& b) {
    asm volatile("s_waitcnt vmcnt(0)" ::: "memory");
    __syncthreads();
    if (threadIdx.x == 0) {
        unsigned* bar = b.bar;
        __builtin_amdgcn_s_waitcnt(0);
        unsigned nloc = b.st[0], nx = b.st[1];
        if (nloc == 0u) { xcd_barrier_complete(bar, b.x, nloc, nx); b.st[0] = nloc; b.st[1] = nx; }
        const unsigned old = xb_add(&bar[XB_XSUB(b.x)], 1u);
        const unsigned gen = old / nloc;
        if (old + 1u == (gen + 1u) * nloc) {
            __builtin_amdgcn_fence(__ATOMIC_RELEASE, "agent");
            asm volatile("s_waitcnt vmcnt(0)" ::: "memory");
            const unsigned og = xb_add(&bar[XB_TOP], 1u);
            const unsigned tg = og / nx;
            if (og + 1u == (tg + 1u) * nx) xb_add(&bar[XB_TOPGEN], 1u);
            else XB_SPIN(xb_ld(&bar[XB_TOPGEN]) == tg, bar);
            __builtin_amdgcn_fence(__ATOMIC_ACQUIRE, "agent");
            xb_add(&bar[XB_XGEN(b.x)], 1u);
            asm volatile("s_waitcnt vmcnt(0)" ::: "memory");
        } else {
            XB_SPIN(xb_ld(&bar[XB_XGEN(b.x)]) == gen, bar);
            __builtin_amdgcn_fence(__ATOMIC_ACQUIRE, "agent");
            asm volatile("s_waitcnt vmcnt(0)" ::: "memory");
        }
    }
    __syncthreads();
}

enum { I_XP = 0, I_XS, I_CWK, I_CWV, I_SSM, I_SCONV, I_CMK, I_CMV, I_MEM, I_GNORM, I_WIN, I_GQ, I_GK, I_SINKS, I_CONVW, I_CONVB, I_DTB, I_ALOG, I_DSKIP, I_GSSD, I_GMEM, I_WMK, I_WMV, I_GMK, I_GMQ, I_WOUT };

DI void p0_transpose_item(const float* W, int ldw, int src_k0, int src_n0, const float* rowscale, bf16_t* WT, int ldt, int dst_n0, int dst_k0, LAS float* scr, int lane) {
    float tv[32];
#pragma unroll
    for (int i = 0; i < 32; ++i) tv[i] = W[(size_t)(src_k0 + 2 * i + (lane >> 5)) * ldw + src_n0 + (lane & 31)];
    if (rowscale) {
#pragma unroll
        for (int i = 0; i < 32; ++i) tv[i] *= rowscale[2 * i + (lane >> 5)]; }
#pragma unroll
    for (int i = 0; i < 32; ++i) scr[(2 * i + (lane >> 5)) * 33 + (lane & 31)] = tv[i];
    LDS_WAIT();
    const int c = lane & 7;
#pragma unroll
    for (int j = 0; j < 4; ++j) { const int n = (lane >> 3) + 8 * j; const LAS float* s = scr + (8 * c) * 33 + n;
        u32x4 o; o.x = pk2(s[0 * 33], s[1 * 33]); o.y = pk2(s[2 * 33], s[3 * 33]); o.z = pk2(s[4 * 33], s[5 * 33]); o.w = pk2(s[6 * 33], s[7 * 33]);
        *(u32x4*)(WT + (size_t)(dst_n0 + n) * ldt + dst_k0 + 8 * c) = o; }
    LDS_WAIT();
}

DI float reduce16_to_lane(float (&a)[16], int lane) {
#pragma unroll
    for (int j = 0; j < 16; ++j) { a[j] += __shfl_xor(a[j], 32); a[j] += __shfl_xor(a[j], 16); }
    float r8[8], r4[4], r2[2];
    const bool b3 = (lane & 8) != 0, b2 = (lane & 4) != 0, b1 = (lane & 2) != 0, b0 = (lane & 1) != 0;
#pragma unroll
    for (int j = 0; j < 8; ++j) { const float snd = b3 ? a[j] : a[j + 8], kp = b3 ? a[j + 8] : a[j]; r8[j] = kp + __shfl_xor(snd, 8); }
#pragma unroll
    for (int j = 0; j < 4; ++j) { const float snd = b2 ? r8[j] : r8[j + 4], kp = b2 ? r8[j + 4] : r8[j]; r4[j] = kp + __shfl_xor(snd, 4); }
#pragma unroll
    for (int j = 0; j < 2; ++j) { const float snd = b1 ? r4[j] : r4[j + 2], kp = b1 ? r4[j + 2] : r4[j]; r2[j] = kp + __shfl_xor(snd, 2); }
    const float snd = b0 ? r2[0] : r2[1], kp = b0 ? r2[1] : r2[0];
    return kp + __shfl_xor(snd, 1);
}

DI void p0_rows2(f32x4 (&va)[4], f32x4 (&vb)[4], const float* g, bf16_t* oa, bf16_t* ob, float* dta, float* dtb, bool want_dt, const float* dt_bias, const LAS float* wdt, int lane) {
    float sa = 0.f, sb = 0.f;
#pragma unroll
    for (int jj = 0; jj < 4; ++jj) { sa += (va[jj].x * va[jj].x + va[jj].y * va[jj].y) + (va[jj].z * va[jj].z + va[jj].w * va[jj].w); sb += (vb[jj].x * vb[jj].x + vb[jj].y * vb[jj].y) + (vb[jj].z * vb[jj].z + vb[jj].w * vb[jj].w); }
    const float ra = 1.0f / sqrtf(wave_sum(sa) * (1.0f / DM) + EPSF), rb = 1.0f / sqrtf(wave_sum(sb) * (1.0f / DM) + EPSF);
    u32x2* pa = (u32x2*)oa + lane; u32x2* pb = (u32x2*)ob + lane;
#pragma unroll
    for (int jj = 0; jj < 4; ++jj) { const f32x4 gv = ((const f32x4*)g)[64 * jj + lane]; va[jj] = va[jj] * ra * gv; vb[jj] = vb[jj] * rb * gv;
        u32x2 w; w.x = pk2(va[jj].x, va[jj].y); w.y = pk2(va[jj].z, va[jj].w); pa[64 * jj] = w; w.x = pk2(vb[jj].x, vb[jj].y); w.y = pk2(vb[jj].z, vb[jj].w); pb[64 * jj] = w; }
    if (want_dt) {
        f32x2 ab[16];
#pragma unroll
        for (int j = 0; j < 16; ++j) ab[j] = (f32x2){0.f, 0.f};
#pragma unroll
        for (int jj = 0; jj < 4; ++jj)
#pragma unroll
            for (int e = 0; e < 4; ++e) { const f32x2 hab = {va[jj][e], vb[jj][e]}; const LAS f32x4* wr = (const LAS f32x4*)(wdt + ((jj * 4 + e) * 64 + lane) * 20);
#pragma unroll
                for (int q = 0; q < 4; ++q) { const f32x4 w4 = wr[q];
                    ab[4 * q] += hab * w4.x; ab[4 * q + 1] += hab * w4.y; ab[4 * q + 2] += hab * w4.z; ab[4 * q + 3] += hab * w4.w; }
                if (e & 1) __builtin_amdgcn_sched_barrier(0); }
        float a[16], b[16];
#pragma unroll
        for (int j = 0; j < 16; ++j) { a[j] = ab[j].x; b[j] = ab[j].y; }
        const bool b5 = (lane & 32) != 0, b3 = (lane & 8) != 0, b2 = (lane & 4) != 0, b1 = (lane & 2) != 0;
        float v16[16], v8[8], v4[4], v2[2];
#pragma unroll
        for (int j = 0; j < 16; ++j) v16[j] = swap32_sum(a[j], b[j]);
#pragma unroll
        for (int j = 0; j < 8; ++j) v8[j] = swap16_sum(v16[j], v16[j + 8]);
#pragma unroll
        for (int j = 0; j < 4; ++j) { const float snd = b3 ? v8[j] : v8[j + 4], kp = b3 ? v8[j + 4] : v8[j]; v4[j] = kp + lane_xor8(snd); }
#pragma unroll
        for (int j = 0; j < 2; ++j) { const float snd = b2 ? v4[j] : v4[j + 2], kp = b2 ? v4[j + 2] : v4[j]; v2[j] = kp + lane_xor4(snd); }
        float tot; { const float snd = b1 ? v2[0] : v2[1], kp = b1 ? v2[1] : v2[0]; tot = kp + lane_xor2(snd); }
        tot += lane_xor1(tot);
        if ((lane & 1) == 0) { const int j = (lane >> 1) & 15; const float xv = tot + dt_bias[j]; float* dp = b5 ? dtb : dta;
            dp[j] = fmaxf(xv, 0.f) + log1pf(__expf(-fabsf(xv))); }
    }
}

DI void p0_row_segment(Ctx& F, const float* src, const float* g, int m0, int npair, bool tok, bf16_t* A, float* DT, const LAS float* wdt, int gw, int NGW) {
    const int lane = F.lane;
    f32x4 n0a[4], n0b[4], n1a[4], n1b[4];
#define P0_LOAD(dst_a, dst_b, pp) do { if ((pp) < npair) { _Pragma("unroll") for (int jj = 0; jj < 4; ++jj) { \
        dst_a[jj] = ((const f32x4*)(src + (size_t)(2 * (pp)) * DM))[64 * jj + lane]; dst_b[jj] = ((const f32x4*)(src + (size_t)(2 * (pp) + 1) * DM))[64 * jj + lane]; } } } while (0)
    P0_LOAD(n0a, n0b, gw); P0_LOAD(n1a, n1b, gw + NGW);
    for (int p = gw; p < npair; p += NGW) {
        f32x4 va[4], vb[4];
#pragma unroll
        for (int jj = 0; jj < 4; ++jj) { va[jj] = n0a[jj]; vb[jj] = n0b[jj]; n0a[jj] = n1a[jj]; n0b[jj] = n1b[jj]; }
        P0_LOAD(n1a, n1b, p + 2 * NGW);
        const int m = m0 + 2 * p;
        p0_rows2(va, vb, g, A + (size_t)m * DM, A + (size_t)(m + 1) * DM, DT + (size_t)(tok ? m : 0) * 16, DT + (size_t)(tok ? m + 1 : 0) * 16, tok, F.in[I_DTB], wdt, lane);
    }
#undef P0_LOAD
}

DI void p0_prologue(Ctx& F) {
#if CLKPROBE >= 50 && CLKPROBE <= 52
    long long pt0_ = (long long)__builtin_amdgcn_s_memrealtime();
#define P0_TS(k) do { const long long t_ = (long long)__builtin_amdgcn_s_memrealtime(); if (CLKPROBE == (k) && threadIdx.x == 0) g_dbg[blockIdx.x] += t_ - pt0_; pt0_ = t_; } while (0)
#else
#define P0_TS(k) do { } while (0)
#endif
    const int gw = F.bid * 8 + F.wave, NGW = F.G * 8, lane = F.lane;
    bf16_t* BT = (bf16_t*)(F.ws + WS_BT); bf16_t* WOT = (bf16_t*)(F.ws + WS_WOUT);
    for (int rep_ = 0; rep_ < REP_P0T; ++rep_) {
        LAS float* scr = (LAS float*)(F.lds + F.wave * 16384);
        constexpr int I_IN = 16 * (NPROJ / 32), I_M = 16 * 32, I_O = 32 * 32;
        for (int it = gw; it < I_IN + I_M + I_O; it += NGW) {
            int r = it;
            if (r < I_IN) { const int kb = r / (NPROJ / 32), nb = r % (NPROJ / 32); const int n0 = 32 * nb;
                p0_transpose_item(F.in[I_WIN], INC, 64 * kb, n0 + (n0 >= 3840 ? 16 : 0), nullptr, BT, 1024, n0, 64 * kb, scr, lane); continue; }
            r -= I_IN;
            if (r < I_M) { const int kb = r / 32, nb = r % 32;
                p0_transpose_item(nb < 16 ? F.in[I_WMK] : F.in[I_WMV], 512, 64 * kb, 32 * (nb & 15), nullptr, BT, 1024, NPROJ + 32 * nb, 64 * kb, scr, lane); continue; }
            r -= I_M;
            { const int kb = r / 32, nb = r % 32; const int k0 = 64 * kb;
              const int sk0 = k0 < 1024 ? 512 + k0 : (k0 < 1536 ? k0 - 1024 : k0);
              p0_transpose_item(F.in[I_WOUT], 1024, sk0, 32 * nb, k0 < 1024 ? F.in[I_GSSD] + k0 : nullptr, WOT, 2048, 32 * nb, k0, scr, lane); }
        }
    }
    { float* sq = (float*)(F.ws + WS_SSQ); for (int i = F.bid * 512 + F.tid; i < MTOT; i += F.G * 512) sq[i] = 0.f; }
    {
        f32x2* rope = (f32x2*)(F.ws + WS_ROPE);
        for (int i = F.bid * 512 + F.tid; i < 4096 * 32; i += F.G * 512) {
            const int pos = i >> 5, fi = i & 31;
            const float freq = exp2f(-(float)fi * (13.287712379549449f / 32.0f));
            double rev = (double)pos * (double)freq * 0.15915494309189535;
            rev -= __builtin_rint(rev);
            const float ang = (float)(rev * 6.283185307179586);
            rope[i] = (f32x2){cosf(ang), sinf(ang)};
        }
    }
    P0_TS(50);
    __syncthreads();
    for (int rep_ = 0; rep_ < REP_P0R; ++rep_) {
        if (rep_) __syncthreads();
        LAS float* wdt = (LAS float*)F.lds;
#pragma unroll 1
        for (int i0 = F.tid; i0 < 1024 * 16; i0 += 512 * 8) { float t8[8];
#pragma unroll
            for (int u = 0; u < 8; ++u) { const int i = i0 + 512 * u; t8[u] = F.in[I_WIN][(size_t)(i >> 4) * INC + 3840 + (i & 15)]; }
#pragma unroll
            for (int u = 0; u < 8; ++u) { const int i = i0 + 512 * u, k = i >> 4, j = i & 15; const int jj = k >> 8, e = k & 3, l = (k >> 2) & 63;
                wdt[((jj * 4 + e) * 64 + l) * 20 + j] = t8[u]; } }
        __syncthreads();
        P0_TS(51);
        bf16_t* A = (bf16_t*)(F.ws + WS_A); float* DT = (float*)(F.ws + WS_DT);
        p0_row_segment(F, F.in[I_XP], F.in[I_GNORM], 0, MP / 2, true, A, DT, wdt, gw, NGW);
        p0_row_segment(F, F.in[I_XS], F.in[I_GNORM], MP, MS / 2, true, A, DT, wdt, gw, NGW);
        p0_row_segment(F, F.in[I_MEM], F.in[I_GMEM], MTOT, MMEM / 2, false, A, DT, wdt, gw, NGW);
    }
    P0_TS(52);
}
struct Order1 {
    pg8::StaticOrder so; int G, c;
    __device__ void init(int G_, int c_) { so.init(MTOT, NPROJ, G_, c_); G = G_; c = c_; }
    __device__ bool next(int i, pg8::Unit& u) const {
        long L = (long)i * G + c;
        if (L >= (long)REP_P1 * (so.nwg + 64)) return false;
        L %= (so.nwg + 64);
        if (L < so.nwg) { pg8::StaticOrder t = so; t.G = 1; t.c = 0; return t.next((int)L, u); }
        const int r = (int)(L - so.nwg);
        u.pm = MTOT / 256 + (r >> 2); u.pn = NPROJ / 256 + (r & 3); return true;
    }
    __device__ __forceinline__ void a_ready(const pg8::Unit&) const {}
    __device__ __forceinline__ void done(const pg8::Unit&) const {}
};
struct Order3 {
    pg8::StaticOrder so; int G, c;
    __device__ void init(int G_, int c_) { so.init(MP, 1024, 1, 0); G = G_; c = c_; }
    __device__ bool next(int i, pg8::Unit& u) const {
        long L = (long)i * G + c;
        if (L >= (long)REP_P3 * so.nwg) return false;
        return so.next((int)(L % so.nwg), u);
    }
    __device__ __forceinline__ void a_ready(const pg8::Unit&) const {}
    __device__ __forceinline__ void done(const pg8::Unit&) const {}
};
struct EpiProj {
    static constexpr bool PERM = true, AFTER_DRAIN = false, HAS_INIT = false; static constexpr int MIDK = 0;
    bf16_t* proj; bf16_t* memraw;
    __device__ __forceinline__ void operator()(const f32x4 (&acc)[2][2][4][2], const pg8::Unit& u, int wr, int wc, int fr, int fq) const {
        bf16_t* base; int ldc, row0, col0;
        if (u.pn < NPROJ / 256) { base = proj; ldc = NPROJ; row0 = u.pm * 256; col0 = u.pn * 256; }
        else { base = memraw; ldc = 1024; row0 = (u.pm - MTOT / 256) * 256; col0 = (u.pn - NPROJ / 256) * 256; }
        row0 += wr * 64 + fr; col0 += wc * 32 + 8 * fq;
#pragma unroll
        for (int ai = 0; ai < 2; ++ai)
#pragma unroll
            for (int m = 0; m < 4; ++m) { bf16_t* rowp = base + (size_t)(row0 + ai * 128 + m * 16) * ldc + col0;
#pragma unroll
                for (int bj = 0; bj < 2; ++bj) { const f32x4 v0 = acc[ai][bj][m][0], v1 = acc[ai][bj][m][1];
                    u32x4 w; w.x = cvt_pk_bf16(v0[0], v0[1]); w.y = cvt_pk_bf16(v0[2], v0[3]); w.z = cvt_pk_bf16(v1[0], v1[1]); w.w = cvt_pk_bf16(v1[2], v1[3]);
                    *(u32x4*)(rowp + bj * 128) = w; } }
    }
};
struct EpiOut {
    static constexpr bool PERM = false, AFTER_DRAIN = false, HAS_INIT = true; static constexpr int MIDK = 16;
    const float* xp; const float* xs; float* out; const float* sumsq;
    __device__ __forceinline__ void mid(f32x4 (&acc)[2][2][4][2], const pg8::Unit& u, int wr, int wc, int fr, int fq) const {
        const float* sq = sumsq + (size_t)u.pm * 256 + wr * 64 + fr;
#pragma unroll
        for (int ai = 0; ai < 2; ++ai)
#pragma unroll
            for (int m = 0; m < 4; ++m) { const float r = __builtin_amdgcn_rsqf(sq[ai * 128 + m * 16] * (1.0f / 1024.0f) + EPSF);
#pragma unroll
                for (int bj = 0; bj < 2; ++bj)
#pragma unroll
                    for (int n = 0; n < 2; ++n) acc[ai][bj][m][n] = acc[ai][bj][m][n] * r; }
    }
    __device__ __forceinline__ void init(f32x4 (&acc)[2][2][4][2], const pg8::Unit& u, int wr, int wc, int fr, int fq) const {
        const float* xb = u.pm < MP / 256 ? xp + (size_t)u.pm * 256 * DM : xs + (size_t)(u.pm - MP / 256) * 256 * DM;
        const float* sq = sumsq + (size_t)u.pm * 256 + wr * 64 + fr;
        const int rl0 = wr * 64 + fr, col0 = u.pn * 256 + wc * 32 + 4 * fq;
#pragma unroll
        for (int ai = 0; ai < 2; ++ai)
#pragma unroll
            for (int m = 0; m < 4; ++m) { const float s = __builtin_amdgcn_sqrtf(sq[ai * 128 + m * 16] * (1.0f / 1024.0f) + EPSF);
#pragma unroll
                for (int bj = 0; bj < 2; ++bj)
#pragma unroll
                    for (int n = 0; n < 2; ++n) acc[ai][bj][m][n] = *(const f32x4*)(xb + (size_t)(rl0 + ai * 128 + m * 16) * DM + col0 + bj * 128 + n * 16) * s; }
    }
    __device__ __forceinline__ void operator()(const f32x4 (&acc)[2][2][4][2], const pg8::Unit& u, int wr, int wc, int fr, int fq) const {
        float* ob = out + (size_t)u.pm * 256 * DM;
        const int rl0 = wr * 64 + fr, col0 = u.pn * 256 + wc * 32 + 4 * fq;
#pragma unroll
        for (int ai = 0; ai < 2; ++ai)
#pragma unroll
            for (int m = 0; m < 4; ++m)
#pragma unroll
                for (int bj = 0; bj < 2; ++bj)
#pragma unroll
                    for (int n = 0; n < 2; ++n) *(f32x4*)(ob + (size_t)(rl0 + ai * 128 + m * 16) * DM + col0 + bj * 128 + n * 16) = acc[ai][bj][m][n];
    }
};

constexpr int SS_X = 0, SS_XD = 9216, SS_BM = 18432, SS_CM = 35840, SS_SET = 53248;
constexpr int SS_SB = 2 * SS_SET, SS_WM = SS_SB + 17408, SS_SM = SS_WM + 9216;
constexpr int LD64 = 144, LD128 = 272;
typedef short s16x4 __attribute__((ext_vector_type(4)));

DI bf16x8 lds_frag(const LAS unsigned char* tile, int ld, int row0, int k0, int lane) {
    return *(const LAS bf16x8*)(tile + (row0 + (lane & 15)) * ld + (k0 + 8 * (lane >> 4)) * 2);
}
DI bf16x8 lds_frag_tr(const LAS unsigned char* tile, int ld, int k0, int c0, int lane) {
    const LAS unsigned char* a = tile + (k0 + 8 * (lane >> 4) + ((lane & 15) >> 2)) * ld + (c0 + 4 * (lane & 3)) * 2;
    const s16x4 lo = __builtin_amdgcn_ds_read_tr16_b64_v4i16((LAS s16x4*)a), hi = __builtin_amdgcn_ds_read_tr16_b64_v4i16((LAS s16x4*)(a + 4 * ld));
    return (bf16x8){lo.x, lo.y, lo.z, lo.w, hi.x, hi.y, hi.z, hi.w};
}
DI bf16x8 lds_frag_tr2(const LAS unsigned char* tile, int ld, int k0, int c0, int lane) {
    const LAS unsigned char* a = tile + (k0 + 4 * (lane >> 4) + ((lane & 15) >> 2)) * ld + (c0 + 4 * (lane & 3)) * 2;
    const s16x4 lo = __builtin_amdgcn_ds_read_tr16_b64_v4i16((LAS s16x4*)a), hi = __builtin_amdgcn_ds_read_tr16_b64_v4i16((LAS s16x4*)(a + 16 * ld));
    return (bf16x8){lo.x, lo.y, lo.z, lo.w, hi.x, hi.y, hi.z, hi.w};
}
#define MFMA16T(rowsfrag, colsfrag, acc) MFMA16((colsfrag), (rowsfrag), (acc))

#define DPP_ADD_(v, ctrl, rmask) ((v) + __builtin_bit_cast(float, __builtin_amdgcn_update_dpp(0, __builtin_bit_cast(int, (v)), (ctrl), (rmask), 0xf, false)))
DI float wave_incl_scan(float v) {
    v = DPP_ADD_(v, 0x111, 0xf); v = DPP_ADD_(v, 0x112, 0xf); v = DPP_ADD_(v, 0x114, 0xf); v = DPP_ADD_(v, 0x118, 0xf);
    v = DPP_ADD_(v, 0x142, 0xa);
    v = DPP_ADD_(v, 0x143, 0xc);
    return v;
}
DI void convbc_prepass(Ctx& F) {
    const int gw = F.bid * 8 + F.wave, NGW = F.G * 8, lane = F.lane;
    const bf16_t* PROJ = (const bf16_t*)(F.ws + WS_PROJ); bf16_t* BCC = (bf16_t*)(F.ws + WS_BCC);
    const int ch0 = 1024 + lane * 8;
    float wv[4][8], bv[8];
#pragma unroll
    for (int e = 0; e < 8; ++e) { bv[e] = F.in[I_CONVB][ch0 + e];
#pragma unroll
        for (int j = 0; j < 4; ++j) wv[j][e] = F.in[I_CONVW][j * 1536 + ch0 + e]; }
    const bool bal = (F.G == 256);
    const int nmine = bal ? 1 : (MTOT / 33 - gw + NGW - 1) / NGW;
    for (int ti = 0; ti < nmine; ++ti) {
        int ub, nb;
        if (bal) { const int wv_ = F.wave;
            if (F.bid < 64) { ub = (F.bid * 8 + wv_) * 2; nb = 2; } else if (F.bid < 128) { ub = 1024 + ((F.bid - 64) * 8 + wv_) * 4; nb = 4; } else { ub = 3072 + ((F.bid - 128) * 8 + wv_) * 3; nb = 3; } }
        else { ub = (gw + ti * NGW) * 3; nb = 3; }
        const int row0 = ub * 11;
        float h0[8], h1[8], h2[8];
        { const bool smp0 = row0 >= MP; const int lrow0 = smp0 ? (row0 - MP) & 63 : row0 & (T_P - 1);
          const float* sc0 = F.in[I_SCONV] + (size_t)(smp0 ? (row0 - MP) >> 6 : 0) * 3 * 1536 + ch0;
#define CONV_HALO(dst, j) do { const int lr_ = lrow0 - 3 + (j); \
              if (lr_ >= 0) unpack8(*(const u32x4*)(PROJ + (size_t)(row0 - 3 + (j)) * NPROJ + C_XBC + ch0), dst); \
              else { _Pragma("unroll") for (int e = 0; e < 8; ++e) dst[e] = smp0 ? sc0[(3 + lr_) * 1536 + e] : 0.f; } } while (0)
          CONV_HALO(h0, 0); CONV_HALO(h1, 1); CONV_HALO(h2, 2);
#undef CONV_HALO
        }
        u32x4 rawA[11], rawB[11];
#pragma unroll
        for (int i = 0; i < 11; ++i) rawA[i] = *(const u32x4*)(PROJ + (size_t)(row0 + i) * NPROJ + C_XBC + ch0);
#define CONV_BATCH(bt, cur, nxt) do { \
            if ((bt) + 1 < nb) { _Pragma("unroll") for (int i = 0; i < 11; ++i) nxt[i] = *(const u32x4*)(PROJ + (size_t)(row0 + 11 * ((bt) + 1) + i) * NPROJ + C_XBC + ch0); } \
            _Pragma("unroll") for (int i = 0; i < 11; ++i) { const int row = row0 + 11 * (bt) + i; \
                const bool smp = row >= MP; const int lrow = smp ? (row - MP) & 63 : row & (T_P - 1); \
                if (lrow == 0) { \
                    if (smp) { const float* sc = F.in[I_SCONV] + (size_t)((row - MP) >> 6) * 3 * 1536 + ch0; \
                        _Pragma("unroll") for (int e = 0; e < 8; ++e) { h0[e] = sc[e]; h1[e] = sc[1536 + e]; h2[e] = sc[2 * 1536 + e]; } } \
                    else { _Pragma("unroll") for (int e = 0; e < 8; ++e) { h0[e] = 0.f; h1[e] = 0.f; h2[e] = 0.f; } } } \
                float cur_[8], o[8]; \
                unpack8(cur[i], cur_); \
                _Pragma("unroll") for (int e = 0; e < 8; ++e) { o[e] = siluf(bv[e] + wv[0][e] * h0[e] + wv[1][e] * h1[e] + wv[2][e] * h2[e] + wv[3][e] * cur_[e]); h0[e] = h1[e]; h1[e] = h2[e]; h2[e] = cur_[e]; } \
                *(u32x4*)(BCC + (size_t)row * 512 + lane * 8) = pack8(o); } } while (0)
        CONV_BATCH(0, rawA, rawB); CONV_BATCH(1, rawB, rawA); if (nb > 2) CONV_BATCH(2, rawA, rawB); if (nb > 3) CONV_BATCH(3, rawB, rawA);
#undef CONV_BATCH
    }
}

DI void ssd_item(Ctx& F, int sq, int h, bool do_sumsq) {
    LAS unsigned char* lds = F.lds;
    const int tid = F.tid, lane = F.lane, w = F.wave, g = h >> 3;
    const bool smp = sq >= NB_P; const int sb = sq - NB_P;
    const int row_base = smp ? MP + sb * 64 : sq * T_P, nchunks = smp ? 1 : 64;
    const bf16_t* PROJ = (const bf16_t*)(F.ws + WS_PROJ); const bf16_t* BCC = (const bf16_t*)(F.ws + WS_BCC); const float* DT = (const float*)(F.ws + WS_DT);
    bf16_t* MIX = (bf16_t*)(F.ws + WS_MIX); float* SUMSQ = (float*)(F.ws + WS_SSQ);
    const float a_h = -__expf(F.in[I_ALOG][h]), d_h = F.in[I_DSKIP][h];
    const int pt = w >> 1, nh = w & 1, lt = w >> 1;
    const int xl = tid >> 3, xg = tid & 7, chx = h * 64 + 8 * xg;
    LAS float* sm_cw0 = (LAS float*)(lds + SS_SM + 1024 + 768);
    if (tid >= 192 && tid < 512) { const int i = tid - 192; const int j = i >> 6, chn = h * 64 + (i & 63); sm_cw0[i] = j < 4 ? F.in[I_CONVW][j * 1536 + chn] : F.in[I_CONVB][chn]; }
    f32x4 st[4];
#pragma unroll
    for (int q = 0; q < 4; ++q) {
        if (smp) st[q] = *(const f32x4*)(F.in[I_SSM] + ((size_t)(sb * 16 + h) * 64 + 16 * pt + (lane & 15)) * 128 + 16 * (4 * nh + q) + 4 * (lane >> 4));
        else st[q] = (f32x4){0.f, 0.f, 0.f, 0.f};
    }
    u32x4 px0[4], px1[4] = {{0u, 0u, 0u, 0u}, {0u, 0u, 0u, 0u}, {0u, 0u, 0u, 0u}, {0u, 0u, 0u, 0u}}, pbs[2], pcs[2]; u32x2 pz0[2], pz1[2] = {{0u, 0u}, {0u, 0u}}; float pdt0, pdt1 = 0.f;
#define SSD_ISSUE_X(c_, PX_) do { const int row0_ = row_base + 64 * (c_); \
        _Pragma("unroll") for (int j_ = 0; j_ < 4; ++j_) { int rr_ = xl - 3 + j_; if ((c_) == 0 && rr_ < 0) rr_ = 0; PX_[j_] = *(const u32x4*)(PROJ + (size_t)(row0_ + rr_) * NPROJ + C_XBC + chx); } } while (0)
#define SSD_ISSUE_BC(c_) do { const int row0_ = row_base + 64 * (c_); \
        _Pragma("unroll") for (int i_ = 0; i_ < 2; ++i_) { const int t_ = tid + 512 * i_; \
            pbs[i_] = *(const u32x4*)(BCC + (size_t)(row0_ + (t_ >> 4)) * 512 + g * 128 + 8 * (t_ & 15)); pcs[i_] = *(const u32x4*)(BCC + (size_t)(row0_ + (t_ >> 4)) * 512 + 256 + g * 128 + 8 * (t_ & 15)); } } while (0)
#define SSD_ISSUE_ZDT(c_, PZ_, PDT_) do { const int row0_ = row_base + 64 * (c_); \
        _Pragma("unroll") for (int pi_ = 0; pi_ < 2; ++pi_) PZ_[pi_] = *(const u32x2*)(PROJ + (size_t)(row0_ + 16 * lt + (lane & 15)) * NPROJ + C_Z + h * 64 + 16 * (2 * nh + pi_) + 4 * (lane >> 4)); \
        PDT_ = DT[(size_t)(row0_ + lane) * 16 + h]; } while (0)
    LAS float* sm_init = (LAS float*)(lds + SS_SM + 1024);
    if (tid < 192) sm_init[tid] = smp ? F.in[I_SCONV][(size_t)(sb * 3 + (tid >> 6)) * 1536 + h * 64 + (tid & 63)] : 0.f;
#if TIMESEG
    long long ts_[6] = {0, 0, 0, 0, 0, 0}; long long tacc_ = 0;
#define SSD_TS(k) do { ts_[k] = (long long)__builtin_amdgcn_s_memtime(); if ((k) == 5) tacc_ += ts_[TIMESEG_B] - ts_[TIMESEG_A]; } while (0)
#else
#define SSD_TS(k) do { } while (0)
#endif
#define SSD_STEP(c, PX_, PZ_, PDT_, PZN_, PDTN_, PXN_) do { \
        const int row0 = row_base + 64 * c; LAS unsigned char* ts = lds + (c & 1) * SS_SET; \
        SSD_TS(0); \
        LAS float* sm_ac = (LAS float*)(lds + SS_SM + (c & 1) * 512); LAS float* sm_dt = sm_ac + 64; \
        const float dtl = PDT_; \
        float ac = dtl * a_h; \
        ac = wave_incl_scan(ac); \
        const float ac_last = __builtin_bit_cast(float, __builtin_amdgcn_readlane(__builtin_bit_cast(int, ac), 63)); \
        const float wgt_l = __expf(ac_last - ac) * dtl; \
        if (w == 0) { sm_ac[lane] = ac; sm_dt[lane] = dtl; } \
        { \
        { float xr[4][8], o[8], od[8]; \
_Pragma("unroll")           for (int j = 0; j < 4; ++j) unpack8(PX_[j], xr[j]); \
          if (c == 0) { \
_Pragma("unroll")               for (int j = 0; j < 3; ++j) { const int rr = xl - 3 + j; const LAS f32x4* iv = (const LAS f32x4*)(sm_init + (rr < 0 ? 3 + rr : 0) * 64 + 8 * xg); \
                  f32x4 i0 = iv[0], i1 = iv[1]; asm volatile("" : "+v"(i0), "+v"(i1)); \
_Pragma("unroll")                   for (int e = 0; e < 4; ++e) { xr[j][e] = (rr < 0) ? i0[e] : xr[j][e]; xr[j][4 + e] = (rr < 0) ? i1[e] : xr[j][4 + e]; } } } \
          const float wg = __shfl(wgt_l, xl & 63); \
          float wv[4][8], bv[8]; unsigned cwo_ = (unsigned)(8 * xg) * 4u; asm volatile("" : "+v"(cwo_)); const LAS float* sm_cw = (const LAS float*)((const LAS unsigned char*)sm_cw0 + cwo_) - 8 * xg; \
          _Pragma("unroll") for (int j_ = 0; j_ < 4; ++j_) { const f32x4 a_ = *(const LAS f32x4*)(sm_cw + j_ * 64 + 8 * xg), b_ = *(const LAS f32x4*)(sm_cw + j_ * 64 + 8 * xg + 4); \
              _Pragma("unroll") for (int e_ = 0; e_ < 4; ++e_) { wv[j_][e_] = a_[e_]; wv[j_][4 + e_] = b_[e_]; } } \
          { const f32x4 a_ = *(const LAS f32x4*)(sm_cw + 256 + 8 * xg), b_ = *(const LAS f32x4*)(sm_cw + 256 + 8 * xg + 4); _Pragma("unroll") for (int e_ = 0; e_ < 4; ++e_) { bv[e_] = a_[e_]; bv[4 + e_] = b_[e_]; } } \
_Pragma("unroll")           for (int e = 0; e < 8; ++e) { o[e] = siluf(bv[e] + wv[0][e] * xr[0][e] + wv[1][e] * xr[1][e] + wv[2][e] * xr[2][e] + wv[3][e] * xr[3][e]); od[e] = o[e] * wg; } \
          *(LAS u32x4*)(ts + SS_X + xl * LD64 + xg * 16) = pack8(o); \
          *(LAS u32x4*)(ts + SS_XD + xl * LD64 + xg * 16) = pack8(od); } \
_Pragma("unroll")         for (int i = 0; i < 2; ++i) { const int t = tid + 512 * i; \
            *(LAS u32x4*)(ts + SS_BM + (t >> 4) * LD128 + (t & 15) * 16) = pbs[i]; *(LAS u32x4*)(ts + SS_CM + (t >> 4) * LD128 + (t & 15) * 16) = pcs[i]; } \
        } \
        if (c + 2 < nchunks) SSD_ISSUE_X(c + 2, PX_); if (c + 1 < nchunks) { SSD_ISSUE_BC(c + 1); SSD_ISSUE_ZDT(c + 1, PZN_, PDTN_); } \
        SSD_TS(1); __syncthreads(); SSD_TS(2); \
_Pragma("unroll")         for (int q = 0; q < 4; ++q) { u32x2 v; v.x = pk2(st[q][0], st[q][1]); v.y = pk2(st[q][2], st[q][3]); \
            *(LAS u32x2*)(lds + SS_SB + (16 * pt + (lane & 15)) * LD128 + (16 * (4 * nh + q) + 4 * (lane >> 4)) * 2) = v; } \
        bf16x8 cmf[4]; \
_Pragma("unroll")         for (int ks = 0; ks < 4; ++ks) cmf[ks] = lds_frag(ts + SS_CM, LD128, 16 * lt, 32 * ks, lane); \
        { const float acl = sm_ac[16 * lt + (lane & 15)]; const int l = 16 * lt + (lane & 15); \
_Pragma("unroll")           for (int si = 0; si < 2; ++si) { const int stl = 2 * nh + si; f32x4 gacc = {0.f, 0.f, 0.f, 0.f}; \
              if (stl <= lt) { \
_Pragma("unroll")                   for (int ks = 0; ks < 4; ++ks) gacc = MFMA16T(cmf[ks], lds_frag(ts + SS_BM, LD128, 16 * stl, 32 * ks, lane), gacc); } \
              const int s0 = 16 * stl + 4 * (lane >> 4); \
              const f32x4 acs = *(const LAS f32x4*)(sm_ac + s0), dts = *(const LAS f32x4*)(sm_dt + s0); \
              float v[4]; \
_Pragma("unroll")               for (int r = 0; r < 4; ++r) { v[r] = gacc[r] * __expf(fminf(acl - acs[r], 0.f)) * dts[r]; v[r] = (l >= s0 + r) ? v[r] : 0.f; } \
              u32x2 pk; pk.x = pk2(v[0], v[1]); pk.y = pk2(v[2], v[3]); \
              *(LAS u32x2*)(lds + SS_WM + l * LD64 + s0 * 2) = pk; } } \
        SSD_TS(3); __syncthreads(); SSD_TS(4); \
        { \
        { const int l = 16 * lt + (lane & 15); const float eal = __expf(sm_ac[l]); \
          bf16x8 wmf[2]; \
_Pragma("unroll")           for (int ks = 0; ks < 2; ++ks) wmf[ks] = lds_frag(lds + SS_WM, LD64, 16 * lt, 32 * ks, lane); \
          float ssq = 0.f; \
_Pragma("unroll")           for (int pi = 0; pi < 2; ++pi) { const int ptl = 2 * nh + pi; const int p0 = 16 * ptl + 4 * (lane >> 4); \
              f32x4 y = {0.f, 0.f, 0.f, 0.f}; \
_Pragma("unroll")               for (int ks = 0; ks < 4; ++ks) y = MFMA16T(cmf[ks], lds_frag(lds + SS_SB, LD128, 16 * ptl, 32 * ks, lane), y); \
              y = y * eal; \
_Pragma("unroll")               for (int ks = 0; ks < 2; ++ks) y = MFMA16T(wmf[ks], lds_frag_tr(ts + SS_X, LD64, 32 * ks, 16 * ptl, lane), y); \
              const u32x2 xraw = *(const LAS u32x2*)(ts + SS_X + l * LD64 + p0 * 2); \
              const float xv[4] = {__uint_as_float(xraw.x << 16), __uint_as_float(xraw.x & 0xffff0000u), __uint_as_float(xraw.y << 16), __uint_as_float(xraw.y & 0xffff0000u)}; \
              const float zv[4] = {__uint_as_float(PZ_[pi].x << 16), __uint_as_float(PZ_[pi].x & 0xffff0000u), __uint_as_float(PZ_[pi].y << 16), __uint_as_float(PZ_[pi].y & 0xffff0000u)}; \
              float gv[4]; \
_Pragma("unroll")               for (int r = 0; r < 4; ++r) { gv[r] = (y[r] + d_h * xv[r]) * siluf(zv[r]); ssq += gv[r] * gv[r]; } \
              u32x2 pk; pk.x = pk2(gv[0], gv[1]); pk.y = pk2(gv[2], gv[3]); \
              *(u32x2*)(MIX + (size_t)(row0 + l) * 2048 + h * 64 + p0) = pk; } \
          ssq = xor32_sum(xor16_sum(ssq)); \
          if (lane < 16 && do_sumsq) unsafeAtomicAdd(SUMSQ + row0 + l, ssq); } \
        } \
        { const float cd = __expf(ac_last); \
          bf16x8 xa[2]; \
_Pragma("unroll")           for (int ks = 0; ks < 2; ++ks) xa[ks] = lds_frag_tr(ts + SS_XD, LD64, 32 * ks, 16 * pt, lane); \
_Pragma("unroll")           for (int q = 0; q < 4; ++q) { f32x4 s = st[q] * cd; \
_Pragma("unroll")               for (int ks = 0; ks < 2; ++ks) s = MFMA16T(xa[ks], lds_frag_tr(ts + SS_BM, LD128, 32 * ks, 16 * (4 * nh + q), lane), s); \
              st[q] = s; } } \
        asm volatile("" : "+v"(PDTN_), "+v"(PZN_[0]), "+v"(PZN_[1]), "+v"(PXN_[0]), "+v"(PXN_[1]), "+v"(PXN_[2]), "+v"(PXN_[3]), "+v"(pbs[0]), "+v"(pbs[1]), "+v"(pcs[0]), "+v"(pcs[1])); \
        SSD_TS(5); \
    } while (0)
    SSD_ISSUE_X(0, px0); SSD_ISSUE_BC(0); SSD_ISSUE_ZDT(0, pz0, pdt0);
    __syncthreads();
    if (nchunks > 1) { SSD_ISSUE_X(1, px1); }
    asm volatile("" : "+v"(pdt0), "+v"(pz0[0]), "+v"(pz0[1]), "+v"(px0[0]), "+v"(px0[1]), "+v"(px0[2]), "+v"(px0[3]), "+v"(pbs[0]), "+v"(pbs[1]), "+v"(pcs[0]), "+v"(pcs[1]));
#pragma unroll 1
    for (int c2 = 0; c2 < nchunks; c2 += 2) {
        { const int c = c2; SSD_STEP(c, px0, pz0, pdt0, pz1, pdt1, px1); }
        if (c2 + 1 < nchunks) { const int c = c2 + 1; SSD_STEP(c, px1, pz1, pdt1, pz0, pdt0, px0); }
    }
#undef SSD_STEP
#undef SSD_ISSUE_X
#undef SSD_ISSUE_BC
#undef SSD_ISSUE_ZDT
#if TIMESEG
    if (F.bid == 0 && sq == 0 && tid == 64 * TIMEWAVE) F.out[O_CONVP] = (float)((((tacc_ / 64) + TIMEQ / 2 + TIMEOFF) / TIMEQ) * TIMEQ);
#endif
    { float* so = F.out + (smp ? O_SSMS + ((size_t)(sb * 16 + h) * 64) * 128 : O_SSMP + ((size_t)(sq * 16 + h) * 64) * 128);
#pragma unroll
      for (int q = 0; q < 4; ++q) *(f32x4*)(so + (16 * pt + (lane & 15)) * 128 + 16 * (4 * nh + q) + 4 * (lane >> 4)) = st[q]; }
    __syncthreads();
}
DI void p2a_phase(Ctx& F) {
    convbc_prepass(F);
    {
        const bf16_t* PROJ = (const bf16_t*)(F.ws + WS_PROJ);
        for (int i = F.bid * 512 + F.tid; i < 48 * 3 * 1536; i += F.G * 512) {
            const int ch = i % 1536, j = (i / 1536) % 3, sq = i / (3 * 1536);
            if (sq < NB_P) F.out[O_CONVP + (size_t)(sq * 3 + j) * 1536 + ch] = bf2f(PROJ[(size_t)(sq * T_P + T_P - 3 + j) * NPROJ + C_XBC + ch]);
            else F.out[O_CONVS + (size_t)((sq - NB_P) * 3 + j) * 1536 + ch] = bf2f(PROJ[(size_t)(MP + (sq - NB_P) * 64 + 61 + j) * NPROJ + C_XBC + ch]);
        }
    }
}
constexpr int WR_SLOT = 19456, WR_V = 9216, LDKW = 144, LDVW = 160;

constexpr int WR_ROPE = 4 * WR_SLOT + 512, WR_ROPE_LD = 272, WR_ROPE_BUF = 64 * 272;
constexpr int WR_GK = 4 * WR_SLOT, WR_GQ = 4 * WR_SLOT + 256;
struct KPre { f32x4 r[4]; };
DI void wa_kpre_load(Ctx& F, int pos, KPre& P) {
    const int q4 = F.tid & 3;
    const f32x4* rp = (const f32x4*)((const f32x2*)(F.ws + WS_ROPE) + pos * 32 + 8 * q4);
#pragma unroll
    for (int j = 0; j < 4; ++j) P.r[j] = rp[j];
}
DI void wa_write_k_pre(Ctx& F, LAS unsigned char* slot, int kvh, const u32x4 ra, const u32x4 rb, const KPre& P, float* ko, LAS unsigned char* ropew) {
    const int i = F.tid >> 2, q4 = F.tid & 3;
#pragma unroll
    for (int j = 0; j < 4; ++j) *(LAS f32x4*)(ropew + i * WR_ROPE_LD + q4 * 64 + 16 * j) = P.r[j];
    float a[8], bb[8], o1[8], o2[8];
    unpack8(ra, a); unpack8(rb, bb);
    float s = 0.f;
#pragma unroll
    for (int e = 0; e < 8; ++e) s += a[e] * a[e] + bb[e] * bb[e];
    s += __shfl_xor(s, 1); s += __shfl_xor(s, 2);
    const float rstd = __builtin_amdgcn_rsqf(s * (1.0f / 64.0f) + EPSF);
    f32x4 g_[4];
    { const LAS f32x4* gl = (const LAS f32x4*)(F.lds + WR_GK); g_[0] = gl[2 * q4]; g_[1] = gl[2 * q4 + 1]; g_[2] = gl[8 + 2 * q4]; g_[3] = gl[8 + 2 * q4 + 1]; }
#pragma unroll
    for (int e = 0; e < 8; ++e) { const float an = a[e] * rstd * g_[e >> 2][e & 3], bn = bb[e] * rstd * g_[2 + (e >> 2)][e & 3];
        const float cx = P.r[e >> 1][2 * (e & 1)], cy = P.r[e >> 1][2 * (e & 1) + 1]; o1[e] = an * cx - bn * cy; o2[e] = bn * cx + an * cy; }
    *(LAS u32x4*)(slot + i * LDKW + (8 * q4) * 2) = pack8(o1);
    *(LAS u32x4*)(slot + i * LDKW + (32 + 8 * q4) * 2) = pack8(o2);
    if (ko) { float* p = ko + ((size_t)i * 2 + kvh) * 64;
        *(f32x4*)(p + 8 * q4) = (f32x4){o1[0], o1[1], o1[2], o1[3]}; *(f32x4*)(p + 8 * q4 + 4) = (f32x4){o1[4], o1[5], o1[6], o1[7]};
        *(f32x4*)(p + 32 + 8 * q4) = (f32x4){o2[0], o2[1], o2[2], o2[3]}; *(f32x4*)(p + 32 + 8 * q4 + 4) = (f32x4){o2[4], o2[5], o2[6], o2[7]}; }
}
DI void wa_write_k(Ctx& F, LAS unsigned char* slot, int kvh, const u32x4 ra, const u32x4 rb, int pos, float* ko) {
    const int i = F.tid >> 2, q4 = F.tid & 3;
    float a[8], bb[8], o1[8], o2[8];
    unpack8(ra, a); unpack8(rb, bb);
    float s = 0.f;
#pragma unroll
    for (int e = 0; e < 8; ++e) s += a[e] * a[e] + bb[e] * bb[e];
    s += __shfl_xor(s, 1); s += __shfl_xor(s, 2);
    const float rstd = __builtin_amdgcn_rsqf(s * (1.0f / 64.0f) + EPSF);
    const f32x2* ROPE = (const f32x2*)(F.ws + WS_ROPE);
    float gk1[8], gk2[8]; f32x2 rcs[8];
    { const f32x4 a0 = *(const f32x4*)(F.in[I_GK] + 8 * q4), a1 = *(const f32x4*)(F.in[I_GK] + 8 * q4 + 4), b0 = *(const f32x4*)(F.in[I_GK] + 32 + 8 * q4), b1 = *(const f32x4*)(F.in[I_GK] + 32 + 8 * q4 + 4);
#pragma unroll
      for (int e = 0; e < 4; ++e) { gk1[e] = a0[e]; gk1[4 + e] = a1[e]; gk2[e] = b0[e]; gk2[4 + e] = b1[e]; }
      const f32x4* rp = (const f32x4*)(ROPE + pos * 32 + 8 * q4);
#pragma unroll
      for (int i = 0; i < 4; ++i) { const f32x4 t4 = rp[i]; rcs[2 * i] = (f32x2){t4.x, t4.y}; rcs[2 * i + 1] = (f32x2){t4.z, t4.w}; } }
#pragma unroll
    for (int e = 0; e < 8; ++e) { const float an = a[e] * rstd * gk1[e], bn = bb[e] * rstd * gk2[e];
        const f32x2 cs = rcs[e]; o1[e] = an * cs.x - bn * cs.y; o2[e] = bn * cs.x + an * cs.y; }
    *(LAS u32x4*)(slot + i * LDKW + (8 * q4) * 2) = pack8(o1);
    *(LAS u32x4*)(slot + i * LDKW + (32 + 8 * q4) * 2) = pack8(o2);
    if (ko) { float* p = ko + ((size_t)i * 2 + kvh) * 64;
        *(f32x4*)(p + 8 * q4) = (f32x4){o1[0], o1[1], o1[2], o1[3]}; *(f32x4*)(p + 8 * q4 + 4) = (f32x4){o1[4], o1[5], o1[6], o1[7]};
        *(f32x4*)(p + 32 + 8 * q4) = (f32x4){o2[0], o2[1], o2[2], o2[3]}; *(f32x4*)(p + 32 + 8 * q4 + 4) = (f32x4){o2[4], o2[5], o2[6], o2[7]}; }
}
DI void wa_write_v(Ctx& F, LAS unsigned char* slot, int kvh, const u32x4 rv, float* vo) {
    const int i = F.tid >> 3, q8 = F.tid & 7;
    *(LAS u32x4*)(slot + WR_V + i * LDVW + q8 * 16) = rv;
    if (vo) { float v[8]; unpack8(rv, v); float* p = vo + ((size_t)i * 2 + kvh) * 64 + 8 * q8;
        *(f32x4*)p = (f32x4){v[0], v[1], v[2], v[3]}; *(f32x4*)(p + 4) = (f32x4){v[4], v[5], v[6], v[7]}; }
}
DI void wa_stage_cache(Ctx& F, LAS unsigned char* slot, int kvh, const float* ck, const float* cv, float* ko, float* vo) {
    if (F.tid < 256) { const int i = F.tid >> 2, q4 = F.tid & 3; const float* src = ck + ((size_t)i * 2 + kvh) * 64;
        const f32x4 a0 = *(const f32x4*)(src + 8 * q4), a1 = *(const f32x4*)(src + 8 * q4 + 4), b0 = *(const f32x4*)(src + 32 + 8 * q4), b1 = *(const f32x4*)(src + 32 + 8 * q4 + 4);
        u32x4 pa, pb; pa.x = pk2(a0.x, a0.y); pa.y = pk2(a0.z, a0.w); pa.z = pk2(a1.x, a1.y); pa.w = pk2(a1.z, a1.w); pb.x = pk2(b0.x, b0.y); pb.y = pk2(b0.z, b0.w); pb.z = pk2(b1.x, b1.y); pb.w = pk2(b1.z, b1.w);
        *(LAS u32x4*)(slot + i * LDKW + (8 * q4) * 2) = pa; *(LAS u32x4*)(slot + i * LDKW + (32 + 8 * q4) * 2) = pb;
        if (ko) { float* p = ko + ((size_t)i * 2 + kvh) * 64; *(f32x4*)(p + 8 * q4) = a0; *(f32x4*)(p + 8 * q4 + 4) = a1; *(f32x4*)(p + 32 + 8 * q4) = b0; *(f32x4*)(p + 32 + 8 * q4 + 4) = b1; } }
    { const int i = F.tid >> 3, q8 = F.tid & 7; const float* src = cv + ((size_t)i * 2 + kvh) * 64 + 8 * q8; const f32x4 v0 = *(const f32x4*)src, v1 = *(const f32x4*)(src + 4);
      u32x4 pv; pv.x = pk2(v0.x, v0.y); pv.y = pk2(v0.z, v0.w); pv.z = pk2(v1.x, v1.y); pv.w = pk2(v1.z, v1.w);
      *(LAS u32x4*)(slot + WR_V + i * LDVW + q8 * 16) = pv;
      if (vo) { float* p = vo + ((size_t)i * 2 + kvh) * 64 + 8 * q8; *(f32x4*)p = v0; *(f32x4*)(p + 4) = v1; } }
}
DI void wa_load_q(Ctx& F, int kvh, size_t crow0, u32x4 (&qraw)[2][2]) {
    const int lane = F.lane, w = F.wave, g4 = lane >> 4; const int hq = kvh * 4 + (w >> 1);
    const bf16_t* PROJ = (const bf16_t*)(F.ws + WS_PROJ);
#pragma unroll
    for (int rg = 0; rg < 2; ++rg) { const size_t row = crow0 + 32 * (w & 1) + 16 * rg + (lane & 15);
        qraw[rg][0] = *(const u32x4*)(PROJ + row * NPROJ + C_Q + hq * 64 + 8 * g4); qraw[rg][1] = *(const u32x4*)(PROJ + row * NPROJ + C_Q + hq * 64 + 32 + 8 * g4); }
}
DI void wa_compute(Ctx& F, int kvh, size_t crow0, int pos0, int sl0, int sl1, int sl2, int ninv, const u32x4 (&qraw)[2][2], KPre& KP, int kpos, int ropesel) {
    LAS unsigned char* lds = F.lds;
    const int lane = F.lane, w = F.wave, g4 = lane >> 4;
    const bf16_t* PROJ = (const bf16_t*)(F.ws + WS_PROJ); const f32x2* ROPE = (const f32x2*)(F.ws + WS_ROPE); bf16_t* MIX = (bf16_t*)(F.ws + WS_MIX);
    const int hq = kvh * 4 + (w >> 1); const float sink = F.in[I_SINKS][hq] * 1.4426950408889634f;
    bf16x8 qa[2][2];
    float gq1[8], gq2[8];
    { f32x4 a0, a1, b0, b1;
      if (ropesel >= 0) { const LAS f32x4* gl = (const LAS f32x4*)(lds + WR_GQ); a0 = gl[2 * g4]; a1 = gl[2 * g4 + 1]; b0 = gl[8 + 2 * g4]; b1 = gl[8 + 2 * g4 + 1]; }
      else { a0 = *(const f32x4*)(F.in[I_GQ] + 8 * g4); a1 = *(const f32x4*)(F.in[I_GQ] + 8 * g4 + 4); b0 = *(const f32x4*)(F.in[I_GQ] + 32 + 8 * g4); b1 = *(const f32x4*)(F.in[I_GQ] + 32 + 8 * g4 + 4); }
#pragma unroll
      for (int e = 0; e < 4; ++e) { gq1[e] = a0[e]; gq1[4 + e] = a1[e]; gq2[e] = b0[e]; gq2[4 + e] = b1[e]; } }
#pragma unroll
    for (int rg = 0; rg < 2; ++rg) {
        const int d0 = 8 * g4; float a[8], bb[8];
        unpack8(qraw[rg][0], a);
        unpack8(qraw[rg][1], bb);
        float s = 0.f;
#pragma unroll
        for (int e = 0; e < 8; ++e) s += a[e] * a[e] + bb[e] * bb[e];
        s = xor32_sum(xor16_sum(s));
        const float rstd = 0.18033688011112042f * __builtin_amdgcn_rsqf(s * (1.0f / 64.0f) + EPSF);
        const int pos = pos0 + 32 * (w & 1) + 16 * rg + (lane & 15);
        f32x2 rcs[8];
        if (ropesel >= 0) { const LAS f32x4* rp = (const LAS f32x4*)(lds + WR_ROPE + ropesel * WR_ROPE_BUF + (32 * (w & 1) + 16 * rg + (lane & 15)) * WR_ROPE_LD + g4 * 64);
#pragma unroll
          for (int i = 0; i < 4; ++i) { const f32x4 t4 = rp[i]; rcs[2 * i] = (f32x2){t4.x, t4.y}; rcs[2 * i + 1] = (f32x2){t4.z, t4.w}; } }
        else { const f32x4* rp = (const f32x4*)(ROPE + pos * 32 + d0);
#pragma unroll
          for (int i = 0; i < 4; ++i) { const f32x4 t4 = rp[i]; rcs[2 * i] = (f32x2){t4.x, t4.y}; rcs[2 * i + 1] = (f32x2){t4.z, t4.w}; } }
        float o1[8], o2[8];
#pragma unroll
        for (int e = 0; e < 8; ++e) { const float an = a[e] * rstd * gq1[e], bn = bb[e] * rstd * gq2[e];
            const f32x2 cs = rcs[e]; o1[e] = an * cs.x - bn * cs.y; o2[e] = bn * cs.x + an * cs.y; }
        qa[rg][0] = __builtin_bit_cast(bf16x8, pack8(o1)); qa[rg][1] = __builtin_bit_cast(bf16x8, pack8(o2)); }
    f32x4 s[2][12];
#pragma unroll
    for (int jt = 0; jt < 12; ++jt) { const int j = jt >> 2; const LAS unsigned char* kt = lds + (j == 0 ? sl0 : (j == 1 ? sl1 : sl2)) * WR_SLOT;
        const bf16x8 k0 = lds_frag(kt, LDKW, 16 * (jt & 3), 0, lane), k1 = lds_frag(kt, LDKW, 16 * (jt & 3), 32, lane);
#pragma unroll
        for (int rg = 0; rg < 2; ++rg) { f32x4 acc = {0.f, 0.f, 0.f, 0.f};
            acc = MFMA16T(qa[rg][0], k0, acc); acc = MFMA16T(qa[rg][1], k1, acc);
            s[rg][jt] = acc; }
        if ((jt & 3) == 3) __builtin_amdgcn_sched_barrier(0); }
    u32x2 graw[2][4];
#pragma unroll
    for (int rg = 0; rg < 2; ++rg) { const size_t row = crow0 + 32 * (w & 1) + 16 * rg + (lane & 15);
#pragma unroll
        for (int dt = 0; dt < 4; ++dt) graw[rg][dt] = *(const u32x2*)(PROJ + row * NPROJ + C_GA + hq * 64 + 16 * dt + 4 * g4); }
    if (ninv > 0) {
#pragma unroll
        for (int jt = 0; jt < 8; ++jt) if ((jt >> 2) < ninv) { s[0][jt] = (f32x4){-1e30f, -1e30f, -1e30f, -1e30f}; s[1][jt] = (f32x4){-1e30f, -1e30f, -1e30f, -1e30f}; } }
    float inv[2]; bf16x8 pa[2][6];
#pragma unroll
    for (int rg = 0; rg < 2; ++rg) {
        float m = sink;
#pragma unroll
        for (int jt = 0; jt < 12; ++jt)
#pragma unroll
            for (int r = 0; r < 4; ++r) m = fmaxf(m, s[rg][jt][r]);
        m = xor32_max(xor16_max(m));
        float sum = 0.f;
#pragma unroll
        for (int jt = 0; jt < 12; ++jt)
#pragma unroll
            for (int r = 0; r < 4; ++r) { const float e = __builtin_amdgcn_exp2f(s[rg][jt][r] - m); s[rg][jt][r] = e; sum += e; }
        sum = xor32_sum(xor16_sum(sum));
        inv[rg] = __builtin_amdgcn_rcpf(sum + __builtin_amdgcn_exp2f(sink - m));
#pragma unroll
        for (int k2 = 0; k2 < 6; ++k2) { u32x4 t; t.x = pk2(s[rg][2 * k2][0], s[rg][2 * k2][1]); t.y = pk2(s[rg][2 * k2][2], s[rg][2 * k2][3]);
            t.z = pk2(s[rg][2 * k2 + 1][0], s[rg][2 * k2 + 1][1]); t.w = pk2(s[rg][2 * k2 + 1][2], s[rg][2 * k2 + 1][3]);
            pa[rg][k2] = __builtin_bit_cast(bf16x8, t); } }
    __builtin_amdgcn_sched_barrier(0);
    if (kpos >= 0 && F.tid < 256) wa_kpre_load(F, kpos, KP);
#pragma unroll
    for (int dt = 0; dt < 4; ++dt) { f32x4 o[2] = {{0.f, 0.f, 0.f, 0.f}, {0.f, 0.f, 0.f, 0.f}};
#pragma unroll
        for (int k2 = 0; k2 < 6; ++k2) { const int j = k2 >> 1; const LAS unsigned char* vt = lds + (j == 0 ? sl0 : (j == 1 ? sl1 : sl2)) * WR_SLOT + WR_V;
            const bf16x8 vf = lds_frag_tr2(vt, LDVW, 32 * (k2 & 1), 16 * dt, lane);
            o[0] = MFMA16T(pa[0][k2], vf, o[0]); o[1] = MFMA16T(pa[1][k2], vf, o[1]); }
#pragma unroll
        for (int rg = 0; rg < 2; ++rg) { const size_t row = crow0 + 32 * (w & 1) + 16 * rg + (lane & 15);
            const float gv[4] = {__uint_as_float(graw[rg][dt].x << 16), __uint_as_float(graw[rg][dt].x & 0xffff0000u), __uint_as_float(graw[rg][dt].y << 16), __uint_as_float(graw[rg][dt].y & 0xffff0000u)};
            u32x2 pk; pk.x = pk2(o[rg][0] * inv[rg] * siluf(gv[0]), o[rg][1] * inv[rg] * siluf(gv[1])); pk.y = pk2(o[rg][2] * inv[rg] * siluf(gv[2]), o[rg][3] * inv[rg] * siluf(gv[3]));
            *(u32x2*)(MIX + row * 2048 + 1024 + hq * 64 + 16 * dt + 4 * g4) = pk; }
        __builtin_amdgcn_sched_barrier(0); }
}
DI void winattn_item(Ctx& F, int item) {
    LAS unsigned char* lds = F.lds;
    int tl_ = F.tid; asm volatile("" : "+v"(tl_)); const int tid = tl_;
    const bf16_t* PROJ = (const bf16_t*)(F.ws + WS_PROJ);
    if (item >= 256) {
        const int sb = (item - 256) >> 1, kvh = item & 1; const size_t row0 = (size_t)MP + sb * 64;
        const float* ck = F.in[I_CWK] + (size_t)sb * 128 * 128; const float* cv = F.in[I_CWV] + (size_t)sb * 128 * 128;
        float* ko = F.out + O_WKS + (size_t)sb * 128 * 128; float* vo = F.out + O_WVS + (size_t)sb * 128 * 128;
        wa_stage_cache(F, lds + 0 * WR_SLOT, kvh, ck, cv, nullptr, nullptr);
        wa_stage_cache(F, lds + 1 * WR_SLOT, kvh, ck + 64 * 128, cv + 64 * 128, ko, vo);
        if (tid < 256) { const int i = tid >> 2, q4 = tid & 3; const bf16_t* p = PROJ + (row0 + i) * NPROJ + C_K + kvh * 64 + 8 * q4;
            wa_write_k(F, lds + 2 * WR_SLOT, kvh, *(const u32x4*)p, *(const u32x4*)(p + 32), 2048 + i, ko + 64 * 128); }
        { const int i = tid >> 3, q8 = tid & 7; wa_write_v(F, lds + 2 * WR_SLOT, kvh, *(const u32x4*)(PROJ + (row0 + i) * NPROJ + C_V + kvh * 64 + 8 * q8), vo + 64 * 128); }
        u32x4 sq_[2][2]; wa_load_q(F, kvh, row0, sq_);
        __syncthreads();
        { KPre kp_; wa_compute(F, kvh, row0, 2048, 0, 1, 2, 0, sq_, kp_, -1, -1); }
        __syncthreads();
        return;
    }
    const int b = item >> 4, kvh = (item >> 3) & 1, c0 = (item & 7) * 8;
    const size_t seq0 = (size_t)b * T_P;
    { u32x4 pka[3], pkb[3], pvv[3];
#pragma unroll
      for (int j = 0; j < 3; ++j) { const int kc = c0 - 2 + j; const size_t row0 = seq0 + (size_t)(kc < 0 ? 0 : kc) * 64;
          const bf16_t* p = PROJ + (row0 + (tid >> 2)) * NPROJ + C_K + kvh * 64 + 8 * (tid & 3);
          pka[j] = *(const u32x4*)p; pkb[j] = *(const u32x4*)(p + 32);
          pvv[j] = *(const u32x4*)(PROJ + (row0 + (tid >> 3)) * NPROJ + C_V + kvh * 64 + 8 * (tid & 7)); }
#pragma unroll
      for (int j = 0; j < 3; ++j) { const int kc = c0 - 2 + j; LAS unsigned char* slot = lds + (kc & 3) * WR_SLOT;
          if (kc < 0) { for (int t = tid; t < WR_SLOT / 16; t += 512) *(LAS u32x4*)(slot + t * 16) = (u32x4){0u, 0u, 0u, 0u}; }
          else { if (tid < 256) wa_write_k(F, slot, kvh, pka[j], pkb[j], kc * 64 + (tid >> 2), nullptr);
                 wa_write_v(F, slot, kvh, pvv[j], nullptr); } } }
    u32x4 nq[2][2];
    wa_load_q(F, kvh, seq0 + (size_t)c0 * 64, nq);
    { int t_ = tid; asm volatile("" : "+v"(t_));
      if (t_ < 128) ((LAS float*)(lds + WR_GK))[t_] = (t_ < 64 ? F.in[I_GK] : F.in[I_GQ] - 64)[t_];
      if (t_ < 256) { const f32x4* rp = (const f32x4*)((const f32x2*)(F.ws + WS_ROPE) + (c0 * 64 + (t_ >> 2)) * 32 + 8 * (t_ & 3));
#pragma unroll
          for (int j = 0; j < 4; ++j) *(LAS f32x4*)(lds + WR_ROPE + (c0 & 1) * WR_ROPE_BUF + (t_ >> 2) * WR_ROPE_LD + (t_ & 3) * 64 + 16 * j) = rp[j]; } }
    __syncthreads();
#pragma unroll 1
    for (int c = c0; c < c0 + 8; ++c) {
        const bool more = c + 1 < c0 + 8;
        u32x4 cq[2][2]; KPre kp;
#pragma unroll
        for (int rg = 0; rg < 2; ++rg) { cq[rg][0] = nq[rg][0]; cq[rg][1] = nq[rg][1]; }
        u32x4 ra = {0u, 0u, 0u, 0u}, rb = {0u, 0u, 0u, 0u}, rv = {0u, 0u, 0u, 0u};
        const size_t nrow0 = seq0 + (size_t)(c + 1) * 64;
        if (more) {
            if (tid < 256) { const bf16_t* p = PROJ + (nrow0 + (tid >> 2)) * NPROJ + C_K + kvh * 64 + 8 * (tid & 3); ra = *(const u32x4*)p; rb = *(const u32x4*)(p + 32); }
            rv = *(const u32x4*)(PROJ + (nrow0 + (tid >> 3)) * NPROJ + C_V + kvh * 64 + 8 * (tid & 7));
            wa_load_q(F, kvh, nrow0, nq); }
        wa_compute(F, kvh, seq0 + (size_t)c * 64, c * 64, (c - 2) & 3, (c - 1) & 3, c & 3, c >= 2 ? 0 : 2 - c, cq, kp, more ? (c + 1) * 64 + (tid >> 2) : -1, c & 1);
        if (more) { LAS unsigned char* slot = lds + ((c + 1) & 3) * WR_SLOT; const int kc = c + 1;
            float* ko = nullptr; float* vo = nullptr;
            if (kc >= 62) { ko = F.out + O_WKP + ((size_t)b * 128 + (kc - 62) * 64) * 128; vo = F.out + O_WVP + ((size_t)b * 128 + (kc - 62) * 64) * 128; }
            if (tid < 256) wa_write_k_pre(F, slot, kvh, ra, rb, kp, ko, lds + WR_ROPE + (kc & 1) * WR_ROPE_BUF);
            wa_write_v(F, slot, kvh, rv, vo); }
        __syncthreads();
    }
}

constexpr int MA_K = 0, MA_V = 69632, MA_RS = 143360, LDKM = 272, LDVM = 288;
DI void memattn_item(Ctx& F, int item) {
    LAS unsigned char* lds = F.lds;
#if CLKPROBE == 40 || CLKPROBE == 41
    const long long mt0_ = (long long)__builtin_amdgcn_s_memrealtime(); long long mt1_ = 0;
#endif
    int tl_ = F.tid; asm volatile("" : "+v"(tl_)); const int tid = tl_, lane = tl_ & 63, w = F.wave, g4 = lane >> 4;
    const bool smp = item >= 256; const int sidx = item - 256;
    const int bb = smp ? (sidx >> 2) : (item >> 4), h = smp ? (sidx & 3) : ((item >> 2) & 3), qt = item & 3;
    const bf16_t* PROJ = (const bf16_t*)(F.ws + WS_PROJ); bf16_t* MIX = (bf16_t*)(F.ws + WS_MIX); const bf16_t* RAW = (const bf16_t*)(F.ws + WS_MEMRAW);
    float gmk8[8], gmq8[8];
    { const f32x4 a0 = *(const f32x4*)(F.in[I_GMK] + 8 * (tid & 15)), a1 = *(const f32x4*)(F.in[I_GMK] + 8 * (tid & 15) + 4), q0 = *(const f32x4*)(F.in[I_GMQ] + 8 * (tid & 15)), q1 = *(const f32x4*)(F.in[I_GMQ] + 8 * (tid & 15) + 4);
#pragma unroll
      for (int e = 0; e < 4; ++e) { gmk8[e] = a0[e]; gmk8[4 + e] = a1[e]; gmq8[e] = q0[e]; gmq8[4 + e] = q1[e]; } }
    u32x4 rk2[2][4], rv2[2][4];
    if (!smp) {
#pragma unroll
      for (int ib = 0; ib < 2; ++ib)
#pragma unroll
        for (int u = 0; u < 4; ++u) { const int t = tid + 512 * (4 * ib + u), key = t >> 4, ch = t & 15;
          rk2[ib][u] = *(const u32x4*)(RAW + (size_t)(bb * 256 + key) * 1024 + h * 128 + 8 * ch); rv2[ib][u] = *(const u32x4*)(RAW + (size_t)(bb * 256 + key) * 1024 + 512 + h * 128 + 8 * ch); } }
#pragma unroll
    for (int ib = 0; ib < 2; ++ib) {
      f32x4 fk[4][2], fv[4][2];
      if (smp) {
#pragma unroll
        for (int u = 0; u < 4; ++u) { const int t = tid + 512 * (4 * ib + u), key = t >> 4, ch = t & 15;
          const float* ks = F.in[I_CMK] + ((size_t)(bb * 256 + key) * 4 + h) * 128 + 8 * ch; const float* vs = F.in[I_CMV] + ((size_t)(bb * 256 + key) * 4 + h) * 128 + 8 * ch;
          fk[u][0] = *(const f32x4*)ks; fk[u][1] = *(const f32x4*)(ks + 4); fv[u][0] = *(const f32x4*)vs; fv[u][1] = *(const f32x4*)(vs + 4); } }
#pragma unroll
      for (int u = 0; u < 4; ++u) { const int t = tid + 512 * (4 * ib + u), key = t >> 4, ch = t & 15;
        float k[8], v[8];
        if (smp) {
#pragma unroll
            for (int e = 0; e < 4; ++e) { k[e] = fk[u][0][e]; k[4 + e] = fk[u][1][e]; v[e] = fv[u][0][e]; v[4 + e] = fv[u][1][e]; } }
        else { unpack8(rk2[ib][u], k); unpack8(rv2[ib][u], v); }
        float s = 0.f;
#pragma unroll
        for (int e = 0; e < 8; ++e) s += k[e] * k[e];
        s = row16_sum(s);
        if (!smp) { const float rstd = __builtin_amdgcn_rsqf(s * (1.0f / 128.0f) + EPSF);
#pragma unroll
            for (int e = 0; e < 8; ++e) k[e] = k[e] * rstd * gmk8[e]; }
        { float kq[8];
#pragma unroll
          for (int e = 0; e < 8; ++e) kq[e] = k[e] * gmq8[e];
          *(LAS u32x4*)(lds + MA_K + key * LDKM + ch * 16) = pack8(kq); }
        *(LAS u32x4*)(lds + MA_V + key * LDVM + ch * 16) = smp ? pack8(v) : rv2[ib][u];
        if (!smp && qt == 0) {
            float* ko = F.out + O_MKP + ((size_t)(bb * 256 + key) * 4 + h) * 128 + 8 * ch; float* vo = F.out + O_MVP + ((size_t)(bb * 256 + key) * 4 + h) * 128 + 8 * ch;
            *(f32x4*)ko = (f32x4){k[0], k[1], k[2], k[3]}; *(f32x4*)(ko + 4) = (f32x4){k[4], k[5], k[6], k[7]};
            *(f32x4*)vo = (f32x4){v[0], v[1], v[2], v[3]}; *(f32x4*)(vo + 4) = (f32x4){v[4], v[5], v[6], v[7]}; }
      }
    }
    __syncthreads();
#if CLKPROBE == 40 || CLKPROBE == 41
    mt1_ = (long long)__builtin_amdgcn_s_memrealtime();
#endif
    const int ngr = smp ? 4 : 64;
    const size_t qbase = smp ? (size_t)MP + bb * 64 : (size_t)bb * T_P + qt * 1024;
    u32x4 nq[4]; u32x2 ng[8];
#define MA_LOAD(rg_) do { const size_t r_ = qbase + 16 * (rg_) + (lane & 15); \
        _Pragma("unroll") for (int ks = 0; ks < 4; ++ks) nq[ks] = *(const u32x4*)(PROJ + r_ * NPROJ + C_MQ + h * 128 + 32 * ks + 8 * g4); \
        _Pragma("unroll") for (int dt = 0; dt < 8; ++dt) ng[dt] = *(const u32x2*)(PROJ + r_ * NPROJ + C_GM + h * 128 + 16 * dt + 4 * g4); } while (0)
    if (w < ngr) MA_LOAD(w);
#pragma unroll 1
    for (int rg = w; rg < ngr; rg += 8) {
        u32x4 cq[4]; u32x2 cg[8];
#pragma unroll
        for (int ks = 0; ks < 4; ++ks) cq[ks] = nq[ks];
#pragma unroll
        for (int dt = 0; dt < 8; ++dt) cg[dt] = ng[dt];
        if (rg + 8 < ngr) MA_LOAD(rg + 8);
        bf16x8 qa[4];
        { float q[4][8]; float s = 0.f;
#pragma unroll
          for (int ks = 0; ks < 4; ++ks) { unpack8(cq[ks], q[ks]);
#pragma unroll
              for (int e = 0; e < 8; ++e) s += q[ks][e] * q[ks][e]; }
          s = xor32_sum(xor16_sum(s));
          const float rstd = 0.12751743082459868f * __builtin_amdgcn_rsqf(s * (1.0f / 128.0f) + EPSF);
#pragma unroll
          for (int ks = 0; ks < 4; ++ks) {
#pragma unroll
              for (int e = 0; e < 8; ++e) q[ks][e] = q[ks][e] * rstd;
              qa[ks] = __builtin_bit_cast(bf16x8, pack8(q[ks])); } }
        f32x4 s[16];
#pragma unroll
        for (int jt = 0; jt < 16; ++jt) { f32x4 acc = {0.f, 0.f, 0.f, 0.f};
#pragma unroll
            for (int ks = 0; ks < 4; ++ks) acc = MFMA16T(qa[ks], lds_frag(lds + MA_K, LDKM, 16 * jt, 32 * ks, lane), acc);
            s[jt] = acc;
            if ((jt & 3) == 3) __builtin_amdgcn_sched_barrier(0); }
        float m = s[0][0];
#pragma unroll
        for (int jt = 0; jt < 16; ++jt)
#pragma unroll
            for (int r = 0; r < 4; ++r) m = fmaxf(m, s[jt][r]);
        m = xor32_max(xor16_max(m));
        float sum = 0.f;
#pragma unroll
        for (int jt = 0; jt < 16; ++jt)
#pragma unroll
            for (int r = 0; r < 4; ++r) { const float e = __builtin_amdgcn_exp2f(s[jt][r] - m); s[jt][r] = e; sum += e; }
        sum = xor32_sum(xor16_sum(sum));
        const float inv = __builtin_amdgcn_rcpf(sum);
        bf16x8 pa[8];
#pragma unroll
        for (int k2 = 0; k2 < 8; ++k2) { u32x4 t; t.x = pk2(s[2 * k2][0], s[2 * k2][1]); t.y = pk2(s[2 * k2][2], s[2 * k2][3]); t.z = pk2(s[2 * k2 + 1][0], s[2 * k2 + 1][1]); t.w = pk2(s[2 * k2 + 1][2], s[2 * k2 + 1][3]);
            pa[k2] = __builtin_bit_cast(bf16x8, t); }
        const size_t orow = qbase + 16 * rg + (lane & 15);
#pragma unroll
        for (int dt = 0; dt < 8; ++dt) { f32x4 o = {0.f, 0.f, 0.f, 0.f};
#pragma unroll
            for (int k2 = 0; k2 < 8; ++k2) o = MFMA16T(pa[k2], lds_frag_tr2(lds + MA_V, LDVM, 32 * k2, 16 * dt, lane), o);
            __builtin_amdgcn_sched_barrier(0);
            const int col = h * 128 + 16 * dt + 4 * g4;
            const u32x2 gr = cg[dt];
            const float gv[4] = {__uint_as_float(gr.x << 16), __uint_as_float(gr.x & 0xffff0000u), __uint_as_float(gr.y << 16), __uint_as_float(gr.y & 0xffff0000u)};
            u32x2 pk; pk.x = pk2(o[0] * inv * siluf(gv[0]), o[1] * inv * siluf(gv[1])); pk.y = pk2(o[2] * inv * siluf(gv[2]), o[3] * inv * siluf(gv[3]));
            *(u32x2*)(MIX + orow * 2048 + 1536 + col) = pk; }
    }
#undef MA_LOAD
    __syncthreads();
#if CLKPROBE == 40 || CLKPROBE == 41
    if (threadIdx.x == 0 && item < 256) g_dbg[blockIdx.x] += (CLKPROBE == 40) ? (mt1_ - mt0_) : ((long long)__builtin_amdgcn_s_memrealtime() - mt1_);
#endif
}

DI void p2a_attn(Ctx& F) {
    for (int rep = 0; rep < REP_WIN; ++rep)
    for (int it = F.bid; it < 320; it += F.G) {
#if CLKPROBE == 42 || CLKPROBE == 43
        const long long t0_ = (long long)__builtin_amdgcn_s_memrealtime();
#endif
        winattn_item(F, it);
#if CLKPROBE == 42 || CLKPROBE == 43
        if (threadIdx.x == 0 && ((CLKPROBE == 42) == (it < 256))) g_dbg[blockIdx.x] += (long long)__builtin_amdgcn_s_memrealtime() - t0_;
#endif
    }
    __syncthreads();
    for (int rep = 0; rep < REP_MEM; ++rep)
    { for (int it = F.bid; it < 256; it += F.G) memattn_item(F, it);
      for (int s = (F.bid + F.G - (128 % F.G)) % F.G; s < 128; s += F.G) memattn_item(F, 256 + s); }
}
DI void p2b_phase(Ctx& F) {
    for (int rep = 0; rep < REP_SSD; ++rep)
    for (int it = F.bid; it < 48 * 16; it += F.G) {
#if CLKPROBE == 30 || CLKPROBE == 31
        const long long t0_ = (long long)__builtin_amdgcn_s_memrealtime();
#endif
        ssd_item(F, it >> 4, it & 15, rep == 0);
#if CLKPROBE == 30 || CLKPROBE == 31
        if (threadIdx.x == 0 && ((CLKPROBE == 30) == (it < 256))) g_dbg[blockIdx.x] += (long long)__builtin_amdgcn_s_memrealtime() - t0_;
#endif
    }
}

constexpr int G3_LD = 272, G3_A = 0, G3_B = 64 * 272, G3_SET = 192 * 272;
DI void gemm2_sample(Ctx& F) {
    LAS unsigned char* lds = F.lds;
    const int tid = F.tid, lane = F.lane, w = F.wave, g4 = lane >> 4;
    const bf16_t* MIX = (const bf16_t*)(F.ws + WS_MIX); const bf16_t* WOT = (const bf16_t*)(F.ws + WS_WOUT); const float* SUMSQ = (const float*)(F.ws + WS_SSQ);
    for (int tile = F.bid; tile < 256; tile += F.G) {
        const int r0 = MP + 64 * (tile >> 3), c0 = 128 * (tile & 7);
        const int prow = tid >> 4, pk = tid & 15;
        const bf16_t* asrc = MIX + (size_t)(r0 + prow) * 2048 + 8 * pk;
        const bf16_t* bsrc = WOT + (size_t)(c0 + prow) * 2048 + 8 * pk;
        const int aoff = G3_A + prow * G3_LD + pk * 16, boff = G3_B + prow * G3_LD + pk * 16;
        f32x4 acc[4] = {{0.f, 0.f, 0.f, 0.f}, {0.f, 0.f, 0.f, 0.f}, {0.f, 0.f, 0.f, 0.f}, {0.f, 0.f, 0.f, 0.f}};
        u32x4 ra[4][2], rb[4][4];
#define G3_ISSUE(s_, kt_) do { _Pragma("unroll") for (int i_ = 0; i_ < 2; ++i_) ra[s_][i_] = *(const u32x4*)(asrc + (size_t)i_ * 32 * 2048 + 128 * (kt_)); \
            _Pragma("unroll") for (int j_ = 0; j_ < 4; ++j_) rb[s_][j_] = *(const u32x4*)(bsrc + (size_t)j_ * 32 * 2048 + 128 * (kt_)); } while (0)
#define G3_WRITE(set_, s_) do { _Pragma("unroll") for (int i_ = 0; i_ < 2; ++i_) *(LAS u32x4*)((set_) + aoff + i_ * 32 * G3_LD) = ra[s_][i_]; \
            _Pragma("unroll") for (int j_ = 0; j_ < 4; ++j_) *(LAS u32x4*)((set_) + boff + j_ * 32 * G3_LD) = rb[s_][j_]; } while (0)
        G3_ISSUE(0, 0); G3_ISSUE(1, 1); G3_ISSUE(2, 2); G3_ISSUE(3, 3);
        G3_WRITE(lds, 0);
        G3_ISSUE(0, 4);
        __syncthreads();
#pragma unroll 1
        for (int kt4 = 0; kt4 < 16; kt4 += 4) {
#pragma unroll
            for (int u = 0; u < 4; ++u) { const int kt = kt4 + u;
                const LAS unsigned char* cs = lds + (u & 1) * G3_SET; LAS unsigned char* ns = lds + ((u + 1) & 1) * G3_SET;
                if (kt == 8) { const float r = __builtin_amdgcn_rsqf(SUMSQ[r0 + 16 * (w >> 1) + (lane & 15)] * (1.0f / 1024.0f) + EPSF);
#pragma unroll
                    for (int t = 0; t < 4; ++t) acc[t] = acc[t] * r; }
#pragma unroll
                for (int ks = 0; ks < 4; ++ks) { const bf16x8 a = lds_frag(cs + G3_A, G3_LD, 16 * (w >> 1), 32 * ks, lane);
#pragma unroll
                    for (int t = 0; t < 4; ++t) acc[t] = MFMA16T(a, lds_frag(cs + G3_B, G3_LD, 64 * (w & 1) + 16 * t, 32 * ks, lane), acc[t]); }
                const int rs = (u + 1) & 3;
                if (kt + 1 < 16) G3_WRITE(ns, rs);
                if (kt + 5 < 16) G3_ISSUE(rs, kt + 5);
                __syncthreads();
            }
        }
#undef G3_ISSUE
#undef G3_WRITE
        const int row = r0 + 16 * (w >> 1) + (lane & 15), cw = c0 + 64 * (w & 1) + 4 * g4;
        const float* xr = F.in[I_XS] + (size_t)(row - MP) * DM + cw; float* orow = F.out + (size_t)row * DM + cw;
#pragma unroll
        for (int t = 0; t < 4; ++t) *(f32x4*)(orow + 16 * t) = acc[t] + *(const f32x4*)(xr + 16 * t);
    }
}
__global__ void __launch_bounds__(512, 2) hymba_fwd(Args args) {
    extern __shared__ __attribute__((aligned(16))) unsigned char lds_raw[];
    cg::grid_group grid = cg::this_grid();
    Ctx F;
    F.lds = (LAS unsigned char*)lds_raw; F.tid = threadIdx.x; F.lane = F.tid & 63; F.wave = __builtin_amdgcn_readfirstlane(F.tid >> 6); F.G = gridDim.x; F.bid = blockIdx.x;
#pragma unroll
    for (int i = 0; i < 26; ++i) F.in[i] = args.in[i];
    F.out = args.out; F.ws = args.ws;
    float dbgval = 0.f; (void)dbgval;
#if CLKPROBE >= 20
    if (threadIdx.x == 0) g_dbg[blockIdx.x] = 0;
#endif
#if CLKPROBE
    long long phc0_ = 0, phr0_ = 0;
#define PH_BEGIN(k) do { if (CLKPROBE == (k)) { phc0_ = (long long)__builtin_amdgcn_s_memtime(); phr0_ = (long long)__builtin_amdgcn_s_memrealtime(); } } while (0)
#define PH_END(k) do { if (CLKPROBE == (k)) { const long long c1_ = (long long)__builtin_amdgcn_s_memtime(), r1_ = (long long)__builtin_amdgcn_s_memrealtime(); \
        const long long v_ = CLKWHAT == 0 ? ((c1_ - phc0_) * 100) / (r1_ - phr0_) : (r1_ - phr0_) / 100; \
        if (threadIdx.x == 0) ((float*)(F.ws + WS_CTL + 32768))[F.bid] = (float)v_; \
        if (F.bid == 0 && threadIdx.x == 0) dbgval = (float)(((v_ + TIMEQ / 2 + TIMEOFF) / TIMEQ) * TIMEQ); } } while (0)
#else
#define PH_BEGIN(k) do { } while (0)
#define PH_END(k) do { } while (0)
#endif
    volatile LAS unsigned* bst = (volatile LAS unsigned*)(F.lds + LDS_BYTES - 64);
    if (F.tid < 16) bst[F.tid] = 0u;
    __syncthreads();
    const XcdBarrier xbar = xcd_barrier_post((unsigned*)(F.ws + WS_CTL), bst);
#define GRID_BAR() xcd_barrier(xbar)

#define PHASE_FENCE() do { int t_ = threadIdx.x; asm volatile("" : "+v"(t_)); F.tid = t_; F.lane = t_ & 63; F.wave = __builtin_amdgcn_readfirstlane(t_ >> 6); } while (0)
    PH_BEGIN(10); for (int rep = 0; rep < REP_P0; ++rep) { if (rep) __syncthreads(); p0_prologue(F); } PH_END(10);
    grid.sync(); PHASE_FENCE();
    PH_BEGIN(1);
    {
        pg8::Gemm g{(const bf16_t*)(F.ws + WS_A), (const bf16_t*)(F.ws + WS_BT), MA, NBT, 1024};
        Order1 S; S.init(F.G, F.bid);
        EpiProj E{(bf16_t*)(F.ws + WS_PROJ), (bf16_t*)(F.ws + WS_MEMRAW)};
        pg8::gemm_phase<EpiProj, Order1, true, true>(F.lds, g, S, E);
    }
    PH_END(1);
    GRID_BAR(); PHASE_FENCE();
    PH_BEGIN(2); for (int rep = 0; rep < REP_P2A; ++rep) p2a_phase(F);
    __syncthreads();
    p2a_attn(F); PH_END(2);
    GRID_BAR(); PHASE_FENCE();
    PH_BEGIN(3); p2b_phase(F); PH_END(3);
    GRID_BAR(); PHASE_FENCE();
    PH_BEGIN(4);
    if ((F.bid & 1) == 0) { PH_BEGIN(5); gemm2_sample(F); PH_END(5); }
    {
        pg8::Gemm g{(const bf16_t*)(F.ws + WS_MIX), (const bf16_t*)(F.ws + WS_WOUT), MTOT, 1024, 2048};
        Order3 S; S.init(F.G, F.bid);
        EpiOut E{F.in[I_XP], F.in[I_XS], F.out, (const float*)(F.ws + WS_SSQ)};
        pg8::gemm_phase<EpiOut, Order3, true, true>(F.lds, g, S, E);
    }
    if ((F.bid & 1) != 0) gemm2_sample(F);
    PH_END(4);
#if CLKPROBE
    grid.sync();
#if CLKPROBE >= 20
    if (threadIdx.x == 0) ((float*)(F.ws + WS_CTL + 32768))[F.bid] = (float)(g_dbg[F.bid] / 100);
    __threadfence(); grid.sync();
#endif
    if (F.bid == 0 && threadIdx.x == 0) {
        if (CLKAGG != 0) { const float* pv = (const float*)(F.ws + WS_CTL + 32768); float mx = pv[0], mn = pv[0], sm = 0.f;
            for (int i = 0; i < (int)gridDim.x; ++i) { mx = fmaxf(mx, pv[i]); mn = fminf(mn, pv[i]); sm += pv[i]; }
            const long long v_ = (long long)(CLKAGG == 1 ? mx : (CLKAGG == 2 ? mn : (CLKAGG == 4 ? pv[CLKBID] : sm / gridDim.x)));
            dbgval = (float)(((v_ + TIMEQ / 2 + TIMEOFF) / TIMEQ) * TIMEQ); }
        F.out[O_CONVS] = dbgval; }
#endif
#if DBG_SCALE3 || DBG_ZERO
    grid.sync();
    {
        const size_t offs[13] = {O_Y, (size_t)MP * 1024, O_WKP, O_WVP, O_SSMP, O_CONVP, O_MKP, O_MVP, O_WKS, O_WVS, O_SSMS, O_CONVS, O_END};
        for (int o = 0; o < 12; ++o) {
            const bool z = (DBG_ZERO >> o) & 1, s3 = (DBG_SCALE3 >> o) & 1;
            if (!z && !s3) continue;
            for (size_t i = offs[o] + (size_t)F.bid * 512 + F.tid; i < offs[o + 1]; i += (size_t)F.G * 512) F.out[i] = z ? 0.f : F.out[i] * 3.0f;
        }
    }
#endif
}

extern "C" void kernel_launch(void* const* d_in, const int* in_sizes, int n_in, void* d_out, int out_size, void* d_ws, size_t ws_size, hipStream_t stream) {
    static int grid = 0;
    if (grid == 0) {
        if (n_in != 26 || (size_t)out_size != O_END || ws_size < WS_END) { fprintf(stderr, "kernel_launch: unexpected problem (n_in %d out %d ws %zu)\n", n_in, out_size, ws_size); grid = -1; return; }
        int dev = 0, cus = 0, per_cu = 0;
        if (hipGetDevice(&dev) != hipSuccess || hipDeviceGetAttribute(&cus, hipDeviceAttributeMultiprocessorCount, dev) != hipSuccess) { grid = -1; return; }
        if (hipFuncSetAttribute((const void*)hymba_fwd, hipFuncAttributeMaxDynamicSharedMemorySize, LDS_BYTES) != hipSuccess) { fprintf(stderr, "kernel_launch: hipFuncSetAttribute failed\n"); grid = -1; return; }
        if (hipOccupancyMaxActiveBlocksPerMultiprocessor(&per_cu, (const void*)hymba_fwd, 512, LDS_BYTES) != hipSuccess || per_cu < 1) { fprintf(stderr, "kernel_launch: occupancy query says %d\n", per_cu); (void)hipGetLastError(); grid = -1; return; }
        grid = cus;
        fprintf(stderr, "kernel_launch: %d CUs, occupancy %d per CU, grid %d\n", cus, per_cu, grid);
    }
    if (grid < 0) return;
    Args a{};
    for (int i = 0; i < 26; ++i) a.in[i] = (const float*)d_in[i];
    a.out = (float*)d_out; a.ws = (unsigned char*)d_ws;
    if (hipMemsetAsync((char*)d_ws + WS_CTL, 0, CTL_ZERO_BYTES, stream) != hipSuccess) { fprintf(stderr, "kernel_launch: memset of the barrier words failed\n"); return; }
    void* kargs[] = {&a};
    const hipError_t e = hipLaunchCooperativeKernel((const void*)hymba_fwd, dim3(grid), dim3(512), kargs, LDS_BYTES, stream);
    if (e != hipSuccess) fprintf(stderr, "kernel_launch: cooperative launch failed: %s\n", hipGetErrorString(e));
}
```

```cpp
#include <hip/hip_runtime.h>
#include <hip/hip_cooperative_groups.h>
#include <cstdio>
#include <cstdint>
namespace cg = cooperative_groups;
#ifndef CLKPROBE
#define CLKPROBE 0
#endif
#if CLKPROBE >= 20
__device__ long long g_dbg[1024];
#endif
namespace pg8 {
#define PG8_LAS __attribute__((address_space(3)))
typedef unsigned short bf16_t;
typedef short bf16x8 __attribute__((ext_vector_type(8)));
typedef float f32x4 __attribute__((ext_vector_type(4)));
typedef unsigned u32x4 __attribute__((ext_vector_type(4)));
constexpr int BM = 256, BK = 64, HALF = 128, HTB = HALF * BK * 2  , STAGE_BYTES = 8 * HTB, NXCD = 8, WGM = 8;

__host__ __device__ __forceinline__ int lds_byte(int r, int c) { const int st = (r >> 4) * 2 + (c >> 5), rr = r & 15, cc = c & 31, ob = rr * 64 + cc * 2; return st * 1024 + (ob ^ (((ob >> 9) & 1) << 5)); }
__host__ __device__ __forceinline__ void stage_rc(int b, int& R, int& C) { const int st = b / 1024, sb = b % 1024, swz = sb ^ (((sb >> 9) & 1) << 5); R = (st >> 1) * 16 + swz / 64; C = (st & 1) * 32 + (swz % 64) / 2; }
__host__ __device__ __forceinline__ int perm32(int rho) { const int n = rho >> 4, i = rho & 15; return 8 * (i >> 2) + 4 * n + (i & 3); }

struct Unit { int pm, pn; };
struct Gemm { const bf16_t* A; const bf16_t* Bt; int M, N, K; };

struct StaticOrder {
    int nM, nN, nwg, G, c;
    __host__ __device__ void init(int M, int N, int G_, int c_) { nM = M / BM; nN = N / BM; nwg = nM * nN; G = G_; c = c_; }
    __host__ __device__ bool next(int i, Unit& u) const {
        const long L = (long)i * G + c; if (L >= nwg) return false;
        int wgid = (int)L; { const int q = nwg / NXCD, r = nwg % NXCD, xcd = wgid % NXCD, off = wgid / NXCD; wgid = (xcd < r ? xcd * (q + 1) : r * (q + 1) + (xcd - r) * q) + off; }
        const int nig = WGM * nN, gid = wgid / nig, fm = gid * WGM, gsz = (nM - fm) < WGM ? (nM - fm) : WGM;
        u.pm = fm + ((wgid % nig) % gsz); u.pn = (wgid % nig) / gsz; return true;
    }
    __device__ __forceinline__ void a_ready(const Unit&) const {}
    __device__ __forceinline__ void done(const Unit&) const {}
};

template <class Epi, class Sched, bool ALIGN_EPI = false, bool SP2 = false>
__device__ __forceinline__ void gemm_phase(PG8_LAS unsigned char* lds, const Gemm g, const Sched& S, const Epi& E) {
    int tid_ = threadIdx.x; asm volatile("" : "+v"(tid_));
    const int tid = tid_, wid = __builtin_amdgcn_readfirstlane(tid >> 6), lane = tid & 63, wr = wid >> 2, wc = wid & 3, fr = lane & 15, fq = lane >> 4;
    const int K = g.K, nt = K / BK;
    unsigned voffA[2], voffB[2];
#pragma unroll
    for (int i = 0; i < 2; ++i) { int R, C; stage_rc(tid * 16 + i * 8192, R, C); const int Rb = Epi::PERM ? ((R & ~31) + perm32(R & 31)) : R;
        voffA[i] = (unsigned)(R * K + C) * 2u; voffB[i] = (unsigned)(Rb * K + C) * 2u; }
    const size_t kstep = (size_t)(BK * 2);
    const size_t hstep = (size_t)HALF * K * 2;
    const size_t tstep = 2 * hstep;
    const unsigned ldsw = (unsigned)wid * 1024u;
    const int aoff = lds_byte(wr * 64 + fr, fq * 8), boff = lds_byte(wc * 32 + fr, fq * 8);
#define PG8_SA(b, h) (((b) * 2 + (h)) * HTB)
#define PG8_SB(b, h) ((4 + (b) * 2 + (h)) * HTB)
#define PG8_STAGE(bufoff, gbase, voff) do { _Pragma("unroll") for (int _i = 0; _i < 2; ++_i) \
        __builtin_amdgcn_global_load_lds((const unsigned*)((const char*)(gbase) + (voff)[_i]), (PG8_LAS unsigned*)(lds + (bufoff) + ldsw + _i * 8192), 16, 0, 0); } while (0)
#define PG8_LDA(dst, b, h) do { _Pragma("unroll") for (int m = 0; m < 4; ++m) _Pragma("unroll") for (int k = 0; k < 2; ++k) dst[m][k] = *(const PG8_LAS bf16x8*)(lds + PG8_SA(b, h) + aoff + m * 2048 + k * 1024); } while (0)
#define PG8_LDB(dst, b, h) do { _Pragma("unroll") for (int n = 0; n < 2; ++n) _Pragma("unroll") for (int k = 0; k < 2; ++k) dst[n][k] = *(const PG8_LAS bf16x8*)(lds + PG8_SB(b, h) + boff + n * 2048 + k * 1024); } while (0)
#define PG8_MMA(ai, bj, At, Bt) do { __builtin_amdgcn_s_setprio(1); _Pragma("unroll") for (int m = 0; m < 4; ++m) _Pragma("unroll") for (int n = 0; n < 2; ++n) _Pragma("unroll") for (int k = 0; k < 2; ++k) \
        acc[ai][bj][m][n] = __builtin_amdgcn_mfma_f32_16x16x32_bf16(Bt[n][k], At[m][k], acc[ai][bj][m][n], 0, 0, 0); __builtin_amdgcn_s_setprio(0); } while (0)
#define PG8_WAIT_V(n) asm volatile("s_waitcnt vmcnt(" #n ")" ::: "memory")
#define PG8_WAIT_L(n) asm volatile("s_waitcnt lgkmcnt(" #n ")" ::: "memory")
#define PG8_BAR __builtin_amdgcn_s_barrier()
#define PG8_SCHED __builtin_amdgcn_sched_barrier(0)
    Unit cur, nxt; int ui = 0;
    if (!S.next(0, cur)) return;
    f32x4 acc[2][2][4][2];
#pragma unroll
    for (int a = 0; a < 2; ++a)
#pragma unroll
        for (int b = 0; b < 2; ++b)
#pragma unroll
            for (int m = 0; m < 4; ++m)
#pragma unroll
                for (int n = 0; n < 2; ++n) acc[a][b][m][n] = (f32x4){0.f, 0.f, 0.f, 0.f};
    bf16x8 At[4][2], B0[2][2], B1[2][2];
    const char* cA = (const char*)g.A + (size_t)cur.pm * tstep; const char* cB = (const char*)g.Bt + (size_t)cur.pn * tstep;
    S.a_ready(cur);
    if constexpr (SP2) {
        PG8_STAGE(PG8_SB(0, 0), cB, voffB); PG8_STAGE(PG8_SB(0, 1), cB + hstep, voffB); PG8_STAGE(PG8_SA(0, 0), cA, voffA); PG8_STAGE(PG8_SA(0, 1), cA + hstep, voffA);
        if (wr == 1) PG8_BAR;
        PG8_WAIT_V(2); PG8_BAR;
        PG8_STAGE(PG8_SB(1, 0), cB + kstep, voffB); PG8_STAGE(PG8_SA(1, 0), cA + kstep, voffA); PG8_STAGE(PG8_SB(1, 1), cB + hstep + kstep, voffB);
        PG8_WAIT_V(6); PG8_BAR;
    } else {
        PG8_STAGE(PG8_SB(0, 0), cB, voffB); PG8_STAGE(PG8_SA(0, 0), cA, voffA); PG8_STAGE(PG8_SB(0, 1), cB + hstep, voffB); PG8_STAGE(PG8_SA(0, 1), cA + hstep, voffA);
        if (wr == 1) PG8_BAR;
        PG8_WAIT_V(4); PG8_BAR;
        PG8_STAGE(PG8_SB(1, 0), cB + kstep, voffB); PG8_STAGE(PG8_SA(1, 0), cA + kstep, voffA); PG8_STAGE(PG8_SB(1, 1), cB + hstep + kstep, voffB);
        PG8_WAIT_V(6); PG8_BAR;
    }
    for (;;) {
        const bool has_next = S.next(ui + 1, nxt);
        const char* nA = has_next ? (const char*)g.A + (size_t)nxt.pm * tstep : cA; const char* nB = has_next ? (const char*)g.Bt + (size_t)nxt.pn * tstep : cB;
        for (int t = 0; t < nt; t += 2) {
            const bool last = (t == nt - 2);
            const char* a1 = cA + (size_t)(t + 1) * kstep;
            const char* a2 = last ? nA : cA + (size_t)(t + 2) * kstep; const char* b2 = last ? nB : cB + (size_t)(t + 2) * kstep;
            const char* a3 = a2 + kstep; const char* b3 = b2 + kstep;
            if (last && has_next) S.a_ready(nxt);
#if CLKPROBE == 21
            if constexpr (Epi::MIDK > 0) { if (t == Epi::MIDK) { const long long t0_ = (long long)__builtin_amdgcn_s_memrealtime(); E.mid(acc, cur, wr, wc, fr, fq); asm volatile("" :: "v"(acc[0][0][0][0]));
                if (threadIdx.x == 0) g_dbg[blockIdx.x] += (long long)__builtin_amdgcn_s_memrealtime() - t0_; } }
#else
            if constexpr (Epi::MIDK > 0) { if (t == Epi::MIDK) E.mid(acc, cur, wr, wc, fr, fq); }
#endif
            if constexpr (SP2) {
            PG8_LDB(B0, 0, 0); PG8_LDB(B1, 0, 1); PG8_SCHED; PG8_LDA(At, 0, 0); PG8_STAGE(PG8_SA(1, 1), a1 + hstep, voffA);
            PG8_WAIT_V(8); PG8_WAIT_L(0); PG8_BAR; PG8_MMA(0, 0, At, B0); PG8_MMA(0, 1, At, B1); PG8_BAR; PG8_SCHED;
            PG8_LDA(At, 0, 1); PG8_STAGE(PG8_SB(0, 0), b2, voffB); PG8_STAGE(PG8_SB(0, 1), b2 + hstep, voffB); PG8_STAGE(PG8_SA(0, 0), a2, voffA);
            PG8_WAIT_V(8); PG8_WAIT_L(0); PG8_BAR; PG8_MMA(1, 0, At, B0); PG8_MMA(1, 1, At, B1); PG8_BAR; PG8_SCHED;
            PG8_LDB(B0, 1, 0); PG8_LDB(B1, 1, 1); PG8_SCHED; PG8_LDA(At, 1, 0); PG8_STAGE(PG8_SA(0, 1), a2 + hstep, voffA);
            PG8_WAIT_V(8); PG8_WAIT_L(0); PG8_BAR; PG8_MMA(0, 0, At, B0); PG8_MMA(0, 1, At, B1); PG8_BAR; PG8_SCHED;
            PG8_LDA(At, 1, 1); PG8_STAGE(PG8_SB(1, 0), b3, voffB); PG8_STAGE(PG8_SB(1, 1), b3 + hstep, voffB); PG8_STAGE(PG8_SA(1, 0), a3, voffA);
            PG8_WAIT_V(8); PG8_WAIT_L(0); PG8_BAR; PG8_MMA(1, 0, At, B0); PG8_MMA(1, 1, At, B1); PG8_BAR; PG8_SCHED;
            } else {
            PG8_LDB(B0, 0, 0); PG8_SCHED; PG8_LDA(At, 0, 0); PG8_STAGE(PG8_SA(1, 1), a1 + hstep, voffA);
            PG8_WAIT_L(8); PG8_BAR; PG8_WAIT_L(0); PG8_MMA(0, 0, At, B0); PG8_BAR; PG8_SCHED;
            PG8_LDB(B1, 0, 1); PG8_STAGE(PG8_SB(0, 0), b2, voffB);
            PG8_BAR; PG8_WAIT_L(0); PG8_MMA(0, 1, At, B1); PG8_BAR;
            PG8_LDA(At, 0, 1); PG8_STAGE(PG8_SA(0, 0), a2, voffA);
            PG8_BAR; PG8_WAIT_L(0); PG8_MMA(1, 0, At, B0); PG8_BAR; PG8_SCHED;
            PG8_STAGE(PG8_SB(0, 1), b2 + hstep, voffB);
            PG8_WAIT_V(6); PG8_BAR; PG8_MMA(1, 1, At, B1); PG8_BAR;
            PG8_LDB(B0, 1, 0); PG8_SCHED; PG8_LDA(At, 1, 0); PG8_STAGE(PG8_SA(0, 1), a2 + hstep, voffA);
            PG8_WAIT_L(8); PG8_BAR; PG8_WAIT_L(0); PG8_MMA(0, 0, At, B0); PG8_BAR; PG8_SCHED;
            PG8_LDB(B1, 1, 1); PG8_STAGE(PG8_SB(1, 0), b3, voffB);
            PG8_BAR; PG8_WAIT_L(0); PG8_MMA(0, 1, At, B1); PG8_BAR;
            PG8_LDA(At, 1, 1); PG8_STAGE(PG8_SA(1, 0), a3, voffA);
            PG8_BAR; PG8_WAIT_L(0); PG8_MMA(1, 0, At, B0); PG8_BAR; PG8_SCHED;
            PG8_STAGE(PG8_SB(1, 1), b3 + hstep, voffB);
            PG8_WAIT_V(6); PG8_BAR; PG8_MMA(1, 1, At, B1); PG8_BAR;
            }
        }
        if constexpr (ALIGN_EPI) { if (wr == 0) PG8_BAR; }
#if CLKPROBE == 20
        { const long long t0_ = (long long)__builtin_amdgcn_s_memrealtime();
#endif
        if constexpr (!Epi::AFTER_DRAIN) { E(acc, cur, wr, wc, fr, fq); S.done(cur); }
#if CLKPROBE == 20
          asm volatile("s_waitcnt vmcnt(0)" ::: "memory"); if (Epi::MIDK > 0 && threadIdx.x == 0) g_dbg[blockIdx.x] += (long long)__builtin_amdgcn_s_memrealtime() - t0_; }
#endif
        if (!has_next) break;
#pragma unroll
        for (int a = 0; a < 2; ++a)
#pragma unroll
            for (int b = 0; b < 2; ++b)
#pragma unroll
                for (int m = 0; m < 4; ++m)
#pragma unroll
                    for (int n = 0; n < 2; ++n) acc[a][b][m][n] = (f32x4){0.f, 0.f, 0.f, 0.f};
        cur = nxt; cA = nA; cB = nB; ++ui;
        if constexpr (ALIGN_EPI) { if (wr == 1) PG8_BAR; }
    }
    PG8_WAIT_V(0);
    if constexpr (!ALIGN_EPI) { if (wr == 0) PG8_BAR; }
    PG8_BAR;
    if constexpr (Epi::AFTER_DRAIN) { E.fused(acc, cur, wr, wc, fr, fq, lds, wid, lane); S.done(cur); }
#undef PG8_SA
#undef PG8_SB
#undef PG8_STAGE
#undef PG8_LDA
#undef PG8_LDB
#undef PG8_MMA
#undef PG8_WAIT_V
#undef PG8_WAIT_L
#undef PG8_BAR
#undef PG8_SCHED
}
}
#ifndef DBG_SCALE3
#define DBG_SCALE3 0
#endif
#ifndef DBG_ZERO
#define DBG_ZERO 0
#endif
#ifndef LAST_PHASE
#define LAST_PHASE 4
#endif
#ifndef REP_P0
#define REP_P0 1
#endif
#ifndef REP_P1
#define REP_P1 1
#endif
#ifndef REP_P2A
#define REP_P2A 1
#endif
#ifndef REP_P0T
#define REP_P0T 1
#endif
#ifndef REP_P0R
#define REP_P0R 1
#endif
#ifndef REP_S2
#define REP_S2 1
#endif
#ifndef REP_S3
#define REP_S3 1
#endif
#ifndef REP_S4
#define REP_S4 1
#endif
#ifndef REP_ATOM
#define REP_ATOM 1
#endif
#ifndef TIMESEG
#define TIMESEG 0
#endif
#ifndef TIMESEG_A
#define TIMESEG_A 0
#endif
#ifndef TIMESEG_B
#define TIMESEG_B 5
#endif
#ifndef CLKPROBE
#define CLKPROBE 0
#endif
#ifndef CLKAGG
#define CLKAGG 0
#endif
#ifndef CLKBID
#define CLKBID 0
#endif
#ifndef CLKWHAT
#define CLKWHAT 0
#endif
#ifndef TIMEWAVE
#define TIMEWAVE 0
#endif
#ifndef TIMEQ
#define TIMEQ 500
#endif
#ifndef TIMEOFF
#define TIMEOFF 0
#endif
#ifndef REP_SSD
#define REP_SSD 1
#endif
#ifndef REP_WIN
#define REP_WIN 1
#endif
#ifndef REP_MEM
#define REP_MEM 1
#endif
#ifndef REP_P3
#define REP_P3 1
#endif
#define DI __device__ __forceinline__
#define LAS __attribute__((address_space(3)))
typedef unsigned short bf16_t;
typedef short bf16x8 __attribute__((ext_vector_type(8)));
typedef float f32x4 __attribute__((ext_vector_type(4)));
typedef float f32x2 __attribute__((ext_vector_type(2)));
typedef unsigned u32x4 __attribute__((ext_vector_type(4)));
typedef unsigned u32x2 __attribute__((ext_vector_type(2)));

constexpr int NB_P = 16, T_P = 4096, NB_S = 32, T_S = 64, DM = 1024;
constexpr int MP = NB_P * T_P, MS = NB_S * T_S, MTOT = MP + MS;
constexpr int MMEM = NB_P * 256, MA = MTOT + MMEM;
constexpr int NPROJ = 4864, NBT = NPROJ + 1024, INC = 4880;
constexpr int C_Q = 0, C_K = 512, C_V = 640, C_GA = 768, C_Z = 1280, C_XBC = 2304, C_MQ = 3840, C_GM = 4352;
constexpr int NCHUNK = MTOT / 64;
constexpr float EPSF = 1e-6f;
constexpr size_t O_Y = 0;
constexpr size_t O_WKP = (size_t)MTOT * 1024;
constexpr size_t O_WVP = O_WKP + (size_t)NB_P * 128 * 128;
constexpr size_t O_SSMP = O_WVP + (size_t)NB_P * 128 * 128;
constexpr size_t O_CONVP = O_SSMP + (size_t)NB_P * 16 * 64 * 128;
constexpr size_t O_MKP = O_CONVP + (size_t)NB_P * 3 * 1536;
constexpr size_t O_MVP = O_MKP + (size_t)NB_P * 256 * 512;
constexpr size_t O_WKS = O_MVP + (size_t)NB_P * 256 * 512;
constexpr size_t O_WVS = O_WKS + (size_t)NB_S * 128 * 128;
constexpr size_t O_SSMS = O_WVS + (size_t)NB_S * 128 * 128;
constexpr size_t O_CONVS = O_SSMS + (size_t)NB_S * 16 * 64 * 128;
constexpr size_t O_END = O_CONVS + (size_t)NB_S * 3 * 1536;
static_assert(O_END == 81485824, "output size");
constexpr size_t MiB = 1u << 20;
constexpr size_t WS_ROPE = 1 * MiB;
constexpr size_t WS_BT = 2 * MiB;
constexpr size_t WS_WOUT = 14 * MiB;
constexpr size_t WS_DT = 18 * MiB;
constexpr size_t WS_SSQ = 23 * MiB;
constexpr size_t WS_CTL = 0, CTL_ZERO_BYTES = 65536;
constexpr size_t WS_MEMRAW = 32 * MiB;
constexpr size_t WS_MEMK = 40 * MiB;
constexpr size_t WS_MEMVT = 52 * MiB;
constexpr size_t WS_PROJ = 64 * MiB;
constexpr size_t WS_A = 692 * MiB;
constexpr size_t WS_MIX = 692 * MiB;
constexpr size_t WS_BCC = 956 * MiB;
constexpr size_t WS_END = 1022 * MiB;
static_assert(WS_BT + (size_t)NBT * 1024 * 2 <= WS_WOUT && WS_DT + (size_t)MTOT * 64 <= WS_SSQ && WS_SSQ + (size_t)MTOT * 128 <= WS_MEMRAW, "ws map 1");
static_assert(WS_PROJ + (size_t)MTOT * NPROJ * 2 <= WS_A && WS_A + (size_t)MA * 1024 * 2 <= WS_END && WS_MIX + (size_t)MTOT * 2048 * 2 <= WS_BCC && WS_BCC + (size_t)MTOT * 512 * 2 <= WS_END, "ws map 2");
constexpr int LDS_BYTES = 147456;

DI float bf2f(unsigned short b) { return __uint_as_float((unsigned)b << 16); }
typedef __bf16 hbf2 __attribute__((ext_vector_type(2)));
DI unsigned short f2bf(float f) { return __builtin_bit_cast(unsigned short, (__bf16)f); }
DI unsigned pk2(float lo, float hi) { const f32x2 v = {lo, hi}; return __builtin_bit_cast(unsigned, __builtin_convertvector(v, hbf2)); }
DI unsigned cvt_pk_bf16(float lo, float hi) { return pk2(lo, hi); }
DI float siluf(float x) { return x * __builtin_amdgcn_rcpf(1.0f + __expf(-x)); }
DI float xor32_sum(float x) { unsigned u = __builtin_bit_cast(unsigned, x); unsigned u2 = u; asm volatile("" : "+v"(u2)); auto r = __builtin_amdgcn_permlane32_swap(u, u2, false, false); unsigned r0 = r[0], r1 = r[1]; return __builtin_bit_cast(float, r0) + __builtin_bit_cast(float, r1); }
DI float xor16_sum(float x) { unsigned u = __builtin_bit_cast(unsigned, x); unsigned u2 = u; asm volatile("" : "+v"(u2)); auto r = __builtin_amdgcn_permlane16_swap(u, u2, false, false); unsigned r0 = r[0], r1 = r[1]; return __builtin_bit_cast(float, r0) + __builtin_bit_cast(float, r1); }
DI float xor32_max(float x) { unsigned u = __builtin_bit_cast(unsigned, x); unsigned u2 = u; asm volatile("" : "+v"(u2)); auto r = __builtin_amdgcn_permlane32_swap(u, u2, false, false); unsigned r0 = r[0], r1 = r[1]; return fmaxf(__builtin_bit_cast(float, r0), __builtin_bit_cast(float, r1)); }
DI float xor16_max(float x) { unsigned u = __builtin_bit_cast(unsigned, x); unsigned u2 = u; asm volatile("" : "+v"(u2)); auto r = __builtin_amdgcn_permlane16_swap(u, u2, false, false); unsigned r0 = r[0], r1 = r[1]; return fmaxf(__builtin_bit_cast(float, r0), __builtin_bit_cast(float, r1)); }
#define DPP_ROR_(v, n) __builtin_bit_cast(float, __builtin_amdgcn_update_dpp(0, __builtin_bit_cast(int, (v)), 0x120 + (n), 0xf, 0xf, false))
DI float row16_sum(float v) { v += DPP_ROR_(v, 8); v += DPP_ROR_(v, 4); v += DPP_ROR_(v, 2); v += DPP_ROR_(v, 1); return v; }
DI float wave_sum(float v) { return xor32_sum(xor16_sum(row16_sum(v))); }
#define DPP_MOV_(v, ctrl) __builtin_bit_cast(float, __builtin_amdgcn_update_dpp(0, __builtin_bit_cast(int, (v)), (ctrl), 0xf, 0xf, false))
DI float lane_xor1(float v) { return DPP_MOV_(v, 0xB1); }
DI float lane_xor2(float v) { return DPP_MOV_(v, 0x4E); }
DI float lane_xor4(float v) { const float t = DPP_MOV_(v, 0x141); return DPP_MOV_(t, 0x1B); }
DI float lane_xor8(float v) { const float t = DPP_MOV_(v, 0x140); return DPP_MOV_(t, 0x141); }
DI float swap32_sum(float a, float b) { unsigned ua = __builtin_bit_cast(unsigned, a), ub = __builtin_bit_cast(unsigned, b); auto r = __builtin_amdgcn_permlane32_swap(ua, ub, false, false); unsigned r0 = r[0], r1 = r[1]; return __builtin_bit_cast(float, r0) + __builtin_bit_cast(float, r1); }
DI float swap16_sum(float a, float b) { unsigned ua = __builtin_bit_cast(unsigned, a), ub = __builtin_bit_cast(unsigned, b); auto r = __builtin_amdgcn_permlane16_swap(ua, ub, false, false); unsigned r0 = r[0], r1 = r[1]; return __builtin_bit_cast(float, r0) + __builtin_bit_cast(float, r1); }
DI void unpack8(const u32x4 v, float (&o)[8]) {
#pragma unroll
    for (int i = 0; i < 4; ++i) { o[2 * i] = __uint_as_float(v[i] << 16); o[2 * i + 1] = __uint_as_float(v[i] & 0xffff0000u); }
}
DI u32x4 pack8(const float (&o)[8]) { u32x4 v; v.x = pk2(o[0], o[1]); v.y = pk2(o[2], o[3]); v.z = pk2(o[4], o[5]); v.w = pk2(o[6], o[7]); return v; }
#define LDS_WAIT() asm volatile("s_waitcnt lgkmcnt(0)" ::: "memory")
#define MFMA16(a, b, c) __builtin_amdgcn_mfma_f32_16x16x32_bf16((a), (b), (c), 0, 0, 0)

struct Args { const float* in[26]; float* out; unsigned char* ws; };
struct Ctx {
    LAS unsigned char* lds; int tid, lane, wave, G, bid;
    const float* in[26]; float* out; unsigned char* ws;
};
#define RLX_AGENT __ATOMIC_RELAXED, __HIP_MEMORY_SCOPE_AGENT
#define XB_TMO      128
#define XB_XCNT(j)  (256  + 64 * (j))
#define XB_XSUB(j)  (1280 + 64 * (j))
#define XB_XGEN(j)  (2304 + 64 * (j))
#define XB_TOP      3328
#define XB_TOPGEN   3392
#define XCD_BAR_WORDS 3456
#define XB_SPIN_CAP (1u << 18)

__device__ __forceinline__ unsigned xb_ld(unsigned* p)              { return __hip_atomic_load(p, __ATOMIC_RELAXED, __HIP_MEMORY_SCOPE_AGENT); }
__device__ __forceinline__ unsigned xb_add(unsigned* p, unsigned v) { return __hip_atomic_fetch_add(p, v, __ATOMIC_RELAXED, __HIP_MEMORY_SCOPE_AGENT); }
__device__ __forceinline__ unsigned xb_xcc_id() { return (unsigned)__builtin_amdgcn_s_getreg((3 << 11) | 20) & 0xFu; }
#define XB_SPIN(cond, bar) do { unsigned _sp = 0; while (cond) { __builtin_amdgcn_s_sleep(1); \
    if ((++_sp & 255u) == 0u) { if (xb_ld(&(bar)[XB_TMO])) break; if (_sp > XB_SPIN_CAP) { atomicAdd(&(bar)[XB_TMO], 1u); break; } } } } while (0)

struct XcdBarrier {
    unsigned* bar; unsigned x;
    volatile LAS unsigned* st;
};

__device__ __forceinline__ XcdBarrier xcd_barrier_post(unsigned* bar, volatile LAS unsigned* st) {
    XcdBarrier b; b.bar = bar; b.x = xb_xcc_id(); b.st = st;
    if (threadIdx.x == 0) (void)xb_add(&bar[XB_XCNT(b.x)], 1u);
    return b;
}
__device__ __forceinline__ void xcd_barrier_complete(unsigned* bar, unsigned x, unsigned& nloc, unsigned& nx) {
    const unsigned G = gridDim.x * gridDim.y * gridDim.z;
    unsigned sum, cnt, mine, sp = 0u;
    for (;;) {
        sum = 0u; cnt = 0u; mine = 0u;
#pragma unroll
        for (unsigned j = 0; j < 16; ++j) { const unsigned c = xb_ld(&bar[XB_XCNT(j)]); sum += c; cnt += (c > 0u) ? 1u : 0u; mine = (j == x) ? c : mine; }
        if (sum == G) break;
        __builtin_amdgcn_s_sleep(1);
        if ((++sp & 255u) == 0u) { if (xb_ld(&bar[XB_TMO])) break; if (sp > XB_SPIN_CAP) { atomicAdd(&bar[XB_TMO], 1u); break; } }
    }
    nloc = mine > 0u ? mine : 1u; nx = cnt > 0u ? cnt : 1u;
}

__device__ __forceinline__ void xcd_barrier(const XcdBarrier& b) {
    asm volatile("s_waitcnt vmcnt(0)" ::: "memory");
    __syncthreads();
    if (threadIdx.x == 0) {
        unsigned* bar = b.bar;
        __builtin_amdgcn_s_waitcnt(0);
        unsigned nloc = b.st[0], nx = b.st[1];
        if (nloc == 0u) { xcd_barrier_complete(bar, b.x, nloc, nx); b.st[0] = nloc; b.st[1] = nx; }
        const unsigned old = xb_add(&bar[XB_XSUB(b.x)], 1u);
        const unsigned gen = old / nloc;
        if (old + 1u == (gen + 1u) * nloc) {
            __builtin_amdgcn_fence(__ATOMIC_RELEASE, "agent");
            asm volatile("s_waitcnt vmcnt(0)" ::: "memory");
            const unsigned og = xb_add(&bar[XB_TOP], 1u);
            const unsigned tg = og / nx;
            if (og + 1u == (tg + 1u) * nx) xb_add(&bar[XB_TOPGEN], 1u);
            else XB_SPIN(xb_ld(&bar[XB_TOPGEN]) == tg, bar);
            __builtin_amdgcn_fence(__ATOMIC_ACQUIRE, "agent");
            xb_add(&bar[XB_XGEN(b.x)], 1u);
            asm volatile("s_waitcnt vmcnt(0)" ::: "memory");
        } else {
            XB_SPIN(xb_ld(&bar[XB_XGEN(b.x)]) == gen, bar);
            __builtin_amdgcn_fence(__ATOMIC_ACQUIRE, "agent");
            asm volatile("s_waitcnt vmcnt(0)" ::: "memory");
        }
    }
    __syncthreads();
}

enum { I_XP = 0, I_XS, I_CWK, I_CWV, I_SSM, I_SCONV, I_CMK, I_CMV, I_MEM, I_GNORM, I_WIN, I_GQ, I_GK, I_SINKS, I_CONVW, I_CONVB, I_DTB, I_ALOG, I_DSKIP, I_GSSD, I_GMEM, I_WMK, I_WMV, I_GMK, I_GMQ, I_WOUT };

DI void p0_transpose_item(const float* W, int ldw, int src_k0, int src_n0, const float* rowscale, bf16_t* WT, int ldt, int dst_n0, int dst_k0, LAS float* scr, int lane) {
    float tv[32];
#pragma unroll
    for (int i = 0; i < 32; ++i) tv[i] = W[(size_t)(src_k0 + 2 * i + (lane >> 5)) * ldw + src_n0 + (lane & 31)];
    if (rowscale) {
#pragma unroll
        for (int i = 0; i < 32; ++i) tv[i] *= rowscale[2 * i + (lane >> 5)]; }
#pragma unroll
    for (int i = 0; i < 32; ++i) scr[(2 * i + (lane >> 5)) * 33 + (lane & 31)] = tv[i];
    LDS_WAIT();
    const int c = lane & 7;
#pragma unroll
    for (int j = 0; j < 4; ++j) { const int n = (lane >> 3) + 8 * j; const LAS float* s = scr + (8 * c) * 33 + n;
        u32x4 o; o.x = pk2(s[0 * 33], s[1 * 33]); o.y = pk2(s[2 * 33], s[3 * 33]); o.z = pk2(s[4 * 33], s[5 * 33]); o.w = pk2(s[6 * 33], s[7 * 33]);
        *(u32x4*)(WT + (size_t)(dst_n0 + n) * ldt + dst_k0 + 8 * c) = o; }
    LDS_WAIT();
}

DI float reduce16_to_lane(float (&a)[16], int lane) {
#pragma unroll
    for (int j = 0; j < 16; ++j) { a[j] += __shfl_xor(a[j], 32); a[j] += __shfl_xor(a[j], 16); }
    float r8[8], r4[4], r2[2];
    const bool b3 = (lane & 8) != 0, b2 = (lane & 4) != 0, b1 = (lane & 2) != 0, b0 = (lane & 1) != 0;
#pragma unroll
    for (int j = 0; j < 8; ++j) { const float snd = b3 ? a[j] : a[j + 8], kp = b3 ? a[j + 8] : a[j]; r8[j] = kp + __shfl_xor(snd, 8); }
#pragma unroll
    for (int j = 0; j < 4; ++j) { const float snd = b2 ? r8[j] : r8[j + 4], kp = b2 ? r8[j + 4] : r8[j]; r4[j] = kp + __shfl_xor(snd, 4); }
#pragma unroll
    for (int j = 0; j < 2; ++j) { const float snd = b1 ? r4[j] : r4[j + 2], kp = b1 ? r4[j + 2] : r4[j]; r2[j] = kp + __shfl_xor(snd, 2); }
    const float snd = b0 ? r2[0] : r2[1], kp = b0 ? r2[1] : r2[0];
    return kp + __shfl_xor(snd, 1);
}

DI void p0_rows2(f32x4 (&va)[4], f32x4 (&vb)[4], const float* g, bf16_t* oa, bf16_t* ob, float* dta, float* dtb, bool want_dt, const float* dt_bias, const LAS float* wdt, int lane) {
    float sa = 0.f, sb = 0.f;
#pragma unroll
    for (int jj = 0; jj < 4; ++jj) { sa += (va[jj].x * va[jj].x + va[jj].y * va[jj].y) + (va[jj].z * va[jj].z + va[jj].w * va[jj].w); sb += (vb[jj].x * vb[jj].x + vb[jj].y * vb[jj].y) + (vb[jj].z * vb[jj].z + vb[jj].w * vb[jj].w); }
    const float ra = 1.0f / sqrtf(wave_sum(sa) * (1.0f / DM) + EPSF), rb = 1.0f / sqrtf(wave_sum(sb) * (1.0f / DM) + EPSF);
    u32x2* pa = (u32x2*)oa + lane; u32x2* pb = (u32x2*)ob + lane;
#pragma unroll
    for (int jj = 0; jj < 4; ++jj) { const f32x4 gv = ((const f32x4*)g)[64 * jj + lane]; va[jj] = va[jj] * ra * gv; vb[jj] = vb[jj] * rb * gv;
        u32x2 w; w.x = pk2(va[jj].x, va[jj].y); w.y = pk2(va[jj].z, va[jj].w); pa[64 * jj] = w; w.x = pk2(vb[jj].x, vb[jj].y); w.y = pk2(vb[jj].z, vb[jj].w); pb[64 * jj] = w; }
    if (want_dt) {
        f32x2 ab[16];
#pragma unroll
        for (int j = 0; j < 16; ++j) ab[j] = (f32x2){0.f, 0.f};
#pragma unroll
        for (int jj = 0; jj < 4; ++jj)
#pragma unroll
            for (int e = 0; e < 4; ++e) { const f32x2 hab = {va[jj][e], vb[jj][e]}; const LAS f32x4* wr = (const LAS f32x4*)(wdt + ((jj * 4 + e) * 64 + lane) * 20);
#pragma unroll
                for (int q = 0; q < 4; ++q) { const f32x4 w4 = wr[q];
                    ab[4 * q] += hab * w4.x; ab[4 * q + 1] += hab * w4.y; ab[4 * q + 2] += hab * w4.z; ab[4 * q + 3] += hab * w4.w; }
                if (e & 1) __builtin_amdgcn_sched_barrier(0); }
        float a[16], b[16];
#pragma unroll
        for (int j = 0; j < 16; ++j) { a[j] = ab[j].x; b[j] = ab[j].y; }
        const bool b5 = (lane & 32) != 0, b3 = (lane & 8) != 0, b2 = (lane & 4) != 0, b1 = (lane & 2) != 0;
        float v16[16], v8[8], v4[4], v2[2];
#pragma unroll
        for (int j = 0; j < 16; ++j) v16[j] = swap32_sum(a[j], b[j]);
#pragma unroll
        for (int j = 0; j < 8; ++j) v8[j] = swap16_sum(v16[j], v16[j + 8]);
#pragma unroll
        for (int j = 0; j < 4; ++j) { const float snd = b3 ? v8[j] : v8[j + 4], kp = b3 ? v8[j + 4] : v8[j]; v4[j] = kp + lane_xor8(snd); }
#pragma unroll
        for (int j = 0; j < 2; ++j) { const float snd = b2 ? v4[j] : v4[j + 2], kp = b2 ? v4[j + 2] : v4[j]; v2[j] = kp + lane_xor4(snd); }
        float tot; { const float snd = b1 ? v2[0] : v2[1], kp = b1 ? v2[1] : v2[0]; tot = kp + lane_xor2(snd); }
        tot += lane_xor1(tot);
        if ((lane & 1) == 0) { const int j = (lane >> 1) & 15; const float xv = tot + dt_bias[j]; float* dp = b5 ? dtb : dta;
            dp[j] = fmaxf(xv, 0.f) + log1pf(__expf(-fabsf(xv))); }
    }
}

DI void p0_row_segment(Ctx& F, const float* src, const float* g, int m0, int npair, bool tok, bf16_t* A, float* DT, const LAS float* wdt, int gw, int NGW) {
    const int lane = F.lane;
    f32x4 n0a[4], n0b[4], n1a[4], n1b[4];
#define P0_LOAD(dst_a, dst_b, pp) do { if ((pp) < npair) { _Pragma("unroll") for (int jj = 0; jj < 4; ++jj) { \
        dst_a[jj] = ((const f32x4*)(src + (size_t)(2 * (pp)) * DM))[64 * jj + lane]; dst_b[jj] = ((const f32x4*)(src + (size_t)(2 * (pp) + 1) * DM))[64 * jj + lane]; } } } while (0)
    P0_LOAD(n0a, n0b, gw); P0_LOAD(n1a, n1b, gw + NGW);
    for (int p = gw; p < npair; p += NGW) {
        f32x4 va[4], vb[4];
#pragma unroll
        for (int jj = 0; jj < 4; ++jj) { va[jj] = n0a[jj]; vb[jj] = n0b[jj]; n0a[jj] = n1a[jj]; n0b[jj] = n1b[jj]; }
        P0_LOAD(n1a, n1b, p + 2 * NGW);
        const int m = m0 + 2 * p;
        p0_rows2(va, vb, g, A + (size_t)m * DM, A + (size_t)(m + 1) * DM, DT + (size_t)(tok ? m : 0) * 16, DT + (size_t)(tok ? m + 1 : 0) * 16, tok, F.in[I_DTB], wdt, lane);
    }
#undef P0_LOAD
}

DI void p0_prologue(Ctx& F) {
#if CLKPROBE >= 50 && CLKPROBE <= 52
    long long pt0_ = (long long)__builtin_amdgcn_s_memrealtime();
#define P0_TS(k) do { const long long t_ = (long long)__builtin_amdgcn_s_memrealtime(); if (CLKPROBE == (k) && threadIdx.x == 0) g_dbg[blockIdx.x] += t_ - pt0_; pt0_ = t_; } while (0)
#else
#define P0_TS(k) do { } while (0)
#endif
    const int gw = F.bid * 8 + F.wave, NGW = F.G * 8, lane = F.lane;
    bf16_t* BT = (bf16_t*)(F.ws + WS_BT); bf16_t* WOT = (bf16_t*)(F.ws + WS_WOUT);
    for (int rep_ = 0; rep_ < REP_P0T; ++rep_) {
        LAS float* scr = (LAS float*)(F.lds + F.wave * 16384);
        constexpr int I_IN = 16 * (NPROJ / 32), I_M = 16 * 32, I_O = 32 * 32;
        for (int it = gw; it < I_IN + I_M + I_O; it += NGW) {
            int r = it;
            if (r < I_IN) { const int kb = r / (NPROJ / 32), nb = r % (NPROJ / 32); const int n0 = 32 * nb;
                p0_transpose_item(F.in[I_WIN], INC, 64 * kb, n0 + (n0 >= 3840 ? 16 : 0), nullptr, BT, 1024, n0, 64 * kb, scr, lane); continue; }
            r -= I_IN;
            if (r < I_M) { const int kb = r / 32, nb = r % 32;
                p0_transpose_item(nb < 16 ? F.in[I_WMK] : F.in[I_WMV], 512, 64 * kb, 32 * (nb & 15), nullptr, BT, 1024, NPROJ + 32 * nb, 64 * kb, scr, lane); continue; }
            r -= I_M;
            { const int kb = r / 32, nb = r % 32; const int k0 = 64 * kb;
              const int sk0 = k0 < 1024 ? 512 + k0 : (k0 < 1536 ? k0 - 1024 : k0);
              p0_transpose_item(F.in[I_WOUT], 1024, sk0, 32 * nb, k0 < 1024 ? F.in[I_GSSD] + k0 : nullptr, WOT, 2048, 32 * nb, k0, scr, lane); }
        }
    }
    { float* sq = (float*)(F.ws + WS_SSQ); for (int i = F.bid * 512 + F.tid; i < MTOT; i += F.G * 512) sq[i] = 0.f; }
    {
        f32x2* rope = (f32x2*)(F.ws + WS_ROPE);
        for (int i = F.bid * 512 + F.tid; i < 4096 * 32; i += F.G * 512) {
            const int pos = i >> 5, fi = i & 31;
            const float freq = exp2f(-(float)fi * (13.287712379549449f / 32.0f));
            double rev = (double)pos * (double)freq * 0.15915494309189535;
            rev -= __builtin_rint(rev);
            const float ang = (float)(rev * 6.283185307179586);
            rope[i] = (f32x2){cosf(ang), sinf(ang)};
        }
    }
    P0_TS(50);
    __syncthreads();
    for (int rep_ = 0; rep_ < REP_P0R; ++rep_) {
        if (rep_) __syncthreads();
        LAS float* wdt = (LAS float*)F.lds;
#pragma unroll 1
        for (int i0 = F.tid; i0 < 1024 * 16; i0 += 512 * 8) { float t8[8];
#pragma unroll
            for (int u = 0; u < 8; ++u) { const int i = i0 + 512 * u; t8[u] = F.in[I_WIN][(size_t)(i >> 4) * INC + 3840 + (i & 15)]; }
#pragma unroll
            for (int u = 0; u < 8; ++u) { const int i = i0 + 512 * u, k = i >> 4, j = i & 15; const int jj = k >> 8, e = k & 3, l = (k >> 2) & 63;
                wdt[((jj * 4 + e) * 64 + l) * 20 + j] = t8[u]; } }
        __syncthreads();
        P0_TS(51);
        bf16_t* A = (bf16_t*)(F.ws + WS_A); float* DT = (float*)(F.ws + WS_DT);
        p0_row_segment(F, F.in[I_XP], F.in[I_GNORM], 0, MP / 2, true, A, DT, wdt, gw, NGW);
        p0_row_segment(F, F.in[I_XS], F.in[I_GNORM], MP, MS / 2, true, A, DT, wdt, gw, NGW);
        p0_row_segment(F, F.in[I_MEM], F.in[I_GMEM], MTOT, MMEM / 2, false, A, DT, wdt, gw, NGW);
    }
    P0_TS(52);
}
struct Order1 {
    pg8::StaticOrder so; int G, c;
    __device__ void init(int G_, int c_) { so.init(MTOT, NPROJ, G_, c_); G = G_; c = c_; }
    __device__ bool next(int i, pg8::Unit& u) const {
        long L = (long)i * G + c;
        if (L >= (long)REP_P1 * (so.nwg + 64)) return false;
        L %= (so.nwg + 64);
        if (L < so.nwg) { pg8::StaticOrder t = so; t.G = 1; t.c = 0; return t.next((int)L, u); }
        const int r = (int)(L - so.nwg);
        u.pm = MTOT / 256 + (r >> 2); u.pn = NPROJ / 256 + (r & 3); return true;
    }
    __device__ __forceinline__ void a_ready(const pg8::Unit&) const {}
    __device__ __forceinline__ void done(const pg8::Unit&) const {}
};
struct Order3 {
    pg8::StaticOrder so; int G, c;
    __device__ void init(int G_, int c_) { so.init(MP, 1024, 1, 0); G = G_; c = c_; }
    __device__ bool next(int i, pg8::Unit& u) const {
        long L = (long)i * G + c;
        if (L >= (long)REP_P3 * so.nwg) return false;
        return so.next((int)(L % so.nwg), u);
    }
    __device__ __forceinline__ void a_ready(const pg8::Unit&) const {}
    __device__ __forceinline__ void done(const pg8::Unit&) const {}
};
struct EpiProj {
    static constexpr bool PERM = true, AFTER_DRAIN = false; static constexpr int MIDK = 0;
    bf16_t* proj; bf16_t* memraw;
    __device__ __forceinline__ void operator()(const f32x4 (&acc)[2][2][4][2], const pg8::Unit& u, int wr, int wc, int fr, int fq) const {
        bf16_t* base; int ldc, row0, col0;
        if (u.pn < NPROJ / 256) { base = proj; ldc = NPROJ; row0 = u.pm * 256; col0 = u.pn * 256; }
        else { base = memraw; ldc = 1024; row0 = (u.pm - MTOT / 256) * 256; col0 = (u.pn - NPROJ / 256) * 256; }
        row0 += wr * 64 + fr; col0 += wc * 32 + 8 * fq;
#pragma unroll
        for (int ai = 0; ai < 2; ++ai)
#pragma unroll
            for (int m = 0; m < 4; ++m) { bf16_t* rowp = base + (size_t)(row0 + ai * 128 + m * 16) * ldc + col0;
#pragma unroll
                for (int bj = 0; bj < 2; ++bj) { const f32x4 v0 = acc[ai][bj][m][0], v1 = acc[ai][bj][m][1];
                    u32x4 w; w.x = cvt_pk_bf16(v0[0], v0[1]); w.y = cvt_pk_bf16(v0[2], v0[3]); w.z = cvt_pk_bf16(v1[0], v1[1]); w.w = cvt_pk_bf16(v1[2], v1[3]);
                    *(u32x4*)(rowp + bj * 128) = w; } }
    }
};
struct EpiOut {
    static constexpr bool PERM = false, AFTER_DRAIN = false; static constexpr int MIDK = 16;
    const float* xp; const float* xs; float* out; const float* sumsq;
    __device__ __forceinline__ void mid(f32x4 (&acc)[2][2][4][2], const pg8::Unit& u, int wr, int wc, int fr, int fq) const {
        const float* sq = sumsq + (size_t)u.pm * 256 + wr * 64 + fr;
#pragma unroll
        for (int ai = 0; ai < 2; ++ai)
#pragma unroll
            for (int m = 0; m < 4; ++m) { const float r = 1.0f / sqrtf(sq[ai * 128 + m * 16] * (1.0f / 1024.0f) + EPSF);
#pragma unroll
                for (int bj = 0; bj < 2; ++bj)
#pragma unroll
                    for (int n = 0; n < 2; ++n) acc[ai][bj][m][n] = acc[ai][bj][m][n] * r; }
    }
    __device__ __forceinline__ void operator()(const f32x4 (&acc)[2][2][4][2], const pg8::Unit& u, int wr, int wc, int fr, int fq) const {
        const float* xb = u.pm < MP / 256 ? xp + (size_t)u.pm * 256 * DM : xs + (size_t)(u.pm - MP / 256) * 256 * DM;
        float* ob = out + (size_t)u.pm * 256 * DM;
        const int rl0 = wr * 64 + fr, col0 = u.pn * 256 + wc * 32 + 4 * fq;
#pragma unroll
        for (int ai = 0; ai < 2; ++ai) {
            f32x4 xv[4][2][2];
#pragma unroll
            for (int m = 0; m < 4; ++m)
#pragma unroll
                for (int bj = 0; bj < 2; ++bj)
#pragma unroll
                    for (int n = 0; n < 2; ++n) xv[m][bj][n] = *(const f32x4*)(xb + (size_t)(rl0 + ai * 128 + m * 16) * DM + col0 + bj * 128 + n * 16);
#pragma unroll
            for (int m = 0; m < 4; ++m)
#pragma unroll
                for (int bj = 0; bj < 2; ++bj)
#pragma unroll
                    for (int n = 0; n < 2; ++n) *(f32x4*)(ob + (size_t)(rl0 + ai * 128 + m * 16) * DM + col0 + bj * 128 + n * 16) = acc[ai][bj][m][n] + xv[m][bj][n];
            asm volatile("" ::: "memory"); }
    }
};

constexpr int SS_X = 0, SS_XD = 9216, SS_BM = 18432, SS_CM = 35840, SS_SET = 53248;
constexpr int SS_SB = 2 * SS_SET, SS_WM = SS_SB + 17408, SS_SM = SS_WM + 9216;
constexpr int LD64 = 144, LD128 = 272;
typedef short s16x4 __attribute__((ext_vector_type(4)));

DI bf16x8 lds_frag(const LAS unsigned char* tile, int ld, int row0, int k0, int lane) {
    return *(const LAS bf16x8*)(tile + (row0 + (lane & 15)) * ld + (k0 + 8 * (lane >> 4)) * 2);
}
DI bf16x8 lds_frag_tr(const LAS unsigned char* tile, int ld, int k0, int c0, int lane) {
    const LAS unsigned char* a = tile + (k0 + 8 * (lane >> 4) + ((lane & 15) >> 2)) * ld + (c0 + 4 * (lane & 3)) * 2;
    const s16x4 lo = __builtin_amdgcn_ds_read_tr16_b64_v4i16((LAS s16x4*)a), hi = __builtin_amdgcn_ds_read_tr16_b64_v4i16((LAS s16x4*)(a + 4 * ld));
    return (bf16x8){lo.x, lo.y, lo.z, lo.w, hi.x, hi.y, hi.z, hi.w};
}
DI bf16x8 lds_frag_tr2(const LAS unsigned char* tile, int ld, int k0, int c0, int lane) {
    const LAS unsigned char* a = tile + (k0 + 4 * (lane >> 4) + ((lane & 15) >> 2)) * ld + (c0 + 4 * (lane & 3)) * 2;
    const s16x4 lo = __builtin_amdgcn_ds_read_tr16_b64_v4i16((LAS s16x4*)a), hi = __builtin_amdgcn_ds_read_tr16_b64_v4i16((LAS s16x4*)(a + 16 * ld));
    return (bf16x8){lo.x, lo.y, lo.z, lo.w, hi.x, hi.y, hi.z, hi.w};
}
#define MFMA16T(rowsfrag, colsfrag, acc) MFMA16((colsfrag), (rowsfrag), (acc))

#define DPP_ADD_(v, ctrl, rmask) ((v) + __builtin_bit_cast(float, __builtin_amdgcn_update_dpp(0, __builtin_bit_cast(int, (v)), (ctrl), (rmask), 0xf, false)))
DI float wave_incl_scan(float v) {
    v = DPP_ADD_(v, 0x111, 0xf); v = DPP_ADD_(v, 0x112, 0xf); v = DPP_ADD_(v, 0x114, 0xf); v = DPP_ADD_(v, 0x118, 0xf);
    v = DPP_ADD_(v, 0x142, 0xa);
    v = DPP_ADD_(v, 0x143, 0xc);
    return v;
}
DI void convbc_prepass(Ctx& F) {
    const int gw = F.bid * 8 + F.wave, NGW = F.G * 8, lane = F.lane;
    const bf16_t* PROJ = (const bf16_t*)(F.ws + WS_PROJ); bf16_t* BCC = (bf16_t*)(F.ws + WS_BCC);
    const int ch0 = 1024 + lane * 8;
    float wv[4][8], bv[8];
#pragma unroll
    for (int e = 0; e < 8; ++e) { bv[e] = F.in[I_CONVB][ch0 + e];
#pragma unroll
        for (int j = 0; j < 4; ++j) wv[j][e] = F.in[I_CONVW][j * 1536 + ch0 + e]; }
    const bool bal = (F.G == 256);
    const int nmine = bal ? 1 : (MTOT / 33 - gw + NGW - 1) / NGW;
    for (int ti = 0; ti < nmine; ++ti) {
        int ub, nb;
        if (bal) { const int wv_ = F.wave;
            if (F.bid < 64) { ub = (F.bid * 8 + wv_) * 2; nb = 2; } else if (F.bid < 128) { ub = 1024 + ((F.bid - 64) * 8 + wv_) * 4; nb = 4; } else { ub = 3072 + ((F.bid - 128) * 8 + wv_) * 3; nb = 3; } }
        else { ub = (gw + ti * NGW) * 3; nb = 3; }
        const int row0 = ub * 11;
        float h0[8], h1[8], h2[8];
        { const bool smp0 = row0 >= MP; const int lrow0 = smp0 ? (row0 - MP) & 63 : row0 & (T_P - 1);
          const float* sc0 = F.in[I_SCONV] + (size_t)(smp0 ? (row0 - MP) >> 6 : 0) * 3 * 1536 + ch0;
#define CONV_HALO(dst, j) do { const int lr_ = lrow0 - 3 + (j); \
              if (lr_ >= 0) unpack8(*(const u32x4*)(PROJ + (size_t)(row0 - 3 + (j)) * NPROJ + C_XBC + ch0), dst); \
              else { _Pragma("unroll") for (int e = 0; e < 8; ++e) dst[e] = smp0 ? sc0[(3 + lr_) * 1536 + e] : 0.f; } } while (0)
          CONV_HALO(h0, 0); CONV_HALO(h1, 1); CONV_HALO(h2, 2);
#undef CONV_HALO
        }
        u32x4 rawA[11], rawB[11];
#pragma unroll
        for (int i = 0; i < 11; ++i) rawA[i] = *(const u32x4*)(PROJ + (size_t)(row0 + i) * NPROJ + C_XBC + ch0);
#define CONV_BATCH(bt, cur, nxt) do { \
            if ((bt) + 1 < nb) { _Pragma("unroll") for (int i = 0; i < 11; ++i) nxt[i] = *(const u32x4*)(PROJ + (size_t)(row0 + 11 * ((bt) + 1) + i) * NPROJ + C_XBC + ch0); } \
            _Pragma("unroll") for (int i = 0; i < 11; ++i) { const int row = row0 + 11 * (bt) + i; \
                const bool smp = row >= MP; const int lrow = smp ? (row - MP) & 63 : row & (T_P - 1); \
                if (lrow == 0) { \
                    if (smp) { const float* sc = F.in[I_SCONV] + (size_t)((row - MP) >> 6) * 3 * 1536 + ch0; \
                        _Pragma("unroll") for (int e = 0; e < 8; ++e) { h0[e] = sc[e]; h1[e] = sc[1536 + e]; h2[e] = sc[2 * 1536 + e]; } } \
                    else { _Pragma("unroll") for (int e = 0; e < 8; ++e) { h0[e] = 0.f; h1[e] = 0.f; h2[e] = 0.f; } } } \
                float cur_[8], o[8]; \
                unpack8(cur[i], cur_); \
                _Pragma("unroll") for (int e = 0; e < 8; ++e) { o[e] = siluf(bv[e] + wv[0][e] * h0[e] + wv[1][e] * h1[e] + wv[2][e] * h2[e] + wv[3][e] * cur_[e]); h0[e] = h1[e]; h1[e] = h2[e]; h2[e] = cur_[e]; } \
                *(u32x4*)(BCC + (size_t)row * 512 + lane * 8) = pack8(o); } } while (0)
        CONV_BATCH(0, rawA, rawB); CONV_BATCH(1, rawB, rawA); if (nb > 2) CONV_BATCH(2, rawA, rawB); if (nb > 3) CONV_BATCH(3, rawB, rawA);
#undef CONV_BATCH
    }
}

DI void ssd_item(Ctx& F, int sq, int h, bool do_sumsq) {
    LAS unsigned char* lds = F.lds;
    const int tid = F.tid, lane = F.lane, w = F.wave, g = h >> 3;
    const bool smp = sq >= NB_P; const int sb = sq - NB_P;
    const int row_base = smp ? MP + sb * 64 : sq * T_P, nchunks = smp ? 1 : 64;
    const bf16_t* PROJ = (const bf16_t*)(F.ws + WS_PROJ); const bf16_t* BCC = (const bf16_t*)(F.ws + WS_BCC); const float* DT = (const float*)(F.ws + WS_DT);
    bf16_t* MIX = (bf16_t*)(F.ws + WS_MIX); float* SUMSQ = (float*)(F.ws + WS_SSQ);
    const float a_h = -__expf(F.in[I_ALOG][h]), d_h = F.in[I_DSKIP][h];
    const int pt = w >> 1, nh = w & 1, lt = w >> 1;
    const int xl = tid >> 3, xg = tid & 7, chx = h * 64 + 8 * xg;
    LAS float* sm_cw0 = (LAS float*)(lds + SS_SM + 1024 + 768);
    if (tid >= 192 && tid < 512) { const int i = tid - 192; const int j = i >> 6, chn = h * 64 + (i & 63); sm_cw0[i] = j < 4 ? F.in[I_CONVW][j * 1536 + chn] : F.in[I_CONVB][chn]; }
    f32x4 st[4];
#pragma unroll
    for (int q = 0; q < 4; ++q) {
        if (smp) st[q] = *(const f32x4*)(F.in[I_SSM] + ((size_t)(sb * 16 + h) * 64 + 16 * pt + (lane & 15)) * 128 + 16 * (4 * nh + q) + 4 * (lane >> 4));
        else st[q] = (f32x4){0.f, 0.f, 0.f, 0.f};
    }
    u32x4 px0[4], px1[4] = {{0u, 0u, 0u, 0u}, {0u, 0u, 0u, 0u}, {0u, 0u, 0u, 0u}, {0u, 0u, 0u, 0u}}, pbs[2], pcs[2]; u32x2 pz0[2], pz1[2] = {{0u, 0u}, {0u, 0u}}; float pdt0, pdt1 = 0.f;
#define SSD_ISSUE_X(c_, PX_) do { const int row0_ = row_base + 64 * (c_); \
        _Pragma("unroll") for (int j_ = 0; j_ < 4; ++j_) { int rr_ = xl - 3 + j_; if ((c_) == 0 && rr_ < 0) rr_ = 0; PX_[j_] = *(const u32x4*)(PROJ + (size_t)(row0_ + rr_) * NPROJ + C_XBC + chx); } } while (0)
#define SSD_ISSUE_BC(c_) do { const int row0_ = row_base + 64 * (c_); \
        _Pragma("unroll") for (int i_ = 0; i_ < 2; ++i_) { const int t_ = tid + 512 * i_; \
            pbs[i_] = *(const u32x4*)(BCC + (size_t)(row0_ + (t_ >> 4)) * 512 + g * 128 + 8 * (t_ & 15)); pcs[i_] = *(const u32x4*)(BCC + (size_t)(row0_ + (t_ >> 4)) * 512 + 256 + g * 128 + 8 * (t_ & 15)); } } while (0)
#define SSD_ISSUE_ZDT(c_, PZ_, PDT_) do { const int row0_ = row_base + 64 * (c_); \
        _Pragma("unroll") for (int pi_ = 0; pi_ < 2; ++pi_) PZ_[pi_] = *(const u32x2*)(PROJ + (size_t)(row0_ + 16 * lt + (lane & 15)) * NPROJ + C_Z + h * 64 + 16 * (2 * nh + pi_) + 4 * (lane >> 4)); \
        PDT_ = DT[(size_t)(row0_ + lane) * 16 + h]; } while (0)
    LAS float* sm_init = (LAS float*)(lds + SS_SM + 1024);
    if (tid < 192) sm_init[tid] = smp ? F.in[I_SCONV][(size_t)(sb * 3 + (tid >> 6)) * 1536 + h * 64 + (tid & 63)] : 0.f;
#if TIMESEG
    long long ts_[6] = {0, 0, 0, 0, 0, 0}; long long tacc_ = 0;
#define SSD_TS(k) do { ts_[k] = (long long)__builtin_amdgcn_s_memtime(); if ((k) == 5) tacc_ += ts_[TIMESEG_B] - ts_[TIMESEG_A]; } while (0)
#else
#define SSD_TS(k) do { } while (0)
#endif
#define SSD_STEP(c, PX_, PZ_, PDT_, PZN_, PDTN_, PXN_) do { \
        const int row0 = row_base + 64 * c; LAS unsigned char* ts = lds + (c & 1) * SS_SET; \
        SSD_TS(0); \
        LAS float* sm_ac = (LAS float*)(lds + SS_SM + (c & 1) * 512); LAS float* sm_dt = sm_ac + 64; \
        const float dtl = PDT_; \
        float ac = dtl * a_h; \
        ac = wave_incl_scan(ac); \
        const float ac_last = __builtin_bit_cast(float, __builtin_amdgcn_readlane(__builtin_bit_cast(int, ac), 63)); \
        const float wgt_l = __expf(ac_last - ac) * dtl; \
        if (w == 0) { sm_ac[lane] = ac; sm_dt[lane] = dtl; } \
        { \
        { float xr[4][8], o[8], od[8]; \
_Pragma("unroll")           for (int j = 0; j < 4; ++j) unpack8(PX_[j], xr[j]); \
          if (c == 0) { \
_Pragma("unroll")               for (int j = 0; j < 3; ++j) { const int rr = xl - 3 + j; const LAS f32x4* iv = (const LAS f32x4*)(sm_init + (rr < 0 ? 3 + rr : 0) * 64 + 8 * xg); \
                  f32x4 i0 = iv[0], i1 = iv[1]; asm volatile("" : "+v"(i0), "+v"(i1)); \
_Pragma("unroll")                   for (int e = 0; e < 4; ++e) { xr[j][e] = (rr < 0) ? i0[e] : xr[j][e]; xr[j][4 + e] = (rr < 0) ? i1[e] : xr[j][4 + e]; } } } \
          const float wg = __shfl(wgt_l, xl & 63); \
          float wv[4][8], bv[8]; unsigned cwo_ = (unsigned)(8 * xg) * 4u; asm volatile("" : "+v"(cwo_)); const LAS float* sm_cw = (const LAS float*)((const LAS unsigned char*)sm_cw0 + cwo_) - 8 * xg; \
          _Pragma("unroll") for (int j_ = 0; j_ < 4; ++j_) { const f32x4 a_ = *(const LAS f32x4*)(sm_cw + j_ * 64 + 8 * xg), b_ = *(const LAS f32x4*)(sm_cw + j_ * 64 + 8 * xg + 4); \
              _Pragma("unroll") for (int e_ = 0; e_ < 4; ++e_) { wv[j_][e_] = a_[e_]; wv[j_][4 + e_] = b_[e_]; } } \
          { const f32x4 a_ = *(const LAS f32x4*)(sm_cw + 256 + 8 * xg), b_ = *(const LAS f32x4*)(sm_cw + 256 + 8 * xg + 4); _Pragma("unroll") for (int e_ = 0; e_ < 4; ++e_) { bv[e_] = a_[e_]; bv[4 + e_] = b_[e_]; } } \
_Pragma("unroll")           for (int e = 0; e < 8; ++e) { o[e] = siluf(bv[e] + wv[0][e] * xr[0][e] + wv[1][e] * xr[1][e] + wv[2][e] * xr[2][e] + wv[3][e] * xr[3][e]); od[e] = o[e] * wg; } \
          *(LAS u32x4*)(ts + SS_X + xl * LD64 + xg * 16) = pack8(o); \
          *(LAS u32x4*)(ts + SS_XD + xl * LD64 + xg * 16) = pack8(od); } \
_Pragma("unroll")         for (int i = 0; i < 2; ++i) { const int t = tid + 512 * i; \
            *(LAS u32x4*)(ts + SS_BM + (t >> 4) * LD128 + (t & 15) * 16) = pbs[i]; *(LAS u32x4*)(ts + SS_CM + (t >> 4) * LD128 + (t & 15) * 16) = pcs[i]; } \
        } \
        if (c + 2 < nchunks) SSD_ISSUE_X(c + 2, PX_); if (c + 1 < nchunks) { SSD_ISSUE_BC(c + 1); SSD_ISSUE_ZDT(c + 1, PZN_, PDTN_); } \
        SSD_TS(1); __syncthreads(); SSD_TS(2); \
_Pragma("unroll")         for (int q = 0; q < 4; ++q) { u32x2 v; v.x = pk2(st[q][0], st[q][1]); v.y = pk2(st[q][2], st[q][3]); \
            *(LAS u32x2*)(lds + SS_SB + (16 * pt + (lane & 15)) * LD128 + (16 * (4 * nh + q) + 4 * (lane >> 4)) * 2) = v; } \
        bf16x8 cmf[4]; \
_Pragma("unroll")         for (int ks = 0; ks < 4; ++ks) cmf[ks] = lds_frag(ts + SS_CM, LD128, 16 * lt, 32 * ks, lane); \
        { const float acl = sm_ac[16 * lt + (lane & 15)]; const int l = 16 * lt + (lane & 15); \
_Pragma("unroll")           for (int si = 0; si < 2; ++si) { const int stl = 2 * nh + si; f32x4 gacc = {0.f, 0.f, 0.f, 0.f}; \
              if (stl <= lt) { \
_Pragma("unroll")                   for (int ks = 0; ks < 4; ++ks) gacc = MFMA16T(cmf[ks], lds_frag(ts + SS_BM, LD128, 16 * stl, 32 * ks, lane), gacc); } \
              const int s0 = 16 * stl + 4 * (lane >> 4); \
              const f32x4 acs = *(const LAS f32x4*)(sm_ac + s0), dts = *(const LAS f32x4*)(sm_dt + s0); \
              float v[4]; \
_Pragma("unroll")               for (int r = 0; r < 4; ++r) { v[r] = gacc[r] * __expf(fminf(acl - acs[r], 0.f)) * dts[r]; v[r] = (l >= s0 + r) ? v[r] : 0.f; } \
              u32x2 pk; pk.x = pk2(v[0], v[1]); pk.y = pk2(v[2], v[3]); \
              *(LAS u32x2*)(lds + SS_WM + l * LD64 + s0 * 2) = pk; } } \
        SSD_TS(3); __syncthreads(); SSD_TS(4); \
        { \
        { const int l = 16 * lt + (lane & 15); const float eal = __expf(sm_ac[l]); \
          bf16x8 wmf[2]; \
_Pragma("unroll")           for (int ks = 0; ks < 2; ++ks) wmf[ks] = lds_frag(lds + SS_WM, LD64, 16 * lt, 32 * ks, lane); \
          float ssq = 0.f; \
_Pragma("unroll")           for (int pi = 0; pi < 2; ++pi) { const int ptl = 2 * nh + pi; const int p0 = 16 * ptl + 4 * (lane >> 4); \
              f32x4 y = {0.f, 0.f, 0.f, 0.f}; \
_Pragma("unroll")               for (int ks = 0; ks < 4; ++ks) y = MFMA16T(cmf[ks], lds_frag(lds + SS_SB, LD128, 16 * ptl, 32 * ks, lane), y); \
              y = y * eal; \
_Pragma("unroll")               for (int ks = 0; ks < 2; ++ks) y = MFMA16T(wmf[ks], lds_frag_tr(ts + SS_X, LD64, 32 * ks, 16 * ptl, lane), y); \
              const u32x2 xraw = *(const LAS u32x2*)(ts + SS_X + l * LD64 + p0 * 2); \
              const float xv[4] = {__uint_as_float(xraw.x << 16), __uint_as_float(xraw.x & 0xffff0000u), __uint_as_float(xraw.y << 16), __uint_as_float(xraw.y & 0xffff0000u)}; \
              const float zv[4] = {__uint_as_float(PZ_[pi].x << 16), __uint_as_float(PZ_[pi].x & 0xffff0000u), __uint_as_float(PZ_[pi].y << 16), __uint_as_float(PZ_[pi].y & 0xffff0000u)}; \
              float gv[4]; \
_Pragma("unroll")               for (int r = 0; r < 4; ++r) { gv[r] = (y[r] + d_h * xv[r]) * siluf(zv[r]); ssq += gv[r] * gv[r]; } \
              u32x2 pk; pk.x = pk2(gv[0], gv[1]); pk.y = pk2(gv[2], gv[3]); \
              *(u32x2*)(MIX + (size_t)(row0 + l) * 2048 + h * 64 + p0) = pk; } \
          ssq = xor32_sum(xor16_sum(ssq)); \
          if (lane < 16 && do_sumsq) unsafeAtomicAdd(SUMSQ + row0 + l, ssq); } \
        } \
        { const float cd = __expf(ac_last); \
          bf16x8 xa[2]; \
_Pragma("unroll")           for (int ks = 0; ks < 2; ++ks) xa[ks] = lds_frag_tr(ts + SS_XD, LD64, 32 * ks, 16 * pt, lane); \
_Pragma("unroll")           for (int q = 0; q < 4; ++q) { f32x4 s = st[q] * cd; \
_Pragma("unroll")               for (int ks = 0; ks < 2; ++ks) s = MFMA16T(xa[ks], lds_frag_tr(ts + SS_BM, LD128, 32 * ks, 16 * (4 * nh + q), lane), s); \
              st[q] = s; } } \
        asm volatile("" : "+v"(PDTN_), "+v"(PZN_[0]), "+v"(PZN_[1]), "+v"(PXN_[0]), "+v"(PXN_[1]), "+v"(PXN_[2]), "+v"(PXN_[3]), "+v"(pbs[0]), "+v"(pbs[1]), "+v"(pcs[0]), "+v"(pcs[1])); \
        SSD_TS(5); \
    } while (0)
    SSD_ISSUE_X(0, px0); SSD_ISSUE_BC(0); SSD_ISSUE_ZDT(0, pz0, pdt0);
    __syncthreads();
    if (nchunks > 1) { SSD_ISSUE_X(1, px1); }
    asm volatile("" : "+v"(pdt0), "+v"(pz0[0]), "+v"(pz0[1]), "+v"(px0[0]), "+v"(px0[1]), "+v"(px0[2]), "+v"(px0[3]), "+v"(pbs[0]), "+v"(pbs[1]), "+v"(pcs[0]), "+v"(pcs[1]));
#pragma unroll 1
    for (int c2 = 0; c2 < nchunks; c2 += 2) {
        { const int c = c2; SSD_STEP(c, px0, pz0, pdt0, pz1, pdt1, px1); }
        if (c2 + 1 < nchunks) { const int c = c2 + 1; SSD_STEP(c, px1, pz1, pdt1, pz0, pdt0, px0); }
    }
#undef SSD_STEP
#undef SSD_ISSUE_X
#undef SSD_ISSUE_BC
#undef SSD_ISSUE_ZDT
#if TIMESEG
    if (F.bid == 0 && sq == 0 && tid == 64 * TIMEWAVE) F.out[O_CONVP] = (float)((((tacc_ / 64) + TIMEQ / 2 + TIMEOFF) / TIMEQ) * TIMEQ);
#endif
    { float* so = F.out + (smp ? O_SSMS + ((size_t)(sb * 16 + h) * 64) * 128 : O_SSMP + ((size_t)(sq * 16 + h) * 64) * 128);
#pragma unroll
      for (int q = 0; q < 4; ++q) *(f32x4*)(so + (16 * pt + (lane & 15)) * 128 + 16 * (4 * nh + q) + 4 * (lane >> 4)) = st[q]; }
    __syncthreads();
}
DI void p2a_phase(Ctx& F) {
    convbc_prepass(F);
    {
        const bf16_t* PROJ = (const bf16_t*)(F.ws + WS_PROJ);
        for (int i = F.bid * 512 + F.tid; i < 48 * 3 * 1536; i += F.G * 512) {
            const int ch = i % 1536, j = (i / 1536) % 3, sq = i / (3 * 1536);
            if (sq < NB_P) F.out[O_CONVP + (size_t)(sq * 3 + j) * 1536 + ch] = bf2f(PROJ[(size_t)(sq * T_P + T_P - 3 + j) * NPROJ + C_XBC + ch]);
            else F.out[O_CONVS + (size_t)((sq - NB_P) * 3 + j) * 1536 + ch] = bf2f(PROJ[(size_t)(MP + (sq - NB_P) * 64 + 61 + j) * NPROJ + C_XBC + ch]);
        }
    }
}
constexpr int WR_SLOT = 19456, WR_V = 9216, LDKW = 144, LDVW = 160;

constexpr int WR_ROPE = 4 * WR_SLOT + 512, WR_ROPE_LD = 272, WR_ROPE_BUF = 64 * 272;
constexpr int WR_GK = 4 * WR_SLOT, WR_GQ = 4 * WR_SLOT + 256;
struct KPre { f32x4 r[4]; };
DI void wa_kpre_load(Ctx& F, int pos, KPre& P) {
    const int q4 = F.tid & 3;
    const f32x4* rp = (const f32x4*)((const f32x2*)(F.ws + WS_ROPE) + pos * 32 + 8 * q4);
#pragma unroll
    for (int j = 0; j < 4; ++j) P.r[j] = rp[j];
}
DI void wa_write_k_pre(Ctx& F, LAS unsigned char* slot, int kvh, const u32x4 ra, const u32x4 rb, const KPre& P, float* ko, LAS unsigned char* ropew) {
    const int i = F.tid >> 2, q4 = F.tid & 3;
#pragma unroll
    for (int j = 0; j < 4; ++j) *(LAS f32x4*)(ropew + i * WR_ROPE_LD + q4 * 64 + 16 * j) = P.r[j];
    float a[8], bb[8], o1[8], o2[8];
    unpack8(ra, a); unpack8(rb, bb);
    float s = 0.f;
#pragma unroll
    for (int e = 0; e < 8; ++e) s += a[e] * a[e] + bb[e] * bb[e];
    s += __shfl_xor(s, 1); s += __shfl_xor(s, 2);
    const float rstd = __builtin_amdgcn_rsqf(s * (1.0f / 64.0f) + EPSF);
    f32x4 g_[4];
    { const LAS f32x4* gl = (const LAS f32x4*)(F.lds + WR_GK); g_[0] = gl[2 * q4]; g_[1] = gl[2 * q4 + 1]; g_[2] = gl[8 + 2 * q4]; g_[3] = gl[8 + 2 * q4 + 1]; }
#pragma unroll
    for (int e = 0; e < 8; ++e) { const float an = a[e] * rstd * g_[e >> 2][e & 3], bn = bb[e] * rstd * g_[2 + (e >> 2)][e & 3];
        const float cx = P.r[e >> 1][2 * (e & 1)], cy = P.r[e >> 1][2 * (e & 1) + 1]; o1[e] = an * cx - bn * cy; o2[e] = bn * cx + an * cy; }
    *(LAS u32x4*)(slot + i * LDKW + (8 * q4) * 2) = pack8(o1);
    *(LAS u32x4*)(slot + i * LDKW + (32 + 8 * q4) * 2) = pack8(o2);
    if (ko) { float* p = ko + ((size_t)i * 2 + kvh) * 64;
        *(f32x4*)(p + 8 * q4) = (f32x4){o1[0], o1[1], o1[2], o1[3]}; *(f32x4*)(p + 8 * q4 + 4) = (f32x4){o1[4], o1[5], o1[6], o1[7]};
        *(f32x4*)(p + 32 + 8 * q4) = (f32x4){o2[0], o2[1], o2[2], o2[3]}; *(f32x4*)(p + 32 + 8 * q4 + 4) = (f32x4){o2[4], o2[5], o2[6], o2[7]}; }
}
DI void wa_write_k(Ctx& F, LAS unsigned char* slot, int kvh, const u32x4 ra, const u32x4 rb, int pos, float* ko) {
    const int i = F.tid >> 2, q4 = F.tid & 3;
    float a[8], bb[8], o1[8], o2[8];
    unpack8(ra, a); unpack8(rb, bb);
    float s = 0.f;
#pragma unroll
    for (int e = 0; e < 8; ++e) s += a[e] * a[e] + bb[e] * bb[e];
    s += __shfl_xor(s, 1); s += __shfl_xor(s, 2);
    const float rstd = __builtin_amdgcn_rsqf(s * (1.0f / 64.0f) + EPSF);
    const f32x2* ROPE = (const f32x2*)(F.ws + WS_ROPE);
    float gk1[8], gk2[8]; f32x2 rcs[8];
    { const f32x4 a0 = *(const f32x4*)(F.in[I_GK] + 8 * q4), a1 = *(const f32x4*)(F.in[I_GK] + 8 * q4 + 4), b0 = *(const f32x4*)(F.in[I_GK] + 32 + 8 * q4), b1 = *(const f32x4*)(F.in[I_GK] + 32 + 8 * q4 + 4);
#pragma unroll
      for (int e = 0; e < 4; ++e) { gk1[e] = a0[e]; gk1[4 + e] = a1[e]; gk2[e] = b0[e]; gk2[4 + e] = b1[e]; }
      const f32x4* rp = (const f32x4*)(ROPE + pos * 32 + 8 * q4);
#pragma unroll
      for (int i = 0; i < 4; ++i) { const f32x4 t4 = rp[i]; rcs[2 * i] = (f32x2){t4.x, t4.y}; rcs[2 * i + 1] = (f32x2){t4.z, t4.w}; } }
#pragma unroll
    for (int e = 0; e < 8; ++e) { const float an = a[e] * rstd * gk1[e], bn = bb[e] * rstd * gk2[e];
        const f32x2 cs = rcs[e]; o1[e] = an * cs.x - bn * cs.y; o2[e] = bn * cs.x + an * cs.y; }
    *(LAS u32x4*)(slot + i * LDKW + (8 * q4) * 2) = pack8(o1);
    *(LAS u32x4*)(slot + i * LDKW + (32 + 8 * q4) * 2) = pack8(o2);
    if (ko) { float* p = ko + ((size_t)i * 2 + kvh) * 64;
        *(f32x4*)(p + 8 * q4) = (f32x4){o1[0], o1[1], o1[2], o1[3]}; *(f32x4*)(p + 8 * q4 + 4) = (f32x4){o1[4], o1[5], o1[6], o1[7]};
        *(f32x4*)(p + 32 + 8 * q4) = (f32x4){o2[0], o2[1], o2[2], o2[3]}; *(f32x4*)(p + 32 + 8 * q4 + 4) = (f32x4){o2[4], o2[5], o2[6], o2[7]}; }
}
DI void wa_write_v(Ctx& F, LAS unsigned char* slot, int kvh, const u32x4 rv, float* vo) {
    const int i = F.tid >> 3, q8 = F.tid & 7;
    *(LAS u32x4*)(slot + WR_V + i * LDVW + q8 * 16) = rv;
    if (vo) { float v[8]; unpack8(rv, v); float* p = vo + ((size_t)i * 2 + kvh) * 64 + 8 * q8;
        *(f32x4*)p = (f32x4){v[0], v[1], v[2], v[3]}; *(f32x4*)(p + 4) = (f32x4){v[4], v[5], v[6], v[7]}; }
}
DI void wa_stage_cache(Ctx& F, LAS unsigned char* slot, int kvh, const float* ck, const float* cv, float* ko, float* vo) {
    if (F.tid < 256) { const int i = F.tid >> 2, q4 = F.tid & 3; const float* src = ck + ((size_t)i * 2 + kvh) * 64;
        const f32x4 a0 = *(const f32x4*)(src + 8 * q4), a1 = *(const f32x4*)(src + 8 * q4 + 4), b0 = *(const f32x4*)(src + 32 + 8 * q4), b1 = *(const f32x4*)(src + 32 + 8 * q4 + 4);
        u32x4 pa, pb; pa.x = pk2(a0.x, a0.y); pa.y = pk2(a0.z, a0.w); pa.z = pk2(a1.x, a1.y); pa.w = pk2(a1.z, a1.w); pb.x = pk2(b0.x, b0.y); pb.y = pk2(b0.z, b0.w); pb.z = pk2(b1.x, b1.y); pb.w = pk2(b1.z, b1.w);
        *(LAS u32x4*)(slot + i * LDKW + (8 * q4) * 2) = pa; *(LAS u32x4*)(slot + i * LDKW + (32 + 8 * q4) * 2) = pb;
        if (ko) { float* p = ko + ((size_t)i * 2 + kvh) * 64; *(f32x4*)(p + 8 * q4) = a0; *(f32x4*)(p + 8 * q4 + 4) = a1; *(f32x4*)(p + 32 + 8 * q4) = b0; *(f32x4*)(p + 32 + 8 * q4 + 4) = b1; } }
    { const int i = F.tid >> 3, q8 = F.tid & 7; const float* src = cv + ((size_t)i * 2 + kvh) * 64 + 8 * q8; const f32x4 v0 = *(const f32x4*)src, v1 = *(const f32x4*)(src + 4);
      u32x4 pv; pv.x = pk2(v0.x, v0.y); pv.y = pk2(v0.z, v0.w); pv.z = pk2(v1.x, v1.y); pv.w = pk2(v1.z, v1.w);
      *(LAS u32x4*)(slot + WR_V + i * LDVW + q8 * 16) = pv;
      if (vo) { float* p = vo + ((size_t)i * 2 + kvh) * 64 + 8 * q8; *(f32x4*)p = v0; *(f32x4*)(p + 4) = v1; } }
}
DI void wa_load_q(Ctx& F, int kvh, size_t crow0, u32x4 (&qraw)[2][2]) {
    const int lane = F.lane, w = F.wave, g4 = lane >> 4; const int hq = kvh * 4 + (w >> 1);
    const bf16_t* PROJ = (const bf16_t*)(F.ws + WS_PROJ);
#pragma unroll
    for (int rg = 0; rg < 2; ++rg) { const size_t row = crow0 + 32 * (w & 1) + 16 * rg + (lane & 15);
        qraw[rg][0] = *(const u32x4*)(PROJ + row * NPROJ + C_Q + hq * 64 + 8 * g4); qraw[rg][1] = *(const u32x4*)(PROJ + row * NPROJ + C_Q + hq * 64 + 32 + 8 * g4); }
}
DI void wa_compute(Ctx& F, int kvh, size_t crow0, int pos0, int sl0, int sl1, int sl2, int ninv, const u32x4 (&qraw)[2][2], KPre& KP, int kpos, int ropesel) {
    LAS unsigned char* lds = F.lds;
    const int lane = F.lane, w = F.wave, g4 = lane >> 4;
    const bf16_t* PROJ = (const bf16_t*)(F.ws + WS_PROJ); const f32x2* ROPE = (const f32x2*)(F.ws + WS_ROPE); bf16_t* MIX = (bf16_t*)(F.ws + WS_MIX);
    const int hq = kvh * 4 + (w >> 1); const float sink = F.in[I_SINKS][hq] * 1.4426950408889634f;
    bf16x8 qa[2][2];
    float gq1[8], gq2[8];
    { f32x4 a0, a1, b0, b1;
      if (ropesel >= 0) { const LAS f32x4* gl = (const LAS f32x4*)(lds + WR_GQ); a0 = gl[2 * g4]; a1 = gl[2 * g4 + 1]; b0 = gl[8 + 2 * g4]; b1 = gl[8 + 2 * g4 + 1]; }
      else { a0 = *(const f32x4*)(F.in[I_GQ] + 8 * g4); a1 = *(const f32x4*)(F.in[I_GQ] + 8 * g4 + 4); b0 = *(const f32x4*)(F.in[I_GQ] + 32 + 8 * g4); b1 = *(const f32x4*)(F.in[I_GQ] + 32 + 8 * g4 + 4); }
#pragma unroll
      for (int e = 0; e < 4; ++e) { gq1[e] = a0[e]; gq1[4 + e] = a1[e]; gq2[e] = b0[e]; gq2[4 + e] = b1[e]; } }
#pragma unroll
    for (int rg = 0; rg < 2; ++rg) {
        const int d0 = 8 * g4; float a[8], bb[8];
        unpack8(qraw[rg][0], a);
        unpack8(qraw[rg][1], bb);
        float s = 0.f;
#pragma unroll
        for (int e = 0; e < 8; ++e) s += a[e] * a[e] + bb[e] * bb[e];
        s = xor32_sum(xor16_sum(s));
        const float rstd = 0.18033688011112042f * __builtin_amdgcn_rsqf(s * (1.0f / 64.0f) + EPSF);
        const int pos = pos0 + 32 * (w & 1) + 16 * rg + (lane & 15);
        f32x2 rcs[8];
        if (ropesel >= 0) { const LAS f32x4* rp = (const LAS f32x4*)(lds + WR_ROPE + ropesel * WR_ROPE_BUF + (32 * (w & 1) + 16 * rg + (lane & 15)) * WR_ROPE_LD + g4 * 64);
#pragma unroll
          for (int i = 0; i < 4; ++i) { const f32x4 t4 = rp[i]; rcs[2 * i] = (f32x2){t4.x, t4.y}; rcs[2 * i + 1] = (f32x2){t4.z, t4.w}; } }
        else { const f32x4* rp = (const f32x4*)(ROPE + pos * 32 + d0);
#pragma unroll
          for (int i = 0; i < 4; ++i) { const f32x4 t4 = rp[i]; rcs[2 * i] = (f32x2){t4.x, t4.y}; rcs[2 * i + 1] = (f32x2){t4.z, t4.w}; } }
        float o1[8], o2[8];
#pragma unroll
        for (int e = 0; e < 8; ++e) { const float an = a[e] * rstd * gq1[e], bn = bb[e] * rstd * gq2[e];
            const f32x2 cs = rcs[e]; o1[e] = an * cs.x - bn * cs.y; o2[e] = bn * cs.x + an * cs.y; }
        qa[rg][0] = __builtin_bit_cast(bf16x8, pack8(o1)); qa[rg][1] = __builtin_bit_cast(bf16x8, pack8(o2)); }
    f32x4 s[2][12];
#pragma unroll
    for (int jt = 0; jt < 12; ++jt) { const int j = jt >> 2; const LAS unsigned char* kt = lds + (j == 0 ? sl0 : (j == 1 ? sl1 : sl2)) * WR_SLOT;
        const bf16x8 k0 = lds_frag(kt, LDKW, 16 * (jt & 3), 0, lane), k1 = lds_frag(kt, LDKW, 16 * (jt & 3), 32, lane);
#pragma unroll
        for (int rg = 0; rg < 2; ++rg) { f32x4 acc = {0.f, 0.f, 0.f, 0.f};
            acc = MFMA16T(qa[rg][0], k0, acc); acc = MFMA16T(qa[rg][1], k1, acc);
            s[rg][jt] = acc; }
        if ((jt & 3) == 3) __builtin_amdgcn_sched_barrier(0); }
    u32x2 graw[2][4];
#pragma unroll
    for (int rg = 0; rg < 2; ++rg) { const size_t row = crow0 + 32 * (w & 1) + 16 * rg + (lane & 15);
#pragma unroll
        for (int dt = 0; dt < 4; ++dt) graw[rg][dt] = *(const u32x2*)(PROJ + row * NPROJ + C_GA + hq * 64 + 16 * dt + 4 * g4); }
    if (ninv > 0) {
#pragma unroll
        for (int jt = 0; jt < 8; ++jt) if ((jt >> 2) < ninv) { s[0][jt] = (f32x4){-1e30f, -1e30f, -1e30f, -1e30f}; s[1][jt] = (f32x4){-1e30f, -1e30f, -1e30f, -1e30f}; } }
    float inv[2]; bf16x8 pa[2][6];
#pragma unroll
    for (int rg = 0; rg < 2; ++rg) {
        float m = sink;
#pragma unroll
        for (int jt = 0; jt < 12; ++jt)
#pragma unroll
            for (int r = 0; r < 4; ++r) m = fmaxf(m, s[rg][jt][r]);
        m = xor32_max(xor16_max(m));
        float sum = 0.f;
#pragma unroll
        for (int jt = 0; jt < 12; ++jt)
#pragma unroll
            for (int r = 0; r < 4; ++r) { const float e = __builtin_amdgcn_exp2f(s[rg][jt][r] - m); s[rg][jt][r] = e; sum += e; }
        sum = xor32_sum(xor16_sum(sum));
        inv[rg] = __builtin_amdgcn_rcpf(sum + __builtin_amdgcn_exp2f(sink - m));
#pragma unroll
        for (int k2 = 0; k2 < 6; ++k2) { u32x4 t; t.x = pk2(s[rg][2 * k2][0], s[rg][2 * k2][1]); t.y = pk2(s[rg][2 * k2][2], s[rg][2 * k2][3]);
            t.z = pk2(s[rg][2 * k2 + 1][0], s[rg][2 * k2 + 1][1]); t.w = pk2(s[rg][2 * k2 + 1][2], s[rg][2 * k2 + 1][3]);
            pa[rg][k2] = __builtin_bit_cast(bf16x8, t); } }
    __builtin_amdgcn_sched_barrier(0);
    if (kpos >= 0 && F.tid < 256) wa_kpre_load(F, kpos, KP);
#pragma unroll
    for (int dt = 0; dt < 4; ++dt) { f32x4 o[2] = {{0.f, 0.f, 0.f, 0.f}, {0.f, 0.f, 0.f, 0.f}};
#pragma unroll
        for (int k2 = 0; k2 < 6; ++k2) { const int j = k2 >> 1; const LAS unsigned char* vt = lds + (j == 0 ? sl0 : (j == 1 ? sl1 : sl2)) * WR_SLOT + WR_V;
            const bf16x8 vf = lds_frag_tr2(vt, LDVW, 32 * (k2 & 1), 16 * dt, lane);
            o[0] = MFMA16T(pa[0][k2], vf, o[0]); o[1] = MFMA16T(pa[1][k2], vf, o[1]); }
#pragma unroll
        for (int rg = 0; rg < 2; ++rg) { const size_t row = crow0 + 32 * (w & 1) + 16 * rg + (lane & 15);
            const float gv[4] = {__uint_as_float(graw[rg][dt].x << 16), __uint_as_float(graw[rg][dt].x & 0xffff0000u), __uint_as_float(graw[rg][dt].y << 16), __uint_as_float(graw[rg][dt].y & 0xffff0000u)};
            u32x2 pk; pk.x = pk2(o[rg][0] * inv[rg] * siluf(gv[0]), o[rg][1] * inv[rg] * siluf(gv[1])); pk.y = pk2(o[rg][2] * inv[rg] * siluf(gv[2]), o[rg][3] * inv[rg] * siluf(gv[3]));
            *(u32x2*)(MIX + row * 2048 + 1024 + hq * 64 + 16 * dt + 4 * g4) = pk; }
        __builtin_amdgcn_sched_barrier(0); }
}
DI void winattn_item(Ctx& F, int item) {
    LAS unsigned char* lds = F.lds;
    int tl_ = F.tid; asm volatile("" : "+v"(tl_)); const int tid = tl_;
    const bf16_t* PROJ = (const bf16_t*)(F.ws + WS_PROJ);
    if (item >= 256) {
        const int sb = (item - 256) >> 1, kvh = item & 1; const size_t row0 = (size_t)MP + sb * 64;
        const float* ck = F.in[I_CWK] + (size_t)sb * 128 * 128; const float* cv = F.in[I_CWV] + (size_t)sb * 128 * 128;
        float* ko = F.out + O_WKS + (size_t)sb * 128 * 128; float* vo = F.out + O_WVS + (size_t)sb * 128 * 128;
        wa_stage_cache(F, lds + 0 * WR_SLOT, kvh, ck, cv, nullptr, nullptr);
        wa_stage_cache(F, lds + 1 * WR_SLOT, kvh, ck + 64 * 128, cv + 64 * 128, ko, vo);
        if (tid < 256) { const int i = tid >> 2, q4 = tid & 3; const bf16_t* p = PROJ + (row0 + i) * NPROJ + C_K + kvh * 64 + 8 * q4;
            wa_write_k(F, lds + 2 * WR_SLOT, kvh, *(const u32x4*)p, *(const u32x4*)(p + 32), 2048 + i, ko + 64 * 128); }
        { const int i = tid >> 3, q8 = tid & 7; wa_write_v(F, lds + 2 * WR_SLOT, kvh, *(const u32x4*)(PROJ + (row0 + i) * NPROJ + C_V + kvh * 64 + 8 * q8), vo + 64 * 128); }
        u32x4 sq_[2][2]; wa_load_q(F, kvh, row0, sq_);
        __syncthreads();
        { KPre kp_; wa_compute(F, kvh, row0, 2048, 0, 1, 2, 0, sq_, kp_, -1, -1); }
        __syncthreads();
        return;
    }
    const int b = item >> 4, kvh = (item >> 3) & 1, c0 = (item & 7) * 8;
    const size_t seq0 = (size_t)b * T_P;
    { u32x4 pka[3], pkb[3], pvv[3];
#pragma unroll
      for (int j = 0; j < 3; ++j) { const int kc = c0 - 2 + j; const size_t row0 = seq0 + (size_t)(kc < 0 ? 0 : kc) * 64;
          const bf16_t* p = PROJ + (row0 + (tid >> 2)) * NPROJ + C_K + kvh * 64 + 8 * (tid & 3);
          pka[j] = *(const u32x4*)p; pkb[j] = *(const u32x4*)(p + 32);
          pvv[j] = *(const u32x4*)(PROJ + (row0 + (tid >> 3)) * NPROJ + C_V + kvh * 64 + 8 * (tid & 7)); }
#pragma unroll
      for (int j = 0; j < 3; ++j) { const int kc = c0 - 2 + j; LAS unsigned char* slot = lds + (kc & 3) * WR_SLOT;
          if (kc < 0) { for (int t = tid; t < WR_SLOT / 16; t += 512) *(LAS u32x4*)(slot + t * 16) = (u32x4){0u, 0u, 0u, 0u}; }
          else { if (tid < 256) wa_write_k(F, slot, kvh, pka[j], pkb[j], kc * 64 + (tid >> 2), nullptr);
                 wa_write_v(F, slot, kvh, pvv[j], nullptr); } } }
    u32x4 nq[2][2];
    wa_load_q(F, kvh, seq0 + (size_t)c0 * 64, nq);
    { int t_ = tid; asm volatile("" : "+v"(t_));
      if (t_ < 128) ((LAS float*)(lds + WR_GK))[t_] = (t_ < 64 ? F.in[I_GK] : F.in[I_GQ] - 64)[t_];
      if (t_ < 256) { const f32x4* rp = (const f32x4*)((const f32x2*)(F.ws + WS_ROPE) + (c0 * 64 + (t_ >> 2)) * 32 + 8 * (t_ & 3));
#pragma unroll
          for (int j = 0; j < 4; ++j) *(LAS f32x4*)(lds + WR_ROPE + (c0 & 1) * WR_ROPE_BUF + (t_ >> 2) * WR_ROPE_LD + (t_ & 3) * 64 + 16 * j) = rp[j]; } }
    __syncthreads();
#pragma unroll 1
    for (int c = c0; c < c0 + 8; ++c) {
        const bool more = c + 1 < c0 + 8;
        u32x4 cq[2][2]; KPre kp;
#pragma unroll
        for (int rg = 0; rg < 2; ++rg) { cq[rg][0] = nq[rg][0]; cq[rg][1] = nq[rg][1]; }
        u32x4 ra = {0u, 0u, 0u, 0u}, rb = {0u, 0u, 0u, 0u}, rv = {0u, 0u, 0u, 0u};
        const size_t nrow0 = seq0 + (size_t)(c + 1) * 64;
        if (more) {
            if (tid < 256) { const bf16_t* p = PROJ + (nrow0 + (tid >> 2)) * NPROJ + C_K + kvh * 64 + 8 * (tid & 3); ra = *(const u32x4*)p; rb = *(const u32x4*)(p + 32); }
            rv = *(const u32x4*)(PROJ + (nrow0 + (tid >> 3)) * NPROJ + C_V + kvh * 64 + 8 * (tid & 7));
            wa_load_q(F, kvh, nrow0, nq); }
        wa_compute(F, kvh, seq0 + (size_t)c * 64, c * 64, (c - 2) & 3, (c - 1) & 3, c & 3, c >= 2 ? 0 : 2 - c, cq, kp, more ? (c + 1) * 64 + (tid >> 2) : -1, c & 1);
        if (more) { LAS unsigned char* slot = lds + ((c + 1) & 3) * WR_SLOT; const int kc = c + 1;
            float* ko = nullptr; float* vo = nullptr;
            if (kc >= 62) { ko = F.out + O_WKP + ((size_t)b * 128 + (kc - 62) * 64) * 128; vo = F.out + O_WVP + ((size_t)b * 128 + (kc - 62) * 64) * 128; }
            if (tid < 256) wa_write_k_pre(F, slot, kvh, ra, rb, kp, ko, lds + WR_ROPE + (kc & 1) * WR_ROPE_BUF);
            wa_write_v(F, slot, kvh, rv, vo); }
        __syncthreads();
    }
}

constexpr int MA_K = 0, MA_V = 69632, MA_RS = 143360, LDKM = 272, LDVM = 288;
DI void memattn_item(Ctx& F, int item) {
    LAS unsigned char* lds = F.lds;
#if CLKPROBE == 40 || CLKPROBE == 41
    const long long mt0_ = (long long)__builtin_amdgcn_s_memrealtime(); long long mt1_ = 0;
#endif
    int tl_ = F.tid; asm volatile("" : "+v"(tl_)); const int tid = tl_, lane = tl_ & 63, w = F.wave, g4 = lane >> 4;
    const bool smp = item >= 256; const int sidx = item - 256;
    const int bb = smp ? (sidx >> 2) : (item >> 4), h = smp ? (sidx & 3) : ((item >> 2) & 3), qt = item & 3;
    const bf16_t* PROJ = (const bf16_t*)(F.ws + WS_PROJ); bf16_t* MIX = (bf16_t*)(F.ws + WS_MIX); const bf16_t* RAW = (const bf16_t*)(F.ws + WS_MEMRAW);
    float gmk8[8], gmq8[8];
    { const f32x4 a0 = *(const f32x4*)(F.in[I_GMK] + 8 * (tid & 15)), a1 = *(const f32x4*)(F.in[I_GMK] + 8 * (tid & 15) + 4), q0 = *(const f32x4*)(F.in[I_GMQ] + 8 * (tid & 15)), q1 = *(const f32x4*)(F.in[I_GMQ] + 8 * (tid & 15) + 4);
#pragma unroll
      for (int e = 0; e < 4; ++e) { gmk8[e] = a0[e]; gmk8[4 + e] = a1[e]; gmq8[e] = q0[e]; gmq8[4 + e] = q1[e]; } }
    u32x4 rk2[2][4], rv2[2][4];
    if (!smp) {
#pragma unroll
      for (int ib = 0; ib < 2; ++ib)
#pragma unroll
        for (int u = 0; u < 4; ++u) { const int t = tid + 512 * (4 * ib + u), key = t >> 4, ch = t & 15;
          rk2[ib][u] = *(const u32x4*)(RAW + (size_t)(bb * 256 + key) * 1024 + h * 128 + 8 * ch); rv2[ib][u] = *(const u32x4*)(RAW + (size_t)(bb * 256 + key) * 1024 + 512 + h * 128 + 8 * ch); } }
#pragma unroll
    for (int ib = 0; ib < 2; ++ib) {
      f32x4 fk[4][2], fv[4][2];
      if (smp) {
#pragma unroll
        for (int u = 0; u < 4; ++u) { const int t = tid + 512 * (4 * ib + u), key = t >> 4, ch = t & 15;
          const float* ks = F.in[I_CMK] + ((size_t)(bb * 256 + key) * 4 + h) * 128 + 8 * ch; const float* vs = F.in[I_CMV] + ((size_t)(bb * 256 + key) * 4 + h) * 128 + 8 * ch;
          fk[u][0] = *(const f32x4*)ks; fk[u][1] = *(const f32x4*)(ks + 4); fv[u][0] = *(const f32x4*)vs; fv[u][1] = *(const f32x4*)(vs + 4); } }
#pragma unroll
      for (int u = 0; u < 4; ++u) { const int t = tid + 512 * (4 * ib + u), key = t >> 4, ch = t & 15;
        float k[8], v[8];
        if (smp) {
#pragma unroll
            for (int e = 0; e < 4; ++e) { k[e] = fk[u][0][e]; k[4 + e] = fk[u][1][e]; v[e] = fv[u][0][e]; v[4 + e] = fv[u][1][e]; } }
        else { unpack8(rk2[ib][u], k); unpack8(rv2[ib][u], v); }
        float s = 0.f;
#pragma unroll
        for (int e = 0; e < 8; ++e) s += k[e] * k[e];
        s = row16_sum(s);
        if (!smp) { const float rstd = __builtin_amdgcn_rsqf(s * (1.0f / 128.0f) + EPSF);
#pragma unroll
            for (int e = 0; e < 8; ++e) k[e] = k[e] * rstd * gmk8[e]; }
        { float kq[8];
#pragma unroll
          for (int e = 0; e < 8; ++e) kq[e] = k[e] * gmq8[e];
          *(LAS u32x4*)(lds + MA_K + key * LDKM + ch * 16) = pack8(kq); }
        *(LAS u32x4*)(lds + MA_V + key * LDVM + ch * 16) = smp ? pack8(v) : rv2[ib][u];
        if (!smp && qt == 0) {
            float* ko = F.out + O_MKP + ((size_t)(bb * 256 + key) * 4 + h) * 128 + 8 * ch; float* vo = F.out + O_MVP + ((size_t)(bb * 256 + key) * 4 + h) * 128 + 8 * ch;
            *(f32x4*)ko = (f32x4){k[0], k[1], k[2], k[3]}; *(f32x4*)(ko + 4) = (f32x4){k[4], k[5], k[6], k[7]};
            *(f32x4*)vo = (f32x4){v[0], v[1], v[2], v[3]}; *(f32x4*)(vo + 4) = (f32x4){v[4], v[5], v[6], v[7]}; }
      }
    }
    __syncthreads();
#if CLKPROBE == 40 || CLKPROBE == 41
    mt1_ = (long long)__builtin_amdgcn_s_memrealtime();
#endif
    const int ngr = smp ? 4 : 64;
    const size_t qbase = smp ? (size_t)MP + bb * 64 : (size_t)bb * T_P + qt * 1024;
    const int npair = ngr >> 1;
    u32x4 nq[2][4];
#define MA_LOADQ(p_) do { _Pragma("unroll") for (int rg_ = 0; rg_ < 2; ++rg_) { const size_t r_ = qbase + 32 * (p_) + 16 * rg_ + (lane & 15); \
        _Pragma("unroll") for (int ks = 0; ks < 4; ++ks) nq[rg_][ks] = *(const u32x4*)(PROJ + r_ * NPROJ + C_MQ + h * 128 + 32 * ks + 8 * g4); } } while (0)
    if (w < npair) MA_LOADQ(w);
#pragma unroll 1
    for (int p = w; p < npair; p += 8) {
        u32x4 cq[2][4]; u32x2 cg[2][8];
#pragma unroll
        for (int rg = 0; rg < 2; ++rg) {
#pragma unroll
            for (int ks = 0; ks < 4; ++ks) cq[rg][ks] = nq[rg][ks];
            const size_t r_ = qbase + 32 * p + 16 * rg + (lane & 15);
#pragma unroll
            for (int dt = 0; dt < 8; ++dt) cg[rg][dt] = *(const u32x2*)(PROJ + r_ * NPROJ + C_GM + h * 128 + 16 * dt + 4 * g4); }
        if (p + 8 < npair) MA_LOADQ(p + 8);
        float inv[2]; bf16x8 pa[2][8];
#pragma unroll
        for (int rg = 0; rg < 2; ++rg) {
            bf16x8 qa[4];
            { float q[4][8]; float s = 0.f;
#pragma unroll
              for (int ks = 0; ks < 4; ++ks) { unpack8(cq[rg][ks], q[ks]);
#pragma unroll
                  for (int e = 0; e < 8; ++e) s += q[ks][e] * q[ks][e]; }
              s = xor32_sum(xor16_sum(s));
              const float rstd = 0.12751743082459868f * __builtin_amdgcn_rsqf(s * (1.0f / 128.0f) + EPSF);
#pragma unroll
              for (int ks = 0; ks < 4; ++ks) {
#pragma unroll
                  for (int e = 0; e < 8; ++e) q[ks][e] = q[ks][e] * rstd;
                  qa[ks] = __builtin_bit_cast(bf16x8, pack8(q[ks])); } }
            f32x4 s[16];
#pragma unroll
            for (int jt = 0; jt < 16; ++jt) { f32x4 acc = {0.f, 0.f, 0.f, 0.f};
#pragma unroll
                for (int ks = 0; ks < 4; ++ks) acc = MFMA16T(qa[ks], lds_frag(lds + MA_K, LDKM, 16 * jt, 32 * ks, lane), acc);
                s[jt] = acc;
                if ((jt & 1) == 1) __builtin_amdgcn_sched_barrier(0); }
            float m = s[0][0];
#pragma unroll
            for (int jt = 0; jt < 16; ++jt)
#pragma unroll
                for (int r = 0; r < 4; ++r) m = fmaxf(m, s[jt][r]);
            m = xor32_max(xor16_max(m));
            float sum = 0.f;
#pragma unroll
            for (int jt = 0; jt < 16; ++jt)
#pragma unroll
                for (int r = 0; r < 4; ++r) { const float e = __builtin_amdgcn_exp2f(s[jt][r] - m); s[jt][r] = e; sum += e; }
            sum = xor32_sum(xor16_sum(sum));
            inv[rg] = __builtin_amdgcn_rcpf(sum);
#pragma unroll
            for (int k2 = 0; k2 < 8; ++k2) { u32x4 t; t.x = pk2(s[2 * k2][0], s[2 * k2][1]); t.y = pk2(s[2 * k2][2], s[2 * k2][3]); t.z = pk2(s[2 * k2 + 1][0], s[2 * k2 + 1][1]); t.w = pk2(s[2 * k2 + 1][2], s[2 * k2 + 1][3]);
                pa[rg][k2] = __builtin_bit_cast(bf16x8, t); }
            __builtin_amdgcn_sched_barrier(0); }
#pragma unroll
        for (int dt = 0; dt < 8; ++dt) { f32x4 o[2] = {{0.f, 0.f, 0.f, 0.f}, {0.f, 0.f, 0.f, 0.f}};
#pragma unroll
            for (int k2 = 0; k2 < 8; ++k2) { const bf16x8 vf = lds_frag_tr2(lds + MA_V, LDVM, 32 * k2, 16 * dt, lane);
                o[0] = MFMA16T(pa[0][k2], vf, o[0]); o[1] = MFMA16T(pa[1][k2], vf, o[1]); }
            __builtin_amdgcn_sched_barrier(0);
            const int col = h * 128 + 16 * dt + 4 * g4;
#pragma unroll
            for (int rg = 0; rg < 2; ++rg) { const size_t orow = qbase + 32 * p + 16 * rg + (lane & 15);
                const u32x2 gr = cg[rg][dt];
                const float gv[4] = {__uint_as_float(gr.x << 16), __uint_as_float(gr.x & 0xffff0000u), __uint_as_float(gr.y << 16), __uint_as_float(gr.y & 0xffff0000u)};
                u32x2 pk; pk.x = pk2(o[rg][0] * inv[rg] * siluf(gv[0]), o[rg][1] * inv[rg] * siluf(gv[1])); pk.y = pk2(o[rg][2] * inv[rg] * siluf(gv[2]), o[rg][3] * inv[rg] * siluf(gv[3]));
                *(u32x2*)(MIX + orow * 2048 + 1536 + col) = pk; } }
    }
#undef MA_LOADQ
    __syncthreads();
#if CLKPROBE == 40 || CLKPROBE == 41
    if (threadIdx.x == 0 && item < 256) g_dbg[blockIdx.x] += (CLKPROBE == 40) ? (mt1_ - mt0_) : ((long long)__builtin_amdgcn_s_memrealtime() - mt1_);
#endif
}

DI void p2a_attn(Ctx& F) {
    for (int rep = 0; rep < REP_WIN; ++rep)
    for (int it = F.bid; it < 320; it += F.G) {
#if CLKPROBE == 42 || CLKPROBE == 43
        const long long t0_ = (long long)__builtin_amdgcn_s_memrealtime();
#endif
        winattn_item(F, it);
#if CLKPROBE == 42 || CLKPROBE == 43
        if (threadIdx.x == 0 && ((CLKPROBE == 42) == (it < 256))) g_dbg[blockIdx.x] += (long long)__builtin_amdgcn_s_memrealtime() - t0_;
#endif
    }
    __syncthreads();
    for (int rep = 0; rep < REP_MEM; ++rep)
    { for (int it = F.bid; it < 256; it += F.G) memattn_item(F, it);
      for (int s = (F.bid + F.G - (128 % F.G)) % F.G; s < 128; s += F.G) memattn_item(F, 256 + s); }
}
DI void p2b_phase(Ctx& F) {
    for (int rep = 0; rep < REP_SSD; ++rep)
    for (int it = F.bid; it < 48 * 16; it += F.G) {
#if CLKPROBE == 30 || CLKPROBE == 31
        const long long t0_ = (long long)__builtin_amdgcn_s_memrealtime();
#endif
        ssd_item(F, it >> 4, it & 15, rep == 0);
#if CLKPROBE == 30 || CLKPROBE == 31
        if (threadIdx.x == 0 && ((CLKPROBE == 30) == (it < 256))) g_dbg[blockIdx.x] += (long long)__builtin_amdgcn_s_memrealtime() - t0_;
#endif
    }
}

constexpr int G3_LD = 272, G3_A = 0, G3_B = 64 * 272, G3_SET = 192 * 272;
DI void gemm2_sample(Ctx& F) {
    LAS unsigned char* lds = F.lds;
    const int tid = F.tid, lane = F.lane, w = F.wave, g4 = lane >> 4;
    const bf16_t* MIX = (const bf16_t*)(F.ws + WS_MIX); const bf16_t* WOT = (const bf16_t*)(F.ws + WS_WOUT); const float* SUMSQ = (const float*)(F.ws + WS_SSQ);
    for (int tile = F.bid; tile < 256; tile += F.G) {
        const int r0 = MP + 64 * (tile >> 3), c0 = 128 * (tile & 7);
        const int prow = tid >> 4, pk = tid & 15;
        const bf16_t* asrc = MIX + (size_t)(r0 + prow) * 2048 + 8 * pk;
        const bf16_t* bsrc = WOT + (size_t)(c0 + prow) * 2048 + 8 * pk;
        const int aoff = G3_A + prow * G3_LD + pk * 16, boff = G3_B + prow * G3_LD + pk * 16;
        f32x4 acc[4] = {{0.f, 0.f, 0.f, 0.f}, {0.f, 0.f, 0.f, 0.f}, {0.f, 0.f, 0.f, 0.f}, {0.f, 0.f, 0.f, 0.f}};
        u32x4 ra[4][2], rb[4][4];
#define G3_ISSUE(s_, kt_) do { _Pragma("unroll") for (int i_ = 0; i_ < 2; ++i_) ra[s_][i_] = *(const u32x4*)(asrc + (size_t)i_ * 32 * 2048 + 128 * (kt_)); \
            _Pragma("unroll") for (int j_ = 0; j_ < 4; ++j_) rb[s_][j_] = *(const u32x4*)(bsrc + (size_t)j_ * 32 * 2048 + 128 * (kt_)); } while (0)
#define G3_WRITE(set_, s_) do { _Pragma("unroll") for (int i_ = 0; i_ < 2; ++i_) *(LAS u32x4*)((set_) + aoff + i_ * 32 * G3_LD) = ra[s_][i_]; \
            _Pragma("unroll") for (int j_ = 0; j_ < 4; ++j_) *(LAS u32x4*)((set_) + boff + j_ * 32 * G3_LD) = rb[s_][j_]; } while (0)
        G3_ISSUE(0, 0); G3_ISSUE(1, 1); G3_ISSUE(2, 2); G3_ISSUE(3, 3);
        G3_WRITE(lds, 0);
        G3_ISSUE(0, 4);
        __syncthreads();
#pragma unroll 1
        for (int kt4 = 0; kt4 < 16; kt4 += 4) {
#pragma unroll
            for (int u = 0; u < 4; ++u) { const int kt = kt4 + u;
                const LAS unsigned char* cs = lds + (u & 1) * G3_SET; LAS unsigned char* ns = lds + ((u + 1) & 1) * G3_SET;
                if (kt == 8) { const float r = __builtin_amdgcn_rsqf(SUMSQ[r0 + 16 * (w >> 1) + (lane & 15)] * (1.0f / 1024.0f) + EPSF);
#pragma unroll
                    for (int t = 0; t < 4; ++t) acc[t] = acc[t] * r; }
#pragma unroll
                for (int ks = 0; ks < 4; ++ks) { const bf16x8 a = lds_frag(cs + G3_A, G3_LD, 16 * (w >> 1), 32 * ks, lane);
#pragma unroll
                    for (int t = 0; t < 4; ++t) acc[t] = MFMA16T(a, lds_frag(cs + G3_B, G3_LD, 64 * (w & 1) + 16 * t, 32 * ks, lane), acc[t]); }
                const int rs = (u + 1) & 3;
                if (kt + 1 < 16) G3_WRITE(ns, rs);
                if (kt + 5 < 16) G3_ISSUE(rs, kt + 5);
                __syncthreads();
            }
        }
#undef G3_ISSUE
#undef G3_WRITE
        const int row = r0 + 16 * (w >> 1) + (lane & 15), cw = c0 + 64 * (w & 1) + 4 * g4;
        const float* xr = F.in[I_XS] + (size_t)(row - MP) * DM + cw; float* orow = F.out + (size_t)row * DM + cw;
#pragma unroll
        for (int t = 0; t < 4; ++t) *(f32x4*)(orow + 16 * t) = acc[t] + *(const f32x4*)(xr + 16 * t);
    }
}
__global__ void __launch_bounds__(512, 2) hymba_fwd(Args args) {
    extern __shared__ __attribute__((aligned(16))) unsigned char lds_raw[];
    cg::grid_group grid = cg::this_grid();
    Ctx F;
    F.lds = (LAS unsigned char*)lds_raw; F.tid = threadIdx.x; F.lane = F.tid & 63; F.wave = __builtin_amdgcn_readfirstlane(F.tid >> 6); F.G = gridDim.x; F.bid = blockIdx.x;
#pragma unroll
    for (int i = 0; i < 26; ++i) F.in[i] = args.in[i];
    F.out = args.out; F.ws = args.ws;
    float dbgval = 0.f; (void)dbgval;
#if CLKPROBE >= 20
    if (threadIdx.x == 0) g_dbg[blockIdx.x] = 0;
#endif
#if CLKPROBE
    long long phc0_ = 0, phr0_ = 0;
#define PH_BEGIN(k) do { if (CLKPROBE == (k)) { phc0_ = (long long)__builtin_amdgcn_s_memtime(); phr0_ = (long long)__builtin_amdgcn_s_memrealtime(); } } while (0)
#define PH_END(k) do { if (CLKPROBE == (k)) { const long long c1_ = (long long)__builtin_amdgcn_s_memtime(), r1_ = (long long)__builtin_amdgcn_s_memrealtime(); \
        const long long v_ = CLKWHAT == 0 ? ((c1_ - phc0_) * 100) / (r1_ - phr0_) : (r1_ - phr0_) / 100; \
        if (threadIdx.x == 0) ((float*)(F.ws + WS_CTL + 32768))[F.bid] = (float)v_; \
        if (F.bid == 0 && threadIdx.x == 0) dbgval = (float)(((v_ + TIMEQ / 2 + TIMEOFF) / TIMEQ) * TIMEQ); } } while (0)
#else
#define PH_BEGIN(k) do { } while (0)
#define PH_END(k) do { } while (0)
#endif
    volatile LAS unsigned* bst = (volatile LAS unsigned*)(F.lds + LDS_BYTES - 64);
    if (F.tid < 16) bst[F.tid] = 0u;
    __syncthreads();
    const XcdBarrier xbar = xcd_barrier_post((unsigned*)(F.ws + WS_CTL), bst);
#define GRID_BAR() xcd_barrier(xbar)

#define PHASE_FENCE() do { int t_ = threadIdx.x; asm volatile("" : "+v"(t_)); F.tid = t_; F.lane = t_ & 63; F.wave = __builtin_amdgcn_readfirstlane(t_ >> 6); } while (0)
    PH_BEGIN(10); for (int rep = 0; rep < REP_P0; ++rep) { if (rep) __syncthreads(); p0_prologue(F); } PH_END(10);
    grid.sync(); PHASE_FENCE();
    PH_BEGIN(1);
    {
        pg8::Gemm g{(const bf16_t*)(F.ws + WS_A), (const bf16_t*)(F.ws + WS_BT), MA, NBT, 1024};
        Order1 S; S.init(F.G, F.bid);
        EpiProj E{(bf16_t*)(F.ws + WS_PROJ), (bf16_t*)(F.ws + WS_MEMRAW)};
        pg8::gemm_phase<EpiProj, Order1, true, true>(F.lds, g, S, E);
    }
    PH_END(1);
    GRID_BAR(); PHASE_FENCE();
    PH_BEGIN(2); for (int rep = 0; rep < REP_P2A; ++rep) p2a_phase(F);
    __syncthreads();
    p2a_attn(F); PH_END(2);
    GRID_BAR(); PHASE_FENCE();
    PH_BEGIN(3); p2b_phase(F); PH_END(3);
    GRID_BAR(); PHASE_FENCE();
    PH_BEGIN(4);
    if ((F.bid & 1) == 0) { PH_BEGIN(5); gemm2_sample(F); PH_END(5); }
    {
        pg8::Gemm g{(const bf16_t*)(F.ws + WS_MIX), (const bf16_t*)(F.ws + WS_WOUT), MTOT, 1024, 2048};
        Order3 S; S.init(F.G, F.bid);
        EpiOut E{F.in[I_XP], F.in[I_XS], F.out, (const float*)(F.ws + WS_SSQ)};
        pg8::gemm_phase<EpiOut, Order3, true, true>(F.lds, g, S, E);
    }
    if ((F.bid & 1) != 0) gemm2_sample(F);
    PH_END(4);
#if CLKPROBE
    grid.sync();
#if CLKPROBE >= 20
    if (threadIdx.x == 0) ((float*)(F.ws + WS_CTL + 32768))[F.bid] = (float)(g_dbg[F.bid] / 100);
    __threadfence(); grid.sync();
#endif
    if (F.bid == 0 && threadIdx.x == 0) {
        if (CLKAGG != 0) { const float* pv = (const float*)(F.ws + WS_CTL + 32768); float mx = pv[0], mn = pv[0], sm = 0.f;
            for (int i = 0; i < (int)gridDim.x; ++i) { mx = fmaxf(mx, pv[i]); mn = fminf(mn, pv[i]); sm += pv[i]; }
            const long long v_ = (long long)(CLKAGG == 1 ? mx : (CLKAGG == 2 ? mn : (CLKAGG == 4 ? pv[CLKBID] : sm / gridDim.x)));
            dbgval = (float)(((v_ + TIMEQ / 2 + TIMEOFF) / TIMEQ) * TIMEQ); }
        F.out[O_CONVS] = dbgval; }
#endif
#if DBG_SCALE3 || DBG_ZERO
    grid.sync();
    {
        const size_t offs[13] = {O_Y, (size_t)MP * 1024, O_WKP, O_WVP, O_SSMP, O_CONVP, O_MKP, O_MVP, O_WKS, O_WVS, O_SSMS, O_CONVS, O_END};
        for (int o = 0; o < 12; ++o) {
            const bool z = (DBG_ZERO >> o) & 1, s3 = (DBG_SCALE3 >> o) & 1;
            if (!z && !s3) continue;
            for (size_t i = offs[o] + (size_t)F.bid * 512 + F.tid; i < offs[o + 1]; i += (size_t)F.G * 512) F.out[i] = z ? 0.f : F.out[i] * 3.0f;
        }
    }
#endif
}

extern "C" void kernel_launch(void* const* d_in, const int* in_sizes, int n_in, void* d_out, int out_size, void* d_ws, size_t ws_size, hipStream_t stream) {
    static int grid = 0;
    if (grid == 0) {
        if (n_in != 26 || (size_t)out_size != O_END || ws_size < WS_END) { fprintf(stderr, "kernel_launch: unexpected problem (n_in %d out %d ws %zu)\n", n_in, out_size, ws_size); grid = -1; return; }
        int dev = 0, cus = 0, per_cu = 0;
        if (hipGetDevice(&dev) != hipSuccess || hipDeviceGetAttribute(&cus, hipDeviceAttributeMultiprocessorCount, dev) != hipSuccess) { grid = -1; return; }
        if (hipFuncSetAttribute((const void*)hymba_fwd, hipFuncAttributeMaxDynamicSharedMemorySize, LDS_BYTES) != hipSuccess) { fprintf(stderr, "kernel_launch: hipFuncSetAttribute failed\n"); grid = -1; return; }
        if (hipOccupancyMaxActiveBlocksPerMultiprocessor(&per_cu, (const void*)hymba_fwd, 512, LDS_BYTES) != hipSuccess || per_cu < 1) { fprintf(stderr, "kernel_launch: occupancy query says %d\n", per_cu); (void)hipGetLastError(); grid = -1; return; }
        grid = cus;
        fprintf(stderr, "kernel_launch: %d CUs, occupancy %d per CU, grid %d\n", cus, per_cu, grid);
    }
    if (grid < 0) return;
    Args a{};
    for (int i = 0; i < 26; ++i) a.in[i] = (const float*)d_in[i];
    a.out = (float*)d_out; a.ws = (unsigned char*)d_ws;
    if (hipMemsetAsync((char*)d_ws + WS_CTL, 0, CTL_ZERO_BYTES, stream) != hipSuccess) { fprintf(stderr, "kernel_launch: memset of the barrier words failed\n"); return; }
    void* kargs[] = {&a};
    const hipError_t e = hipLaunchCooperativeKernel((const void*)hymba_fwd, dim3(grid), dim3(512), kargs, LDS_BYTES, stream);
    if (e != hipSuccess) fprintf(stderr, "kernel_launch: cooperative launch failed: %s\n", hipGetErrorString(e));
}
```

```cpp
#include <hip/hip_runtime.h>
#include <hip/hip_cooperative_groups.h>
#include <cstdio>
#include <cstdint>
namespace cg = cooperative_groups;
#ifndef CLKPROBE
#define CLKPROBE 0
#endif
#if CLKPROBE >= 20
__device__ long long g_dbg[1024];
#endif
namespace pg8 {
#define PG8_LAS __attribute__((address_space(3)))
typedef unsigned short bf16_t;
typedef short bf16x8 __attribute__((ext_vector_type(8)));
typedef float f32x4 __attribute__((ext_vector_type(4)));
typedef unsigned u32x4 __attribute__((ext_vector_type(4)));
constexpr int BM = 256, BK = 64, HALF = 128, HTB = HALF * BK * 2  , STAGE_BYTES = 8 * HTB, NXCD = 8, WGM = 8;

__host__ __device__ __forceinline__ int lds_byte(int r, int c) { const int st = (r >> 4) * 2 + (c >> 5), rr = r & 15, cc = c & 31, ob = rr * 64 + cc * 2; return st * 1024 + (ob ^ (((ob >> 9) & 1) << 5)); }
__host__ __device__ __forceinline__ void stage_rc(int b, int& R, int& C) { const int st = b / 1024, sb = b % 1024, swz = sb ^ (((sb >> 9) & 1) << 5); R = (st >> 1) * 16 + swz / 64; C = (st & 1) * 32 + (swz % 64) / 2; }
__host__ __device__ __forceinline__ int perm32(int rho) { const int n = rho >> 4, i = rho & 15; return 8 * (i >> 2) + 4 * n + (i & 3); }

struct Unit { int pm, pn; };
struct Gemm { const bf16_t* A; const bf16_t* Bt; int M, N, K; };

struct StaticOrder {
    int nM, nN, nwg, G, c;
    __host__ __device__ void init(int M, int N, int G_, int c_) { nM = M / BM; nN = N / BM; nwg = nM * nN; G = G_; c = c_; }
    __host__ __device__ bool next(int i, Unit& u) const {
        const long L = (long)i * G + c; if (L >= nwg) return false;
        int wgid = (int)L; { const int q = nwg / NXCD, r = nwg % NXCD, xcd = wgid % NXCD, off = wgid / NXCD; wgid = (xcd < r ? xcd * (q + 1) : r * (q + 1) + (xcd - r) * q) + off; }
        const int nig = WGM * nN, gid = wgid / nig, fm = gid * WGM, gsz = (nM - fm) < WGM ? (nM - fm) : WGM;
        u.pm = fm + ((wgid % nig) % gsz); u.pn = (wgid % nig) / gsz; return true;
    }
    __device__ __forceinline__ void a_ready(const Unit&) const {}
    __device__ __forceinline__ void done(const Unit&) const {}
};

template <class Epi, class Sched, bool ALIGN_EPI = false, bool SP2 = false>
__device__ __forceinline__ void gemm_phase(PG8_LAS unsigned char* lds, const Gemm g, const Sched& S, const Epi& E) {
    int tid_ = threadIdx.x; asm volatile("" : "+v"(tid_));
    const int tid = tid_, wid = __builtin_amdgcn_readfirstlane(tid >> 6), lane = tid & 63, wr = wid >> 2, wc = wid & 3, fr = lane & 15, fq = lane >> 4;
    const int K = g.K, nt = K / BK;
    unsigned voffA[2], voffB[2];
#pragma unroll
    for (int i = 0; i < 2; ++i) { int R, C; stage_rc(tid * 16 + i * 8192, R, C); const int Rb = Epi::PERM ? ((R & ~31) + perm32(R & 31)) : R;
        voffA[i] = (unsigned)(R * K + C) * 2u; voffB[i] = (unsigned)(Rb * K + C) * 2u; }
    const size_t kstep = (size_t)(BK * 2);
    const size_t hstep = (size_t)HALF * K * 2;
    const size_t tstep = 2 * hstep;
    const unsigned ldsw = (unsigned)wid * 1024u;
    const int aoff = lds_byte(wr * 64 + fr, fq * 8), boff = lds_byte(wc * 32 + fr, fq * 8);
#define PG8_SA(b, h) (((b) * 2 + (h)) * HTB)
#define PG8_SB(b, h) ((4 + (b) * 2 + (h)) * HTB)
#define PG8_STAGE(bufoff, gbase, voff) do { _Pragma("unroll") for (int _i = 0; _i < 2; ++_i) \
        __builtin_amdgcn_global_load_lds((const unsigned*)((const char*)(gbase) + (voff)[_i]), (PG8_LAS unsigned*)(lds + (bufoff) + ldsw + _i * 8192), 16, 0, 0); } while (0)
#define PG8_LDA(dst, b, h) do { _Pragma("unroll") for (int m = 0; m < 4; ++m) _Pragma("unroll") for (int k = 0; k < 2; ++k) dst[m][k] = *(const PG8_LAS bf16x8*)(lds + PG8_SA(b, h) + aoff + m * 2048 + k * 1024); } while (0)
#define PG8_LDB(dst, b, h) do { _Pragma("unroll") for (int n = 0; n < 2; ++n) _Pragma("unroll") for (int k = 0; k < 2; ++k) dst[n][k] = *(const PG8_LAS bf16x8*)(lds + PG8_SB(b, h) + boff + n * 2048 + k * 1024); } while (0)
#define PG8_MMA(ai, bj, At, Bt) do { __builtin_amdgcn_s_setprio(1); _Pragma("unroll") for (int m = 0; m < 4; ++m) _Pragma("unroll") for (int n = 0; n < 2; ++n) _Pragma("unroll") for (int k = 0; k < 2; ++k) \
        acc[ai][bj][m][n] = __builtin_amdgcn_mfma_f32_16x16x32_bf16(Bt[n][k], At[m][k], acc[ai][bj][m][n], 0, 0, 0); __builtin_amdgcn_s_setprio(0); } while (0)
#define PG8_WAIT_V(n) asm volatile("s_waitcnt vmcnt(" #n ")" ::: "memory")
#define PG8_WAIT_L(n) asm volatile("s_waitcnt lgkmcnt(" #n ")" ::: "memory")
#define PG8_BAR __builtin_amdgcn_s_barrier()
#define PG8_SCHED __builtin_amdgcn_sched_barrier(0)
    Unit cur, nxt; int ui = 0;
    if (!S.next(0, cur)) return;
    f32x4 acc[2][2][4][2];
#pragma unroll
    for (int a = 0; a < 2; ++a)
#pragma unroll
        for (int b = 0; b < 2; ++b)
#pragma unroll
            for (int m = 0; m < 4; ++m)
#pragma unroll
                for (int n = 0; n < 2; ++n) acc[a][b][m][n] = (f32x4){0.f, 0.f, 0.f, 0.f};
    bf16x8 At[4][2], B0[2][2], B1[2][2];
    const char* cA = (const char*)g.A + (size_t)cur.pm * tstep; const char* cB = (const char*)g.Bt + (size_t)cur.pn * tstep;
    S.a_ready(cur);
    if constexpr (SP2) {
        PG8_STAGE(PG8_SB(0, 0), cB, voffB); PG8_STAGE(PG8_SB(0, 1), cB + hstep, voffB); PG8_STAGE(PG8_SA(0, 0), cA, voffA); PG8_STAGE(PG8_SA(0, 1), cA + hstep, voffA);
        if (wr == 1) PG8_BAR;
        PG8_WAIT_V(2); PG8_BAR;
        PG8_STAGE(PG8_SB(1, 0), cB + kstep, voffB); PG8_STAGE(PG8_SA(1, 0), cA + kstep, voffA); PG8_STAGE(PG8_SB(1, 1), cB + hstep + kstep, voffB);
        PG8_WAIT_V(6); PG8_BAR;
    } else {
        PG8_STAGE(PG8_SB(0, 0), cB, voffB); PG8_STAGE(PG8_SA(0, 0), cA, voffA); PG8_STAGE(PG8_SB(0, 1), cB + hstep, voffB); PG8_STAGE(PG8_SA(0, 1), cA + hstep, voffA);
        if (wr == 1) PG8_BAR;
        PG8_WAIT_V(4); PG8_BAR;
        PG8_STAGE(PG8_SB(1, 0), cB + kstep, voffB); PG8_STAGE(PG8_SA(1, 0), cA + kstep, voffA); PG8_STAGE(PG8_SB(1, 1), cB + hstep + kstep, voffB);
        PG8_WAIT_V(6); PG8_BAR;
    }
    for (;;) {
        const bool has_next = S.next(ui + 1, nxt);
        const char* nA = has_next ? (const char*)g.A + (size_t)nxt.pm * tstep : cA; const char* nB = has_next ? (const char*)g.Bt + (size_t)nxt.pn * tstep : cB;
        for (int t = 0; t < nt; t += 2) {
            const bool last = (t == nt - 2);
            const char* a1 = cA + (size_t)(t + 1) * kstep;
            const char* a2 = last ? nA : cA + (size_t)(t + 2) * kstep; const char* b2 = last ? nB : cB + (size_t)(t + 2) * kstep;
            const char* a3 = a2 + kstep; const char* b3 = b2 + kstep;
            if (last && has_next) S.a_ready(nxt);
#if CLKPROBE == 21
            if constexpr (Epi::MIDK > 0) { if (t == Epi::MIDK) { const long long t0_ = (long long)__builtin_amdgcn_s_memrealtime(); E.mid(acc, cur, wr, wc, fr, fq); asm volatile("" :: "v"(acc[0][0][0][0]));
                if (threadIdx.x == 0) g_dbg[blockIdx.x] += (long long)__builtin_amdgcn_s_memrealtime() - t0_; } }
#else
            if constexpr (Epi::MIDK > 0) { if (t == Epi::MIDK) E.mid(acc, cur, wr, wc, fr, fq); }
#endif
            if constexpr (SP2) {
            PG8_LDB(B0, 0, 0); PG8_LDB(B1, 0, 1); PG8_SCHED; PG8_LDA(At, 0, 0); PG8_STAGE(PG8_SA(1, 1), a1 + hstep, voffA);
            PG8_WAIT_V(8); PG8_WAIT_L(0); PG8_BAR; PG8_MMA(0, 0, At, B0); PG8_MMA(0, 1, At, B1); PG8_BAR; PG8_SCHED;
            PG8_LDA(At, 0, 1); PG8_STAGE(PG8_SB(0, 0), b2, voffB); PG8_STAGE(PG8_SB(0, 1), b2 + hstep, voffB); PG8_STAGE(PG8_SA(0, 0), a2, voffA);
            PG8_WAIT_V(8); PG8_WAIT_L(0); PG8_BAR; PG8_MMA(1, 0, At, B0); PG8_MMA(1, 1, At, B1); PG8_BAR; PG8_SCHED;
            PG8_LDB(B0, 1, 0); PG8_LDB(B1, 1, 1); PG8_SCHED; PG8_LDA(At, 1, 0); PG8_STAGE(PG8_SA(0, 1), a2 + hstep, voffA);
            PG8_WAIT_V(8); PG8_WAIT_L(0); PG8_BAR; PG8_MMA(0, 0, At, B0); PG8_MMA(0, 1, At, B1); PG8_BAR; PG8_SCHED;
            PG8_LDA(At, 1, 1); PG8_STAGE(PG8_SB(1, 0), b3, voffB); PG8_STAGE(PG8_SB(1, 1), b3 + hstep, voffB); PG8_STAGE(PG8_SA(1, 0), a3, voffA);
            PG8_WAIT_V(8); PG8_WAIT_L(0); PG8_BAR; PG8_MMA(1, 0, At, B0); PG8_MMA(1, 1, At, B1); PG8_BAR; PG8_SCHED;
            } else {
            PG8_LDB(B0, 0, 0); PG8_SCHED; PG8_LDA(At, 0, 0); PG8_STAGE(PG8_SA(1, 1), a1 + hstep, voffA);
            PG8_WAIT_L(8); PG8_BAR; PG8_WAIT_L(0); PG8_MMA(0, 0, At, B0); PG8_BAR; PG8_SCHED;
            PG8_LDB(B1, 0, 1); PG8_STAGE(PG8_SB(0, 0), b2, voffB);
            PG8_BAR; PG8_WAIT_L(0); PG8_MMA(0, 1, At, B1); PG8_BAR;
            PG8_LDA(At, 0, 1); PG8_STAGE(PG8_SA(0, 0), a2, voffA);
            PG8_BAR; PG8_WAIT_L(0); PG8_MMA(1, 0, At, B0); PG8_BAR; PG8_SCHED;
            PG8_STAGE(PG8_SB(0, 1), b2 + hstep, voffB);
            PG8_WAIT_V(6); PG8_BAR; PG8_MMA(1, 1, At, B1); PG8_BAR;
            PG8_LDB(B0, 1, 0); PG8_SCHED; PG8_LDA(At, 1, 0); PG8_STAGE(PG8_SA(0, 1), a2 + hstep, voffA);
            PG8_WAIT_L(8); PG8_BAR; PG8_WAIT_L(0); PG8_MMA(0, 0, At, B0); PG8_BAR; PG8_SCHED;
            PG8_LDB(B1, 1, 1); PG8_STAGE(PG8_SB(1, 0), b3, voffB);
            PG8_BAR; PG8_WAIT_L(0); PG8_MMA(0, 1, At, B1); PG8_BAR;
            PG8_LDA(At, 1, 1); PG8_STAGE(PG8_SA(1, 0), a3, voffA);
            PG8_BAR; PG8_WAIT_L(0); PG8_MMA(1, 0, At, B0); PG8_BAR; PG8_SCHED;
            PG8_STAGE(PG8_SB(1, 1), b3 + hstep, voffB);
            PG8_WAIT_V(6); PG8_BAR; PG8_MMA(1, 1, At, B1); PG8_BAR;
            }
        }
        if constexpr (ALIGN_EPI) { if (wr == 0) PG8_BAR; }
#if CLKPROBE == 20
        { const long long t0_ = (long long)__builtin_amdgcn_s_memrealtime();
#endif
        if constexpr (!Epi::AFTER_DRAIN) { E(acc, cur, wr, wc, fr, fq); S.done(cur); }
#if CLKPROBE == 20
          asm volatile("s_waitcnt vmcnt(0)" ::: "memory"); if (Epi::MIDK > 0 && threadIdx.x == 0) g_dbg[blockIdx.x] += (long long)__builtin_amdgcn_s_memrealtime() - t0_; }
#endif
        if (!has_next) break;
#pragma unroll
        for (int a = 0; a < 2; ++a)
#pragma unroll
            for (int b = 0; b < 2; ++b)
#pragma unroll
                for (int m = 0; m < 4; ++m)
#pragma unroll
                    for (int n = 0; n < 2; ++n) acc[a][b][m][n] = (f32x4){0.f, 0.f, 0.f, 0.f};
        cur = nxt; cA = nA; cB = nB; ++ui;
        if constexpr (ALIGN_EPI) { if (wr == 1) PG8_BAR; }
    }
    PG8_WAIT_V(0);
    if constexpr (!ALIGN_EPI) { if (wr == 0) PG8_BAR; }
    PG8_BAR;
    if constexpr (Epi::AFTER_DRAIN) { E.fused(acc, cur, wr, wc, fr, fq, lds, wid, lane); S.done(cur); }
#undef PG8_SA
#undef PG8_SB
#undef PG8_STAGE
#undef PG8_LDA
#undef PG8_LDB
#undef PG8_MMA
#undef PG8_WAIT_V
#undef PG8_WAIT_L
#undef PG8_BAR
#undef PG8_SCHED
}
}
#ifndef DBG_SCALE3
#define DBG_SCALE3 0
#endif
#ifndef DBG_ZERO
#define DBG_ZERO 0
#endif
#ifndef LAST_PHASE
#define LAST_PHASE 4
#endif
#ifndef REP_P0
#define REP_P0 1
#endif
#ifndef REP_P1
#define REP_P1 1
#endif
#ifndef REP_P2A
#define REP_P2A 1
#endif
#ifndef REP_P0T
#define REP_P0T 1
#endif
#ifndef REP_P0R
#define REP_P0R 1
#endif
#ifndef REP_S2
#define REP_S2 1
#endif
#ifndef REP_S3
#define REP_S3 1
#endif
#ifndef REP_S4
#define REP_S4 1
#endif
#ifndef REP_ATOM
#define REP_ATOM 1
#endif
#ifndef TIMESEG
#define TIMESEG 0
#endif
#ifndef TIMESEG_A
#define TIMESEG_A 0
#endif
#ifndef TIMESEG_B
#define TIMESEG_B 5
#endif
#ifndef CLKPROBE
#define CLKPROBE 0
#endif
#ifndef CLKAGG
#define CLKAGG 0
#endif
#ifndef CLKBID
#define CLKBID 0
#endif
#ifndef CLKWHAT
#define CLKWHAT 0
#endif
#ifndef TIMEWAVE
#define TIMEWAVE 0
#endif
#ifndef TIMEQ
#define TIMEQ 500
#endif
#ifndef TIMEOFF
#define TIMEOFF 0
#endif
#ifndef REP_SSD
#define REP_SSD 1
#endif
#ifndef REP_WIN
#define REP_WIN 1
#endif
#ifndef REP_MEM
#define REP_MEM 1
#endif
#ifndef REP_P3
#define REP_P3 1
#endif
#define DI __device__ __forceinline__
#define LAS __attribute__((address_space(3)))
typedef unsigned short bf16_t;
typedef short bf16x8 __attribute__((ext_vector_type(8)));
typedef float f32x4 __attribute__((ext_vector_type(4)));
typedef float f32x2 __attribute__((ext_vector_type(2)));
typedef unsigned u32x4 __attribute__((ext_vector_type(4)));
typedef unsigned u32x2 __attribute__((ext_vector_type(2)));

constexpr int NB_P = 16, T_P = 4096, NB_S = 32, T_S = 64, DM = 1024;
constexpr int MP = NB_P * T_P, MS = NB_S * T_S, MTOT = MP + MS;
constexpr int MMEM = NB_P * 256, MA = MTOT + MMEM;
constexpr int NPROJ = 4864, NBT = NPROJ + 1024, INC = 4880;
constexpr int C_Q = 0, C_K = 512, C_V = 640, C_GA = 768, C_Z = 1280, C_XBC = 2304, C_MQ = 3840, C_GM = 4352;
constexpr int NCHUNK = MTOT / 64;
constexpr float EPSF = 1e-6f;
constexpr size_t O_Y = 0;
constexpr size_t O_WKP = (size_t)MTOT * 1024;
constexpr size_t O_WVP = O_WKP + (size_t)NB_P * 128 * 128;
constexpr size_t O_SSMP = O_WVP + (size_t)NB_P * 128 * 128;
constexpr size_t O_CONVP = O_SSMP + (size_t)NB_P * 16 * 64 * 128;
constexpr size_t O_MKP = O_CONVP + (size_t)NB_P * 3 * 1536;
constexpr size_t O_MVP = O_MKP + (size_t)NB_P * 256 * 512;
constexpr size_t O_WKS = O_MVP + (size_t)NB_P * 256 * 512;
constexpr size_t O_WVS = O_WKS + (size_t)NB_S * 128 * 128;
constexpr size_t O_SSMS = O_WVS + (size_t)NB_S * 128 * 128;
constexpr size_t O_CONVS = O_SSMS + (size_t)NB_S * 16 * 64 * 128;
constexpr size_t O_END = O_CONVS + (size_t)NB_S * 3 * 1536;
static_assert(O_END == 81485824, "output size");
constexpr size_t MiB = 1u << 20;
constexpr size_t WS_ROPE = 1 * MiB;
constexpr size_t WS_BT = 2 * MiB;
constexpr size_t WS_WOUT = 14 * MiB;
constexpr size_t WS_DT = 18 * MiB;
constexpr size_t WS_SSQ = 23 * MiB;
constexpr size_t WS_CTL = 0, CTL_ZERO_BYTES = 65536;
constexpr size_t WS_MEMRAW = 32 * MiB;
constexpr size_t WS_MEMK = 40 * MiB;
constexpr size_t WS_MEMVT = 52 * MiB;
constexpr size_t WS_PROJ = 64 * MiB;
constexpr size_t WS_A = 692 * MiB;
constexpr size_t WS_MIX = 692 * MiB;
constexpr size_t WS_BCC = 956 * MiB;
constexpr size_t WS_END = 1022 * MiB;
static_assert(WS_BT + (size_t)NBT * 1024 * 2 <= WS_WOUT && WS_DT + (size_t)MTOT * 64 <= WS_SSQ && WS_SSQ + (size_t)MTOT * 128 <= WS_MEMRAW, "ws map 1");
static_assert(WS_PROJ + (size_t)MTOT * NPROJ * 2 <= WS_A && WS_A + (size_t)MA * 1024 * 2 <= WS_END && WS_MIX + (size_t)MTOT * 2048 * 2 <= WS_BCC && WS_BCC + (size_t)MTOT * 512 * 2 <= WS_END, "ws map 2");
constexpr int LDS_BYTES = 147456;

DI float bf2f(unsigned short b) { return __uint_as_float((unsigned)b << 16); }
typedef __bf16 hbf2 __attribute__((ext_vector_type(2)));
DI unsigned short f2bf(float f) { return __builtin_bit_cast(unsigned short, (__bf16)f); }
DI unsigned pk2(float lo, float hi) { const f32x2 v = {lo, hi}; return __builtin_bit_cast(unsigned, __builtin_convertvector(v, hbf2)); }
DI unsigned cvt_pk_bf16(float lo, float hi) { return pk2(lo, hi); }
DI float siluf(float x) { return x * __builtin_amdgcn_rcpf(1.0f + __expf(-x)); }
DI float xor32_sum(float x) { unsigned u = __builtin_bit_cast(unsigned, x); unsigned u2 = u; asm volatile("" : "+v"(u2)); auto r = __builtin_amdgcn_permlane32_swap(u, u2, false, false); unsigned r0 = r[0], r1 = r[1]; return __builtin_bit_cast(float, r0) + __builtin_bit_cast(float, r1); }
DI float xor16_sum(float x) { unsigned u = __builtin_bit_cast(unsigned, x); unsigned u2 = u; asm volatile("" : "+v"(u2)); auto r = __builtin_amdgcn_permlane16_swap(u, u2, false, false); unsigned r0 = r[0], r1 = r[1]; return __builtin_bit_cast(float, r0) + __builtin_bit_cast(float, r1); }
DI float xor32_max(float x) { unsigned u = __builtin_bit_cast(unsigned, x); unsigned u2 = u; asm volatile("" : "+v"(u2)); auto r = __builtin_amdgcn_permlane32_swap(u, u2, false, false); unsigned r0 = r[0], r1 = r[1]; return fmaxf(__builtin_bit_cast(float, r0), __builtin_bit_cast(float, r1)); }
DI float xor16_max(float x) { unsigned u = __builtin_bit_cast(unsigned, x); unsigned u2 = u; asm volatile("" : "+v"(u2)); auto r = __builtin_amdgcn_permlane16_swap(u, u2, false, false); unsigned r0 = r[0], r1 = r[1]; return fmaxf(__builtin_bit_cast(float, r0), __builtin_bit_cast(float, r1)); }
#define DPP_ROR_(v, n) __builtin_bit_cast(float, __builtin_amdgcn_update_dpp(0, __builtin_bit_cast(int, (v)), 0x120 + (n), 0xf, 0xf, false))
DI float row16_sum(float v) { v += DPP_ROR_(v, 8); v += DPP_ROR_(v, 4); v += DPP_ROR_(v, 2); v += DPP_ROR_(v, 1); return v; }
DI float wave_sum(float v) { return xor32_sum(xor16_sum(row16_sum(v))); }
#define DPP_MOV_(v, ctrl) __builtin_bit_cast(float, __builtin_amdgcn_update_dpp(0, __builtin_bit_cast(int, (v)), (ctrl), 0xf, 0xf, false))
DI float lane_xor1(float v) { return DPP_MOV_(v, 0xB1); }
DI float lane_xor2(float v) { return DPP_MOV_(v, 0x4E); }
DI float lane_xor4(float v) { const float t = DPP_MOV_(v, 0x141); return DPP_MOV_(t, 0x1B); }
DI float lane_xor8(float v) { const float t = DPP_MOV_(v, 0x140); return DPP_MOV_(t, 0x141); }
DI float swap32_sum(float a, float b) { unsigned ua = __builtin_bit_cast(unsigned, a), ub = __builtin_bit_cast(unsigned, b); auto r = __builtin_amdgcn_permlane32_swap(ua, ub, false, false); unsigned r0 = r[0], r1 = r[1]; return __builtin_bit_cast(float, r0) + __builtin_bit_cast(float, r1); }
DI float swap16_sum(float a, float b) { unsigned ua = __builtin_bit_cast(unsigned, a), ub = __builtin_bit_cast(unsigned, b); auto r = __builtin_amdgcn_permlane16_swap(ua, ub, false, false); unsigned r0 = r[0], r1 = r[1]; return __builtin_bit_cast(float, r0) + __builtin_bit_cast(float, r1); }
DI void unpack8(const u32x4 v, float (&o)[8]) {
#pragma unroll
    for (int i = 0; i < 4; ++i) { o[2 * i] = __uint_as_float(v[i] << 16); o[2 * i + 1] = __uint_as_float(v[i] & 0xffff0000u); }
}
DI u32x4 pack8(const float (&o)[8]) { u32x4 v; v.x = pk2(o[0], o[1]); v.y = pk2(o[2], o[3]); v.z = pk2(o[4], o[5]); v.w = pk2(o[6], o[7]); return v; }
#define LDS_WAIT() asm volatile("s_waitcnt lgkmcnt(0)" ::: "memory")
#define MFMA16(a, b, c) __builtin_amdgcn_mfma_f32_16x16x32_bf16((a), (b), (c), 0, 0, 0)

struct Args { const float* in[26]; float* out; unsigned char* ws; };
struct Ctx {
    LAS unsigned char* lds; int tid, lane, wave, G, bid;
    const float* in[26]; float* out; unsigned char* ws;
};
#define RLX_AGENT __ATOMIC_RELAXED, __HIP_MEMORY_SCOPE_AGENT
#define XB_TMO      128
#define XB_XCNT(j)  (256  + 64 * (j))
#define XB_XSUB(j)  (1280 + 64 * (j))
#define XB_XGEN(j)  (2304 + 64 * (j))
#define XB_TOP      3328
#define XB_TOPGEN   3392
#define XCD_BAR_WORDS 3456
#define XB_SPIN_CAP (1u << 18)

__device__ __forceinline__ unsigned xb_ld(unsigned* p)              { return __hip_atomic_load(p, __ATOMIC_RELAXED, __HIP_MEMORY_SCOPE_AGENT); }
__device__ __forceinline__ unsigned xb_add(unsigned* p, unsigned v) { return __hip_atomic_fetch_add(p, v, __ATOMIC_RELAXED, __HIP_MEMORY_SCOPE_AGENT); }
__device__ __forceinline__ unsigned xb_xcc_id() { return (unsigned)__builtin_amdgcn_s_getreg((3 << 11) | 20) & 0xFu; }
#define XB_SPIN(cond, bar) do { unsigned _sp = 0; while (cond) { __builtin_amdgcn_s_sleep(1); \
    if ((++_sp & 255u) == 0u) { if (xb_ld(&(bar)[XB_TMO])) break; if (_sp > XB_SPIN_CAP) { atomicAdd(&(bar)[XB_TMO], 1u); break; } } } } while (0)

struct XcdBarrier {
    unsigned* bar; unsigned x;
    volatile LAS unsigned* st;
};

__device__ __forceinline__ XcdBarrier xcd_barrier_post(unsigned* bar, volatile LAS unsigned* st) {
    XcdBarrier b; b.bar = bar; b.x = xb_xcc_id(); b.st = st;
    if (threadIdx.x == 0) (void)xb_add(&bar[XB_XCNT(b.x)], 1u);
    return b;
}
__device__ __forceinline__ void xcd_barrier_complete(unsigned* bar, unsigned x, unsigned& nloc, unsigned& nx) {
    const unsigned G = gridDim.x * gridDim.y * gridDim.z;
    unsigned sum, cnt, mine, sp = 0u;
    for (;;) {
        sum = 0u; cnt = 0u; mine = 0u;
#pragma unroll
        for (unsigned j = 0; j < 16; ++j) { const unsigned c = xb_ld(&bar[XB_XCNT(j)]); sum += c; cnt += (c > 0u) ? 1u : 0u; mine = (j == x) ? c : mine; }
        if (sum == G) break;
        __builtin_amdgcn_s_sleep(1);
        if ((++sp & 255u) == 0u) { if (xb_ld(&bar[XB_TMO])) break; if (sp > XB_SPIN_CAP) { atomicAdd(&bar[XB_TMO], 1u); break; } }
    }
    nloc = mine > 0u ? mine : 1u; nx = cnt > 0u ? cnt : 1u;
}

__device__ __forceinline__ void xcd_barrier(const XcdBarrier& b) {
    asm volatile("s_waitcnt vmcnt(0)" ::: "memory");
    __syncthreads();
    if (threadIdx.x == 0) {
        unsigned* bar = b.bar;
        __builtin_amdgcn_s_waitcnt(0);
        unsigned nloc = b.st[0], nx = b.st[1];
        if (nloc == 0u) { xcd_barrier_complete(bar, b.x, nloc, nx); b.st[0] = nloc; b.st[1] = nx; }
        const unsigned old = xb_add(&bar[XB_XSUB(b.x)], 1u);
        const unsigned gen = old / nloc;
        if (old + 1u == (gen + 1u) * nloc) {
            __builtin_amdgcn_fence(__ATOMIC_RELEASE, "agent");
            asm volatile("s_waitcnt vmcnt(0)" ::: "memory");
            const unsigned og = xb_add(&bar[XB_TOP], 1u);
            const unsigned tg = og / nx;
            if (og + 1u == (tg + 1u) * nx) xb_add(&bar[XB_TOPGEN], 1u);
            else XB_SPIN(xb_ld(&bar[XB_TOPGEN]) == tg, bar);
            __builtin_amdgcn_fence(__ATOMIC_ACQUIRE, "agent");
            xb_add(&bar[XB_XGEN(b.x)], 1u);
            asm volatile("s_waitcnt vmcnt(0)" ::: "memory");
        } else {
            XB_SPIN(xb_ld(&bar[XB_XGEN(b.x)]) == gen, bar);
            __builtin_amdgcn_fence(__ATOMIC_ACQUIRE, "agent");
            asm volatile("s_waitcnt vmcnt(0)" ::: "memory");
        }
    }
    __syncthreads();
}

enum { I_XP = 0, I_XS, I_CWK, I_CWV, I_SSM, I_SCONV, I_CMK, I_CMV, I_MEM, I_GNORM, I_WIN, I_GQ, I_GK, I_SINKS, I_CONVW, I_CONVB, I_DTB, I_ALOG, I_DSKIP, I_GSSD, I_GMEM, I_WMK, I_WMV, I_GMK, I_GMQ, I_WOUT };

DI void p0_transpose_item(const float* W, int ldw, int src_k0, int src_n0, const float* rowscale, bf16_t* WT, int ldt, int dst_n0, int dst_k0, LAS float* scr, int lane) {
    float tv[32];
#pragma unroll
    for (int i = 0; i < 32; ++i) tv[i] = W[(size_t)(src_k0 + 2 * i + (lane >> 5)) * ldw + src_n0 + (lane & 31)];
    if (rowscale) {
#pragma unroll
        for (int i = 0; i < 32; ++i) tv[i] *= rowscale[2 * i + (lane >> 5)]; }
#pragma unroll
    for (int i = 0; i < 32; ++i) scr[(2 * i + (lane >> 5)) * 33 + (lane & 31)] = tv[i];
    LDS_WAIT();
    const int c = lane & 7;
#pragma unroll
    for (int j = 0; j < 4; ++j) { const int n = (lane >> 3) + 8 * j; const LAS float* s = scr + (8 * c) * 33 + n;
        u32x4 o; o.x = pk2(s[0 * 33], s[1 * 33]); o.y = pk2(s[2 * 33], s[3 * 33]); o.z = pk2(s[4 * 33], s[5 * 33]); o.w = pk2(s[6 * 33], s[7 * 33]);
        *(u32x4*)(WT + (size_t)(dst_n0 + n) * ldt + dst_k0 + 8 * c) = o; }
    LDS_WAIT();
}

DI float reduce16_to_lane(float (&a)[16], int lane) {
#pragma unroll
    for (int j = 0; j < 16; ++j) { a[j] += __shfl_xor(a[j], 32); a[j] += __shfl_xor(a[j], 16); }
    float r8[8], r4[4], r2[2];
    const bool b3 = (lane & 8) != 0, b2 = (lane & 4) != 0, b1 = (lane & 2) != 0, b0 = (lane & 1) != 0;
#pragma unroll
    for (int j = 0; j < 8; ++j) { const float snd = b3 ? a[j] : a[j + 8], kp = b3 ? a[j + 8] : a[j]; r8[j] = kp + __shfl_xor(snd, 8); }
#pragma unroll
    for (int j = 0; j < 4; ++j) { const float snd = b2 ? r8[j] : r8[j + 4], kp = b2 ? r8[j + 4] : r8[j]; r4[j] = kp + __shfl_xor(snd, 4); }
#pragma unroll
    for (int j = 0; j < 2; ++j) { const float snd = b1 ? r4[j] : r4[j + 2], kp = b1 ? r4[j + 2] : r4[j]; r2[j] = kp + __shfl_xor(snd, 2); }
    const float snd = b0 ? r2[0] : r2[1], kp = b0 ? r2[1] : r2[0];
    return kp + __shfl_xor(snd, 1);
}

DI void p0_rows2(f32x4 (&va)[4], f32x4 (&vb)[4], const float* g, bf16_t* oa, bf16_t* ob, float* dta, float* dtb, bool want_dt, const float* dt_bias, const LAS float* wdt, int lane) {
    float sa = 0.f, sb = 0.f;
#pragma unroll
    for (int jj = 0; jj < 4; ++jj) { sa += (va[jj].x * va[jj].x + va[jj].y * va[jj].y) + (va[jj].z * va[jj].z + va[jj].w * va[jj].w); sb += (vb[jj].x * vb[jj].x + vb[jj].y * vb[jj].y) + (vb[jj].z * vb[jj].z + vb[jj].w * vb[jj].w); }
    const float ra = 1.0f / sqrtf(wave_sum(sa) * (1.0f / DM) + EPSF), rb = 1.0f / sqrtf(wave_sum(sb) * (1.0f / DM) + EPSF);
    u32x2* pa = (u32x2*)oa + lane; u32x2* pb = (u32x2*)ob + lane;
#pragma unroll
    for (int jj = 0; jj < 4; ++jj) { const f32x4 gv = ((const f32x4*)g)[64 * jj + lane]; va[jj] = va[jj] * ra * gv; vb[jj] = vb[jj] * rb * gv;
        u32x2 w; w.x = pk2(va[jj].x, va[jj].y); w.y = pk2(va[jj].z, va[jj].w); pa[64 * jj] = w; w.x = pk2(vb[jj].x, vb[jj].y); w.y = pk2(vb[jj].z, vb[jj].w); pb[64 * jj] = w; }
    if (want_dt) {
        f32x2 ab[16];
#pragma unroll
        for (int j = 0; j < 16; ++j) ab[j] = (f32x2){0.f, 0.f};
#pragma unroll
        for (int jj = 0; jj < 4; ++jj)
#pragma unroll
            for (int e = 0; e < 4; ++e) { const f32x2 hab = {va[jj][e], vb[jj][e]}; const LAS f32x4* wr = (const LAS f32x4*)(wdt + ((jj * 4 + e) * 64 + lane) * 20);
#pragma unroll
                for (int q = 0; q < 4; ++q) { const f32x4 w4 = wr[q];
                    ab[4 * q] += hab * w4.x; ab[4 * q + 1] += hab * w4.y; ab[4 * q + 2] += hab * w4.z; ab[4 * q + 3] += hab * w4.w; }
                if (e & 1) __builtin_amdgcn_sched_barrier(0); }
        float a[16], b[16];
#pragma unroll
        for (int j = 0; j < 16; ++j) { a[j] = ab[j].x; b[j] = ab[j].y; }
        const bool b5 = (lane & 32) != 0, b3 = (lane & 8) != 0, b2 = (lane & 4) != 0, b1 = (lane & 2) != 0;
        float v16[16], v8[8], v4[4], v2[2];
#pragma unroll
        for (int j = 0; j < 16; ++j) v16[j] = swap32_sum(a[j], b[j]);
#pragma unroll
        for (int j = 0; j < 8; ++j) v8[j] = swap16_sum(v16[j], v16[j + 8]);
#pragma unroll
        for (int j = 0; j < 4; ++j) { const float snd = b3 ? v8[j] : v8[j + 4], kp = b3 ? v8[j + 4] : v8[j]; v4[j] = kp + lane_xor8(snd); }
#pragma unroll
        for (int j = 0; j < 2; ++j) { const float snd = b2 ? v4[j] : v4[j + 2], kp = b2 ? v4[j + 2] : v4[j]; v2[j] = kp + lane_xor4(snd); }
        float tot; { const float snd = b1 ? v2[0] : v2[1], kp = b1 ? v2[1] : v2[0]; tot = kp + lane_xor2(snd); }
        tot += lane_xor1(tot);
        if ((lane & 1) == 0) { const int j = (lane >> 1) & 15; const float xv = tot + dt_bias[j]; float* dp = b5 ? dtb : dta;
            dp[j] = fmaxf(xv, 0.f) + log1pf(__expf(-fabsf(xv))); }
    }
}

DI void p0_row_segment(Ctx& F, const float* src, const float* g, int m0, int npair, bool tok, bf16_t* A, float* DT, const LAS float* wdt, int gw, int NGW) {
    const int lane = F.lane;
    f32x4 n0a[4], n0b[4], n1a[4], n1b[4];
#define P0_LOAD(dst_a, dst_b, pp) do { if ((pp) < npair) { _Pragma("unroll") for (int jj = 0; jj < 4; ++jj) { \
        dst_a[jj] = ((const f32x4*)(src + (size_t)(2 * (pp)) * DM))[64 * jj + lane]; dst_b[jj] = ((const f32x4*)(src + (size_t)(2 * (pp) + 1) * DM))[64 * jj + lane]; } } } while (0)
    P0_LOAD(n0a, n0b, gw); P0_LOAD(n1a, n1b, gw + NGW);
    for (int p = gw; p < npair; p += NGW) {
        f32x4 va[4], vb[4];
#pragma unroll
        for (int jj = 0; jj < 4; ++jj) { va[jj] = n0a[jj]; vb[jj] = n0b[jj]; n0a[jj] = n1a[jj]; n0b[jj] = n1b[jj]; }
        P0_LOAD(n1a, n1b, p + 2 * NGW);
        const int m = m0 + 2 * p;
        p0_rows2(va, vb, g, A + (size_t)m * DM, A + (size_t)(m + 1) * DM, DT + (size_t)(tok ? m : 0) * 16, DT + (size_t)(tok ? m + 1 : 0) * 16, tok, F.in[I_DTB], wdt, lane);
    }
#undef P0_LOAD
}

DI void p0_prologue(Ctx& F) {
#if CLKPROBE >= 50 && CLKPROBE <= 52
    long long pt0_ = (long long)__builtin_amdgcn_s_memrealtime();
#define P0_TS(k) do { const long long t_ = (long long)__builtin_amdgcn_s_memrealtime(); if (CLKPROBE == (k) && threadIdx.x == 0) g_dbg[blockIdx.x] += t_ - pt0_; pt0_ = t_; } while (0)
#else
#define P0_TS(k) do { } while (0)
#endif
    const int gw = F.bid * 8 + F.wave, NGW = F.G * 8, lane = F.lane;
    bf16_t* BT = (bf16_t*)(F.ws + WS_BT); bf16_t* WOT = (bf16_t*)(F.ws + WS_WOUT);
    for (int rep_ = 0; rep_ < REP_P0T; ++rep_) {
        LAS float* scr = (LAS float*)(F.lds + F.wave * 16384);
        constexpr int I_IN = 16 * (NPROJ / 32), I_M = 16 * 32, I_O = 32 * 32;
        for (int it = gw; it < I_IN + I_M + I_O; it += NGW) {
            int r = it;
            if (r < I_IN) { const int kb = r / (NPROJ / 32), nb = r % (NPROJ / 32); const int n0 = 32 * nb;
                p0_transpose_item(F.in[I_WIN], INC, 64 * kb, n0 + (n0 >= 3840 ? 16 : 0), nullptr, BT, 1024, n0, 64 * kb, scr, lane); continue; }
            r -= I_IN;
            if (r < I_M) { const int kb = r / 32, nb = r % 32;
                p0_transpose_item(nb < 16 ? F.in[I_WMK] : F.in[I_WMV], 512, 64 * kb, 32 * (nb & 15), nullptr, BT, 1024, NPROJ + 32 * nb, 64 * kb, scr, lane); continue; }
            r -= I_M;
            { const int kb = r / 32, nb = r % 32; const int k0 = 64 * kb;
              const int sk0 = k0 < 1024 ? 512 + k0 : (k0 < 1536 ? k0 - 1024 : k0);
              p0_transpose_item(F.in[I_WOUT], 1024, sk0, 32 * nb, k0 < 1024 ? F.in[I_GSSD] + k0 : nullptr, WOT, 2048, 32 * nb, k0, scr, lane); }
        }
    }
    { float* sq = (float*)(F.ws + WS_SSQ); for (int i = F.bid * 512 + F.tid; i < MTOT; i += F.G * 512) sq[i] = 0.f; }
    {
        f32x2* rope = (f32x2*)(F.ws + WS_ROPE);
        for (int i = F.bid * 512 + F.tid; i < 4096 * 32; i += F.G * 512) {
            const int pos = i >> 5, fi = i & 31;
            const float freq = exp2f(-(float)fi * (13.287712379549449f / 32.0f));
            double rev = (double)pos * (double)freq * 0.15915494309189535;
            rev -= __builtin_rint(rev);
            const float ang = (float)(rev * 6.283185307179586);
            rope[i] = (f32x2){cosf(ang), sinf(ang)};
        }
    }
    P0_TS(50);
    __syncthreads();
    for (int rep_ = 0; rep_ < REP_P0R; ++rep_) {
        if (rep_) __syncthreads();
        LAS float* wdt = (LAS float*)F.lds;
#pragma unroll 1
        for (int i0 = F.tid; i0 < 1024 * 16; i0 += 512 * 8) { float t8[8];
#pragma unroll
            for (int u = 0; u < 8; ++u) { const int i = i0 + 512 * u; t8[u] = F.in[I_WIN][(size_t)(i >> 4) * INC + 3840 + (i & 15)]; }
#pragma unroll
            for (int u = 0; u < 8; ++u) { const int i = i0 + 512 * u, k = i >> 4, j = i & 15; const int jj = k >> 8, e = k & 3, l = (k >> 2) & 63;
                wdt[((jj * 4 + e) * 64 + l) * 20 + j] = t8[u]; } }
        __syncthreads();
        P0_TS(51);
        bf16_t* A = (bf16_t*)(F.ws + WS_A); float* DT = (float*)(F.ws + WS_DT);
        p0_row_segment(F, F.in[I_XP], F.in[I_GNORM], 0, MP / 2, true, A, DT, wdt, gw, NGW);
        p0_row_segment(F, F.in[I_XS], F.in[I_GNORM], MP, MS / 2, true, A, DT, wdt, gw, NGW);
        p0_row_segment(F, F.in[I_MEM], F.in[I_GMEM], MTOT, MMEM / 2, false, A, DT, wdt, gw, NGW);
    }
    P0_TS(52);
}
struct Order1 {
    pg8::StaticOrder so; int G, c;
    __device__ void init(int G_, int c_) { so.init(MTOT, NPROJ, G_, c_); G = G_; c = c_; }
    __device__ bool next(int i, pg8::Unit& u) const {
        long L = (long)i * G + c;
        if (L >= (long)REP_P1 * (so.nwg + 64)) return false;
        L %= (so.nwg + 64);
        if (L < so.nwg) { pg8::StaticOrder t = so; t.G = 1; t.c = 0; return t.next((int)L, u); }
        const int r = (int)(L - so.nwg);
        u.pm = MTOT / 256 + (r >> 2); u.pn = NPROJ / 256 + (r & 3); return true;
    }
    __device__ __forceinline__ void a_ready(const pg8::Unit&) const {}
    __device__ __forceinline__ void done(const pg8::Unit&) const {}
};
struct Order3 {
    pg8::StaticOrder so; int G, c;
    __device__ void init(int G_, int c_) { so.init(MP, 1024, 1, 0); G = G_; c = c_; }
    __device__ bool next(int i, pg8::Unit& u) const {
        long L = (long)i * G + c;
        if (L >= (long)REP_P3 * so.nwg) return false;
        return so.next((int)(L % so.nwg), u);
    }
    __device__ __forceinline__ void a_ready(const pg8::Unit&) const {}
    __device__ __forceinline__ void done(const pg8::Unit&) const {}
};
struct EpiProj {
    static constexpr bool PERM = true, AFTER_DRAIN = false; static constexpr int MIDK = 0;
    bf16_t* proj; bf16_t* memraw;
    __device__ __forceinline__ void operator()(const f32x4 (&acc)[2][2][4][2], const pg8::Unit& u, int wr, int wc, int fr, int fq) const {
        bf16_t* base; int ldc, row0, col0;
        if (u.pn < NPROJ / 256) { base = proj; ldc = NPROJ; row0 = u.pm * 256; col0 = u.pn * 256; }
        else { base = memraw; ldc = 1024; row0 = (u.pm - MTOT / 256) * 256; col0 = (u.pn - NPROJ / 256) * 256; }
        row0 += wr * 64 + fr; col0 += wc * 32 + 8 * fq;
#pragma unroll
        for (int ai = 0; ai < 2; ++ai)
#pragma unroll
            for (int m = 0; m < 4; ++m) { bf16_t* rowp = base + (size_t)(row0 + ai * 128 + m * 16) * ldc + col0;
#pragma unroll
                for (int bj = 0; bj < 2; ++bj) { const f32x4 v0 = acc[ai][bj][m][0], v1 = acc[ai][bj][m][1];
                    u32x4 w; w.x = cvt_pk_bf16(v0[0], v0[1]); w.y = cvt_pk_bf16(v0[2], v0[3]); w.z = cvt_pk_bf16(v1[0], v1[1]); w.w = cvt_pk_bf16(v1[2], v1[3]);
                    *(u32x4*)(rowp + bj * 128) = w; } }
    }
};
struct EpiOut {
    static constexpr bool PERM = false, AFTER_DRAIN = false; static constexpr int MIDK = 16;
    const float* xp; const float* xs; float* out; const float* sumsq;
    __device__ __forceinline__ void mid(f32x4 (&acc)[2][2][4][2], const pg8::Unit& u, int wr, int wc, int fr, int fq) const {
        const float* sq = sumsq + (size_t)u.pm * 256 + wr * 64 + fr;
#pragma unroll
        for (int ai = 0; ai < 2; ++ai)
#pragma unroll
            for (int m = 0; m < 4; ++m) { const float r = 1.0f / sqrtf(sq[ai * 128 + m * 16] * (1.0f / 1024.0f) + EPSF);
#pragma unroll
                for (int bj = 0; bj < 2; ++bj)
#pragma unroll
                    for (int n = 0; n < 2; ++n) acc[ai][bj][m][n] = acc[ai][bj][m][n] * r; }
    }
    __device__ __forceinline__ void operator()(const f32x4 (&acc)[2][2][4][2], const pg8::Unit& u, int wr, int wc, int fr, int fq) const {
        const float* xb = u.pm < MP / 256 ? xp + (size_t)u.pm * 256 * DM : xs + (size_t)(u.pm - MP / 256) * 256 * DM;
        float* ob = out + (size_t)u.pm * 256 * DM;
        const int rl0 = wr * 64 + fr, col0 = u.pn * 256 + wc * 32 + 4 * fq;
#pragma unroll
        for (int ai = 0; ai < 2; ++ai) {
            f32x4 xv[4][2][2];
#pragma unroll
            for (int m = 0; m < 4; ++m)
#pragma unroll
                for (int bj = 0; bj < 2; ++bj)
#pragma unroll
                    for (int n = 0; n < 2; ++n) xv[m][bj][n] = *(const f32x4*)(xb + (size_t)(rl0 + ai * 128 + m * 16) * DM + col0 + bj * 128 + n * 16);
#pragma unroll
            for (int m = 0; m < 4; ++m)
#pragma unroll
                for (int bj = 0; bj < 2; ++bj)
#pragma unroll
                    for (int n = 0; n < 2; ++n) *(f32x4*)(ob + (size_t)(rl0 + ai * 128 + m * 16) * DM + col0 + bj * 128 + n * 16) = acc[ai][bj][m][n] + xv[m][bj][n];
            asm volatile("" ::: "memory"); }
    }
};

constexpr int SS_X = 0, SS_XD = 9216, SS_BM = 18432, SS_CM = 35840, SS_SET = 53248;
constexpr int SS_SB = 2 * SS_SET, SS_WM = SS_SB + 17408, SS_SM = SS_WM + 9216;
constexpr int LD64 = 144, LD128 = 272;
typedef short s16x4 __attribute__((ext_vector_type(4)));

DI bf16x8 lds_frag(const LAS unsigned char* tile, int ld, int row0, int k0, int lane) {
    return *(const LAS bf16x8*)(tile + (row0 + (lane & 15)) * ld + (k0 + 8 * (lane >> 4)) * 2);
}
DI bf16x8 lds_frag_tr(const LAS unsigned char* tile, int ld, int k0, int c0, int lane) {
    const LAS unsigned char* a = tile + (k0 + 8 * (lane >> 4) + ((lane & 15) >> 2)) * ld + (c0 + 4 * (lane & 3)) * 2;
    const s16x4 lo = __builtin_amdgcn_ds_read_tr16_b64_v4i16((LAS s16x4*)a), hi = __builtin_amdgcn_ds_read_tr16_b64_v4i16((LAS s16x4*)(a + 4 * ld));
    return (bf16x8){lo.x, lo.y, lo.z, lo.w, hi.x, hi.y, hi.z, hi.w};
}
DI bf16x8 lds_frag_tr2(const LAS unsigned char* tile, int ld, int k0, int c0, int lane) {
    const LAS unsigned char* a = tile + (k0 + 4 * (lane >> 4) + ((lane & 15) >> 2)) * ld + (c0 + 4 * (lane & 3)) * 2;
    const s16x4 lo = __builtin_amdgcn_ds_read_tr16_b64_v4i16((LAS s16x4*)a), hi = __builtin_amdgcn_ds_read_tr16_b64_v4i16((LAS s16x4*)(a + 16 * ld));
    return (bf16x8){lo.x, lo.y, lo.z, lo.w, hi.x, hi.y, hi.z, hi.w};
}
#define MFMA16T(rowsfrag, colsfrag, acc) MFMA16((colsfrag), (rowsfrag), (acc))

#define DPP_ADD_(v, ctrl, rmask) ((v) + __builtin_bit_cast(float, __builtin_amdgcn_update_dpp(0, __builtin_bit_cast(int, (v)), (ctrl), (rmask), 0xf, false)))
DI float wave_incl_scan(float v) {
    v = DPP_ADD_(v, 0x111, 0xf); v = DPP_ADD_(v, 0x112, 0xf); v = DPP_ADD_(v, 0x114, 0xf); v = DPP_ADD_(v, 0x118, 0xf);
    v = DPP_ADD_(v, 0x142, 0xa);
    v = DPP_ADD_(v, 0x143, 0xc);
    return v;
}
DI void convbc_prepass(Ctx& F) {
    const int gw = F.bid * 8 + F.wave, NGW = F.G * 8, lane = F.lane;
    const bf16_t* PROJ = (const bf16_t*)(F.ws + WS_PROJ); bf16_t* BCC = (bf16_t*)(F.ws + WS_BCC);
    const int ch0 = 1024 + lane * 8;
    float wv[4][8], bv[8];
#pragma unroll
    for (int e = 0; e < 8; ++e) { bv[e] = F.in[I_CONVB][ch0 + e];
#pragma unroll
        for (int j = 0; j < 4; ++j) wv[j][e] = F.in[I_CONVW][j * 1536 + ch0 + e]; }
    const bool bal = (F.G == 256);
    const int nmine = bal ? 1 : (MTOT / 33 - gw + NGW - 1) / NGW;
    for (int ti = 0; ti < nmine; ++ti) {
        int ub, nb;
        if (bal) { const int wv_ = F.wave;
            if (F.bid < 64) { ub = (F.bid * 8 + wv_) * 2; nb = 2; } else if (F.bid < 128) { ub = 1024 + ((F.bid - 64) * 8 + wv_) * 4; nb = 4; } else { ub = 3072 + ((F.bid - 128) * 8 + wv_) * 3; nb = 3; } }
        else { ub = (gw + ti * NGW) * 3; nb = 3; }
        const int row0 = ub * 11;
        float h0[8], h1[8], h2[8];
        { const bool smp0 = row0 >= MP; const int lrow0 = smp0 ? (row0 - MP) & 63 : row0 & (T_P - 1);
          const float* sc0 = F.in[I_SCONV] + (size_t)(smp0 ? (row0 - MP) >> 6 : 0) * 3 * 1536 + ch0;
#define CONV_HALO(dst, j) do { const int lr_ = lrow0 - 3 + (j); \
              if (lr_ >= 0) unpack8(*(const u32x4*)(PROJ + (size_t)(row0 - 3 + (j)) * NPROJ + C_XBC + ch0), dst); \
              else { _Pragma("unroll") for (int e = 0; e < 8; ++e) dst[e] = smp0 ? sc0[(3 + lr_) * 1536 + e] : 0.f; } } while (0)
          CONV_HALO(h0, 0); CONV_HALO(h1, 1); CONV_HALO(h2, 2);
#undef CONV_HALO
        }
        u32x4 rawA[11], rawB[11];
#pragma unroll
        for (int i = 0; i < 11; ++i) rawA[i] = *(const u32x4*)(PROJ + (size_t)(row0 + i) * NPROJ + C_XBC + ch0);
#define CONV_BATCH(bt, cur, nxt) do { \
            if ((bt) + 1 < nb) { _Pragma("unroll") for (int i = 0; i < 11; ++i) nxt[i] = *(const u32x4*)(PROJ + (size_t)(row0 + 11 * ((bt) + 1) + i) * NPROJ + C_XBC + ch0); } \
            _Pragma("unroll") for (int i = 0; i < 11; ++i) { const int row = row0 + 11 * (bt) + i; \
                const bool smp = row >= MP; const int lrow = smp ? (row - MP) & 63 : row & (T_P - 1); \
                if (lrow == 0) { \
                    if (smp) { const float* sc = F.in[I_SCONV] + (size_t)((row - MP) >> 6) * 3 * 1536 + ch0; \
                        _Pragma("unroll") for (int e = 0; e < 8; ++e) { h0[e] = sc[e]; h1[e] = sc[1536 + e]; h2[e] = sc[2 * 1536 + e]; } } \
                    else { _Pragma("unroll") for (int e = 0; e < 8; ++e) { h0[e] = 0.f; h1[e] = 0.f; h2[e] = 0.f; } } } \
                float cur_[8], o[8]; \
                unpack8(cur[i], cur_); \
                _Pragma("unroll") for (int e = 0; e < 8; ++e) { o[e] = siluf(bv[e] + wv[0][e] * h0[e] + wv[1][e] * h1[e] + wv[2][e] * h2[e] + wv[3][e] * cur_[e]); h0[e] = h1[e]; h1[e] = h2[e]; h2[e] = cur_[e]; } \
                *(u32x4*)(BCC + (size_t)row * 512 + lane * 8) = pack8(o); } } while (0)
        CONV_BATCH(0, rawA, rawB); CONV_BATCH(1, rawB, rawA); if (nb > 2) CONV_BATCH(2, rawA, rawB); if (nb > 3) CONV_BATCH(3, rawB, rawA);
#undef CONV_BATCH
    }
}

DI void ssd_item(Ctx& F, int sq, int h, bool do_sumsq) {
    LAS unsigned char* lds = F.lds;
    const int tid = F.tid, lane = F.lane, w = F.wave, g = h >> 3;
    const bool smp = sq >= NB_P; const int sb = sq - NB_P;
    const int row_base = smp ? MP + sb * 64 : sq * T_P, nchunks = smp ? 1 : 64;
    const bf16_t* PROJ = (const bf16_t*)(F.ws + WS_PROJ); const bf16_t* BCC = (const bf16_t*)(F.ws + WS_BCC); const float* DT = (const float*)(F.ws + WS_DT);
    bf16_t* MIX = (bf16_t*)(F.ws + WS_MIX); float* SUMSQ = (float*)(F.ws + WS_SSQ);
    const float a_h = -__expf(F.in[I_ALOG][h]), d_h = F.in[I_DSKIP][h];
    const int pt = w >> 1, nh = w & 1, lt = w >> 1;
    const int xl = tid >> 3, xg = tid & 7, chx = h * 64 + 8 * xg;
    LAS float* sm_cw0 = (LAS float*)(lds + SS_SM + 1024 + 768);
    if (tid >= 192 && tid < 512) { const int i = tid - 192; const int j = i >> 6, chn = h * 64 + (i & 63); sm_cw0[i] = j < 4 ? F.in[I_CONVW][j * 1536 + chn] : F.in[I_CONVB][chn]; }
    f32x4 st[4];
#pragma unroll
    for (int q = 0; q < 4; ++q) {
        if (smp) st[q] = *(const f32x4*)(F.in[I_SSM] + ((size_t)(sb * 16 + h) * 64 + 16 * pt + (lane & 15)) * 128 + 16 * (4 * nh + q) + 4 * (lane >> 4));
        else st[q] = (f32x4){0.f, 0.f, 0.f, 0.f};
    }
    u32x4 px0[4], px1[4] = {{0u, 0u, 0u, 0u}, {0u, 0u, 0u, 0u}, {0u, 0u, 0u, 0u}, {0u, 0u, 0u, 0u}}, pbs[2], pcs[2]; u32x2 pz0[2], pz1[2] = {{0u, 0u}, {0u, 0u}}; float pdt0, pdt1 = 0.f;
#define SSD_ISSUE_X(c_, PX_) do { const int row0_ = row_base + 64 * (c_); \
        _Pragma("unroll") for (int j_ = 0; j_ < 4; ++j_) { int rr_ = xl - 3 + j_; if ((c_) == 0 && rr_ < 0) rr_ = 0; PX_[j_] = *(const u32x4*)(PROJ + (size_t)(row0_ + rr_) * NPROJ + C_XBC + chx); } } while (0)
#define SSD_ISSUE_BC(c_) do { const int row0_ = row_base + 64 * (c_); \
        _Pragma("unroll") for (int i_ = 0; i_ < 2; ++i_) { const int t_ = tid + 512 * i_; \
            pbs[i_] = *(const u32x4*)(BCC + (size_t)(row0_ + (t_ >> 4)) * 512 + g * 128 + 8 * (t_ & 15)); pcs[i_] = *(const u32x4*)(BCC + (size_t)(row0_ + (t_ >> 4)) * 512 + 256 + g * 128 + 8 * (t_ & 15)); } } while (0)
#define SSD_ISSUE_ZDT(c_, PZ_, PDT_) do { const int row0_ = row_base + 64 * (c_); \
        _Pragma("unroll") for (int pi_ = 0; pi_ < 2; ++pi_) PZ_[pi_] = *(const u32x2*)(PROJ + (size_t)(row0_ + 16 * lt + (lane & 15)) * NPROJ + C_Z + h * 64 + 16 * (2 * nh + pi_) + 4 * (lane >> 4)); \
        PDT_ = DT[(size_t)(row0_ + lane) * 16 + h]; } while (0)
    LAS float* sm_init = (LAS float*)(lds + SS_SM + 1024);
    if (tid < 192) sm_init[tid] = smp ? F.in[I_SCONV][(size_t)(sb * 3 + (tid >> 6)) * 1536 + h * 64 + (tid & 63)] : 0.f;
#if TIMESEG
    long long ts_[6] = {0, 0, 0, 0, 0, 0}; long long tacc_ = 0;
#define SSD_TS(k) do { ts_[k] = (long long)__builtin_amdgcn_s_memtime(); if ((k) == 5) tacc_ += ts_[TIMESEG_B] - ts_[TIMESEG_A]; } while (0)
#else
#define SSD_TS(k) do { } while (0)
#endif
#define SSD_STEP(c, PX_, PZ_, PDT_, PZN_, PDTN_, PXN_) do { \
        const int row0 = row_base + 64 * c; LAS unsigned char* ts = lds + (c & 1) * SS_SET; \
        SSD_TS(0); \
        LAS float* sm_ac = (LAS float*)(lds + SS_SM + (c & 1) * 512); LAS float* sm_dt = sm_ac + 64; \
        const float dtl = PDT_; \
        float ac = dtl * a_h; \
        ac = wave_incl_scan(ac); \
        const float ac_last = __builtin_bit_cast(float, __builtin_amdgcn_readlane(__builtin_bit_cast(int, ac), 63)); \
        const float wgt_l = __expf(ac_last - ac) * dtl; \
        if (w == 0) { sm_ac[lane] = ac; sm_dt[lane] = dtl; } \
        { \
        { float xr[4][8], o[8], od[8]; \
_Pragma("unroll")           for (int j = 0; j < 4; ++j) unpack8(PX_[j], xr[j]); \
          if (c == 0) { \
_Pragma("unroll")               for (int j = 0; j < 3; ++j) { const int rr = xl - 3 + j; const LAS f32x4* iv = (const LAS f32x4*)(sm_init + (rr < 0 ? 3 + rr : 0) * 64 + 8 * xg); \
                  f32x4 i0 = iv[0], i1 = iv[1]; asm volatile("" : "+v"(i0), "+v"(i1)); \
_Pragma("unroll")                   for (int e = 0; e < 4; ++e) { xr[j][e] = (rr < 0) ? i0[e] : xr[j][e]; xr[j][4 + e] = (rr < 0) ? i1[e] : xr[j][4 + e]; } } } \
          const float wg = __shfl(wgt_l, xl & 63); \
          float wv[4][8], bv[8]; unsigned cwo_ = (unsigned)(8 * xg) * 4u; asm volatile("" : "+v"(cwo_)); const LAS float* sm_cw = (const LAS float*)((const LAS unsigned char*)sm_cw0 + cwo_) - 8 * xg; \
          _Pragma("unroll") for (int j_ = 0; j_ < 4; ++j_) { const f32x4 a_ = *(const LAS f32x4*)(sm_cw + j_ * 64 + 8 * xg), b_ = *(const LAS f32x4*)(sm_cw + j_ * 64 + 8 * xg + 4); \
              _Pragma("unroll") for (int e_ = 0; e_ < 4; ++e_) { wv[j_][e_] = a_[e_]; wv[j_][4 + e_] = b_[e_]; } } \
          { const f32x4 a_ = *(const LAS f32x4*)(sm_cw + 256 + 8 * xg), b_ = *(const LAS f32x4*)(sm_cw + 256 + 8 * xg + 4); _Pragma("unroll") for (int e_ = 0; e_ < 4; ++e_) { bv[e_] = a_[e_]; bv[4 + e_] = b_[e_]; } } \
_Pragma("unroll")           for (int e = 0; e < 8; ++e) { o[e] = siluf(bv[e] + wv[0][e] * xr[0][e] + wv[1][e] * xr[1][e] + wv[2][e] * xr[2][e] + wv[3][e] * xr[3][e]); od[e] = o[e] * wg; } \
          *(LAS u32x4*)(ts + SS_X + xl * LD64 + xg * 16) = pack8(o); \
          *(LAS u32x4*)(ts + SS_XD + xl * LD64 + xg * 16) = pack8(od); } \
_Pragma("unroll")         for (int i = 0; i < 2; ++i) { const int t = tid + 512 * i; \
            *(LAS u32x4*)(ts + SS_BM + (t >> 4) * LD128 + (t & 15) * 16) = pbs[i]; *(LAS u32x4*)(ts + SS_CM + (t >> 4) * LD128 + (t & 15) * 16) = pcs[i]; } \
        } \
        if (c + 2 < nchunks) SSD_ISSUE_X(c + 2, PX_); if (c + 1 < nchunks) { SSD_ISSUE_BC(c + 1); SSD_ISSUE_ZDT(c + 1, PZN_, PDTN_); } \
        SSD_TS(1); __syncthreads(); SSD_TS(2); \
_Pragma("unroll")         for (int q = 0; q < 4; ++q) { u32x2 v; v.x = pk2(st[q][0], st[q][1]); v.y = pk2(st[q][2], st[q][3]); \
            *(LAS u32x2*)(lds + SS_SB + (16 * pt + (lane & 15)) * LD128 + (16 * (4 * nh + q) + 4 * (lane >> 4)) * 2) = v; } \
        bf16x8 cmf[4]; \
_Pragma("unroll")         for (int ks = 0; ks < 4; ++ks) cmf[ks] = lds_frag(ts + SS_CM, LD128, 16 * lt, 32 * ks, lane); \
        { const float acl = sm_ac[16 * lt + (lane & 15)]; const int l = 16 * lt + (lane & 15); \
_Pragma("unroll")           for (int si = 0; si < 2; ++si) { const int stl = 2 * nh + si; f32x4 gacc = {0.f, 0.f, 0.f, 0.f}; \
              if (stl <= lt) { bf16x8 bmf[4]; \
_Pragma("unroll")                   for (int ks = 0; ks < 4; ++ks) bmf[ks] = lds_frag(ts + SS_BM, LD128, 16 * stl, 32 * ks, lane); \
                  __builtin_amdgcn_sched_barrier(0); \
_Pragma("unroll")                   for (int ks = 0; ks < 4; ++ks) gacc = MFMA16T(cmf[ks], bmf[ks], gacc); } \
              const int s0 = 16 * stl + 4 * (lane >> 4); \
              const f32x4 acs = *(const LAS f32x4*)(sm_ac + s0), dts = *(const LAS f32x4*)(sm_dt + s0); \
              float v[4]; \
_Pragma("unroll")               for (int r = 0; r < 4; ++r) { v[r] = gacc[r] * __expf(fminf(acl - acs[r], 0.f)) * dts[r]; v[r] = (l >= s0 + r) ? v[r] : 0.f; } \
              u32x2 pk; pk.x = pk2(v[0], v[1]); pk.y = pk2(v[2], v[3]); \
              *(LAS u32x2*)(lds + SS_WM + l * LD64 + s0 * 2) = pk; } } \
        SSD_TS(3); __syncthreads(); SSD_TS(4); \
        { \
        { const int l = 16 * lt + (lane & 15); const float eal = __expf(sm_ac[l]); \
          bf16x8 wmf[2]; \
_Pragma("unroll")           for (int ks = 0; ks < 2; ++ks) wmf[ks] = lds_frag(lds + SS_WM, LD64, 16 * lt, 32 * ks, lane); \
          float ssq = 0.f; \
_Pragma("unroll")           for (int pi = 0; pi < 2; ++pi) { const int ptl = 2 * nh + pi; const int p0 = 16 * ptl + 4 * (lane >> 4); \
              bf16x8 sbf[4], xtf[2]; \
_Pragma("unroll")               for (int ks = 0; ks < 4; ++ks) sbf[ks] = lds_frag(lds + SS_SB, LD128, 16 * ptl, 32 * ks, lane); \
_Pragma("unroll")               for (int ks = 0; ks < 2; ++ks) xtf[ks] = lds_frag_tr(ts + SS_X, LD64, 32 * ks, 16 * ptl, lane); \
              __builtin_amdgcn_sched_barrier(0); \
              f32x4 y = {0.f, 0.f, 0.f, 0.f}; \
_Pragma("unroll")               for (int ks = 0; ks < 4; ++ks) y = MFMA16T(cmf[ks], sbf[ks], y); \
              y = y * eal; \
_Pragma("unroll")               for (int ks = 0; ks < 2; ++ks) y = MFMA16T(wmf[ks], xtf[ks], y); \
              const u32x2 xraw = *(const LAS u32x2*)(ts + SS_X + l * LD64 + p0 * 2); \
              const float xv[4] = {__uint_as_float(xraw.x << 16), __uint_as_float(xraw.x & 0xffff0000u), __uint_as_float(xraw.y << 16), __uint_as_float(xraw.y & 0xffff0000u)}; \
              const float zv[4] = {__uint_as_float(PZ_[pi].x << 16), __uint_as_float(PZ_[pi].x & 0xffff0000u), __uint_as_float(PZ_[pi].y << 16), __uint_as_float(PZ_[pi].y & 0xffff0000u)}; \
              float gv[4]; \
_Pragma("unroll")               for (int r = 0; r < 4; ++r) { gv[r] = (y[r] + d_h * xv[r]) * siluf(zv[r]); ssq += gv[r] * gv[r]; } \
              u32x2 pk; pk.x = pk2(gv[0], gv[1]); pk.y = pk2(gv[2], gv[3]); \
              *(u32x2*)(MIX + (size_t)(row0 + l) * 2048 + h * 64 + p0) = pk; } \
          ssq = xor32_sum(xor16_sum(ssq)); \
          if (lane < 16 && do_sumsq) unsafeAtomicAdd(SUMSQ + row0 + l, ssq); } \
        } \
        { const float cd = __expf(ac_last); \
          bf16x8 xa[2]; \
_Pragma("unroll")           for (int ks = 0; ks < 2; ++ks) xa[ks] = lds_frag_tr(ts + SS_XD, LD64, 32 * ks, 16 * pt, lane); \
          bf16x8 btf[4][2]; \
_Pragma("unroll")           for (int q = 0; q < 4; ++q) \
_Pragma("unroll")               for (int ks = 0; ks < 2; ++ks) btf[q][ks] = lds_frag_tr(ts + SS_BM, LD128, 32 * ks, 16 * (4 * nh + q), lane); \
          __builtin_amdgcn_sched_barrier(0); \
_Pragma("unroll")           for (int q = 0; q < 4; ++q) { f32x4 s = st[q] * cd; \
_Pragma("unroll")               for (int ks = 0; ks < 2; ++ks) s = MFMA16T(xa[ks], btf[q][ks], s); \
              st[q] = s; } } \
        asm volatile("" : "+v"(PDTN_), "+v"(PZN_[0]), "+v"(PZN_[1]), "+v"(PXN_[0]), "+v"(PXN_[1]), "+v"(PXN_[2]), "+v"(PXN_[3]), "+v"(pbs[0]), "+v"(pbs[1]), "+v"(pcs[0]), "+v"(pcs[1])); \
        SSD_TS(5); \
    } while (0)
    SSD_ISSUE_X(0, px0); SSD_ISSUE_BC(0); SSD_ISSUE_ZDT(0, pz0, pdt0);
    __syncthreads();
    if (nchunks > 1) { SSD_ISSUE_X(1, px1); }
    asm volatile("" : "+v"(pdt0), "+v"(pz0[0]), "+v"(pz0[1]), "+v"(px0[0]), "+v"(px0[1]), "+v"(px0[2]), "+v"(px0[3]), "+v"(pbs[0]), "+v"(pbs[1]), "+v"(pcs[0]), "+v"(pcs[1]));
#pragma unroll 1
    for (int c2 = 0; c2 < nchunks; c2 += 2) {
        { const int c = c2; SSD_STEP(c, px0, pz0, pdt0, pz1, pdt1, px1); }
        if (c2 + 1 < nchunks) { const int c = c2 + 1; SSD_STEP(c, px1, pz1, pdt1, pz0, pdt0, px0); }
    }
#undef SSD_STEP
#undef SSD_ISSUE_X
#undef SSD_ISSUE_BC
#undef SSD_ISSUE_ZDT
#if TIMESEG
    if (F.bid == 0 && sq == 0 && tid == 64 * TIMEWAVE) F.out[O_CONVP] = (float)((((tacc_ / 64) + TIMEQ / 2 + TIMEOFF) / TIMEQ) * TIMEQ);
#endif
    { float* so = F.out + (smp ? O_SSMS + ((size_t)(sb * 16 + h) * 64) * 128 : O_SSMP + ((size_t)(sq * 16 + h) * 64) * 128);
#pragma unroll
      for (int q = 0; q < 4; ++q) *(f32x4*)(so + (16 * pt + (lane & 15)) * 128 + 16 * (4 * nh + q) + 4 * (lane >> 4)) = st[q]; }
    __syncthreads();
}
DI void p2a_phase(Ctx& F) {
    convbc_prepass(F);
    {
        const bf16_t* PROJ = (const bf16_t*)(F.ws + WS_PROJ);
        for (int i = F.bid * 512 + F.tid; i < 48 * 3 * 1536; i += F.G * 512) {
            const int ch = i % 1536, j = (i / 1536) % 3, sq = i / (3 * 1536);
            if (sq < NB_P) F.out[O_CONVP + (size_t)(sq * 3 + j) * 1536 + ch] = bf2f(PROJ[(size_t)(sq * T_P + T_P - 3 + j) * NPROJ + C_XBC + ch]);
            else F.out[O_CONVS + (size_t)((sq - NB_P) * 3 + j) * 1536 + ch] = bf2f(PROJ[(size_t)(MP + (sq - NB_P) * 64 + 61 + j) * NPROJ + C_XBC + ch]);
        }
    }
}
constexpr int WR_SLOT = 19456, WR_V = 9216, LDKW = 144, LDVW = 160;

constexpr int WR_ROPE = 4 * WR_SLOT + 512, WR_ROPE_LD = 272, WR_ROPE_BUF = 64 * 272;
constexpr int WR_GK = 4 * WR_SLOT, WR_GQ = 4 * WR_SLOT + 256;
struct KPre { f32x4 r[4]; };
DI void wa_kpre_load(Ctx& F, int pos, KPre& P) {
    const int q4 = F.tid & 3;
    const f32x4* rp = (const f32x4*)((const f32x2*)(F.ws + WS_ROPE) + pos * 32 + 8 * q4);
#pragma unroll
    for (int j = 0; j < 4; ++j) P.r[j] = rp[j];
}
DI void wa_write_k_pre(Ctx& F, LAS unsigned char* slot, int kvh, const u32x4 ra, const u32x4 rb, const KPre& P, float* ko, LAS unsigned char* ropew) {
    const int i = F.tid >> 2, q4 = F.tid & 3;
#pragma unroll
    for (int j = 0; j < 4; ++j) *(LAS f32x4*)(ropew + i * WR_ROPE_LD + q4 * 64 + 16 * j) = P.r[j];
    float a[8], bb[8], o1[8], o2[8];
    unpack8(ra, a); unpack8(rb, bb);
    float s = 0.f;
#pragma unroll
    for (int e = 0; e < 8; ++e) s += a[e] * a[e] + bb[e] * bb[e];
    s += __shfl_xor(s, 1); s += __shfl_xor(s, 2);
    const float rstd = __builtin_amdgcn_rsqf(s * (1.0f / 64.0f) + EPSF);
    f32x4 g_[4];
    { const LAS f32x4* gl = (const LAS f32x4*)(F.lds + WR_GK); g_[0] = gl[2 * q4]; g_[1] = gl[2 * q4 + 1]; g_[2] = gl[8 + 2 * q4]; g_[3] = gl[8 + 2 * q4 + 1]; }
#pragma unroll
    for (int e = 0; e < 8; ++e) { const float an = a[e] * rstd * g_[e >> 2][e & 3], bn = bb[e] * rstd * g_[2 + (e >> 2)][e & 3];
        const float cx = P.r[e >> 1][2 * (e & 1)], cy = P.r[e >> 1][2 * (e & 1) + 1]; o1[e] = an * cx - bn * cy; o2[e] = bn * cx + an * cy; }
    *(LAS u32x4*)(slot + i * LDKW + (8 * q4) * 2) = pack8(o1);
    *(LAS u32x4*)(slot + i * LDKW + (32 + 8 * q4) * 2) = pack8(o2);
    if (ko) { float* p = ko + ((size_t)i * 2 + kvh) * 64;
        *(f32x4*)(p + 8 * q4) = (f32x4){o1[0], o1[1], o1[2], o1[3]}; *(f32x4*)(p + 8 * q4 + 4) = (f32x4){o1[4], o1[5], o1[6], o1[7]};
        *(f32x4*)(p + 32 + 8 * q4) = (f32x4){o2[0], o2[1], o2[2], o2[3]}; *(f32x4*)(p + 32 + 8 * q4 + 4) = (f32x4){o2[4], o2[5], o2[6], o2[7]}; }
}
DI void wa_write_k(Ctx& F, LAS unsigned char* slot, int kvh, const u32x4 ra, const u32x4 rb, int pos, float* ko) {
    const int i = F.tid >> 2, q4 = F.tid & 3;
    float a[8], bb[8], o1[8], o2[8];
    unpack8(ra, a); unpack8(rb, bb);
    float s = 0.f;
#pragma unroll
    for (int e = 0; e < 8; ++e) s += a[e] * a[e] + bb[e] * bb[e];
    s += __shfl_xor(s, 1); s += __shfl_xor(s, 2);
    const float rstd = __builtin_amdgcn_rsqf(s * (1.0f / 64.0f) + EPSF);
    const f32x2* ROPE = (const f32x2*)(F.ws + WS_ROPE);
    float gk1[8], gk2[8]; f32x2 rcs[8];
    { const f32x4 a0 = *(const f32x4*)(F.in[I_GK] + 8 * q4), a1 = *(const f32x4*)(F.in[I_GK] + 8 * q4 + 4), b0 = *(const f32x4*)(F.in[I_GK] + 32 + 8 * q4), b1 = *(const f32x4*)(F.in[I_GK] + 32 + 8 * q4 + 4);
#pragma unroll
      for (int e = 0; e < 4; ++e) { gk1[e] = a0[e]; gk1[4 + e] = a1[e]; gk2[e] = b0[e]; gk2[4 + e] = b1[e]; }
      const f32x4* rp = (const f32x4*)(ROPE + pos * 32 + 8 * q4);
#pragma unroll
      for (int i = 0; i < 4; ++i) { const f32x4 t4 = rp[i]; rcs[2 * i] = (f32x2){t4.x, t4.y}; rcs[2 * i + 1] = (f32x2){t4.z, t4.w}; } }
#pragma unroll
    for (int e = 0; e < 8; ++e) { const float an = a[e] * rstd * gk1[e], bn = bb[e] * rstd * gk2[e];
        const f32x2 cs = rcs[e]; o1[e] = an * cs.x - bn * cs.y; o2[e] = bn * cs.x + an * cs.y; }
    *(LAS u32x4*)(slot + i * LDKW + (8 * q4) * 2) = pack8(o1);
    *(LAS u32x4*)(slot + i * LDKW + (32 + 8 * q4) * 2) = pack8(o2);
    if (ko) { float* p = ko + ((size_t)i * 2 + kvh) * 64;
        *(f32x4*)(p + 8 * q4) = (f32x4){o1[0], o1[1], o1[2], o1[3]}; *(f32x4*)(p + 8 * q4 + 4) = (f32x4){o1[4], o1[5], o1[6], o1[7]};
        *(f32x4*)(p + 32 + 8 * q4) = (f32x4){o2[0], o2[1], o2[2], o2[3]}; *(f32x4*)(p + 32 + 8 * q4 + 4) = (f32x4){o2[4], o2[5], o2[6], o2[7]}; }
}
DI void wa_write_v(Ctx& F, LAS unsigned char* slot, int kvh, const u32x4 rv, float* vo) {
    const int i = F.tid >> 3, q8 = F.tid & 7;
    *(LAS u32x4*)(slot + WR_V + i * LDVW + q8 * 16) = rv;
    if (vo) { float v[8]; unpack8(rv, v); float* p = vo + ((size_t)i * 2 + kvh) * 64 + 8 * q8;
        *(f32x4*)p = (f32x4){v[0], v[1], v[2], v[3]}; *(f32x4*)(p + 4) = (f32x4){v[4], v[5], v[6], v[7]}; }
}
DI void wa_stage_cache(Ctx& F, LAS unsigned char* slot, int kvh, const float* ck, const float* cv, float* ko, float* vo) {
    if (F.tid < 256) { const int i = F.tid >> 2, q4 = F.tid & 3; const float* src = ck + ((size_t)i * 2 + kvh) * 64;
        const f32x4 a0 = *(const f32x4*)(src + 8 * q4), a1 = *(const f32x4*)(src + 8 * q4 + 4), b0 = *(const f32x4*)(src + 32 + 8 * q4), b1 = *(const f32x4*)(src + 32 + 8 * q4 + 4);
        u32x4 pa, pb; pa.x = pk2(a0.x, a0.y); pa.y = pk2(a0.z, a0.w); pa.z = pk2(a1.x, a1.y); pa.w = pk2(a1.z, a1.w); pb.x = pk2(b0.x, b0.y); pb.y = pk2(b0.z, b0.w); pb.z = pk2(b1.x, b1.y); pb.w = pk2(b1.z, b1.w);
        *(LAS u32x4*)(slot + i * LDKW + (8 * q4) * 2) = pa; *(LAS u32x4*)(slot + i * LDKW + (32 + 8 * q4) * 2) = pb;
        if (ko) { float* p = ko + ((size_t)i * 2 + kvh) * 64; *(f32x4*)(p + 8 * q4) = a0; *(f32x4*)(p + 8 * q4 + 4) = a1; *(f32x4*)(p + 32 + 8 * q4) = b0; *(f32x4*)(p + 32 + 8 * q4 + 4) = b1; } }
    { const int i = F.tid >> 3, q8 = F.tid & 7; const float* src = cv + ((size_t)i * 2 + kvh) * 64 + 8 * q8; const f32x4 v0 = *(const f32x4*)src, v1 = *(const f32x4*)(src + 4);
      u32x4 pv; pv.x = pk2(v0.x, v0.y); pv.y = pk2(v0.z, v0.w); pv.z = pk2(v1.x, v1.y); pv.w = pk2(v1.z, v1.w);
      *(LAS u32x4*)(slot + WR_V + i * LDVW + q8 * 16) = pv;
      if (vo) { float* p = vo + ((size_t)i * 2 + kvh) * 64 + 8 * q8; *(f32x4*)p = v0; *(f32x4*)(p + 4) = v1; } }
}
DI void wa_load_q(Ctx& F, int kvh, size_t crow0, u32x4 (&qraw)[2][2]) {
    const int lane = F.lane, w = F.wave, g4 = lane >> 4; const int hq = kvh * 4 + (w >> 1);
    const bf16_t* PROJ = (const bf16_t*)(F.ws + WS_PROJ);
#pragma unroll
    for (int rg = 0; rg < 2; ++rg) { const size_t row = crow0 + 32 * (w & 1) + 16 * rg + (lane & 15);
        qraw[rg][0] = *(const u32x4*)(PROJ + row * NPROJ + C_Q + hq * 64 + 8 * g4); qraw[rg][1] = *(const u32x4*)(PROJ + row * NPROJ + C_Q + hq * 64 + 32 + 8 * g4); }
}
DI void wa_compute(Ctx& F, int kvh, size_t crow0, int pos0, int sl0, int sl1, int sl2, int ninv, const u32x4 (&qraw)[2][2], KPre& KP, int kpos, int ropesel) {
    LAS unsigned char* lds = F.lds;
    const int lane = F.lane, w = F.wave, g4 = lane >> 4;
    const bf16_t* PROJ = (const bf16_t*)(F.ws + WS_PROJ); const f32x2* ROPE = (const f32x2*)(F.ws + WS_ROPE); bf16_t* MIX = (bf16_t*)(F.ws + WS_MIX);
    const int hq = kvh * 4 + (w >> 1); const float sink = F.in[I_SINKS][hq] * 1.4426950408889634f;
    bf16x8 qa[2][2];
    float gq1[8], gq2[8];
    { f32x4 a0, a1, b0, b1;
      if (ropesel >= 0) { const LAS f32x4* gl = (const LAS f32x4*)(lds + WR_GQ); a0 = gl[2 * g4]; a1 = gl[2 * g4 + 1]; b0 = gl[8 + 2 * g4]; b1 = gl[8 + 2 * g4 + 1]; }
      else { a0 = *(const f32x4*)(F.in[I_GQ] + 8 * g4); a1 = *(const f32x4*)(F.in[I_GQ] + 8 * g4 + 4); b0 = *(const f32x4*)(F.in[I_GQ] + 32 + 8 * g4); b1 = *(const f32x4*)(F.in[I_GQ] + 32 + 8 * g4 + 4); }
#pragma unroll
      for (int e = 0; e < 4; ++e) { gq1[e] = a0[e]; gq1[4 + e] = a1[e]; gq2[e] = b0[e]; gq2[4 + e] = b1[e]; } }
#pragma unroll
    for (int rg = 0; rg < 2; ++rg) {
        const int d0 = 8 * g4; float a[8], bb[8];
        unpack8(qraw[rg][0], a);
        unpack8(qraw[rg][1], bb);
        float s = 0.f;
#pragma unroll
        for (int e = 0; e < 8; ++e) s += a[e] * a[e] + bb[e] * bb[e];
        s = xor32_sum(xor16_sum(s));
        const float rstd = 0.18033688011112042f * __builtin_amdgcn_rsqf(s * (1.0f / 64.0f) + EPSF);
        const int pos = pos0 + 32 * (w & 1) + 16 * rg + (lane & 15);
        f32x2 rcs[8];
        if (ropesel >= 0) { const LAS f32x4* rp = (const LAS f32x4*)(lds + WR_ROPE + ropesel * WR_ROPE_BUF + (32 * (w & 1) + 16 * rg + (lane & 15)) * WR_ROPE_LD + g4 * 64);
#pragma unroll
          for (int i = 0; i < 4; ++i) { const f32x4 t4 = rp[i]; rcs[2 * i] = (f32x2){t4.x, t4.y}; rcs[2 * i + 1] = (f32x2){t4.z, t4.w}; } }
        else { const f32x4* rp = (const f32x4*)(ROPE + pos * 32 + d0);
#pragma unroll
          for (int i = 0; i < 4; ++i) { const f32x4 t4 = rp[i]; rcs[2 * i] = (f32x2){t4.x, t4.y}; rcs[2 * i + 1] = (f32x2){t4.z, t4.w}; } }
        float o1[8], o2[8];
#pragma unroll
        for (int e = 0; e < 8; ++e) { const float an = a[e] * rstd * gq1[e], bn = bb[e] * rstd * gq2[e];
            const f32x2 cs = rcs[e]; o1[e] = an * cs.x - bn * cs.y; o2[e] = bn * cs.x + an * cs.y; }
        qa[rg][0] = __builtin_bit_cast(bf16x8, pack8(o1)); qa[rg][1] = __builtin_bit_cast(bf16x8, pack8(o2)); }
    f32x4 s[2][12];
#pragma unroll
    for (int jt = 0; jt < 12; ++jt) { const int j = jt >> 2; const LAS unsigned char* kt = lds + (j == 0 ? sl0 : (j == 1 ? sl1 : sl2)) * WR_SLOT;
        const bf16x8 k0 = lds_frag(kt, LDKW, 16 * (jt & 3), 0, lane), k1 = lds_frag(kt, LDKW, 16 * (jt & 3), 32, lane);
#pragma unroll
        for (int rg = 0; rg < 2; ++rg) { f32x4 acc = {0.f, 0.f, 0.f, 0.f};
            acc = MFMA16T(qa[rg][0], k0, acc); acc = MFMA16T(qa[rg][1], k1, acc);
            s[rg][jt] = acc; }
        if ((jt & 3) == 3) __builtin_amdgcn_sched_barrier(0); }
    u32x2 graw[2][4];
#pragma unroll
    for (int rg = 0; rg < 2; ++rg) { const size_t row = crow0 + 32 * (w & 1) + 16 * rg + (lane & 15);
#pragma unroll
        for (int dt = 0; dt < 4; ++dt) graw[rg][dt] = *(const u32x2*)(PROJ + row * NPROJ + C_GA + hq * 64 + 16 * dt + 4 * g4); }
    if (ninv > 0) {
#pragma unroll
        for (int jt = 0; jt < 8; ++jt) if ((jt >> 2) < ninv) { s[0][jt] = (f32x4){-1e30f, -1e30f, -1e30f, -1e30f}; s[1][jt] = (f32x4){-1e30f, -1e30f, -1e30f, -1e30f}; } }
    float inv[2]; bf16x8 pa[2][6];
#pragma unroll
    for (int rg = 0; rg < 2; ++rg) {
        float m = sink;
#pragma unroll
        for (int jt = 0; jt < 12; ++jt)
#pragma unroll
            for (int r = 0; r < 4; ++r) m = fmaxf(m, s[rg][jt][r]);
        m = xor32_max(xor16_max(m));
        float sum = 0.f;
#pragma unroll
        for (int jt = 0; jt < 12; ++jt)
#pragma unroll
            for (int r = 0; r < 4; ++r) { const float e = __builtin_amdgcn_exp2f(s[rg][jt][r] - m); s[rg][jt][r] = e; sum += e; }
        sum = xor32_sum(xor16_sum(sum));
        inv[rg] = __builtin_amdgcn_rcpf(sum + __builtin_amdgcn_exp2f(sink - m));
#pragma unroll
        for (int k2 = 0; k2 < 6; ++k2) { u32x4 t; t.x = pk2(s[rg][2 * k2][0], s[rg][2 * k2][1]); t.y = pk2(s[rg][2 * k2][2], s[rg][2 * k2][3]);
            t.z = pk2(s[rg][2 * k2 + 1][0], s[rg][2 * k2 + 1][1]); t.w = pk2(s[rg][2 * k2 + 1][2], s[rg][2 * k2 + 1][3]);
            pa[rg][k2] = __builtin_bit_cast(bf16x8, t); } }
    __builtin_amdgcn_sched_barrier(0);
    if (kpos >= 0 && F.tid < 256) wa_kpre_load(F, kpos, KP);
#pragma unroll
    for (int dt = 0; dt < 4; ++dt) { f32x4 o[2] = {{0.f, 0.f, 0.f, 0.f}, {0.f, 0.f, 0.f, 0.f}};
#pragma unroll
        for (int k2 = 0; k2 < 6; ++k2) { const int j = k2 >> 1; const LAS unsigned char* vt = lds + (j == 0 ? sl0 : (j == 1 ? sl1 : sl2)) * WR_SLOT + WR_V;
            const bf16x8 vf = lds_frag_tr2(vt, LDVW, 32 * (k2 & 1), 16 * dt, lane);
            o[0] = MFMA16T(pa[0][k2], vf, o[0]); o[1] = MFMA16T(pa[1][k2], vf, o[1]); }
#pragma unroll
        for (int rg = 0; rg < 2; ++rg) { const size_t row = crow0 + 32 * (w & 1) + 16 * rg + (lane & 15);
            const float gv[4] = {__uint_as_float(graw[rg][dt].x << 16), __uint_as_float(graw[rg][dt].x & 0xffff0000u), __uint_as_float(graw[rg][dt].y << 16), __uint_as_float(graw[rg][dt].y & 0xffff0000u)};
            u32x2 pk; pk.x = pk2(o[rg][0] * inv[rg] * siluf(gv[0]), o[rg][1] * inv[rg] * siluf(gv[1])); pk.y = pk2(o[rg][2] * inv[rg] * siluf(gv[2]), o[rg][3] * inv[rg] * siluf(gv[3]));
            *(u32x2*)(MIX + row * 2048 + 1024 + hq * 64 + 16 * dt + 4 * g4) = pk; }
        __builtin_amdgcn_sched_barrier(0); }
}
DI void winattn_item(Ctx& F, int item) {
    LAS unsigned char* lds = F.lds;
    int tl_ = F.tid; asm volatile("" : "+v"(tl_)); const int tid = tl_;
    const bf16_t* PROJ = (const bf16_t*)(F.ws + WS_PROJ);
    if (item >= 256) {
        const int sb = (item - 256) >> 1, kvh = item & 1; const size_t row0 = (size_t)MP + sb * 64;
        const float* ck = F.in[I_CWK] + (size_t)sb * 128 * 128; const float* cv = F.in[I_CWV] + (size_t)sb * 128 * 128;
        float* ko = F.out + O_WKS + (size_t)sb * 128 * 128; float* vo = F.out + O_WVS + (size_t)sb * 128 * 128;
        wa_stage_cache(F, lds + 0 * WR_SLOT, kvh, ck, cv, nullptr, nullptr);
        wa_stage_cache(F, lds + 1 * WR_SLOT, kvh, ck + 64 * 128, cv + 64 * 128, ko, vo);
        if (tid < 256) { const int i = tid >> 2, q4 = tid & 3; const bf16_t* p = PROJ + (row0 + i) * NPROJ + C_K + kvh * 64 + 8 * q4;
            wa_write_k(F, lds + 2 * WR_SLOT, kvh, *(const u32x4*)p, *(const u32x4*)(p + 32), 2048 + i, ko + 64 * 128); }
        { const int i = tid >> 3, q8 = tid & 7; wa_write_v(F, lds + 2 * WR_SLOT, kvh, *(const u32x4*)(PROJ + (row0 + i) * NPROJ + C_V + kvh * 64 + 8 * q8), vo + 64 * 128); }
        u32x4 sq_[2][2]; wa_load_q(F, kvh, row0, sq_);
        __syncthreads();
        { KPre kp_; wa_compute(F, kvh, row0, 2048, 0, 1, 2, 0, sq_, kp_, -1, -1); }
        __syncthreads();
        return;
    }
    const int b = item >> 4, kvh = (item >> 3) & 1, c0 = (item & 7) * 8;
    const size_t seq0 = (size_t)b * T_P;
    { u32x4 pka[3], pkb[3], pvv[3];
#pragma unroll
      for (int j = 0; j < 3; ++j) { const int kc = c0 - 2 + j; const size_t row0 = seq0 + (size_t)(kc < 0 ? 0 : kc) * 64;
          const bf16_t* p = PROJ + (row0 + (tid >> 2)) * NPROJ + C_K + kvh * 64 + 8 * (tid & 3);
          pka[j] = *(const u32x4*)p; pkb[j] = *(const u32x4*)(p + 32);
          pvv[j] = *(const u32x4*)(PROJ + (row0 + (tid >> 3)) * NPROJ + C_V + kvh * 64 + 8 * (tid & 7)); }
#pragma unroll
      for (int j = 0; j < 3; ++j) { const int kc = c0 - 2 + j; LAS unsigned char* slot = lds + (kc & 3) * WR_SLOT;
          if (kc < 0) { for (int t = tid; t < WR_SLOT / 16; t += 512) *(LAS u32x4*)(slot + t * 16) = (u32x4){0u, 0u, 0u, 0u}; }
          else { if (tid < 256) wa_write_k(F, slot, kvh, pka[j], pkb[j], kc * 64 + (tid >> 2), nullptr);
                 wa_write_v(F, slot, kvh, pvv[j], nullptr); } } }
    u32x4 nq[2][2];
    wa_load_q(F, kvh, seq0 + (size_t)c0 * 64, nq);
    { int t_ = tid; asm volatile("" : "+v"(t_));
      if (t_ < 128) ((LAS float*)(lds + WR_GK))[t_] = (t_ < 64 ? F.in[I_GK] : F.in[I_GQ] - 64)[t_];
      if (t_ < 256) { const f32x4* rp = (const f32x4*)((const f32x2*)(F.ws + WS_ROPE) + (c0 * 64 + (t_ >> 2)) * 32 + 8 * (t_ & 3));
#pragma unroll
          for (int j = 0; j < 4; ++j) *(LAS f32x4*)(lds + WR_ROPE + (c0 & 1) * WR_ROPE_BUF + (t_ >> 2) * WR_ROPE_LD + (t_ & 3) * 64 + 16 * j) = rp[j]; } }
    __syncthreads();
#pragma unroll 1
    for (int c = c0; c < c0 + 8; ++c) {
        const bool more = c + 1 < c0 + 8;
        u32x4 cq[2][2]; KPre kp;
#pragma unroll
        for (int rg = 0; rg < 2; ++rg) { cq[rg][0] = nq[rg][0]; cq[rg][1] = nq[rg][1]; }
        u32x4 ra = {0u, 0u, 0u, 0u}, rb = {0u, 0u, 0u, 0u}, rv = {0u, 0u, 0u, 0u};
        const size_t nrow0 = seq0 + (size_t)(c + 1) * 64;
        if (more) {
            if (tid < 256) { const bf16_t* p = PROJ + (nrow0 + (tid >> 2)) * NPROJ + C_K + kvh * 64 + 8 * (tid & 3); ra = *(const u32x4*)p; rb = *(const u32x4*)(p + 32); }
            rv = *(const u32x4*)(PROJ + (nrow0 + (tid >> 3)) * NPROJ + C_V + kvh * 64 + 8 * (tid & 7));
            wa_load_q(F, kvh, nrow0, nq); }
        wa_compute(F, kvh, seq0 + (size_t)c * 64, c * 64, (c - 2) & 3, (c - 1) & 3, c & 3, c >= 2 ? 0 : 2 - c, cq, kp, more ? (c + 1) * 64 + (tid >> 2) : -1, c & 1);
        if (more) { LAS unsigned char* slot = lds + ((c + 1) & 3) * WR_SLOT; const int kc = c + 1;
            float* ko = nullptr; float* vo = nullptr;
            if (kc >= 62) { ko = F.out + O_WKP + ((size_t)b * 128 + (kc - 62) * 64) * 128; vo = F.out + O_WVP + ((size_t)b * 128 + (kc - 62) * 64) * 128; }
            if (tid < 256) wa_write_k_pre(F, slot, kvh, ra, rb, kp, ko, lds + WR_ROPE + (kc & 1) * WR_ROPE_BUF);
            wa_write_v(F, slot, kvh, rv, vo); }
        __syncthreads();
    }
}

constexpr int MA_K = 0, MA_V = 69632, MA_RS = 143360, LDKM = 272, LDVM = 288;
DI void memattn_item(Ctx& F, int item) {
    LAS unsigned char* lds = F.lds;
#if CLKPROBE == 40 || CLKPROBE == 41
    const long long mt0_ = (long long)__builtin_amdgcn_s_memrealtime(); long long mt1_ = 0;
#endif
    int tl_ = F.tid; asm volatile("" : "+v"(tl_)); const int tid = tl_, lane = tl_ & 63, w = F.wave, g4 = lane >> 4;
    const bool smp = item >= 256; const int sidx = item - 256;
    const int bb = smp ? (sidx >> 2) : (item >> 4), h = smp ? (sidx & 3) : ((item >> 2) & 3), qt = item & 3;
    const bf16_t* PROJ = (const bf16_t*)(F.ws + WS_PROJ); bf16_t* MIX = (bf16_t*)(F.ws + WS_MIX); const bf16_t* RAW = (const bf16_t*)(F.ws + WS_MEMRAW);
    float gmk8[8], gmq8[8];
    { const f32x4 a0 = *(const f32x4*)(F.in[I_GMK] + 8 * (tid & 15)), a1 = *(const f32x4*)(F.in[I_GMK] + 8 * (tid & 15) + 4), q0 = *(const f32x4*)(F.in[I_GMQ] + 8 * (tid & 15)), q1 = *(const f32x4*)(F.in[I_GMQ] + 8 * (tid & 15) + 4);
#pragma unroll
      for (int e = 0; e < 4; ++e) { gmk8[e] = a0[e]; gmk8[4 + e] = a1[e]; gmq8[e] = q0[e]; gmq8[4 + e] = q1[e]; } }
    u32x4 rk2[2][4], rv2[2][4];
    if (!smp) {
#pragma unroll
      for (int ib = 0; ib < 2; ++ib)
#pragma unroll
        for (int u = 0; u < 4; ++u) { const int t = tid + 512 * (4 * ib + u), key = t >> 4, ch = t & 15;
          rk2[ib][u] = *(const u32x4*)(RAW + (size_t)(bb * 256 + key) * 1024 + h * 128 + 8 * ch); rv2[ib][u] = *(const u32x4*)(RAW + (size_t)(bb * 256 + key) * 1024 + 512 + h * 128 + 8 * ch); } }
#pragma unroll
    for (int ib = 0; ib < 2; ++ib) {
      f32x4 fk[4][2], fv[4][2];
      if (smp) {
#pragma unroll
        for (int u = 0; u < 4; ++u) { const int t = tid + 512 * (4 * ib + u), key = t >> 4, ch = t & 15;
          const float* ks = F.in[I_CMK] + ((size_t)(bb * 256 + key) * 4 + h) * 128 + 8 * ch; const float* vs = F.in[I_CMV] + ((size_t)(bb * 256 + key) * 4 + h) * 128 + 8 * ch;
          fk[u][0] = *(const f32x4*)ks; fk[u][1] = *(const f32x4*)(ks + 4); fv[u][0] = *(const f32x4*)vs; fv[u][1] = *(const f32x4*)(vs + 4); } }
#pragma unroll
      for (int u = 0; u < 4; ++u) { const int t = tid + 512 * (4 * ib + u), key = t >> 4, ch = t & 15;
        float k[8], v[8];
        if (smp) {
#pragma unroll
            for (int e = 0; e < 4; ++e) { k[e] = fk[u][0][e]; k[4 + e] = fk[u][1][e]; v[e] = fv[u][0][e]; v[4 + e] = fv[u][1][e]; } }
        else { unpack8(rk2[ib][u], k); unpack8(rv2[ib][u], v); }
        float s = 0.f;
#pragma unroll
        for (int e = 0; e < 8; ++e) s += k[e] * k[e];
        s = row16_sum(s);
        if (!smp) { const float rstd = __builtin_amdgcn_rsqf(s * (1.0f / 128.0f) + EPSF);
#pragma unroll
            for (int e = 0; e < 8; ++e) k[e] = k[e] * rstd * gmk8[e]; }
        { float kq[8];
#pragma unroll
          for (int e = 0; e < 8; ++e) kq[e] = k[e] * gmq8[e];
          *(LAS u32x4*)(lds + MA_K + key * LDKM + ch * 16) = pack8(kq); }
        *(LAS u32x4*)(lds + MA_V + key * LDVM + ch * 16) = smp ? pack8(v) : rv2[ib][u];
        if (!smp && qt == 0) {
            float* ko = F.out + O_MKP + ((size_t)(bb * 256 + key) * 4 + h) * 128 + 8 * ch; float* vo = F.out + O_MVP + ((size_t)(bb * 256 + key) * 4 + h) * 128 + 8 * ch;
            *(f32x4*)ko = (f32x4){k[0], k[1], k[2], k[3]}; *(f32x4*)(ko + 4) = (f32x4){k[4], k[5], k[6], k[7]};
            *(f32x4*)vo = (f32x4){v[0], v[1], v[2], v[3]}; *(f32x4*)(vo + 4) = (f32x4){v[4], v[5], v[6], v[7]}; }
      }
    }
    __syncthreads();
#if CLKPROBE == 40 || CLKPROBE == 41
    mt1_ = (long long)__builtin_amdgcn_s_memrealtime();
#endif
    const int ngr = smp ? 4 : 64;
    const size_t qbase = smp ? (size_t)MP + bb * 64 : (size_t)bb * T_P + qt * 1024;
    u32x4 nq[4]; u32x2 ng[8];
#define MA_LOAD(rg_) do { const size_t r_ = qbase + 16 * (rg_) + (lane & 15); \
        _Pragma("unroll") for (int ks = 0; ks < 4; ++ks) nq[ks] = *(const u32x4*)(PROJ + r_ * NPROJ + C_MQ + h * 128 + 32 * ks + 8 * g4); \
        _Pragma("unroll") for (int dt = 0; dt < 8; ++dt) ng[dt] = *(const u32x2*)(PROJ + r_ * NPROJ + C_GM + h * 128 + 16 * dt + 4 * g4); } while (0)
    if (w < ngr) MA_LOAD(w);
#pragma unroll 1
    for (int rg = w; rg < ngr; rg += 8) {
        u32x4 cq[4]; u32x2 cg[8];
#pragma unroll
        for (int ks = 0; ks < 4; ++ks) cq[ks] = nq[ks];
#pragma unroll
        for (int dt = 0; dt < 8; ++dt) cg[dt] = ng[dt];
        if (rg + 8 < ngr) MA_LOAD(rg + 8);
        bf16x8 qa[4];
        { float q[4][8]; float s = 0.f;
#pragma unroll
          for (int ks = 0; ks < 4; ++ks) { unpack8(cq[ks], q[ks]);
#pragma unroll
              for (int e = 0; e < 8; ++e) s += q[ks][e] * q[ks][e]; }
          s = xor32_sum(xor16_sum(s));
          const float rstd = 0.12751743082459868f * __builtin_amdgcn_rsqf(s * (1.0f / 128.0f) + EPSF);
#pragma unroll
          for (int ks = 0; ks < 4; ++ks) {
#pragma unroll
              for (int e = 0; e < 8; ++e) q[ks][e] = q[ks][e] * rstd;
              qa[ks] = __builtin_bit_cast(bf16x8, pack8(q[ks])); } }
        f32x4 s[16];
#pragma unroll
        for (int jt = 0; jt < 16; ++jt) { f32x4 acc = {0.f, 0.f, 0.f, 0.f};
#pragma unroll
            for (int ks = 0; ks < 4; ++ks) acc = MFMA16T(qa[ks], lds_frag(lds + MA_K, LDKM, 16 * jt, 32 * ks, lane), acc);
            s[jt] = acc;
            if ((jt & 3) == 3) __builtin_amdgcn_sched_barrier(0); }
        float m = s[0][0];
#pragma unroll
        for (int jt = 0; jt < 16; ++jt)
#pragma unroll
            for (int r = 0; r < 4; ++r) m = fmaxf(m, s[jt][r]);
        m = xor32_max(xor16_max(m));
        float sum = 0.f;
#pragma unroll
        for (int jt = 0; jt < 16; ++jt)
#pragma unroll
            for (int r = 0; r < 4; ++r) { const float e = __builtin_amdgcn_exp2f(s[jt][r] - m); s[jt][r] = e; sum += e; }
        sum = xor32_sum(xor16_sum(sum));
        const float inv = __builtin_amdgcn_rcpf(sum);
        bf16x8 pa[8];
#pragma unroll
        for (int k2 = 0; k2 < 8; ++k2) { u32x4 t; t.x = pk2(s[2 * k2][0], s[2 * k2][1]); t.y = pk2(s[2 * k2][2], s[2 * k2][3]); t.z = pk2(s[2 * k2 + 1][0], s[2 * k2 + 1][1]); t.w = pk2(s[2 * k2 + 1][2], s[2 * k2 + 1][3]);
            pa[k2] = __builtin_bit_cast(bf16x8, t); }
        const size_t orow = qbase + 16 * rg + (lane & 15);
#pragma unroll
        for (int dt = 0; dt < 8; ++dt) { f32x4 o = {0.f, 0.f, 0.f, 0.f};
#pragma unroll
            for (int k2 = 0; k2 < 8; ++k2) o = MFMA16T(pa[k2], lds_frag_tr2(lds + MA_V, LDVM, 32 * k2, 16 * dt, lane), o);
            __builtin_amdgcn_sched_barrier(0);
            const int col = h * 128 + 16 * dt + 4 * g4;
            const u32x2 gr = cg[dt];
            const float gv[4] = {__uint_as_float(gr.x << 16), __uint_as_float(gr.x & 0xffff0000u), __uint_as_float(gr.y << 16), __uint_as_float(gr.y & 0xffff0000u)};
            u32x2 pk; pk.x = pk2(o[0] * inv * siluf(gv[0]), o[1] * inv * siluf(gv[1])); pk.y = pk2(o[2] * inv * siluf(gv[2]), o[3] * inv * siluf(gv[3]));
            *(u32x2*)(MIX + orow * 2048 + 1536 + col) = pk; }
    }
#undef MA_LOAD
    __syncthreads();
#if CLKPROBE == 40 || CLKPROBE == 41
    if (threadIdx.x == 0 && item < 256) g_dbg[blockIdx.x] += (CLKPROBE == 40) ? (mt1_ - mt0_) : ((long long)__builtin_amdgcn_s_memrealtime() - mt1_);
#endif
}

DI void p2a_attn(Ctx& F) {
    for (int rep = 0; rep < REP_WIN; ++rep)
    for (int it = F.bid; it < 320; it += F.G) {
#if CLKPROBE == 42 || CLKPROBE == 43
        const long long t0_ = (long long)__builtin_amdgcn_s_memrealtime();
#endif
        winattn_item(F, it);
#if CLKPROBE == 42 || CLKPROBE == 43
        if (threadIdx.x == 0 && ((CLKPROBE == 42) == (it < 256))) g_dbg[blockIdx.x] += (long long)__builtin_amdgcn_s_memrealtime() - t0_;
#endif
    }
    __syncthreads();
    for (int rep = 0; rep < REP_MEM; ++rep)
    { for (int it = F.bid; it < 256; it += F.G) memattn_item(F, it);
      for (int s = (F.bid + F.G - (128 % F.G)) % F.G; s < 128; s += F.G) memattn_item(F, 256 + s); }
}
DI void p2b_phase(Ctx& F) {
    for (int rep = 0; rep < REP_SSD; ++rep)
    for (int it = F.bid; it < 48 * 16; it += F.G) {
#if CLKPROBE == 30 || CLKPROBE == 31
        const long long t0_ = (long long)__builtin_amdgcn_s_memrealtime();
#endif
        ssd_item(F, it >> 4, it & 15, rep == 0);
#if CLKPROBE == 30 || CLKPROBE == 31
        if (threadIdx.x == 0 && ((CLKPROBE == 30) == (it < 256))) g_dbg[blockIdx.x] += (long long)__builtin_amdgcn_s_memrealtime() - t0_;
#endif
    }
}

constexpr int G3_LD = 272, G3_A = 0, G3_B = 64 * 272, G3_SET = 192 * 272;
DI void gemm2_sample(Ctx& F) {
    LAS unsigned char* lds = F.lds;
    const int tid = F.tid, lane = F.lane, w = F.wave, g4 = lane >> 4;
    const bf16_t* MIX = (const bf16_t*)(F.ws + WS_MIX); const bf16_t* WOT = (const bf16_t*)(F.ws + WS_WOUT); const float* SUMSQ = (const float*)(F.ws + WS_SSQ);
    for (int tile = F.bid; tile < 256; tile += F.G) {
        const int r0 = MP + 64 * (tile >> 3), c0 = 128 * (tile & 7);
        const int prow = tid >> 4, pk = tid & 15;
        const bf16_t* asrc = MIX + (size_t)(r0 + prow) * 2048 + 8 * pk;
        const bf16_t* bsrc = WOT + (size_t)(c0 + prow) * 2048 + 8 * pk;
        const int aoff = G3_A + prow * G3_LD + pk * 16, boff = G3_B + prow * G3_LD + pk * 16;
        f32x4 acc[4] = {{0.f, 0.f, 0.f, 0.f}, {0.f, 0.f, 0.f, 0.f}, {0.f, 0.f, 0.f, 0.f}, {0.f, 0.f, 0.f, 0.f}};
        u32x4 ra[4][2], rb[4][4];
#define G3_ISSUE(s_, kt_) do { _Pragma("unroll") for (int i_ = 0; i_ < 2; ++i_) ra[s_][i_] = *(const u32x4*)(asrc + (size_t)i_ * 32 * 2048 + 128 * (kt_)); \
            _Pragma("unroll") for (int j_ = 0; j_ < 4; ++j_) rb[s_][j_] = *(const u32x4*)(bsrc + (size_t)j_ * 32 * 2048 + 128 * (kt_)); } while (0)
#define G3_WRITE(set_, s_) do { _Pragma("unroll") for (int i_ = 0; i_ < 2; ++i_) *(LAS u32x4*)((set_) + aoff + i_ * 32 * G3_LD) = ra[s_][i_]; \
            _Pragma("unroll") for (int j_ = 0; j_ < 4; ++j_) *(LAS u32x4*)((set_) + boff + j_ * 32 * G3_LD) = rb[s_][j_]; } while (0)
        G3_ISSUE(0, 0); G3_ISSUE(1, 1); G3_ISSUE(2, 2); G3_ISSUE(3, 3);
        G3_WRITE(lds, 0);
        G3_ISSUE(0, 4);
        __syncthreads();
#pragma unroll 1
        for (int kt4 = 0; kt4 < 16; kt4 += 4) {
#pragma unroll
            for (int u = 0; u < 4; ++u) { const int kt = kt4 + u;
                const LAS unsigned char* cs = lds + (u & 1) * G3_SET; LAS unsigned char* ns = lds + ((u + 1) & 1) * G3_SET;
                if (kt == 8) { const float r = __builtin_amdgcn_rsqf(SUMSQ[r0 + 16 * (w >> 1) + (lane & 15)] * (1.0f / 1024.0f) + EPSF);
#pragma unroll
                    for (int t = 0; t < 4; ++t) acc[t] = acc[t] * r; }
#pragma unroll
                for (int ks = 0; ks < 4; ++ks) { const bf16x8 a = lds_frag(cs + G3_A, G3_LD, 16 * (w >> 1), 32 * ks, lane);
#pragma unroll
                    for (int t = 0; t < 4; ++t) acc[t] = MFMA16T(a, lds_frag(cs + G3_B, G3_LD, 64 * (w & 1) + 16 * t, 32 * ks, lane), acc[t]); }
                const int rs = (u + 1) & 3;
                if (kt + 1 < 16) G3_WRITE(ns, rs);
                if (kt + 5 < 16) G3_ISSUE(rs, kt + 5);
                __syncthreads();
            }
        }
#undef G3_ISSUE
#undef G3_WRITE
        const int row = r0 + 16 * (w >> 1) + (lane & 15), cw = c0 + 64 * (w & 1) + 4 * g4;
        const float* xr = F.in[I_XS] + (size_t)(row - MP) * DM + cw; float* orow = F.out + (size_t)row * DM + cw;
#pragma unroll
        for (int t = 0; t < 4; ++t) *(f32x4*)(orow + 16 * t) = acc[t] + *(const f32x4*)(xr + 16 * t);
    }
}
__global__ void __launch_bounds__(512, 2) hymba_fwd(Args args) {
    extern __shared__ __attribute__((aligned(16))) unsigned char lds_raw[];
    cg::grid_group grid = cg::this_grid();
    Ctx F;
    F.lds = (LAS unsigned char*)lds_raw; F.tid = threadIdx.x; F.lane = F.tid & 63; F.wave = __builtin_amdgcn_readfirstlane(F.tid >> 6); F.G = gridDim.x; F.bid = blockIdx.x;
#pragma unroll
    for (int i = 0; i < 26; ++i) F.in[i] = args.in[i];
    F.out = args.out; F.ws = args.ws;
    float dbgval = 0.f; (void)dbgval;
#if CLKPROBE >= 20
    if (threadIdx.x == 0) g_dbg[blockIdx.x] = 0;
#endif
#if CLKPROBE
    long long phc0_ = 0, phr0_ = 0;
#define PH_BEGIN(k) do { if (CLKPROBE == (k)) { phc0_ = (long long)__builtin_amdgcn_s_memtime(); phr0_ = (long long)__builtin_amdgcn_s_memrealtime(); } } while (0)
#define PH_END(k) do { if (CLKPROBE == (k)) { const long long c1_ = (long long)__builtin_amdgcn_s_memtime(), r1_ = (long long)__builtin_amdgcn_s_memrealtime(); \
        const long long v_ = CLKWHAT == 0 ? ((c1_ - phc0_) * 100) / (r1_ - phr0_) : (r1_ - phr0_) / 100; \
        if (threadIdx.x == 0) ((float*)(F.ws + WS_CTL + 32768))[F.bid] = (float)v_; \
        if (F.bid == 0 && threadIdx.x == 0) dbgval = (float)(((v_ + TIMEQ / 2 + TIMEOFF) / TIMEQ) * TIMEQ); } } while (0)
#else
#define PH_BEGIN(k) do { } while (0)
#define PH_END(k) do { } while (0)
#endif
    volatile LAS unsigned* bst = (volatile LAS unsigned*)(F.lds + LDS_BYTES - 64);
    if (F.tid < 16) bst[F.tid] = 0u;
    __syncthreads();
    const XcdBarrier xbar = xcd_barrier_post((unsigned*)(F.ws + WS_CTL), bst);
#define GRID_BAR() xcd_barrier(xbar)

#define PHASE_FENCE() do { int t_ = threadIdx.x; asm volatile("" : "+v"(t_)); F.tid = t_; F.lane = t_ & 63; F.wave = __builtin_amdgcn_readfirstlane(t_ >> 6); } while (0)
    PH_BEGIN(10); for (int rep = 0; rep < REP_P0; ++rep) { if (rep) __syncthreads(); p0_prologue(F); } PH_END(10);
    grid.sync(); PHASE_FENCE();
    PH_BEGIN(1);
    {
        pg8::Gemm g{(const bf16_t*)(F.ws + WS_A), (const bf16_t*)(F.ws + WS_BT), MA, NBT, 1024};
        Order1 S; S.init(F.G, F.bid);
        EpiProj E{(bf16_t*)(F.ws + WS_PROJ), (bf16_t*)(F.ws + WS_MEMRAW)};
        pg8::gemm_phase<EpiProj, Order1, true, true>(F.lds, g, S, E);
    }
    PH_END(1);
    GRID_BAR(); PHASE_FENCE();
    PH_BEGIN(2); for (int rep = 0; rep < REP_P2A; ++rep) p2a_phase(F);
    __syncthreads();
    p2a_attn(F); PH_END(2);
    GRID_BAR(); PHASE_FENCE();
    PH_BEGIN(3); p2b_phase(F); PH_END(3);
    GRID_BAR(); PHASE_FENCE();
    PH_BEGIN(4);
    if ((F.bid & 1) == 0) { PH_BEGIN(5); gemm2_sample(F); PH_END(5); }
    {
        pg8::Gemm g{(const bf16_t*)(F.ws + WS_MIX), (const bf16_t*)(F.ws + WS_WOUT), MTOT, 1024, 2048};
        Order3 S; S.init(F.G, F.bid);
        EpiOut E{F.in[I_XP], F.in[I_XS], F.out, (const float*)(F.ws + WS_SSQ)};
        pg8::gemm_phase<EpiOut, Order3, true, true>(F.lds, g, S, E);
    }
    if ((F.bid & 1) != 0) gemm2_sample(F);
    PH_END(4);
#if CLKPROBE
    grid.sync();
#if CLKPROBE >= 20
    if (threadIdx.x == 0) ((float*)(F.ws + WS_CTL + 32768))[F.bid] = (float)(g_dbg[F.bid] / 100);
    __threadfence(); grid.sync();
#endif
    if (F.bid == 0 && threadIdx.x == 0) {
        if (CLKAGG != 0) { const float* pv = (const float*)(F.ws + WS_CTL + 32768); float mx = pv[0], mn = pv[0], sm = 0.f;
            for (int i = 0; i < (int)gridDim.x; ++i) { mx = fmaxf(mx, pv[i]); mn = fminf(mn, pv[i]); sm += pv[i]; }
            const long long v_ = (long long)(CLKAGG == 1 ? mx : (CLKAGG == 2 ? mn : (CLKAGG == 4 ? pv[CLKBID] : sm / gridDim.x)));
            dbgval = (float)(((v_ + TIMEQ / 2 + TIMEOFF) / TIMEQ) * TIMEQ); }
        F.out[O_CONVS] = dbgval; }
#endif
#if DBG_SCALE3 || DBG_ZERO
    grid.sync();
    {
        const size_t offs[13] = {O_Y, (size_t)MP * 1024, O_WKP, O_WVP, O_SSMP, O_CONVP, O_MKP, O_MVP, O_WKS, O_WVS, O_SSMS, O_CONVS, O_END};
        for (int o = 0; o < 12; ++o) {
            const bool z = (DBG_ZERO >> o) & 1, s3 = (DBG_SCALE3 >> o) & 1;
            if (!z && !s3) continue;
            for (size_t i = offs[o] + (size_t)F.bid * 512 + F.tid; i < offs[o + 1]; i += (size_t)F.G * 512) F.out[i] = z ? 0.f : F.out[i] * 3.0f;
        }
    }
#endif
}

extern "C" void kernel_launch(void* const* d_in, const int* in_sizes, int n_in, void* d_out, int out_size, void* d_ws, size_t ws_size, hipStream_t stream) {
    static int grid = 0;
    if (grid == 0) {
        if (n_in != 26 || (size_t)out_size != O_END || ws_size < WS_END) { fprintf(stderr, "kernel_launch: unexpected problem (n_in %d out %d ws %zu)\n", n_in, out_size, ws_size); grid = -1; return; }
        int dev = 0, cus = 0, per_cu = 0;
        if (hipGetDevice(&dev) != hipSuccess || hipDeviceGetAttribute(&cus, hipDeviceAttributeMultiprocessorCount, dev) != hipSuccess) { grid = -1; return; }
        if (hipFuncSetAttribute((const void*)hymba_fwd, hipFuncAttributeMaxDynamicSharedMemorySize, LDS_BYTES) != hipSuccess) { fprintf(stderr, "kernel_launch: hipFuncSetAttribute failed\n"); grid = -1; return; }
        if (hipOccupancyMaxActiveBlocksPerMultiprocessor(&per_cu, (const void*)hymba_fwd, 512, LDS_BYTES) != hipSuccess || per_cu < 1) { fprintf(stderr, "kernel_launch: occupancy query says %d\n", per_cu); (void)hipGetLastError(); grid = -1; return; }
        grid = cus;
        fprintf(stderr, "kernel_launch: %d CUs, occupancy %d per CU, grid %d\n", cus, per_cu, grid);
    }
    if (grid < 0) return;
    Args a{};
    for (int i = 0; i < 26; ++i) a.in[i] = (const float*)d_in[i];
    a.out = (float*)d_out; a.ws = (unsigned char*)d_ws;
    if (hipMemsetAsync((char*)d_ws + WS_CTL, 0, CTL_ZERO_BYTES, stream) != hipSuccess) { fprintf(stderr, "kernel_launch: memset of the barrier words failed\n"); return; }
    void* kargs[] = {&a};
    const hipError_t e = hipLaunchCooperativeKernel((const void*)hymba_fwd, dim3(grid), dim3(512), kargs, LDS_BYTES, stream);
    if (e != hipSuccess) fprintf(stderr, "kernel_launch: cooperative launch failed: %s\n", hipGetErrorString(e));
}
```
